# Optimizing an MI355X kernel written in HIP

```python
import math
import jax, jax.numpy as jnp
from jax import lax
import numpy as np

D_MODEL = 2048
BATCH = 2
SEQ = 8192
DEPTH = 1

HEAD_DIM = 64
N_META = 16
GRID_W = 64
A_HEADS = 16
A_KV_HEADS = 4
A_WINDOW = 128
A_BLOCK = 128
N_BUCKETS = 32
MAX_DISTANCE = 128
B_HEADS = 16
NA_ROWS = 8
NA_COLS = 16
NA_COL_BLOCK = 16
NA_COL_BAND = 32
A_WIDTH = A_HEADS * HEAD_DIM
KV_WIDTH = A_KV_HEADS * HEAD_DIM
B_WIDTH = B_HEADS * HEAD_DIM
MIX_WIDTH = A_WIDTH + B_WIDTH
IN_WIDTH = A_WIDTH + 2 * KV_WIDTH + 3 * B_WIDTH
N_EXPERTS = 64
TOP_K = 8
N_GROUPS = 8
TOPK_GROUPS = 4
D_EXPERT = 512
D_SHARED = 512
ROUTED_SCALE = 2.5
MOE_BLOCK = 128
DEEPNORM_ALPHA = (2 * DEPTH) ** 0.25
DEEPNORM_BETA = (8 * DEPTH) ** -0.25
LN_EPS = 1e-5
RMS_EPS = 1e-6
NEG = -1e30

kernel_name = "hybrid_window_gqa_natten_moe_encoder"


def layer_norm(x, g, b):
    xf = x.astype(jnp.float32)
    mu = jnp.mean(xf, axis=-1, keepdims=True)
    xc = xf - mu
    var = jnp.mean(xc * xc, axis=-1, keepdims=True)
    y = xc * lax.rsqrt(var + LN_EPS) * g.astype(jnp.float32) + b.astype(jnp.float32)
    return y.astype(x.dtype)


def rms_norm(x, g):
    xf = x.astype(jnp.float32)
    y = xf * lax.rsqrt(jnp.mean(xf * xf, axis=-1, keepdims=True) + RMS_EPS) * g.astype(jnp.float32)
    return y.astype(x.dtype)


def t5_bucket(rel):
    nb = N_BUCKETS // 2
    max_exact = nb // 2
    ret = jnp.where(rel > 0, nb, 0)
    n = jnp.abs(rel)
    nf = jnp.maximum(n, 1).astype(jnp.float32)
    large = max_exact + (jnp.log(nf / max_exact) / math.log(MAX_DISTANCE / max_exact)
                         * (nb - max_exact)).astype(jnp.int32)
    large = jnp.minimum(large, nb - 1)
    return ret + jnp.where(n < max_exact, n, large)


def window_gqa(q, k, v, sink, t5_table):
    bsz, L = q.shape[0], q.shape[1]
    S = L - N_META
    nblk = S // A_BLOCK
    G = A_HEADS // A_KV_HEADS
    scale = HEAD_DIM ** -0.5
    qm, qr = q[:, :N_META], q[:, N_META:]
    km, kr = k[:, :N_META], k[:, N_META:]
    vm, vr = v[:, :N_META], v[:, N_META:]
    sink_f = sink.astype(jnp.float32).reshape(A_KV_HEADS, G)

    qb = qr.reshape(bsz, nblk, A_BLOCK, A_KV_HEADS, G, HEAD_DIM)
    pad = ((0, 0), (A_BLOCK, A_BLOCK), (0, 0), (0, 0))

    def band(t):
        t = jnp.pad(t, pad).reshape(bsz, nblk + 2, A_BLOCK, A_KV_HEADS, HEAD_DIM)
        return jnp.concatenate([t[:, :-2], t[:, 1:-1], t[:, 2:]], axis=2)

    kb, vb = band(kr), band(vr)
    q_loc = jnp.arange(A_BLOCK, dtype=jnp.int32)
    k_loc = jnp.arange(3 * A_BLOCK, dtype=jnp.int32) - A_BLOCK
    rel = k_loc[None, :] - q_loc[:, None]
    blk0 = jnp.arange(nblk, dtype=jnp.int32)[:, None, None] * A_BLOCK
    gk = blk0 + k_loc[None, None, :]
    mask = (jnp.abs(rel)[None] <= A_WINDOW) & (gk >= 0) & (gk < S)
    bias_band = jnp.moveaxis(t5_table.astype(jnp.float32)[t5_bucket(rel)], -1, 0)
    bias_band = bias_band.reshape(A_KV_HEADS, G, A_BLOCK, 3 * A_BLOCK)
    s_band = jnp.einsum('bnqhgd,bnkhd->bnhgqk', qb, kb).astype(jnp.float32) * scale + bias_band
    s_band = jnp.where(mask[None, :, None, None], s_band, NEG)

    q_pos = N_META + blk0[:, :, 0:1] + q_loc[None, :, None]
    rel_m = jnp.arange(N_META, dtype=jnp.int32)[None, None, :] - q_pos
    bias_m = jnp.moveaxis(t5_table.astype(jnp.float32)[t5_bucket(rel_m)], -1, 1)
    bias_m = bias_m.reshape(nblk, A_KV_HEADS, G, A_BLOCK, N_META)
    s_meta = jnp.einsum('bnqhgd,bmhd->bnhgqm', qb, km).astype(jnp.float32) * scale + bias_m
    s_sink = jnp.broadcast_to(sink_f[None, None, :, :, None, None],
                              (bsz, nblk, A_KV_HEADS, G, A_BLOCK, 1))
    p = jax.nn.softmax(jnp.concatenate([s_meta, s_band, s_sink], axis=-1), axis=-1)
    p_m = p[..., :N_META].astype(v.dtype)
    p_b = p[..., N_META:N_META + 3 * A_BLOCK].astype(v.dtype)
    o_real = (jnp.einsum('bnhgqm,bmhd->bnqhgd', p_m, vm)
              + jnp.einsum('bnhgqk,bnkhd->bnqhgd', p_b, vb))
    o_real = o_real.reshape(bsz, S, A_HEADS, HEAD_DIM)

    qmg = qm.reshape(bsz, N_META, A_KV_HEADS, G, HEAD_DIM)
    kk = jnp.concatenate([km, kr[:, :A_BLOCK]], axis=1)
    vv = jnp.concatenate([vm, vr[:, :A_BLOCK]], axis=1)
    k_pos = jnp.concatenate([jnp.arange(N_META, dtype=jnp.int32),
                             N_META + jnp.arange(A_BLOCK, dtype=jnp.int32)])
    relq = k_pos[None, :] - jnp.arange(N_META, dtype=jnp.int32)[:, None]
    bias_q = jnp.moveaxis(t5_table.astype(jnp.float32)[t5_bucket(relq)], -1, 0)
    bias_q = bias_q.reshape(A_KV_HEADS, G, N_META, N_META + A_BLOCK)
    s_q = jnp.einsum('bqhgd,bkhd->bhgqk', qmg, kk).astype(jnp.float32) * scale + bias_q
    s_q = jnp.where(jnp.abs(relq) <= A_WINDOW, s_q, NEG)
    s_qs = jnp.broadcast_to(sink_f[None, :, :, None, None], (bsz, A_KV_HEADS, G, N_META, 1))
    pq = jax.nn.softmax(jnp.concatenate([s_q, s_qs], axis=-1), axis=-1)[..., :-1].astype(v.dtype)
    o_meta = jnp.einsum('bhgqk,bkhd->bqhgd', pq, vv).reshape(bsz, N_META, A_HEADS, HEAD_DIM)
    return jnp.concatenate([o_meta, o_real], axis=1)


def neighbourhood_attention(q, k, v, rpb):
    bsz, L = q.shape[0], q.shape[1]
    S = L - N_META
    rows = S // GRID_W
    kh = min(NA_ROWS, rows)
    n_cb = GRID_W // NA_COL_BLOCK
    scale = HEAD_DIM ** -0.5
    qm, km, vm = q[:, :N_META], k[:, :N_META], v[:, :N_META]
    qg = q[:, N_META:].reshape(bsz, rows, GRID_W, B_HEADS, HEAD_DIM)
    kg = k[:, N_META:].reshape(bsz, rows, GRID_W, B_HEADS, HEAD_DIM)
    vg = v[:, N_META:].reshape(bsz, rows, GRID_W, B_HEADS, HEAD_DIM)

    cb_start = np.clip(np.arange(n_cb) * NA_COL_BLOCK - NA_COLS // 2, 0, GRID_W - NA_COL_BAND)
    col_idx = cb_start[:, None] + np.arange(NA_COL_BAND)
    qc = np.arange(GRID_W).reshape(n_cb, NA_COL_BLOCK)
    cs = np.clip(qc - NA_COLS // 2, 0, GRID_W - NA_COLS)[..., None]
    kc = col_idx[:, None, :]
    col_mask = jnp.asarray((kc >= cs) & (kc < cs + NA_COLS))
    dc = np.clip(kc - qc[..., None] + NA_COLS - 1, 0, 2 * NA_COLS - 2)
    rpb_cols = rpb.astype(jnp.float32)[:, :, dc]

    def row_fn(r):
        rs = jnp.clip(r - kh // 2, 0, rows - kh)
        kband = lax.dynamic_slice_in_dim(kg, rs, kh, axis=1)[:, :, col_idx]
        vband = lax.dynamic_slice_in_dim(vg, rs, kh, axis=1)[:, :, col_idx]
        qrow = lax.dynamic_index_in_dim(qg, r, axis=1, keepdims=False)
        qrow = qrow.reshape(bsz, n_cb, NA_COL_BLOCK, B_HEADS, HEAD_DIM)
        s = jnp.einsum('bjqhd,bijkhd->bhjqik', qrow, kband).astype(jnp.float32) * scale
        dr = rs + jnp.arange(kh, dtype=jnp.int32) - r + NA_ROWS - 1
        s = s + jnp.transpose(rpb_cols[:, dr], (0, 2, 3, 1, 4))
        s = jnp.where(col_mask[:, :, None, :], s, NEG)
        s = s.reshape(bsz, B_HEADS, n_cb, NA_COL_BLOCK, kh * NA_COL_BAND)
        s_m = jnp.einsum('bjqhd,bmhd->bhjqm', qrow, km).astype(jnp.float32) * scale
        p = jax.nn.softmax(jnp.concatenate([s_m, s], axis=-1), axis=-1)
        p_m = p[..., :N_META].astype(v.dtype)
        p_w = p[..., N_META:].reshape(bsz, B_HEADS, n_cb, NA_COL_BLOCK, kh, NA_COL_BAND).astype(v.dtype)
        o = (jnp.einsum('bhjqm,bmhd->bjqhd', p_m, vm)
             + jnp.einsum('bhjqik,bijkhd->bjqhd', p_w, vband))
        return o.reshape(bsz, GRID_W, B_HEADS, HEAD_DIM)

    o_real = lax.map(row_fn, jnp.arange(rows, dtype=jnp.int32))
    o_real = jnp.transpose(o_real, (1, 0, 2, 3, 4)).reshape(bsz, S, B_HEADS, HEAD_DIM)
    s_mm = jnp.einsum('bqhd,bmhd->bhqm', qm, km).astype(jnp.float32) * scale
    p_mm = jax.nn.softmax(s_mm, axis=-1).astype(v.dtype)
    o_meta = jnp.einsum('bhqm,bmhd->bqhd', p_mm, vm)
    return jnp.concatenate([o_meta, o_real], axis=1)


def mixer(h, w_in, a_sink, na_rpb, g_norm_a, g_norm_b, w_out, t5_table):
    bsz, L, _ = h.shape
    u = h @ w_in
    cuts = np.cumsum([A_WIDTH, KV_WIDTH, KV_WIDTH, B_WIDTH, B_WIDTH]).tolist()
    qa, ka, va, qb, kb, vb = jnp.split(u, cuts, axis=-1)
    ya = window_gqa(qa.reshape(bsz, L, A_HEADS, HEAD_DIM),
                    ka.reshape(bsz, L, A_KV_HEADS, HEAD_DIM),
                    va.reshape(bsz, L, A_KV_HEADS, HEAD_DIM), a_sink, t5_table)
    yb = neighbourhood_attention(qb.reshape(bsz, L, B_HEADS, HEAD_DIM),
                                 kb.reshape(bsz, L, B_HEADS, HEAD_DIM),
                                 vb.reshape(bsz, L, B_HEADS, HEAD_DIM), na_rpb)
    ya = rms_norm(ya.reshape(bsz, L, A_WIDTH), g_norm_a)
    yb = rms_norm(yb.reshape(bsz, L, B_WIDTH), g_norm_b)
    return jnp.concatenate([ya, yb], axis=-1) @ w_out


def moe(h, w_router, router_bias, w_gate, w_up, w_down, ws_gate, ws_up, ws_down):
    bsz, L, D = h.shape
    x = h.reshape(-1, D)
    N = x.shape[0]
    scores = jax.nn.sigmoid((x @ w_router).astype(jnp.float32))
    biased = scores + router_bias.astype(jnp.float32)
    grp = biased.reshape(N, N_GROUPS, N_EXPERTS // N_GROUPS)
    grp_score = lax.top_k(grp, 2)[0].sum(-1)
    _, grp_idx = lax.top_k(grp_score, TOPK_GROUPS)
    grp_mask = jnp.any(grp_idx[..., None] == jnp.arange(N_GROUPS)[None, None, :], axis=1)
    expert_mask = jnp.repeat(grp_mask, N_EXPERTS // N_GROUPS, axis=1)
    _, top_idx = lax.top_k(jnp.where(expert_mask, biased, -jnp.inf), TOP_K)
    top_w = jnp.take_along_axis(scores, top_idx, axis=1)
    top_w = top_w / (top_w.sum(-1, keepdims=True) + 1e-20) * ROUTED_SCALE

    NK = N * TOP_K
    flat_e = top_idx.reshape(-1)
    flat_tok = jnp.repeat(jnp.arange(N, dtype=jnp.int32), TOP_K)
    flat_w = top_w.reshape(-1)
    order = jnp.argsort(flat_e)
    se, stok, sw = flat_e[order], flat_tok[order], flat_w[order]
    counts = jnp.bincount(flat_e, length=N_EXPERTS)
    starts = jnp.cumsum(counts) - counts
    padded = (counts + MOE_BLOCK - 1) // MOE_BLOCK * MOE_BLOCK
    pend = jnp.cumsum(padded)
    pstart = pend - padded
    dest = pstart[se] + jnp.arange(NK, dtype=jnp.int32) - starts[se]
    n_blocks = -(-NK // MOE_BLOCK) + N_EXPERTS
    P = n_blocks * MOE_BLOCK
    buf_tok = jnp.full((P,), N, jnp.int32).at[dest].set(stok)
    buf_w = jnp.zeros((P,), jnp.float32).at[dest].set(sw)
    block_e = jnp.minimum(jnp.searchsorted(pend, jnp.arange(n_blocks) * MOE_BLOCK, side='right'),
                          N_EXPERTS - 1)
    x_pad = jnp.concatenate([x, jnp.zeros((1, D), x.dtype)], axis=0)

    def expert_block(acc, inp):
        e, tok, w = inp
        xb = x_pad[tok]
        hb = jax.nn.silu(xb @ w_gate[e]) * (xb @ w_up[e])
        yb = (hb @ w_down[e]) * w[:, None].astype(x.dtype)
        return acc.at[tok].add(yb), None

    acc, _ = lax.scan(expert_block, jnp.zeros((N + 1, D), x.dtype),
                      (block_e, buf_tok.reshape(n_blocks, MOE_BLOCK), buf_w.reshape(n_blocks, MOE_BLOCK)))
    shared = (jax.nn.silu(x @ ws_gate) * (x @ ws_up)) @ ws_down
    return (acc[:N] + shared).reshape(bsz, L, D)


def setup_inputs(seed: int = 0) -> dict:
    key = jax.random.key(seed)
    ks = jax.random.split(key, 24)
    f32 = jnp.float32
    nrm = lambda k, shape, s: jax.random.normal(k, shape, f32) * s
    gain = lambda k, shape: 1.0 + 0.02 * jax.random.normal(k, shape, f32)
    return {
        "x": jax.random.normal(ks[0], (BATCH, SEQ, D_MODEL), f32),
        "meta_tokens": nrm(ks[1], (N_META, D_MODEL), 1.0),
        "ln_emb_g": gain(ks[2], (D_MODEL,)),
        "ln_emb_b": nrm(ks[3], (D_MODEL,), 0.02),
        "t5_table": nrm(ks[4], (N_BUCKETS, A_HEADS), 0.1),
        "w_in": nrm(ks[5], (DEPTH, D_MODEL, IN_WIDTH), D_MODEL ** -0.5),
        "a_sink": nrm(ks[6], (DEPTH, A_HEADS), 0.1),
        "na_rpb": nrm(ks[7], (DEPTH, B_HEADS, 2 * NA_ROWS - 1, 2 * NA_COLS - 1), 0.1),
        "g_norm_a": gain(ks[8], (DEPTH, A_WIDTH)),
        "g_norm_b": gain(ks[9], (DEPTH, B_WIDTH)),
        "w_out": nrm(ks[10], (DEPTH, MIX_WIDTH, D_MODEL), MIX_WIDTH ** -0.5 * DEEPNORM_BETA),
        "ln1_g": gain(ks[11], (DEPTH, D_MODEL)),
        "ln1_b": nrm(ks[12], (DEPTH, D_MODEL), 0.02),
        "w_router": nrm(ks[13], (DEPTH, D_MODEL, N_EXPERTS), D_MODEL ** -0.5),
        "router_bias": nrm(ks[14], (DEPTH, N_EXPERTS), 0.01),
        "w_gate": nrm(ks[15], (DEPTH, N_EXPERTS, D_MODEL, D_EXPERT), D_MODEL ** -0.5),
        "w_up": nrm(ks[16], (DEPTH, N_EXPERTS, D_MODEL, D_EXPERT), D_MODEL ** -0.5),
        "w_down": nrm(ks[17], (DEPTH, N_EXPERTS, D_EXPERT, D_MODEL), D_EXPERT ** -0.5 * DEEPNORM_BETA),
        "ws_gate": nrm(ks[18], (DEPTH, D_MODEL, D_SHARED), D_MODEL ** -0.5),
        "ws_up": nrm(ks[19], (DEPTH, D_MODEL, D_SHARED), D_MODEL ** -0.5),
        "ws_down": nrm(ks[20], (DEPTH, D_SHARED, D_MODEL), D_SHARED ** -0.5 * DEEPNORM_BETA),
        "ln2_g": gain(ks[21], (DEPTH, D_MODEL)),
        "ln2_b": nrm(ks[22], (DEPTH, D_MODEL), 0.02),
    }


def reference(x, meta_tokens, ln_emb_g, ln_emb_b, t5_table, w_in, a_sink, na_rpb,
              g_norm_a, g_norm_b, w_out, ln1_g, ln1_b, w_router, router_bias,
              w_gate, w_up, w_down, ws_gate, ws_up, ws_down, ln2_g, ln2_b):
    bsz = x.shape[0]
    meta = jnp.broadcast_to(meta_tokens[None].astype(x.dtype), (bsz, N_META, x.shape[-1]))
    h = layer_norm(jnp.concatenate([meta, x], axis=1), ln_emb_g, ln_emb_b)
    for l in range(DEPTH):
        mix = mixer(h, w_in[l], a_sink[l], na_rpb[l], g_norm_a[l], g_norm_b[l], w_out[l], t5_table)
        h = layer_norm(DEEPNORM_ALPHA * h + mix, ln1_g[l], ln1_b[l])
        ffn = moe(h, w_router[l], router_bias[l], w_gate[l], w_up[l], w_down[l],
                  ws_gate[l], ws_up[l], ws_down[l])
        h = layer_norm(DEEPNORM_ALPHA * h + ffn, ln2_g[l], ln2_b[l])
    return h[:, N_META:]
```

```cpp
#include <hip/hip_runtime.h>
#include <cstdio>
#include <cstdint>

#define LAS __attribute__((address_space(3)))
typedef unsigned short bf16_t;
typedef float f32x4 __attribute__((ext_vector_type(4)));
typedef unsigned u32x4 __attribute__((ext_vector_type(4)));
typedef unsigned u32x2 __attribute__((ext_vector_type(2)));

#ifndef MK_ONE_LAUNCH
#define MK_ONE_LAUNCH 1
#endif

constexpr int D = 2048, SEQ = 8192, NB = 2, NTOK = NB * SEQ;
constexpr int NMETA = 16, INW = 4608, MROWS = NTOK + 256;
constexpr int NE = 64, DE = 512, PMAX = 147456, HBROWS = PMAX + NTOK;
constexpr float ALPHA = 1.189207115002721f;
constexpr float LN_EPS = 1e-5f, RMS_EPS = 1e-6f, LOG2E = 1.4426950408889634f, QSCALE = 0.125f * LOG2E;
constexpr int COL_QA = 0, COL_KA = 1024, COL_VA = 1280, COL_QB = 1536, COL_KB = 2560, COL_VB = 3584;
constexpr int NPHASE = 10;
constexpr int LDS_BYTES = 147456;

constexpr size_t WS_CTL = 0, CTL_BYTES = 32768;
constexpr size_t WS_CNT = 16384;
constexpr size_t WS_STATS0 = WS_CTL + CTL_BYTES;
constexpr size_t WS_STATS1 = WS_STATS0 + (size_t)NTOK * 8;
constexpr size_t WS_SSQ = WS_STATS1 + (size_t)NTOK * 8;
constexpr size_t WS_TOKL = WS_SSQ + (size_t)NTOK * 32 * 4;
constexpr size_t WS_WL = WS_TOKL + (size_t)NE * NTOK * 4;
constexpr size_t WS_TKE = WS_WL + (size_t)NE * NTOK * 4;
constexpr size_t WS_TKR = WS_TKE + (size_t)NTOK * 8 * 4;
constexpr size_t WS_TAB = WS_TKR + (size_t)NTOK * 8 * 4;
constexpr size_t WS_Z = WS_TAB + 32768;
constexpr size_t WS_WTD = WS_Z + (size_t)NTOK * D * 4;
constexpr size_t WS_HB = WS_WTD + (size_t)65 * 2048 * 512 * 2;
constexpr size_t WS_B = WS_HB + (size_t)HBROWS * 512 * 2;
constexpr size_t WS_WTGU = WS_B;
constexpr size_t WS_WTIN = WS_WTGU + (size_t)65 * 1024 * 2048 * 2;
constexpr size_t WS_WTOUT = WS_WTIN + (size_t)INW * D * 2;
constexpr size_t WS_H0 = WS_WTOUT + (size_t)D * D * 2;
constexpr size_t WS_U = WS_H0 + (size_t)MROWS * D * 2;
constexpr size_t WS_YA = WS_U + (size_t)MROWS * INW * 2;
constexpr size_t WS_H1 = WS_U;
constexpr size_t WS_YM = WS_B;
constexpr size_t WS_END_A = WS_YA + (size_t)NTOK * D * 2, WS_END_B = WS_YM + (size_t)PMAX * D * 2;
constexpr size_t WS_END = WS_END_A > WS_END_B ? WS_END_A : WS_END_B;
static_assert(WS_END <= ((size_t)1 << 30), "workspace map must fit 1 GiB");

__device__ __forceinline__ float bf2f(bf16_t b) { return __uint_as_float(((unsigned)b) << 16); }
__device__ __forceinline__ bf16_t f2bf(float f) { unsigned u = __float_as_uint(f); u += 0x7FFFu + ((u >> 16) & 1u); return (bf16_t)(u >> 16); }
__device__ __forceinline__ unsigned pack2(float lo, float hi) { return (unsigned)f2bf(lo) | ((unsigned)f2bf(hi) << 16); }
__device__ __forceinline__ float wsum(float v) {
#pragma unroll
    for (int o = 32; o >= 1; o >>= 1) v += __shfl_xor(v, o);
    return v; }
__device__ __forceinline__ float wmax(float v) {
#pragma unroll
    for (int o = 32; o >= 1; o >>= 1) v = fmaxf(v, __shfl_xor(v, o));
    return v; }
__device__ __forceinline__ int t5_bucket(int rel) {
    const int ret = rel > 0 ? 16 : 0, n = rel < 0 ? -rel : rel;
    if (n < 8) return ret + n;
    const int n2 = n > 32768 ? 0x40000000 : n * n; int lg = 31 - __clz(n2) + 2; if (lg > 15) lg = 15;
    return ret + lg; }

#define XB_TMO      128
#define XB_XCNT(j)  (256  + 64 * (j))
#define XB_XSUB(j)  (1280 + 64 * (j))
#define XB_XGEN(j)  (2304 + 64 * (j))
#define XB_TOP      3328
#define XB_TOPGEN   3392
#define XCD_BAR_WORDS 3456
#define XB_SPIN_CAP (1u << 18)
__device__ __forceinline__ unsigned xb_ld(unsigned* p)              { return __hip_atomic_load(p, __ATOMIC_RELAXED, __HIP_MEMORY_SCOPE_AGENT); }
__device__ __forceinline__ unsigned xb_add(unsigned* p, unsigned v) { return __hip_atomic_fetch_add(p, v, __ATOMIC_RELAXED, __HIP_MEMORY_SCOPE_AGENT); }
__device__ __forceinline__ unsigned xb_xcc_id() { return (unsigned)__builtin_amdgcn_s_getreg((3 << 11) | 20) & 0xFu; }
#define XB_SPIN(cond, bar) do { unsigned _sp = 0; while (cond) { __builtin_amdgcn_s_sleep(1); \
    if ((++_sp & 255u) == 0u) { if (xb_ld(&(bar)[XB_TMO])) break; if (_sp > XB_SPIN_CAP) { atomicAdd(&(bar)[XB_TMO], 1u); break; } } } } while (0)
struct XcdBarrier { unsigned* bar; unsigned x; volatile LAS unsigned* st; };
__device__ __forceinline__ XcdBarrier xcd_barrier_post(unsigned* bar, volatile LAS unsigned* st) {
    XcdBarrier b; b.bar = bar; b.x = xb_xcc_id(); b.st = st;
    if (threadIdx.x == 0) (void)xb_add(&bar[XB_XCNT(b.x)], 1u);
    return b;
}
__device__ __forceinline__ void xcd_barrier_complete(unsigned* bar, unsigned x, unsigned& nloc, unsigned& nx) {
    const unsigned G = gridDim.x * gridDim.y * gridDim.z;
    unsigned sum, cnt, mine, sp = 0u;
    for (;;) {
        sum = 0u; cnt = 0u; mine = 0u;
#pragma unroll
        for (unsigned j = 0; j < 16; ++j) { const unsigned c = xb_ld(&bar[XB_XCNT(j)]); sum += c; cnt += (c > 0u) ? 1u : 0u; mine = (j == x) ? c : mine; }
        if (sum == G) break;
        __builtin_amdgcn_s_sleep(1);
        if ((++sp & 255u) == 0u) { if (xb_ld(&bar[XB_TMO])) break; if (sp > XB_SPIN_CAP) { atomicAdd(&bar[XB_TMO], 1u); break; } }
    }
    nloc = mine > 0u ? mine : 1u; nx = cnt > 0u ? cnt : 1u;
}
__device__ __forceinline__ void xcd_barrier(const XcdBarrier& b) {
    asm volatile("s_waitcnt vmcnt(0)" ::: "memory");
    __syncthreads();
    if (threadIdx.x == 0) {
        unsigned* bar = b.bar;
        __builtin_amdgcn_s_waitcnt(0);
        unsigned nloc = b.st[0], nx = b.st[1];
        if (nloc == 0u) { xcd_barrier_complete(bar, b.x, nloc, nx); b.st[0] = nloc; b.st[1] = nx; }
        const unsigned old = xb_add(&bar[XB_XSUB(b.x)], 1u);
        const unsigned gen = old / nloc;
        if (old + 1u == (gen + 1u) * nloc) {
            __builtin_amdgcn_fence(__ATOMIC_RELEASE, "agent");
            asm volatile("s_waitcnt vmcnt(0)" ::: "memory");
            const unsigned og = xb_add(&bar[XB_TOP], 1u);
            const unsigned tg = og / nx;
            if (og + 1u == (tg + 1u) * nx) xb_add(&bar[XB_TOPGEN], 1u);
            else XB_SPIN(xb_ld(&bar[XB_TOPGEN]) == tg, bar);
            __builtin_amdgcn_fence(__ATOMIC_ACQUIRE, "agent");
            xb_add(&bar[XB_XGEN(b.x)], 1u);
            asm volatile("s_waitcnt vmcnt(0)" ::: "memory");
        } else {
            XB_SPIN(xb_ld(&bar[XB_XGEN(b.x)]) == gen, bar);
            __builtin_amdgcn_fence(__ATOMIC_ACQUIRE, "agent");
            asm volatile("s_waitcnt vmcnt(0)" ::: "memory");
        }
    }
    __syncthreads();
}

struct Args { const float* in[23]; float* out; unsigned char* ws; int ph_lo, ph_hi; };
struct Frame {
    LAS unsigned char* lds; int tid, lane, wave, G, bx;
    const float *x, *meta, *lng, *lnb, *t5, *w_in, *sink, *rpb, *ga, *gb, *w_out, *l1g, *l1b, *w_router, *rbias, *w_gate, *w_up, *w_down, *ws_gate, *ws_up, *ws_down, *l2g, *l2b;
    float* out; unsigned char* ws;
    float *stats0, *stats1, *ssq, *wl, *tab, *z; int *cnt, *tokl, *tke, *tkr;
    bf16_t *wtd, *hb, *wtgu, *wtin, *wtout, *h0, *u, *ya, *h1, *ym;
};

__device__ __forceinline__ void transpose_tile(const float* src, size_t ld_src, bf16_t* dst, size_t ld_dst, LAS float* t, int tid, const float* kscale, float cscale) {
#pragma unroll
    for (int p = 0; p < 8; ++p) { const int k = p * 8 + (tid >> 6); float v = src[(size_t)k * ld_src + (tid & 63)]; if (kscale) v *= kscale[k]; t[k * 65 + (tid & 63)] = v * cscale; }
    __syncthreads();
#pragma unroll
    for (int p = 0; p < 4; ++p) { const int n = p * 16 + (tid >> 5), k = (tid & 31) * 2; *(unsigned*)(dst + (size_t)n * ld_dst + k) = pack2(t[k * 65 + n], t[(k + 1) * 65 + n]); }
    __syncthreads();
}
__device__ __forceinline__ void phase_prologue(Frame& F) {
    LAS float* t = (LAS float*)F.lds;
    constexpr int T_IN = 72 * 32, T_OUT = 32 * 32, T_GU = 65 * 2 * 8 * 32, T_D = 65 * 32 * 8, T_ALL = T_IN + T_OUT + T_GU + T_D;
    for (int it = F.bx; it < T_ALL; it += F.G) {
        int r = it;
        if (r < T_IN) { const int tn = r % 72, tk = r / 72; const int n0 = tn * 64; const bool isq = (n0 < COL_KA) || (n0 >= COL_QB && n0 < COL_KB);
            transpose_tile(F.w_in + (size_t)(tk * 64) * INW + n0, INW, F.wtin + (size_t)n0 * D + tk * 64, D, t, F.tid, nullptr, isq ? QSCALE : 1.0f); continue; }
        r -= T_IN;
        if (r < T_OUT) { const int tn = r % 32, tk = r / 32; const int k0 = tk * 64;
            transpose_tile(F.w_out + (size_t)k0 * D + tn * 64, D, F.wtout + (size_t)(tn * 64) * D + k0, D, t, F.tid, k0 < 1024 ? F.ga + k0 : F.gb + (k0 - 1024), 1.0f); continue; }
        r -= T_OUT;
        if (r < T_GU) { const int tk = r % 32, tn = (r / 32) % 8, which = (r / 256) % 2, e = r / 512;
            const float* src = e < NE ? (which ? F.w_up : F.w_gate) + (size_t)e * D * DE : (which ? F.ws_up : F.ws_gate);
            const int c0 = tn * 64, nprime = 256 * (c0 / 128) + 128 * which + (c0 % 128);
            transpose_tile(src + (size_t)(tk * 64) * DE + c0, DE, F.wtgu + ((size_t)e * 1024 + nprime) * D + tk * 64, D, t, F.tid, nullptr, 1.0f); continue; }
        r -= T_GU;
        { const int tk = r % 8, tn = (r / 8) % 32, e = r / 256;
            const float* src = e < NE ? F.w_down + (size_t)e * DE * D : F.ws_down;
            transpose_tile(src + (size_t)(tk * 64) * D + tn * 64, D, F.wtd + ((size_t)e * D + tn * 64) * DE + tk * 64, DE, t, F.tid, nullptr, 1.0f); }
    }
    const int gw = F.bx * 8 + F.wave, NGW = F.G * 8;
    for (int row = gw; row < MROWS; row += NGW) {
        bf16_t* dst = F.h0 + (size_t)row * D;
        if (row >= NTOK + NMETA) {
#pragma unroll
            for (int j = 0; j < 8; ++j) *(u32x2*)(dst + (j * 64 + F.lane) * 4) = (u32x2){0u, 0u};
            continue; }
        const float* src = row < NTOK ? F.x + (size_t)row * D : F.meta + (size_t)(row - NTOK) * D;
        f32x4 v[8]; float s = 0.f;
#pragma unroll
        for (int j = 0; j < 8; ++j) { v[j] = *(const f32x4*)(src + (j * 64 + F.lane) * 4); s += (v[j][0] + v[j][1]) + (v[j][2] + v[j][3]); }
        const float mu = wsum(s) * (1.0f / D); float q = 0.f;
#pragma unroll
        for (int j = 0; j < 8; ++j) { const f32x4 d = v[j] - mu; q += (d[0] * d[0] + d[1] * d[1]) + (d[2] * d[2] + d[3] * d[3]); }
        const float rstd = 1.0f / sqrtf(wsum(q) * (1.0f / D) + LN_EPS);
#pragma unroll
        for (int j = 0; j < 8; ++j) { const int c = (j * 64 + F.lane) * 4; const f32x4 g = *(const f32x4*)(F.lng + c), b = *(const f32x4*)(F.lnb + c); const f32x4 y = (v[j] - mu) * rstd * g + b;
            *(u32x2*)(dst + c) = (u32x2){pack2(y[0], y[1]), pack2(y[2], y[3])}; }
        if (row < NTOK && F.lane == 0) { F.stats0[row * 2] = mu; F.stats0[row * 2 + 1] = rstd; }
    }
    if (F.bx == 0) for (int i = F.tid; i < 16 * 272; i += 512) { const int h = i / 272, r = i % 272; F.tab[i] = r <= 256 ? F.t5[t5_bucket(r - 128) * 16 + h] * LOG2E : 0.f; }
}

template <class Fn> __device__ __forceinline__ void sgemm(const Fn& f, LAS unsigned char* ldsb, int tid, int bx, int G) {
    LAS float* As = (LAS float*)ldsb; LAS float* Bs = As + 32 * 132; LAS float* Bs2 = Bs + 32 * 68;
    const int ntm = f.ntm(), ntn = f.ntn(), K = f.K();
    const int tx = tid & 15, ty = tid >> 4, ar = tid >> 2, akc = (tid & 3) * 8, br = (tid & 255) >> 2;
    for (int tile = bx; tile < ntm * ntn; tile += G) {
        const int tm = tile / ntn, tn = tile % ntn;
        typename Fn::Tile T; if (!f.tile(tm, T)) continue;
        float acc[4][4], acc2[4][4];
#pragma unroll
        for (int i = 0; i < 4; ++i)
#pragma unroll
            for (int j = 0; j < 4; ++j) { acc[i][j] = 0.f; acc2[i][j] = 0.f; }
        const bf16_t* ap = f.arow(T, tm * 128 + ar);
        const bf16_t* bp = tid < 256 ? f.brow(T, tn * 64 + br) : (Fn::DUAL ? f.brow2(T, tn * 64 + br) : nullptr);
        LAS float* Bw = tid < 256 ? Bs : Bs2;
        for (int k0 = 0; k0 < K; k0 += 32) {
            u32x4 av = (u32x4){0u, 0u, 0u, 0u}, bv = (u32x4){0u, 0u, 0u, 0u};
            if (ap) av = *(const u32x4*)(ap + k0 + akc);
            if (bp) bv = *(const u32x4*)(bp + k0 + akc);
            __syncthreads();
#pragma unroll
            for (int i = 0; i < 4; ++i) { As[(akc + 2 * i) * 132 + ar] = __uint_as_float(av[i] << 16); As[(akc + 2 * i + 1) * 132 + ar] = __uint_as_float(av[i] & 0xffff0000u); }
            if (tid < 256 || Fn::DUAL) {
#pragma unroll
                for (int i = 0; i < 4; ++i) { Bw[(akc + 2 * i) * 68 + br] = __uint_as_float(bv[i] << 16); Bw[(akc + 2 * i + 1) * 68 + br] = __uint_as_float(bv[i] & 0xffff0000u); } }
            __syncthreads();
#pragma unroll 8
            for (int kk = 0; kk < 32; ++kk) {
                const f32x4 a = *(const LAS f32x4*)(As + kk * 132 + ty * 4), b = *(const LAS f32x4*)(Bs + kk * 68 + tx * 4);
#pragma unroll
                for (int i = 0; i < 4; ++i)
#pragma unroll
                    for (int j = 0; j < 4; ++j) acc[i][j] += a[i] * b[j];
                if (Fn::DUAL) { const f32x4 b2 = *(const LAS f32x4*)(Bs2 + kk * 68 + tx * 4);
#pragma unroll
                    for (int i = 0; i < 4; ++i)
#pragma unroll
                        for (int j = 0; j < 4; ++j) acc2[i][j] += a[i] * b2[j]; }
            }
        }
#pragma unroll
        for (int i = 0; i < 4; ++i)
#pragma unroll
            for (int j = 0; j < 4; ++j) f.store(T, tm * 128 + ty * 4 + i, tn * 64 + tx * 4 + j, acc[i][j], acc2[i][j]);
    }
}

__device__ __forceinline__ void expert_starts(const Frame& F, LAS int* ps  ) {
    if (F.tid == 0) { int acc = 0; for (int e = 0; e < NE; ++e) { ps[e] = acc; acc += ((F.cnt[e] + 255) >> 8) << 8; } ps[64] = acc; }
    __syncthreads();
}

struct FnInProj {
    static constexpr bool DUAL = false; struct Tile {}; const Frame& F;
    __device__ int ntm() const { return MROWS / 128; } __device__ int ntn() const { return INW / 64; } __device__ int K() const { return D; }
    __device__ bool tile(int, Tile&) const { return true; }
    __device__ const bf16_t* arow(const Tile&, int row) const { return F.h0 + (size_t)row * D; }
    __device__ const bf16_t* brow(const Tile&, int n) const { return F.wtin + (size_t)n * D; }
    __device__ const bf16_t* brow2(const Tile&, int) const { return nullptr; }
    __device__ void store(const Tile&, int row, int n, float a, float) const { F.u[(size_t)row * INW + n] = f2bf(a); }
};
struct FnOutProj {
    static constexpr bool DUAL = false; struct Tile {}; const Frame& F;
    __device__ int ntm() const { return NTOK / 128; } __device__ int ntn() const { return D / 64; } __device__ int K() const { return D; }
    __device__ bool tile(int, Tile&) const { return true; }
    __device__ const bf16_t* arow(const Tile&, int row) const { return F.ya + (size_t)row * D; }
    __device__ const bf16_t* brow(const Tile&, int n) const { return F.wtout + (size_t)n * D; }
    __device__ const bf16_t* brow2(const Tile&, int) const { return nullptr; }
    __device__ void store(const Tile&, int row, int n, float a, float) const {
        const float h0 = (F.x[(size_t)row * D + n] - F.stats0[row * 2]) * F.stats0[row * 2 + 1] * F.lng[n] + F.lnb[n];
        F.z[(size_t)row * D + n] = a + ALPHA * h0; }
};
struct FnGateUp {
    static constexpr bool DUAL = true; struct Tile { int e, r0, n; }; const Frame& F; const LAS int* ps;
    __device__ int ntm() const { return HBROWS / 128; } __device__ int ntn() const { return DE / 64; } __device__ int K() const { return D; }
    __device__ bool tile(int tm, Tile& T) const { const int row0 = tm * 128;
        if (row0 >= PMAX) { T.e = NE; T.r0 = row0 - PMAX; T.n = NTOK; return true; }
        if (row0 >= ps[64]) return false;
        int e = 0; while (e < NE - 1 && row0 >= ps[e + 1]) ++e;
        T.e = e; T.r0 = row0 - ps[e]; T.n = F.cnt[e]; return T.r0 < T.n; }
    __device__ const bf16_t* arow(const Tile& T, int row) const { const int r = T.r0 + (row & 127); if (r >= T.n) return nullptr;
        const int tok = T.e < NE ? F.tokl[(size_t)T.e * NTOK + r] : r; return F.h1 + (size_t)tok * D; }
    __device__ const bf16_t* brow(const Tile& T, int n) const { return F.wtgu + ((size_t)T.e * 1024 + 256 * (n >> 7) + (n & 127)) * D; }
    __device__ const bf16_t* brow2(const Tile& T, int n) const { return F.wtgu + ((size_t)T.e * 1024 + 256 * (n >> 7) + 128 + (n & 127)) * D; }
    __device__ void store(const Tile&, int row, int n, float g, float u) const { F.hb[(size_t)row * DE + n] = f2bf(g / (1.0f + __expf(-g)) * u); }
};
struct FnDown {
    static constexpr bool DUAL = false; struct Tile { int e, r0, n; }; const Frame& F; const LAS int* ps;
    __device__ int ntm() const { return PMAX / 128; } __device__ int ntn() const { return D / 64; } __device__ int K() const { return DE; }
    __device__ bool tile(int tm, Tile& T) const { const int row0 = tm * 128; if (row0 >= ps[64]) return false;
        int e = 0; while (e < NE - 1 && row0 >= ps[e + 1]) ++e;
        T.e = e; T.r0 = row0 - ps[e]; T.n = F.cnt[e]; return T.r0 < T.n; }
    __device__ const bf16_t* arow(const Tile&, int row) const { return F.hb + (size_t)row * DE; }
    __device__ const bf16_t* brow(const Tile& T, int n) const { return F.wtd + ((size_t)T.e * D + n) * DE; }
    __device__ const bf16_t* brow2(const Tile&, int) const { return nullptr; }
    __device__ void store(const Tile& T, int row, int n, float a, float) const { const int r = T.r0 + (row & 127);
        const float w = r < T.n ? F.wl[(size_t)T.e * NTOK + r] : 0.f; F.ym[(size_t)row * D + n] = f2bf(a * w); }
};
struct FnFinal {
    static constexpr bool DUAL = false; struct Tile {}; const Frame& F; const LAS int* ps;
    __device__ int ntm() const { return NTOK / 128; } __device__ int ntn() const { return D / 64; } __device__ int K() const { return DE; }
    __device__ bool tile(int, Tile&) const { return true; }
    __device__ const bf16_t* arow(const Tile&, int row) const { return F.hb + (size_t)(PMAX + row) * DE; }
    __device__ const bf16_t* brow(const Tile&, int n) const { return F.wtd + ((size_t)NE * D + n) * DE; }
    __device__ const bf16_t* brow2(const Tile&, int) const { return nullptr; }
    __device__ void store(const Tile&, int row, int n, float a, float) const {
        const float h1 = (F.z[(size_t)row * D + n] - F.stats1[row * 2]) * F.stats1[row * 2 + 1] * F.l1g[n] + F.l1b[n];
        float s = a + ALPHA * h1;
#pragma unroll
        for (int j = 0; j < 8; ++j) { const int p = ps[F.tke[row * 8 + j]] + F.tkr[row * 8 + j]; s += bf2f(F.ym[(size_t)p * D + n]); }
        F.out[(size_t)row * D + n] = s; }
};

__device__ __forceinline__ void phase_attn_simple(Frame& F) {
    LAS float* qs = (LAS float*)F.lds + F.wave * 512; LAS float* psm = qs + 64;
    const int gw = F.bx * 8 + F.wave, NGW = F.G * 8, lane = F.lane;
    for (int item = gw; item < NTOK * 32; item += NGW) {
        const int tok = item >> 5, hh = item & 31, b = tok >> 13, s = tok & 8191;
        const bool isA = hh < 16; const int h = hh & 15;
        const int qcol = isA ? COL_QA + h * 64 : COL_QB + h * 64, kcol = isA ? COL_KA + (h >> 2) * 64 : COL_KB + h * 64, vcol = isA ? COL_VA + (h >> 2) * 64 : COL_VB + h * 64;
        const int r = s >> 6, c = s & 63, rs = min(max(r - 4, 0), 120), cs = min(max(c - 8, 0), 48);
        const int nkeys = isA ? 16 + 257 : 16 + 128;
        asm volatile("s_waitcnt lgkmcnt(0)" ::: "memory");
        qs[lane] = bf2f(F.u[(size_t)tok * INW + qcol + lane]);
        asm volatile("s_waitcnt lgkmcnt(0)" ::: "memory");
        float sc[5]; float mx = -INFINITY;
#pragma unroll
        for (int i = 0; i < 5; ++i) {
            const int j = lane + 64 * i; sc[i] = -INFINITY;
            if (j < nkeys) {
                int krow; float bias; bool valid = true;
                if (j < 16) { krow = NTOK + j; bias = isA ? F.t5[t5_bucket(j - 16 - s) * 16 + h] * LOG2E : 0.f; }
                else if (isA) { const int kpos = s - 128 + (j - 16); valid = kpos >= 0 && kpos < SEQ; krow = b * SEQ + kpos; bias = F.tab[h * 272 + (j - 16)]; }
                else { const int w = j - 16, kr = rs + (w >> 4), kc = cs + (w & 15); krow = b * SEQ + kr * 64 + kc; bias = F.rpb[(h * 15 + (kr - r + 7)) * 31 + (kc - c + 15)] * LOG2E; }
                if (valid) { const bf16_t* kp = F.u + (size_t)krow * INW + kcol; float dot = 0.f;
#pragma unroll
                    for (int d8 = 0; d8 < 8; ++d8) { const u32x4 kv = *(const u32x4*)(kp + d8 * 8);
#pragma unroll
                        for (int i2 = 0; i2 < 4; ++i2) { dot += qs[d8 * 8 + 2 * i2] * __uint_as_float(kv[i2] << 16); dot += qs[d8 * 8 + 2 * i2 + 1] * __uint_as_float(kv[i2] & 0xffff0000u); } }
                    sc[i] = dot + bias; }
            }
            mx = fmaxf(mx, sc[i]);
        }
        const float sinkl = isA ? F.sink[h] * LOG2E : -INFINITY;
        mx = fmaxf(wmax(mx), sinkl);
        float l = 0.f;
#pragma unroll
        for (int i = 0; i < 5; ++i) { const int j = lane + 64 * i; const float p = sc[i] == -INFINITY ? 0.f : exp2f(sc[i] - mx); l += p; if (j < 320) psm[j] = p; }
        l = wsum(l) + (isA ? exp2f(sinkl - mx) : 0.f);
        asm volatile("s_waitcnt lgkmcnt(0)" ::: "memory");
        float o = 0.f;
        for (int j = 0; j < nkeys; ++j) { const float p = psm[j]; if (p == 0.f) continue;
            int krow; if (j < 16) krow = NTOK + j; else if (isA) krow = b * SEQ + s - 128 + (j - 16); else { const int w = j - 16; krow = b * SEQ + (rs + (w >> 4)) * 64 + cs + (w & 15); }
            o += p * bf2f(F.u[(size_t)krow * INW + vcol + lane]); }
        o /= l;
        const bf16_t ob = f2bf(o); F.ya[(size_t)tok * D + hh * 64 + lane] = ob;
        const float of = bf2f(ob), q = wsum(of * of);
        if (lane == 0) F.ssq[tok * 32 + hh] = q;
    }
}
__device__ __forceinline__ void phase_rmsnorm(Frame& F) {
    const int gw = F.bx * 8 + F.wave, NGW = F.G * 8, lane = F.lane;
    for (int tok = gw; tok < NTOK; tok += NGW) {
        const float q = lane < 32 ? F.ssq[tok * 32 + lane] : 0.f;
        float qa = lane < 16 ? q : 0.f, qb = (lane >= 16 && lane < 32) ? q : 0.f; qa = wsum(qa); qb = wsum(qb);
        const float ra = 1.0f / sqrtf(qa * (1.0f / 1024.f) + RMS_EPS), rb = 1.0f / sqrtf(qb * (1.0f / 1024.f) + RMS_EPS);
        bf16_t* p = F.ya + (size_t)tok * D;
#pragma unroll
        for (int j = 0; j < 8; ++j) { const int c = (j * 64 + lane) * 4; const float rr = c < 1024 ? ra : rb; u32x2 w = *(u32x2*)(p + c);
            w.x = pack2(__uint_as_float(w.x << 16) * rr, __uint_as_float(w.x & 0xffff0000u) * rr); w.y = pack2(__uint_as_float(w.y << 16) * rr, __uint_as_float(w.y & 0xffff0000u) * rr); *(u32x2*)(p + c) = w; }
    }
}

__device__ __forceinline__ void phase_ln1_router(Frame& F) {
    LAS float* hs = (LAS float*)F.lds + F.wave * 2048;
    const int gw = F.bx * 8 + F.wave, NGW = F.G * 8, lane = F.lane;
    for (int tok = gw; tok < NTOK; tok += NGW) {
        const float* src = F.z + (size_t)tok * D; f32x4 v[8]; float s = 0.f;
#pragma unroll
        for (int j = 0; j < 8; ++j) { v[j] = *(const f32x4*)(src + (j * 64 + lane) * 4); s += (v[j][0] + v[j][1]) + (v[j][2] + v[j][3]); }
        const float mu = wsum(s) * (1.0f / D); float q = 0.f;
#pragma unroll
        for (int j = 0; j < 8; ++j) { const f32x4 d = v[j] - mu; q += (d[0] * d[0] + d[1] * d[1]) + (d[2] * d[2] + d[3] * d[3]); }
        const float rstd = 1.0f / sqrtf(wsum(q) * (1.0f / D) + LN_EPS);
        asm volatile("s_waitcnt lgkmcnt(0)" ::: "memory");
#pragma unroll
        for (int j = 0; j < 8; ++j) { const int c = (j * 64 + lane) * 4; const f32x4 g = *(const f32x4*)(F.l1g + c), bb = *(const f32x4*)(F.l1b + c); const f32x4 y = (v[j] - mu) * rstd * g + bb;
            *(u32x2*)(F.h1 + (size_t)tok * D + c) = (u32x2){pack2(y[0], y[1]), pack2(y[2], y[3])}; *(LAS f32x4*)(hs + c) = y; }
        if (lane == 0) { F.stats1[tok * 2] = mu; F.stats1[tok * 2 + 1] = rstd; }
        asm volatile("s_waitcnt lgkmcnt(0)" ::: "memory");
        float lg = 0.f;
#pragma unroll 8
        for (int n = 0; n < D; ++n) lg += hs[n] * F.w_router[(size_t)n * NE + lane];
        const float score = 1.0f / (1.0f + expf(-lg)), v0 = score + F.rbias[lane];
        int rk = 0;
#pragma unroll
        for (int j = 0; j < 8; ++j) { const int o = (lane & ~7) + j; const float w = __shfl(v0, o); rk += (w > v0 || (w == v0 && o < lane)) ? 1 : 0; }
        float gs = rk < 2 ? v0 : 0.f; gs += __shfl_xor(gs, 1); gs += __shfl_xor(gs, 2); gs += __shfl_xor(gs, 4);
        int grk = 0; const int myg = lane >> 3;
#pragma unroll
        for (int g = 0; g < 8; ++g) { const float w = __shfl(gs, g * 8); grk += (w > gs || (w == gs && g < myg)) ? 1 : 0; }
        const float mv = grk < 4 ? v0 : -INFINITY;
        int erk = 0;
        for (int o = 0; o < 64; ++o) { const float w = __shfl(mv, o); erk += (w > mv || (w == mv && o < lane)) ? 1 : 0; }
        const bool sel = erk < 8;
        const float wsm = wsum(sel ? score : 0.f), wgt = score / (wsm + 1e-20f) * 2.5f;
        if (sel) { const int rr = atomicAdd(F.cnt + lane, 1); F.tokl[(size_t)lane * NTOK + rr] = tok; F.wl[(size_t)lane * NTOK + rr] = wgt; F.tke[tok * 8 + erk] = lane; F.tkr[tok * 8 + erk] = rr; }
    }
}
__device__ __forceinline__ void phase_ln2(Frame& F) {
    const int gw = F.bx * 8 + F.wave, NGW = F.G * 8, lane = F.lane;
    for (int tok = gw; tok < NTOK; tok += NGW) {
        float* src = F.out + (size_t)tok * D; f32x4 v[8]; float s = 0.f;
#pragma unroll
        for (int j = 0; j < 8; ++j) { v[j] = *(const f32x4*)(src + (j * 64 + lane) * 4); s += (v[j][0] + v[j][1]) + (v[j][2] + v[j][3]); }
        const float mu = wsum(s) * (1.0f / D); float q = 0.f;
#pragma unroll
        for (int j = 0; j < 8; ++j) { const f32x4 d = v[j] - mu; q += (d[0] * d[0] + d[1] * d[1]) + (d[2] * d[2] + d[3] * d[3]); }
        const float rstd = 1.0f / sqrtf(wsum(q) * (1.0f / D) + LN_EPS);
#pragma unroll
        for (int j = 0; j < 8; ++j) { const int c = (j * 64 + lane) * 4; const f32x4 g = *(const f32x4*)(F.l2g + c), bb = *(const f32x4*)(F.l2b + c); *(f32x4*)(src + c) = (v[j] - mu) * rstd * g + bb; }
    }
}

__global__ void __launch_bounds__(512, 2) mk_fwd(Args args) {
    extern __shared__ __attribute__((aligned(16))) unsigned char lds_raw[];
    Frame F; F.lds = (LAS unsigned char*)lds_raw; F.tid = threadIdx.x; F.lane = F.tid & 63; F.wave = __builtin_amdgcn_readfirstlane(F.tid >> 6); F.G = gridDim.x; F.bx = blockIdx.x;
    F.x = args.in[0]; F.meta = args.in[1]; F.lng = args.in[2]; F.lnb = args.in[3]; F.t5 = args.in[4]; F.w_in = args.in[5]; F.sink = args.in[6]; F.rpb = args.in[7]; F.ga = args.in[8]; F.gb = args.in[9];
    F.w_out = args.in[10]; F.l1g = args.in[11]; F.l1b = args.in[12]; F.w_router = args.in[13]; F.rbias = args.in[14]; F.w_gate = args.in[15]; F.w_up = args.in[16]; F.w_down = args.in[17];
    F.ws_gate = args.in[18]; F.ws_up = args.in[19]; F.ws_down = args.in[20]; F.l2g = args.in[21]; F.l2b = args.in[22]; F.out = args.out; F.ws = args.ws;
    unsigned char* ws = args.ws;
    F.stats0 = (float*)(ws + WS_STATS0); F.stats1 = (float*)(ws + WS_STATS1); F.ssq = (float*)(ws + WS_SSQ); F.wl = (float*)(ws + WS_WL); F.tab = (float*)(ws + WS_TAB); F.z = (float*)(ws + WS_Z);
    F.cnt = (int*)(ws + WS_CNT); F.tokl = (int*)(ws + WS_TOKL); F.tke = (int*)(ws + WS_TKE); F.tkr = (int*)(ws + WS_TKR);
    F.wtd = (bf16_t*)(ws + WS_WTD); F.hb = (bf16_t*)(ws + WS_HB); F.wtgu = (bf16_t*)(ws + WS_WTGU); F.wtin = (bf16_t*)(ws + WS_WTIN); F.wtout = (bf16_t*)(ws + WS_WTOUT);
    F.h0 = (bf16_t*)(ws + WS_H0); F.u = (bf16_t*)(ws + WS_U); F.ya = (bf16_t*)(ws + WS_YA); F.h1 = (bf16_t*)(ws + WS_H1); F.ym = (bf16_t*)(ws + WS_YM);
    volatile LAS unsigned* xbw = (volatile LAS unsigned*)(F.lds + LDS_BYTES - 16);
    LAS int* ps = (LAS int*)(F.lds + LDS_BYTES - 16 - 512);
    if (F.tid < 4) xbw[F.tid] = 0u;
    __syncthreads();
    const int lo = args.ph_lo, hi = args.ph_hi;
    XcdBarrier bar; bar.bar = (unsigned*)(ws + WS_CTL); bar.x = 0; bar.st = xbw;
    if (hi - lo > 1) bar = xcd_barrier_post((unsigned*)(ws + WS_CTL), xbw);
#define IN(k) (lo <= (k) && (k) < hi)
#define SEAM(k) do { if (IN(k) && IN((k) + 1)) xcd_barrier(bar); } while (0)
    if (IN(0)) { phase_prologue(F); } SEAM(0);
    if (IN(1)) { FnInProj f{F}; sgemm(f, F.lds, F.tid, F.bx, F.G); } SEAM(1);
    if (IN(2)) { phase_attn_simple(F); } SEAM(2);
    if (IN(3)) { phase_rmsnorm(F); } SEAM(3);
    if (IN(4)) { FnOutProj f{F}; sgemm(f, F.lds, F.tid, F.bx, F.G); } SEAM(4);
    if (IN(5)) { phase_ln1_router(F); } SEAM(5);
    if (IN(6)) { expert_starts(F, ps); FnGateUp f{F, ps}; sgemm(f, F.lds, F.tid, F.bx, F.G); } SEAM(6);
    if (IN(7)) { expert_starts(F, ps); FnDown f{F, ps}; sgemm(f, F.lds, F.tid, F.bx, F.G); } SEAM(7);
    if (IN(8)) { expert_starts(F, ps); FnFinal f{F, ps}; sgemm(f, F.lds, F.tid, F.bx, F.G); } SEAM(8);
    if (IN(9)) { phase_ln2(F); }
#undef IN
#undef SEAM
}

extern "C" void kernel_launch(void* const* d_in, const int* in_sizes, int n_in, void* d_out, int out_size, void* d_ws, size_t ws_size, hipStream_t stream) {
    static int grid = 0;
    if (grid == 0) {
        if (n_in != 23 || in_sizes[0] != NTOK * D || out_size != NTOK * D || ws_size < WS_END) {
            fprintf(stderr, "kernel_launch: built for 23 inputs, x/out of %d floats, >= %zu bytes of workspace; got n_in %d in0 %d out %d ws %zu; nothing launched\n", NTOK * D, (size_t)WS_END, n_in, n_in > 0 ? in_sizes[0] : -1, out_size, ws_size);
            grid = -1; return; }
        int dev = 0, cus = 0, per_cu = 0;
        if (hipGetDevice(&dev) != hipSuccess || hipDeviceGetAttribute(&cus, hipDeviceAttributeMultiprocessorCount, dev) != hipSuccess) { fprintf(stderr, "kernel_launch: device query failed\n"); grid = -1; return; }
        if (hipFuncSetAttribute((const void*)mk_fwd, hipFuncAttributeMaxDynamicSharedMemorySize, LDS_BYTES) != hipSuccess) { fprintf(stderr, "kernel_launch: hipFuncSetAttribute failed\n"); grid = -1; return; }
        if (hipOccupancyMaxActiveBlocksPerMultiprocessor(&per_cu, (const void*)mk_fwd, 512, LDS_BYTES) != hipSuccess || per_cu < 1) fprintf(stderr, "kernel_launch: note: occupancy query reports %d\n", per_cu);
        (void)hipGetLastError();
        grid = cus;
    }
    if (grid < 0) return;
    if (hipMemsetAsync((char*)d_ws + WS_CTL, 0, CTL_BYTES, stream) != hipSuccess) { fprintf(stderr, "kernel_launch: memset failed\n"); return; }
    Args a{};
    for (int i = 0; i < 23; ++i) a.in[i] = (const float*)d_in[i];
    a.out = (float*)d_out; a.ws = (unsigned char*)d_ws;
#if MK_ONE_LAUNCH
    a.ph_lo = 0; a.ph_hi = NPHASE;
    hipLaunchKernelGGL(mk_fwd, dim3(grid), dim3(512), LDS_BYTES, stream, a);
#else
    for (int p = 0; p < NPHASE; ++p) { a.ph_lo = p; a.ph_hi = p + 1; hipLaunchKernelGGL(mk_fwd, dim3(grid), dim3(512), LDS_BYTES, stream, a); }
#endif
    const hipError_t le = hipPeekAtLastError();
    if (le != hipSuccess) fprintf(stderr, "kernel_launch: launch failed: %s\n", hipGetErrorName(le));
}
```

```cpp
#include <hip/hip_runtime.h>
#include <cstdio>
#include <cstdint>

#define LAS __attribute__((address_space(3)))
typedef unsigned short bf16_t;
typedef float f32x4 __attribute__((ext_vector_type(4)));
typedef unsigned u32x4 __attribute__((ext_vector_type(4)));
typedef unsigned u32x2 __attribute__((ext_vector_type(2)));

#ifndef MK_ONE_LAUNCH
#define MK_ONE_LAUNCH 1
#endif

constexpr int D = 2048, SEQ = 8192, NB = 2, NTOK = NB * SEQ;
constexpr int NMETA = 16, INW = 4608, MROWS = NTOK + 256;
constexpr int NE = 64, DE = 512, PMAX = 147456, HBROWS = PMAX + NTOK;
constexpr float ALPHA = 1.189207115002721f;
constexpr float LN_EPS = 1e-5f, RMS_EPS = 1e-6f, LOG2E = 1.4426950408889634f, QSCALE = 0.125f * LOG2E;
constexpr int COL_QA = 0, COL_KA = 1024, COL_VA = 1280, COL_QB = 1536, COL_KB = 2560, COL_VB = 3584;
constexpr int NPHASE = 9;
constexpr int LDS_BYTES = 147456;

constexpr size_t WS_CTL = 0, CTL_BYTES = 32768;
constexpr size_t WS_CNT = 16384;
constexpr size_t WS_STATS0 = WS_CTL + CTL_BYTES;
constexpr size_t WS_STATS1 = WS_STATS0 + (size_t)NTOK * 8;
constexpr size_t WS_SSQ = WS_STATS1 + (size_t)NTOK * 8;
constexpr size_t WS_TOKL = WS_SSQ + (size_t)NTOK * 32 * 4;
constexpr size_t WS_WL = WS_TOKL + (size_t)NE * NTOK * 4;
constexpr size_t WS_TKE = WS_WL + (size_t)NE * NTOK * 4;
constexpr size_t WS_TKR = WS_TKE + (size_t)NTOK * 8 * 4;
constexpr size_t WS_TAB = WS_TKR + (size_t)NTOK * 8 * 4;
constexpr size_t WS_Z = WS_TAB + 32768;
constexpr size_t WS_WTD = WS_Z + (size_t)NTOK * D * 4;
constexpr size_t WS_HB = WS_WTD + (size_t)65 * 2048 * 512 * 2;
constexpr size_t WS_B = WS_HB + (size_t)HBROWS * 512 * 2;
constexpr size_t WS_WTGU = WS_B;
constexpr size_t WS_WTIN = WS_WTGU + (size_t)65 * 1024 * 2048 * 2;
constexpr size_t WS_WTOUT = WS_WTIN + (size_t)INW * D * 2;
constexpr size_t WS_H0 = WS_WTOUT + (size_t)D * D * 2;
constexpr size_t WS_U = WS_H0 + (size_t)MROWS * D * 2;
constexpr size_t WS_YA = WS_U + (size_t)MROWS * INW * 2;
constexpr size_t WS_H1 = WS_U;
constexpr size_t WS_YM = WS_B;
constexpr size_t WS_END_A = WS_YA + (size_t)NTOK * D * 2, WS_END_B = WS_YM + (size_t)PMAX * D * 2;
constexpr size_t WS_END = WS_END_A > WS_END_B ? WS_END_A : WS_END_B;
static_assert(WS_END <= ((size_t)1 << 30), "workspace map must fit 1 GiB");

__device__ __forceinline__ float bf2f(bf16_t b) { return __uint_as_float(((unsigned)b) << 16); }
__device__ __forceinline__ bf16_t f2bf(float f) { unsigned u = __float_as_uint(f); u += 0x7FFFu + ((u >> 16) & 1u); return (bf16_t)(u >> 16); }
__device__ __forceinline__ unsigned pack2(float lo, float hi) { return (unsigned)f2bf(lo) | ((unsigned)f2bf(hi) << 16); }
__device__ __forceinline__ float wsum(float v) {
#pragma unroll
    for (int o = 32; o >= 1; o >>= 1) v += __shfl_xor(v, o);
    return v; }
__device__ __forceinline__ float wmax(float v) {
#pragma unroll
    for (int o = 32; o >= 1; o >>= 1) v = fmaxf(v, __shfl_xor(v, o));
    return v; }
__device__ __forceinline__ int t5_bucket(int rel) {
    const int ret = rel > 0 ? 16 : 0, n = rel < 0 ? -rel : rel;
    if (n < 8) return ret + n;
    const int n2 = n > 32768 ? 0x40000000 : n * n; int lg = 31 - __clz(n2) + 2; if (lg > 15) lg = 15;
    return ret + lg; }

#define XB_TMO      128
#define XB_XCNT(j)  (256  + 64 * (j))
#define XB_XSUB(j)  (1280 + 64 * (j))
#define XB_XGEN(j)  (2304 + 64 * (j))
#define XB_TOP      3328
#define XB_TOPGEN   3392
#define XCD_BAR_WORDS 3456
#define XB_SPIN_CAP (1u << 18)
__device__ __forceinline__ unsigned xb_ld(unsigned* p)              { return __hip_atomic_load(p, __ATOMIC_RELAXED, __HIP_MEMORY_SCOPE_AGENT); }
__device__ __forceinline__ unsigned xb_add(unsigned* p, unsigned v) { return __hip_atomic_fetch_add(p, v, __ATOMIC_RELAXED, __HIP_MEMORY_SCOPE_AGENT); }
__device__ __forceinline__ unsigned xb_xcc_id() { return (unsigned)__builtin_amdgcn_s_getreg((3 << 11) | 20) & 0xFu; }
#define XB_SPIN(cond, bar) do { unsigned _sp = 0; while (cond) { __builtin_amdgcn_s_sleep(1); \
    if ((++_sp & 255u) == 0u) { if (xb_ld(&(bar)[XB_TMO])) break; if (_sp > XB_SPIN_CAP) { atomicAdd(&(bar)[XB_TMO], 1u); break; } } } } while (0)
struct XcdBarrier { unsigned* bar; unsigned x; volatile LAS unsigned* st; };
__device__ __forceinline__ XcdBarrier xcd_barrier_post(unsigned* bar, volatile LAS unsigned* st) {
    XcdBarrier b; b.bar = bar; b.x = xb_xcc_id(); b.st = st;
    if (threadIdx.x == 0) (void)xb_add(&bar[XB_XCNT(b.x)], 1u);
    return b;
}
__device__ __forceinline__ void xcd_barrier_complete(unsigned* bar, unsigned x, unsigned& nloc, unsigned& nx) {
    const unsigned G = gridDim.x * gridDim.y * gridDim.z;
    unsigned sum, cnt, mine, sp = 0u;
    for (;;) {
        sum = 0u; cnt = 0u; mine = 0u;
#pragma unroll
        for (unsigned j = 0; j < 16; ++j) { const unsigned c = xb_ld(&bar[XB_XCNT(j)]); sum += c; cnt += (c > 0u) ? 1u : 0u; mine = (j == x) ? c : mine; }
        if (sum == G) break;
        __builtin_amdgcn_s_sleep(1);
        if ((++sp & 255u) == 0u) { if (xb_ld(&bar[XB_TMO])) break; if (sp > XB_SPIN_CAP) { atomicAdd(&bar[XB_TMO], 1u); break; } }
    }
    nloc = mine > 0u ? mine : 1u; nx = cnt > 0u ? cnt : 1u;
}
__device__ __forceinline__ void xcd_barrier(const XcdBarrier& b) {
    asm volatile("s_waitcnt vmcnt(0)" ::: "memory");
    __syncthreads();
    if (threadIdx.x == 0) {
        unsigned* bar = b.bar;
        __builtin_amdgcn_s_waitcnt(0);
        unsigned nloc = b.st[0], nx = b.st[1];
        if (nloc == 0u) { xcd_barrier_complete(bar, b.x, nloc, nx); b.st[0] = nloc; b.st[1] = nx; }
        const unsigned old = xb_add(&bar[XB_XSUB(b.x)], 1u);
        const unsigned gen = old / nloc;
        if (old + 1u == (gen + 1u) * nloc) {
            __builtin_amdgcn_fence(__ATOMIC_RELEASE, "agent");
            asm volatile("s_waitcnt vmcnt(0)" ::: "memory");
            const unsigned og = xb_add(&bar[XB_TOP], 1u);
            const unsigned tg = og / nx;
            if (og + 1u == (tg + 1u) * nx) xb_add(&bar[XB_TOPGEN], 1u);
            else XB_SPIN(xb_ld(&bar[XB_TOPGEN]) == tg, bar);
            __builtin_amdgcn_fence(__ATOMIC_ACQUIRE, "agent");
            xb_add(&bar[XB_XGEN(b.x)], 1u);
            asm volatile("s_waitcnt vmcnt(0)" ::: "memory");
        } else {
            XB_SPIN(xb_ld(&bar[XB_XGEN(b.x)]) == gen, bar);
            __builtin_amdgcn_fence(__ATOMIC_ACQUIRE, "agent");
            asm volatile("s_waitcnt vmcnt(0)" ::: "memory");
        }
    }
    __syncthreads();
}

struct Args { const float* in[23]; float* out; unsigned char* ws; int ph_lo, ph_hi; };
struct Frame {
    LAS unsigned char* lds; int tid, lane, wave, G, bx;
    const float *x, *meta, *lng, *lnb, *t5, *w_in, *sink, *rpb, *ga, *gb, *w_out, *l1g, *l1b, *w_router, *rbias, *w_gate, *w_up, *w_down, *ws_gate, *ws_up, *ws_down, *l2g, *l2b;
    float* out; unsigned char* ws;
    float *stats0, *stats1, *ssq, *wl, *tab, *z; int *cnt, *tokl, *tke, *tkr;
    bf16_t *wtd, *hb, *wtgu, *wtin, *wtout, *h0, *u, *ya, *h1, *ym;
};

__device__ __forceinline__ void transpose_tile(const float* src, size_t ld_src, bf16_t* dst, size_t ld_dst, LAS float* t, int tid, const float* kscale, float cscale) {
#pragma unroll
    for (int p = 0; p < 8; ++p) { const int k = p * 8 + (tid >> 6); float v = src[(size_t)k * ld_src + (tid & 63)]; if (kscale) v *= kscale[k]; t[k * 65 + (tid & 63)] = v * cscale; }
    __syncthreads();
#pragma unroll
    for (int p = 0; p < 4; ++p) { const int n = p * 16 + (tid >> 5), k = (tid & 31) * 2; *(unsigned*)(dst + (size_t)n * ld_dst + k) = pack2(t[k * 65 + n], t[(k + 1) * 65 + n]); }
    __syncthreads();
}
__device__ __forceinline__ void phase_prologue(Frame& F) {
    LAS float* t = (LAS float*)F.lds;
    constexpr int T_IN = 72 * 32, T_OUT = 32 * 32, T_GU = 65 * 2 * 8 * 32, T_D = 65 * 32 * 8, T_ALL = T_IN + T_OUT + T_GU + T_D;
    for (int it = F.bx; it < T_ALL; it += F.G) {
        int r = it;
        if (r < T_IN) { const int tn = r % 72, tk = r / 72; const int n0 = tn * 64; const bool isq = (n0 < COL_KA) || (n0 >= COL_QB && n0 < COL_KB);
            transpose_tile(F.w_in + (size_t)(tk * 64) * INW + n0, INW, F.wtin + (size_t)n0 * D + tk * 64, D, t, F.tid, nullptr, isq ? QSCALE : 1.0f); continue; }
        r -= T_IN;
        if (r < T_OUT) { const int tn = r % 32, tk = r / 32; const int k0 = tk * 64;
            transpose_tile(F.w_out + (size_t)k0 * D + tn * 64, D, F.wtout + (size_t)(tn * 64) * D + k0, D, t, F.tid, k0 < 1024 ? F.ga + k0 : F.gb + (k0 - 1024), 1.0f); continue; }
        r -= T_OUT;
        if (r < T_GU) { const int tk = r % 32, tn = (r / 32) % 8, which = (r / 256) % 2, e = r / 512;
            const float* src = e < NE ? (which ? F.w_up : F.w_gate) + (size_t)e * D * DE : (which ? F.ws_up : F.ws_gate);
            const int c0 = tn * 64, nprime = 256 * (c0 / 128) + 128 * which + (c0 % 128);
            transpose_tile(src + (size_t)(tk * 64) * DE + c0, DE, F.wtgu + ((size_t)e * 1024 + nprime) * D + tk * 64, D, t, F.tid, nullptr, 1.0f); continue; }
        r -= T_GU;
        { const int tk = r % 8, tn = (r / 8) % 32, e = r / 256;
            const float* src = e < NE ? F.w_down + (size_t)e * DE * D : F.ws_down;
            transpose_tile(src + (size_t)(tk * 64) * D + tn * 64, D, F.wtd + ((size_t)e * D + tn * 64) * DE + tk * 64, DE, t, F.tid, nullptr, 1.0f); }
    }
    const int gw = F.bx * 8 + F.wave, NGW = F.G * 8;
    for (int row = gw; row < MROWS; row += NGW) {
        bf16_t* dst = F.h0 + (size_t)row * D;
        if (row >= NTOK + NMETA) {
#pragma unroll
            for (int j = 0; j < 8; ++j) *(u32x2*)(dst + (j * 64 + F.lane) * 4) = (u32x2){0u, 0u};
            continue; }
        const float* src = row < NTOK ? F.x + (size_t)row * D : F.meta + (size_t)(row - NTOK) * D;
        f32x4 v[8]; float s = 0.f;
#pragma unroll
        for (int j = 0; j < 8; ++j) { v[j] = *(const f32x4*)(src + (j * 64 + F.lane) * 4); s += (v[j][0] + v[j][1]) + (v[j][2] + v[j][3]); }
        const float mu = wsum(s) * (1.0f / D); float q = 0.f;
#pragma unroll
        for (int j = 0; j < 8; ++j) { const f32x4 d = v[j] - mu; q += (d[0] * d[0] + d[1] * d[1]) + (d[2] * d[2] + d[3] * d[3]); }
        const float rstd = 1.0f / sqrtf(wsum(q) * (1.0f / D) + LN_EPS);
#pragma unroll
        for (int j = 0; j < 8; ++j) { const int c = (j * 64 + F.lane) * 4; const f32x4 g = *(const f32x4*)(F.lng + c), b = *(const f32x4*)(F.lnb + c); const f32x4 y = (v[j] - mu) * rstd * g + b;
            *(u32x2*)(dst + c) = (u32x2){pack2(y[0], y[1]), pack2(y[2], y[3])}; }
        if (row < NTOK && F.lane == 0) { F.stats0[row * 2] = mu; F.stats0[row * 2 + 1] = rstd; }
    }
    if (F.bx == 0) for (int i = F.tid; i < 16 * 272; i += 512) { const int h = i / 272, r = i % 272; F.tab[i] = r <= 256 ? F.t5[t5_bucket(r - 128) * 16 + h] * LOG2E : 0.f; }
}

template <class Fn> __device__ __forceinline__ void sgemm(const Fn& f, LAS unsigned char* ldsb, int tid, int bx, int G) {
    LAS float* As = (LAS float*)ldsb; LAS float* Bs = As + 32 * 132; LAS float* Bs2 = Bs + 32 * 68;
    const int ntm = f.ntm(), ntn = f.ntn(), K = f.K();
    const int tx = tid & 15, ty = tid >> 4, ar = tid >> 2, akc = (tid & 3) * 8, br = (tid & 255) >> 2;
    for (int tile = bx; tile < ntm * ntn; tile += G) {
        const int tm = tile / ntn, tn = tile % ntn;
        typename Fn::Tile T; if (!f.tile(tm, T)) continue;
        float acc[4][4], acc2[4][4];
#pragma unroll
        for (int i = 0; i < 4; ++i)
#pragma unroll
            for (int j = 0; j < 4; ++j) { acc[i][j] = 0.f; acc2[i][j] = 0.f; }
        const bf16_t* ap = f.arow(T, tm * 128 + ar);
        const bf16_t* bp = tid < 256 ? f.brow(T, tn * 64 + br) : (Fn::DUAL ? f.brow2(T, tn * 64 + br) : nullptr);
        LAS float* Bw = tid < 256 ? Bs : Bs2;
        for (int k0 = 0; k0 < K; k0 += 32) {
            u32x4 av = (u32x4){0u, 0u, 0u, 0u}, bv = (u32x4){0u, 0u, 0u, 0u};
            if (ap) av = *(const u32x4*)(ap + k0 + akc);
            if (bp) bv = *(const u32x4*)(bp + k0 + akc);
            __syncthreads();
#pragma unroll
            for (int i = 0; i < 4; ++i) { As[(akc + 2 * i) * 132 + ar] = __uint_as_float(av[i] << 16); As[(akc + 2 * i + 1) * 132 + ar] = __uint_as_float(av[i] & 0xffff0000u); }
            if (tid < 256 || Fn::DUAL) {
#pragma unroll
                for (int i = 0; i < 4; ++i) { Bw[(akc + 2 * i) * 68 + br] = __uint_as_float(bv[i] << 16); Bw[(akc + 2 * i + 1) * 68 + br] = __uint_as_float(bv[i] & 0xffff0000u); } }
            __syncthreads();
#pragma unroll 8
            for (int kk = 0; kk < 32; ++kk) {
                const f32x4 a = *(const LAS f32x4*)(As + kk * 132 + ty * 4), b = *(const LAS f32x4*)(Bs + kk * 68 + tx * 4);
#pragma unroll
                for (int i = 0; i < 4; ++i)
#pragma unroll
                    for (int j = 0; j < 4; ++j) acc[i][j] += a[i] * b[j];
                if (Fn::DUAL) { const f32x4 b2 = *(const LAS f32x4*)(Bs2 + kk * 68 + tx * 4);
#pragma unroll
                    for (int i = 0; i < 4; ++i)
#pragma unroll
                        for (int j = 0; j < 4; ++j) acc2[i][j] += a[i] * b2[j]; }
            }
        }
#pragma unroll
        for (int i = 0; i < 4; ++i)
#pragma unroll
            for (int j = 0; j < 4; ++j) f.store(T, tm * 128 + ty * 4 + i, tn * 64 + tx * 4 + j, acc[i][j], acc2[i][j]);
    }
}

__device__ __forceinline__ void expert_starts(const Frame& F, LAS int* ps  ) {
    if (F.tid == 0) { int acc = 0; for (int e = 0; e < NE; ++e) { ps[e] = acc; acc += ((F.cnt[e] + 255) >> 8) << 8; } ps[64] = acc; }
    __syncthreads();
}

struct FnInProj {
    static constexpr bool DUAL = false; struct Tile {}; const Frame& F;
    __device__ int ntm() const { return MROWS / 128; } __device__ int ntn() const { return INW / 64; } __device__ int K() const { return D; }
    __device__ bool tile(int, Tile&) const { return true; }
    __device__ const bf16_t* arow(const Tile&, int row) const { return F.h0 + (size_t)row * D; }
    __device__ const bf16_t* brow(const Tile&, int n) const { return F.wtin + (size_t)n * D; }
    __device__ const bf16_t* brow2(const Tile&, int) const { return nullptr; }
    __device__ void store(const Tile&, int row, int n, float a, float) const { F.u[(size_t)row * INW + n] = f2bf(a); }
};
struct FnOutProj {
    static constexpr bool DUAL = false; struct Tile {}; const Frame& F;
    __device__ int ntm() const { return NTOK / 128; } __device__ int ntn() const { return D / 64; } __device__ int K() const { return D; }
    __device__ bool tile(int, Tile&) const { return true; }
    __device__ const bf16_t* arow(const Tile&, int row) const { return F.ya + (size_t)row * D; }
    __device__ const bf16_t* brow(const Tile&, int n) const { return F.wtout + (size_t)n * D; }
    __device__ const bf16_t* brow2(const Tile&, int) const { return nullptr; }
    __device__ void store(const Tile&, int row, int n, float a, float) const {
        const float h0 = (F.x[(size_t)row * D + n] - F.stats0[row * 2]) * F.stats0[row * 2 + 1] * F.lng[n] + F.lnb[n];
        F.z[(size_t)row * D + n] = a + ALPHA * h0; }
};
struct FnGateUp {
    static constexpr bool DUAL = true; struct Tile { int e, r0, n; }; const Frame& F; const LAS int* ps;
    __device__ int ntm() const { return HBROWS / 128; } __device__ int ntn() const { return DE / 64; } __device__ int K() const { return D; }
    __device__ bool tile(int tm, Tile& T) const { const int row0 = tm * 128;
        if (row0 >= PMAX) { T.e = NE; T.r0 = row0 - PMAX; T.n = NTOK; return true; }
        if (row0 >= ps[64]) return false;
        int e = 0; while (e < NE - 1 && row0 >= ps[e + 1]) ++e;
        T.e = e; T.r0 = row0 - ps[e]; T.n = F.cnt[e]; return T.r0 < T.n; }
    __device__ const bf16_t* arow(const Tile& T, int row) const { const int r = T.r0 + (row & 127); if (r >= T.n) return nullptr;
        const int tok = T.e < NE ? F.tokl[(size_t)T.e * NTOK + r] : r; return F.h1 + (size_t)tok * D; }
    __device__ const bf16_t* brow(const Tile& T, int n) const { return F.wtgu + ((size_t)T.e * 1024 + 256 * (n >> 7) + (n & 127)) * D; }
    __device__ const bf16_t* brow2(const Tile& T, int n) const { return F.wtgu + ((size_t)T.e * 1024 + 256 * (n >> 7) + 128 + (n & 127)) * D; }
    __device__ void store(const Tile&, int row, int n, float g, float u) const { F.hb[(size_t)row * DE + n] = f2bf(g / (1.0f + __expf(-g)) * u); }
};
struct FnDown {
    static constexpr bool DUAL = false; struct Tile { int e, r0, n; }; const Frame& F; const LAS int* ps;
    __device__ int ntm() const { return PMAX / 128; } __device__ int ntn() const { return D / 64; } __device__ int K() const { return DE; }
    __device__ bool tile(int tm, Tile& T) const { const int row0 = tm * 128; if (row0 >= ps[64]) return false;
        int e = 0; while (e < NE - 1 && row0 >= ps[e + 1]) ++e;
        T.e = e; T.r0 = row0 - ps[e]; T.n = F.cnt[e]; return T.r0 < T.n; }
    __device__ const bf16_t* arow(const Tile&, int row) const { return F.hb + (size_t)row * DE; }
    __device__ const bf16_t* brow(const Tile& T, int n) const { return F.wtd + ((size_t)T.e * D + n) * DE; }
    __device__ const bf16_t* brow2(const Tile&, int) const { return nullptr; }
    __device__ void store(const Tile& T, int row, int n, float a, float) const { const int r = T.r0 + (row & 127);
        const float w = r < T.n ? F.wl[(size_t)T.e * NTOK + r] : 0.f; F.ym[(size_t)row * D + n] = f2bf(a * w); }
};
struct FnFinal {
    static constexpr bool DUAL = false; struct Tile {}; const Frame& F; const LAS int* ps;
    __device__ int ntm() const { return NTOK / 128; } __device__ int ntn() const { return D / 64; } __device__ int K() const { return DE; }
    __device__ bool tile(int, Tile&) const { return true; }
    __device__ const bf16_t* arow(const Tile&, int row) const { return F.hb + (size_t)(PMAX + row) * DE; }
    __device__ const bf16_t* brow(const Tile&, int n) const { return F.wtd + ((size_t)NE * D + n) * DE; }
    __device__ const bf16_t* brow2(const Tile&, int) const { return nullptr; }
    __device__ void store(const Tile&, int row, int n, float a, float) const {
        const float h1 = (F.z[(size_t)row * D + n] - F.stats1[row * 2]) * F.stats1[row * 2 + 1] * F.l1g[n] + F.l1b[n];
        F.out[(size_t)row * D + n] = a + ALPHA * h1; }
};

__device__ __forceinline__ void phase_attn_simple(Frame& F) {
    LAS float* qs = (LAS float*)F.lds + F.wave * 512; LAS float* psm = qs + 64;
    const int gw = F.bx * 8 + F.wave, NGW = F.G * 8, lane = F.lane;
    for (int item = gw; item < NTOK * 32; item += NGW) {
        const int tok = item >> 5, hh = item & 31, b = tok >> 13, s = tok & 8191;
        const bool isA = hh < 16; const int h = hh & 15;
        const int qcol = isA ? COL_QA + h * 64 : COL_QB + h * 64, kcol = isA ? COL_KA + (h >> 2) * 64 : COL_KB + h * 64, vcol = isA ? COL_VA + (h >> 2) * 64 : COL_VB + h * 64;
        const int r = s >> 6, c = s & 63, rs = min(max(r - 4, 0), 120), cs = min(max(c - 8, 0), 48);
        const int nkeys = isA ? 16 + 257 : 16 + 128;
        asm volatile("s_waitcnt lgkmcnt(0)" ::: "memory");
        qs[lane] = bf2f(F.u[(size_t)tok * INW + qcol + lane]);
        asm volatile("s_waitcnt lgkmcnt(0)" ::: "memory");
        float sc[5]; float mx = -INFINITY;
#pragma unroll
        for (int i = 0; i < 5; ++i) {
            const int j = lane + 64 * i; sc[i] = -INFINITY;
            if (j < nkeys) {
                int krow; float bias; bool valid = true;
                if (j < 16) { krow = NTOK + j; bias = isA ? F.t5[t5_bucket(j - 16 - s) * 16 + h] * LOG2E : 0.f; }
                else if (isA) { const int kpos = s - 128 + (j - 16); valid = kpos >= 0 && kpos < SEQ; krow = b * SEQ + kpos; bias = F.tab[h * 272 + (j - 16)]; }
                else { const int w = j - 16, kr = rs + (w >> 4), kc = cs + (w & 15); krow = b * SEQ + kr * 64 + kc; bias = F.rpb[(h * 15 + (kr - r + 7)) * 31 + (kc - c + 15)] * LOG2E; }
                if (valid) { const bf16_t* kp = F.u + (size_t)krow * INW + kcol; float dot = 0.f;
#pragma unroll
                    for (int d8 = 0; d8 < 8; ++d8) { const u32x4 kv = *(const u32x4*)(kp + d8 * 8);
#pragma unroll
                        for (int i2 = 0; i2 < 4; ++i2) { dot += qs[d8 * 8 + 2 * i2] * __uint_as_float(kv[i2] << 16); dot += qs[d8 * 8 + 2 * i2 + 1] * __uint_as_float(kv[i2] & 0xffff0000u); } }
                    sc[i] = dot + bias; }
            }
            mx = fmaxf(mx, sc[i]);
        }
        const float sinkl = isA ? F.sink[h] * LOG2E : -INFINITY;
        mx = fmaxf(wmax(mx), sinkl);
        float l = 0.f;
#pragma unroll
        for (int i = 0; i < 5; ++i) { const int j = lane + 64 * i; const float p = sc[i] == -INFINITY ? 0.f : exp2f(sc[i] - mx); l += p; if (j < 320) psm[j] = p; }
        l = wsum(l) + (isA ? exp2f(sinkl - mx) : 0.f);
        asm volatile("s_waitcnt lgkmcnt(0)" ::: "memory");
        float o = 0.f;
        for (int j = 0; j < nkeys; ++j) { const float p = psm[j]; if (p == 0.f) continue;
            int krow; if (j < 16) krow = NTOK + j; else if (isA) krow = b * SEQ + s - 128 + (j - 16); else { const int w = j - 16; krow = b * SEQ + (rs + (w >> 4)) * 64 + cs + (w & 15); }
            o += p * bf2f(F.u[(size_t)krow * INW + vcol + lane]); }
        o /= l;
        const bf16_t ob = f2bf(o); F.ya[(size_t)tok * D + hh * 64 + lane] = ob;
        const float of = bf2f(ob), q = wsum(of * of);
        if (lane == 0) F.ssq[tok * 32 + hh] = q;
    }
}
__device__ __forceinline__ void phase_rmsnorm(Frame& F) {
    const int gw = F.bx * 8 + F.wave, NGW = F.G * 8, lane = F.lane;
    for (int tok = gw; tok < NTOK; tok += NGW) {
        const float q = lane < 32 ? F.ssq[tok * 32 + lane] : 0.f;
        float qa = lane < 16 ? q : 0.f, qb = (lane >= 16 && lane < 32) ? q : 0.f; qa = wsum(qa); qb = wsum(qb);
        const float ra = 1.0f / sqrtf(qa * (1.0f / 1024.f) + RMS_EPS), rb = 1.0f / sqrtf(qb * (1.0f / 1024.f) + RMS_EPS);
        bf16_t* p = F.ya + (size_t)tok * D;
#pragma unroll
        for (int j = 0; j < 8; ++j) { const int c = (j * 64 + lane) * 4; const float rr = c < 1024 ? ra : rb; u32x2 w = *(u32x2*)(p + c);
            w.x = pack2(__uint_as_float(w.x << 16) * rr, __uint_as_float(w.x & 0xffff0000u) * rr); w.y = pack2(__uint_as_float(w.y << 16) * rr, __uint_as_float(w.y & 0xffff0000u) * rr); *(u32x2*)(p + c) = w; }
    }
}

__device__ __forceinline__ void phase_ln1_router(Frame& F) {
    LAS float* hs = (LAS float*)F.lds + F.wave * 2048;
    const int gw = F.bx * 8 + F.wave, NGW = F.G * 8, lane = F.lane;
    for (int tok = gw; tok < NTOK; tok += NGW) {
        const float* src = F.z + (size_t)tok * D; f32x4 v[8]; float s = 0.f;
#pragma unroll
        for (int j = 0; j < 8; ++j) { v[j] = *(const f32x4*)(src + (j * 64 + lane) * 4); s += (v[j][0] + v[j][1]) + (v[j][2] + v[j][3]); }
        const float mu = wsum(s) * (1.0f / D); float q = 0.f;
#pragma unroll
        for (int j = 0; j < 8; ++j) { const f32x4 d = v[j] - mu; q += (d[0] * d[0] + d[1] * d[1]) + (d[2] * d[2] + d[3] * d[3]); }
        const float rstd = 1.0f / sqrtf(wsum(q) * (1.0f / D) + LN_EPS);
        asm volatile("s_waitcnt lgkmcnt(0)" ::: "memory");
#pragma unroll
        for (int j = 0; j < 8; ++j) { const int c = (j * 64 + lane) * 4; const f32x4 g = *(const f32x4*)(F.l1g + c), bb = *(const f32x4*)(F.l1b + c); const f32x4 y = (v[j] - mu) * rstd * g + bb;
            *(u32x2*)(F.h1 + (size_t)tok * D + c) = (u32x2){pack2(y[0], y[1]), pack2(y[2], y[3])}; *(LAS f32x4*)(hs + c) = y; }
        if (lane == 0) { F.stats1[tok * 2] = mu; F.stats1[tok * 2 + 1] = rstd; }
        asm volatile("s_waitcnt lgkmcnt(0)" ::: "memory");
        float lg = 0.f;
#pragma unroll 8
        for (int n = 0; n < D; ++n) lg += hs[n] * F.w_router[(size_t)n * NE + lane];
        const float score = 1.0f / (1.0f + expf(-lg)), v0 = score + F.rbias[lane];
        int rk = 0;
#pragma unroll
        for (int j = 0; j < 8; ++j) { const int o = (lane & ~7) + j; const float w = __shfl(v0, o); rk += (w > v0 || (w == v0 && o < lane)) ? 1 : 0; }
        float gs = rk < 2 ? v0 : 0.f; gs += __shfl_xor(gs, 1); gs += __shfl_xor(gs, 2); gs += __shfl_xor(gs, 4);
        int grk = 0; const int myg = lane >> 3;
#pragma unroll
        for (int g = 0; g < 8; ++g) { const float w = __shfl(gs, g * 8); grk += (w > gs || (w == gs && g < myg)) ? 1 : 0; }
        const float mv = grk < 4 ? v0 : -INFINITY;
        int erk = 0;
        for (int o = 0; o < 64; ++o) { const float w = __shfl(mv, o); erk += (w > mv || (w == mv && o < lane)) ? 1 : 0; }
        const bool sel = erk < 8;
        const float wsm = wsum(sel ? score : 0.f), wgt = score / (wsm + 1e-20f) * 2.5f;
        if (sel) { const int rr = atomicAdd(F.cnt + lane, 1); F.tokl[(size_t)lane * NTOK + rr] = tok; F.wl[(size_t)lane * NTOK + rr] = wgt; F.tke[tok * 8 + erk] = lane; F.tkr[tok * 8 + erk] = rr; }
    }
}
__device__ __forceinline__ void phase_ln2(Frame& F, const LAS int* ps) {
    const int gw = F.bx * 8 + F.wave, NGW = F.G * 8, lane = F.lane;
    for (int tok = gw; tok < NTOK; tok += NGW) {
        float* src = F.out + (size_t)tok * D; f32x4 v[8]; float s = 0.f;
#pragma unroll
        for (int j = 0; j < 8; ++j) v[j] = *(const f32x4*)(src + (j * 64 + lane) * 4);
        const int mye = F.tke[tok * 8 + (lane & 7)], myr = F.tkr[tok * 8 + (lane & 7)], mypos = ps[mye] + myr;
#pragma unroll
        for (int k = 0; k < 8; ++k) { const int p = __shfl(mypos, k); const bf16_t* yp = F.ym + (size_t)p * D;
#pragma unroll
            for (int j = 0; j < 8; ++j) { const u32x2 w = *(const u32x2*)(yp + (j * 64 + lane) * 4);
                v[j][0] += __uint_as_float(w.x << 16); v[j][1] += __uint_as_float(w.x & 0xffff0000u); v[j][2] += __uint_as_float(w.y << 16); v[j][3] += __uint_as_float(w.y & 0xffff0000u); } }
#pragma unroll
        for (int j = 0; j < 8; ++j) s += (v[j][0] + v[j][1]) + (v[j][2] + v[j][3]);
        const float mu = wsum(s) * (1.0f / D); float q = 0.f;
#pragma unroll
        for (int j = 0; j < 8; ++j) { const f32x4 d = v[j] - mu; q += (d[0] * d[0] + d[1] * d[1]) + (d[2] * d[2] + d[3] * d[3]); }
        const float rstd = 1.0f / sqrtf(wsum(q) * (1.0f / D) + LN_EPS);
#pragma unroll
        for (int j = 0; j < 8; ++j) { const int c = (j * 64 + lane) * 4; const f32x4 g = *(const f32x4*)(F.l2g + c), bb = *(const f32x4*)(F.l2b + c); *(f32x4*)(src + c) = (v[j] - mu) * rstd * g + bb; }
    }
}

#ifndef FAST_P1
#define FAST_P1 1
#endif
#ifndef FAST_P4
#define FAST_P4 1
#endif
#ifndef FAST_P6
#define FAST_P6 1
#endif
#ifndef FAST_P7
#define FAST_P7 1
#endif
namespace pg8 {
typedef short bf16x8 __attribute__((ext_vector_type(8)));
constexpr int BM = 256, BK = 64, HALF = 128, HTB = HALF * BK * 2, STAGE_BYTES = 8 * HTB, NXCD = 8, WGM = 8;
__host__ __device__ __forceinline__ int lds_byte(int r, int c) { const int st = (r >> 4) * 2 + (c >> 5), rr = r & 15, cc = c & 31, ob = rr * 64 + cc * 2; return st * 1024 + (ob ^ (((ob >> 9) & 1) << 5)); }
__host__ __device__ __forceinline__ void stage_rc(int b, int& R, int& C) { const int st = b / 1024, sb = b % 1024, swz = sb ^ (((sb >> 9) & 1) << 5); R = (st >> 1) * 16 + swz / 64; C = (st & 1) * 32 + (swz % 64) / 2; }
__host__ __device__ __forceinline__ int perm32(int rho) { const int n = rho >> 4, i = rho & 15; return 8 * (i >> 2) + 4 * n + (i & 3); }
__device__ __forceinline__ unsigned cvt_pk_bf16(float lo, float hi) { unsigned r; asm volatile("v_cvt_pk_bf16_f32 %0, %1, %2" : "=v"(r) : "v"(lo), "v"(hi)); return r; }
struct Unit { int pm, pn, e, r0, n, orow; };
__device__ __forceinline__ int xcd_remap(int L, int nwg) { const int q = nwg / NXCD, r = nwg % NXCD, xcd = L % NXCD, off = L / NXCD; return (xcd < r ? xcd * (q + 1) : r * (q + 1) + (xcd - r) * q) + off; }
__device__ __forceinline__ void tile_of(int wgid, int nM, int nN, int& pm, int& pn) { const int nig = WGM * nN, gid = wgid / nig, fm = gid * WGM, gsz = (nM - fm) < WGM ? (nM - fm) : WGM; pm = fm + ((wgid % nig) % gsz); pn = (wgid % nig) / gsz; }

template <class Epi, class Sched>
__device__ __forceinline__ void gemm_phase(LAS unsigned char* lds, const Sched& S, const Epi& E, const int lda, const int ldb, const int nt) {
    const int tid = threadIdx.x, wid = __builtin_amdgcn_readfirstlane(tid >> 6), lane = tid & 63, wr = wid >> 2, wc = wid & 3, fr = lane & 15, fq = lane >> 4;
    unsigned voffA[2], voffB[2], c2[2]; int RA[2];
#pragma unroll
    for (int i = 0; i < 2; ++i) { int R, C; stage_rc(tid * 16 + i * 8192, R, C); const int Rb = Epi::PERM ? ((R & ~31) + perm32(R & 31)) : R;
        voffA[i] = (unsigned)(R * lda + C) * 2u; voffB[i] = (unsigned)(Rb * ldb + C) * 2u; RA[i] = R; c2[i] = (unsigned)C * 2u; }
    const size_t kstep = (size_t)(BK * 2), hstepA = (size_t)HALF * lda * 2, hstepB = (size_t)HALF * ldb * 2;
    const unsigned lda2 = (unsigned)lda * 2u;
    const unsigned ldsw = (unsigned)wid * 1024u;
    const int aoff = lds_byte(wr * 64 + fr, fq * 8), boff = lds_byte(wc * 32 + fr, fq * 8);
#define PG8_SA(b, h) (((b) * 2 + (h)) * HTB)
#define PG8_SB(b, h) ((4 + (b) * 2 + (h)) * HTB)
#define PG8_STAGE(bufoff, gbase, voff) do { _Pragma("unroll") for (int _i = 0; _i < 2; ++_i) \
        __builtin_amdgcn_global_load_lds((const unsigned*)((const char*)(gbase) + (voff)[_i]), (LAS unsigned*)(lds + (bufoff) + ldsw + _i * 8192), 16, 0, 0); } while (0)
#define PG8_STG_A(bufoff, p, h, V) do { if constexpr (Sched::GATHER) { PG8_STAGE(bufoff, p, V[h]); } else { PG8_STAGE(bufoff, (p) + (h) * hstepA, voffA); } } while (0)
#define PG8_STG_B(bufoff, p, h) PG8_STAGE(bufoff, (p) + (h) * hstepB, voffB)
#define PG8_LDA(dst, b, h) do { _Pragma("unroll") for (int m = 0; m < 4; ++m) _Pragma("unroll") for (int k = 0; k < 2; ++k) dst[m][k] = *(const LAS bf16x8*)(lds + PG8_SA(b, h) + aoff + m * 2048 + k * 1024); } while (0)
#define PG8_LDB(dst, b, h) do { _Pragma("unroll") for (int n = 0; n < 2; ++n) _Pragma("unroll") for (int k = 0; k < 2; ++k) dst[n][k] = *(const LAS bf16x8*)(lds + PG8_SB(b, h) + boff + n * 2048 + k * 1024); } while (0)
#define PG8_MMA(ai, bj, At, Bt) do { __builtin_amdgcn_s_setprio(1); _Pragma("unroll") for (int m = 0; m < 4; ++m) _Pragma("unroll") for (int n = 0; n < 2; ++n) _Pragma("unroll") for (int k = 0; k < 2; ++k) \
        acc[ai][bj][m][n] = __builtin_amdgcn_mfma_f32_16x16x32_bf16(Bt[n][k], At[m][k], acc[ai][bj][m][n], 0, 0, 0); __builtin_amdgcn_s_setprio(0); } while (0)
#define PG8_WAIT_V(n) asm volatile("s_waitcnt vmcnt(" #n ")" ::: "memory")
#define PG8_WAIT_L(n) asm volatile("s_waitcnt lgkmcnt(" #n ")" ::: "memory")
#define PG8_BAR __builtin_amdgcn_s_barrier()
#define PG8_SCHED __builtin_amdgcn_sched_barrier(0)
    Unit cur, nxt; int ui = 0;
    if (!S.next(0, cur)) return;
    f32x4 acc[2][2][4][2];
#pragma unroll
    for (int a = 0; a < 2; ++a)
#pragma unroll
        for (int b = 0; b < 2; ++b)
#pragma unroll
            for (int m = 0; m < 4; ++m)
#pragma unroll
                for (int n = 0; n < 2; ++n) acc[a][b][m][n] = (f32x4){0.f, 0.f, 0.f, 0.f};
    bf16x8 At[4][2], B0[2][2], B1[2][2];
    unsigned vac[2][2], van[2][2]; int raw[2][2];
    const char* cA = S.abase(cur); const char* cB = S.bbase(cur);
#pragma unroll
    for (int h = 0; h < 2; ++h)
#pragma unroll
        for (int i = 0; i < 2; ++i) { vac[h][i] = Sched::GATHER ? (unsigned)S.arow(cur, h * HALF + RA[i]) * lda2 + c2[i] : 0u; van[h][i] = vac[h][i]; raw[h][i] = 0; }
    PG8_STG_B(PG8_SB(0, 0), cB, 0); PG8_STG_B(PG8_SB(0, 1), cB, 1); PG8_STG_A(PG8_SA(0, 0), cA, 0, vac); PG8_STG_A(PG8_SA(0, 1), cA, 1, vac);
    if (wr == 1) PG8_BAR;
    PG8_WAIT_V(2); PG8_BAR;
    PG8_STG_B(PG8_SB(1, 0), cB + kstep, 0); PG8_STG_A(PG8_SA(1, 0), cA + kstep, 0, vac); PG8_STG_B(PG8_SB(1, 1), cB + kstep, 1);
    PG8_WAIT_V(6); PG8_BAR;
    for (;;) {
        const bool has_next = S.next(ui + 1, nxt);
        const char* nA = has_next ? S.abase(nxt) : cA; const char* nB = has_next ? S.bbase(nxt) : cB;
        if constexpr (Sched::GATHER) { if (has_next) {
#pragma unroll
            for (int h = 0; h < 2; ++h)
#pragma unroll
                for (int i = 0; i < 2; ++i) raw[h][i] = S.arow(nxt, h * HALF + RA[i]); } }
        for (int t = 0; t < nt; t += 2) {
            const bool last = (t == nt - 2);
            const char* a1 = cA + (size_t)(t + 1) * kstep;
            const char* a2 = last ? nA : cA + (size_t)(t + 2) * kstep; const char* b2 = last ? nB : cB + (size_t)(t + 2) * kstep;
            const char* a3 = a2 + kstep; const char* b3 = b2 + kstep;
            unsigned va2[2][2];
#pragma unroll
            for (int h = 0; h < 2; ++h)
#pragma unroll
                for (int i = 0; i < 2; ++i) va2[h][i] = last ? van[h][i] : vac[h][i];
            PG8_LDB(B0, 0, 0); PG8_LDB(B1, 0, 1); PG8_SCHED; PG8_LDA(At, 0, 0); PG8_STG_A(PG8_SA(1, 1), a1, 1, vac);
            PG8_WAIT_V(8); PG8_WAIT_L(0); PG8_BAR; PG8_MMA(0, 0, At, B0); PG8_MMA(0, 1, At, B1); PG8_BAR; PG8_SCHED;
            PG8_LDA(At, 0, 1); PG8_STG_B(PG8_SB(0, 0), b2, 0); PG8_STG_B(PG8_SB(0, 1), b2, 1); PG8_STG_A(PG8_SA(0, 0), a2, 0, va2);
            PG8_WAIT_V(8); PG8_WAIT_L(0); PG8_BAR; PG8_MMA(1, 0, At, B0); PG8_MMA(1, 1, At, B1); PG8_BAR; PG8_SCHED;
            PG8_LDB(B0, 1, 0); PG8_LDB(B1, 1, 1); PG8_SCHED; PG8_LDA(At, 1, 0); PG8_STG_A(PG8_SA(0, 1), a2, 1, va2);
            PG8_WAIT_V(8); PG8_WAIT_L(0); PG8_BAR; PG8_MMA(0, 0, At, B0); PG8_MMA(0, 1, At, B1); PG8_BAR; PG8_SCHED;
            PG8_LDA(At, 1, 1); PG8_STG_B(PG8_SB(1, 0), b3, 0); PG8_STG_B(PG8_SB(1, 1), b3, 1); PG8_STG_A(PG8_SA(1, 0), a3, 0, va2);
            PG8_WAIT_V(8); PG8_WAIT_L(0); PG8_BAR; PG8_MMA(1, 0, At, B0); PG8_MMA(1, 1, At, B1); PG8_BAR; PG8_SCHED;
            if constexpr (Sched::GATHER) { if (t + 4 == nt && has_next) {
#pragma unroll
                for (int h = 0; h < 2; ++h)
#pragma unroll
                    for (int i = 0; i < 2; ++i) { asm volatile("" : "+v"(raw[h][i])); van[h][i] = (unsigned)raw[h][i] * lda2 + c2[i]; } } }
        }
        if (wr == 0) PG8_BAR;
        E(acc, cur, wr, wc, fr, fq);
        if (!has_next) break;
#pragma unroll
        for (int a = 0; a < 2; ++a)
#pragma unroll
            for (int b = 0; b < 2; ++b)
#pragma unroll
                for (int m = 0; m < 4; ++m)
#pragma unroll
                    for (int n = 0; n < 2; ++n) acc[a][b][m][n] = (f32x4){0.f, 0.f, 0.f, 0.f};
        cur = nxt; cA = nA; cB = nB; ++ui;
#pragma unroll
        for (int h = 0; h < 2; ++h)
#pragma unroll
            for (int i = 0; i < 2; ++i) vac[h][i] = van[h][i];
        if (wr == 1) PG8_BAR;
    }
    PG8_WAIT_V(0);
    PG8_BAR;
#undef PG8_SA
#undef PG8_SB
#undef PG8_STAGE
#undef PG8_STG_A
#undef PG8_STG_B
#undef PG8_LDA
#undef PG8_LDB
#undef PG8_MMA
#undef PG8_WAIT_V
#undef PG8_WAIT_L
#undef PG8_BAR
#undef PG8_SCHED
}
}

struct SchedInProj {
    static constexpr bool GATHER = false; const char* A; const char* B; int G, c;
    __device__ __forceinline__ bool next(int i, pg8::Unit& u) const { const int L = i * G + c; if (L >= 1162) return false;
        if (L < 1152) pg8::tile_of(pg8::xcd_remap(L, 1152), 64, 18, u.pm, u.pn); else { const int k = L - 1152; u.pm = 64; u.pn = k < 2 ? 4 + k : 8 + k; }
        return true; }
    __device__ __forceinline__ const char* abase(const pg8::Unit& u) const { return A + (size_t)u.pm * 256 * D * 2; }
    __device__ __forceinline__ const char* bbase(const pg8::Unit& u) const { return B + (size_t)u.pn * 256 * D * 2; }
    __device__ __forceinline__ int arow(const pg8::Unit&, int) const { return 0; }
};
struct SchedOutProj {
    static constexpr bool GATHER = false; const char* A; const char* B; int G, c;
    __device__ __forceinline__ bool next(int i, pg8::Unit& u) const { const int L = i * G + c; if (L >= 512) return false; pg8::tile_of(pg8::xcd_remap(L, 512), 64, 8, u.pm, u.pn); return true; }
    __device__ __forceinline__ const char* abase(const pg8::Unit& u) const { return A + (size_t)u.pm * 256 * D * 2; }
    __device__ __forceinline__ const char* bbase(const pg8::Unit& u) const { return B + (size_t)u.pn * 256 * D * 2; }
    __device__ __forceinline__ int arow(const pg8::Unit&, int) const { return 0; }
};
__device__ __forceinline__ void moe_tables(const Frame& F, LAS int* ps, int NN) {
    if (F.tid == 0) { int acc = 0, ua = 0; for (int e = 0; e < NE; ++e) { const int mt = (F.cnt[e] + 255) >> 8; ps[e] = acc; ps[128 + e] = ua; acc += mt * 256; ua += mt * NN; }
        ps[64] = acc; ps[128 + 64] = ua; ps[128 + 65] = ua + (NTOK / 256) * NN; }
    __syncthreads();
}
template <int NN> __device__ __forceinline__ bool moe_unit(const LAS int* ps, const int* cnt, int L, pg8::Unit& u) {
    const int nU = ps[128 + 65]; if (L >= nU) return false;
    const int wg = pg8::xcd_remap(L, nU); int e = 0; while (wg >= ps[128 + e + 1]) ++e;
    const int k = wg - ps[128 + e]; u.e = e; u.pn = k % NN; u.pm = k / NN; u.r0 = u.pm * 256;
    if (e < NE) { u.n = cnt[e]; u.orow = ps[e] + u.r0; } else { u.n = NTOK; u.orow = PMAX + u.r0; }
    return true; }
struct SchedGU {
    static constexpr bool GATHER = true; const char* A; const char* B; const int* tokl; const int* cnt; const LAS int* ps; int G, c;
    __device__ __forceinline__ bool next(int i, pg8::Unit& u) const { return moe_unit<4>(ps, cnt, i * G + c, u); }
    __device__ __forceinline__ const char* abase(const pg8::Unit&) const { return A; }
    __device__ __forceinline__ const char* bbase(const pg8::Unit& u) const { return B + ((size_t)u.e * 1024 + u.pn * 256) * D * 2; }
    __device__ __forceinline__ int arow(const pg8::Unit& u, int r) const { const int rr = min(u.r0 + r, u.n - 1); return u.e < NE ? tokl[(size_t)u.e * NTOK + rr] : rr; }
};
struct SchedDown {
    static constexpr bool GATHER = false; const char* A; const char* B; const int* cnt; const LAS int* ps; int G, c;
    __device__ __forceinline__ bool next(int i, pg8::Unit& u) const { return moe_unit<8>(ps, cnt, i * G + c, u); }
    __device__ __forceinline__ const char* abase(const pg8::Unit& u) const { return A + (size_t)u.orow * DE * 2; }
    __device__ __forceinline__ const char* bbase(const pg8::Unit& u) const { return B + ((size_t)u.e * D + u.pn * 256) * DE * 2; }
    __device__ __forceinline__ int arow(const pg8::Unit&, int) const { return 0; }
};
struct EpiU {
    static constexpr bool PERM = true; bf16_t* U;
    __device__ __forceinline__ void operator()(const f32x4 (&acc)[2][2][4][2], const pg8::Unit& u, int wr, int wc, int fr, int fq) const {
        const int row0 = u.pm * 256 + wr * 64 + fr, col0 = u.pn * 256 + wc * 32 + 8 * fq;
#pragma unroll
        for (int ai = 0; ai < 2; ++ai)
#pragma unroll
            for (int m = 0; m < 4; ++m) { bf16_t* rowp = U + (size_t)(row0 + ai * 128 + m * 16) * INW + col0;
#pragma unroll
                for (int bj = 0; bj < 2; ++bj) { const f32x4 v0 = acc[ai][bj][m][0], v1 = acc[ai][bj][m][1]; u32x4 w;
                    w.x = pg8::cvt_pk_bf16(v0[0], v0[1]); w.y = pg8::cvt_pk_bf16(v0[2], v0[3]); w.z = pg8::cvt_pk_bf16(v1[0], v1[1]); w.w = pg8::cvt_pk_bf16(v1[2], v1[3]);
                    *(u32x4*)(rowp + bj * 128) = w; } }
    }
};
struct EpiZ {
    static constexpr bool PERM = false; float* Z; const float* X; const float* st; const float* g; const float* b;
    __device__ __forceinline__ void operator()(const f32x4 (&acc)[2][2][4][2], const pg8::Unit& u, int wr, int wc, int fr, int fq) const {
        const int row0 = u.pm * 256 + wr * 64 + fr, col0 = u.pn * 256 + wc * 32 + 4 * fq;
        f32x4 gv[2][2], bv[2][2];
#pragma unroll
        for (int bj = 0; bj < 2; ++bj)
#pragma unroll
            for (int n = 0; n < 2; ++n) { gv[bj][n] = *(const f32x4*)(g + col0 + bj * 128 + n * 16) * ALPHA; bv[bj][n] = *(const f32x4*)(b + col0 + bj * 128 + n * 16) * ALPHA; }
#pragma unroll
        for (int ai = 0; ai < 2; ++ai)
#pragma unroll
            for (int m = 0; m < 4; ++m) { const int row = row0 + ai * 128 + m * 16; const float mu = st[row * 2], rs = st[row * 2 + 1]; const size_t off = (size_t)row * D + col0;
#pragma unroll
                for (int bj = 0; bj < 2; ++bj)
#pragma unroll
                    for (int n = 0; n < 2; ++n) { const f32x4 xv = *(const f32x4*)(X + off + bj * 128 + n * 16);
                        *(f32x4*)(Z + off + bj * 128 + n * 16) = acc[ai][bj][m][n] + ((xv - mu) * rs * gv[bj][n] + bv[bj][n]); }
                asm volatile("" ::: "memory"); }
    }
};
__device__ __forceinline__ float silu_mul(float g, float u) { return g * __builtin_amdgcn_rcpf(1.0f + __builtin_amdgcn_exp2f(-g * LOG2E)) * u; }
struct EpiGU {
    static constexpr bool PERM = true; bf16_t* H;
    __device__ __forceinline__ void operator()(const f32x4 (&acc)[2][2][4][2], const pg8::Unit& u, int wr, int wc, int fr, int fq) const {
        const int row0 = u.orow + wr * 64 + fr, col0 = u.pn * 128 + wc * 32 + 8 * fq;
#pragma unroll
        for (int ai = 0; ai < 2; ++ai)
#pragma unroll
            for (int m = 0; m < 4; ++m) { const f32x4 g0 = acc[ai][0][m][0], g1 = acc[ai][0][m][1], u0 = acc[ai][1][m][0], u1 = acc[ai][1][m][1]; u32x4 w;
                w.x = pg8::cvt_pk_bf16(silu_mul(g0[0], u0[0]), silu_mul(g0[1], u0[1])); w.y = pg8::cvt_pk_bf16(silu_mul(g0[2], u0[2]), silu_mul(g0[3], u0[3]));
                w.z = pg8::cvt_pk_bf16(silu_mul(g1[0], u1[0]), silu_mul(g1[1], u1[1])); w.w = pg8::cvt_pk_bf16(silu_mul(g1[2], u1[2]), silu_mul(g1[3], u1[3]));
                *(u32x4*)(H + (size_t)(row0 + ai * 128 + m * 16) * DE + col0) = w; }
    }
};
struct EpiDown {
    static constexpr bool PERM = true; bf16_t* Y; float* O; const float* wl; const float* Z; const float* st; const float* g; const float* b;
    __device__ __forceinline__ void operator()(const f32x4 (&acc)[2][2][4][2], const pg8::Unit& u, int wr, int wc, int fr, int fq) const {
        const int rl0 = wr * 64 + fr, col0 = u.pn * 256 + wc * 32 + 8 * fq;
        if (u.e < NE) {
#pragma unroll
            for (int ai = 0; ai < 2; ++ai)
#pragma unroll
                for (int m = 0; m < 4; ++m) { const int rl = rl0 + ai * 128 + m * 16, r = u.r0 + rl; const float w = r < u.n ? wl[(size_t)u.e * NTOK + r] : 0.f;
                    bf16_t* rowp = Y + (size_t)(u.orow + rl) * D + col0;
#pragma unroll
                    for (int bj = 0; bj < 2; ++bj) { const f32x4 v0 = acc[ai][bj][m][0] * w, v1 = acc[ai][bj][m][1] * w; u32x4 q;
                        q.x = pg8::cvt_pk_bf16(v0[0], v0[1]); q.y = pg8::cvt_pk_bf16(v0[2], v0[3]); q.z = pg8::cvt_pk_bf16(v1[0], v1[1]); q.w = pg8::cvt_pk_bf16(v1[2], v1[3]);
                        *(u32x4*)(rowp + bj * 128) = q; } }
        } else {
            f32x4 gv[2][2], bv[2][2];
#pragma unroll
            for (int bj = 0; bj < 2; ++bj)
#pragma unroll
                for (int n = 0; n < 2; ++n) { gv[bj][n] = *(const f32x4*)(g + col0 + bj * 128 + n * 4) * ALPHA; bv[bj][n] = *(const f32x4*)(b + col0 + bj * 128 + n * 4) * ALPHA; }
#pragma unroll
            for (int ai = 0; ai < 2; ++ai)
#pragma unroll
                for (int m = 0; m < 4; ++m) { const int row = u.r0 + rl0 + ai * 128 + m * 16; const float mu = st[row * 2], rs = st[row * 2 + 1]; const size_t off = (size_t)row * D + col0;
#pragma unroll
                    for (int bj = 0; bj < 2; ++bj)
#pragma unroll
                        for (int n = 0; n < 2; ++n) { const f32x4 zv = *(const f32x4*)(Z + off + bj * 128 + n * 4);
                            *(f32x4*)(O + off + bj * 128 + n * 4) = acc[ai][bj][m][n] + ((zv - mu) * rs * gv[bj][n] + bv[bj][n]); }
                    asm volatile("" ::: "memory"); }
        }
    }
};

__global__ void __launch_bounds__(512, 2) mk_fwd(Args args) {
    extern __shared__ __attribute__((aligned(16))) unsigned char lds_raw[];
    Frame F; F.lds = (LAS unsigned char*)lds_raw; F.tid = threadIdx.x; F.lane = F.tid & 63; F.wave = __builtin_amdgcn_readfirstlane(F.tid >> 6); F.G = gridDim.x; F.bx = blockIdx.x;
    F.x = args.in[0]; F.meta = args.in[1]; F.lng = args.in[2]; F.lnb = args.in[3]; F.t5 = args.in[4]; F.w_in = args.in[5]; F.sink = args.in[6]; F.rpb = args.in[7]; F.ga = args.in[8]; F.gb = args.in[9];
    F.w_out = args.in[10]; F.l1g = args.in[11]; F.l1b = args.in[12]; F.w_router = args.in[13]; F.rbias = args.in[14]; F.w_gate = args.in[15]; F.w_up = args.in[16]; F.w_down = args.in[17];
    F.ws_gate = args.in[18]; F.ws_up = args.in[19]; F.ws_down = args.in[20]; F.l2g = args.in[21]; F.l2b = args.in[22]; F.out = args.out; F.ws = args.ws;
    unsigned char* ws = args.ws;
    F.stats0 = (float*)(ws + WS_STATS0); F.stats1 = (float*)(ws + WS_STATS1); F.ssq = (float*)(ws + WS_SSQ); F.wl = (float*)(ws + WS_WL); F.tab = (float*)(ws + WS_TAB); F.z = (float*)(ws + WS_Z);
    F.cnt = (int*)(ws + WS_CNT); F.tokl = (int*)(ws + WS_TOKL); F.tke = (int*)(ws + WS_TKE); F.tkr = (int*)(ws + WS_TKR);
    F.wtd = (bf16_t*)(ws + WS_WTD); F.hb = (bf16_t*)(ws + WS_HB); F.wtgu = (bf16_t*)(ws + WS_WTGU); F.wtin = (bf16_t*)(ws + WS_WTIN); F.wtout = (bf16_t*)(ws + WS_WTOUT);
    F.h0 = (bf16_t*)(ws + WS_H0); F.u = (bf16_t*)(ws + WS_U); F.ya = (bf16_t*)(ws + WS_YA); F.h1 = (bf16_t*)(ws + WS_H1); F.ym = (bf16_t*)(ws + WS_YM);
    volatile LAS unsigned* xbw = (volatile LAS unsigned*)(F.lds + LDS_BYTES - 16);
    LAS int* ps = (LAS int*)(F.lds + LDS_BYTES - 16 - 1024);
    if (F.tid < 4) xbw[F.tid] = 0u;
    __syncthreads();
    const int lo = args.ph_lo, hi = args.ph_hi;
    XcdBarrier bar; bar.bar = (unsigned*)(ws + WS_CTL); bar.x = 0; bar.st = xbw;
    if (hi - lo > 1) bar = xcd_barrier_post((unsigned*)(ws + WS_CTL), xbw);
#define IN(k) (lo <= (k) && (k) < hi)
#define SEAM(k) do { if (IN(k) && IN((k) + 1)) xcd_barrier(bar); } while (0)
    if (IN(0)) { phase_prologue(F); } SEAM(0);
    if (IN(1)) {
#if FAST_P1
        SchedInProj S{(const char*)F.h0, (const char*)F.wtin, F.G, F.bx}; EpiU E{F.u};
        pg8::gemm_phase(F.lds, S, E, D, D, D / 64);
#else
        FnInProj f{F}; sgemm(f, F.lds, F.tid, F.bx, F.G);
#endif
    } SEAM(1);
    if (IN(2)) { phase_attn_simple(F); } SEAM(2);
    if (IN(3)) { phase_rmsnorm(F); } SEAM(3);
    if (IN(4)) {
#if FAST_P4
        SchedOutProj S{(const char*)F.ya, (const char*)F.wtout, F.G, F.bx}; EpiZ E{F.z, F.x, F.stats0, F.lng, F.lnb};
        pg8::gemm_phase(F.lds, S, E, D, D, D / 64);
#else
        FnOutProj f{F}; sgemm(f, F.lds, F.tid, F.bx, F.G);
#endif
    } SEAM(4);
    if (IN(5)) { phase_ln1_router(F); } SEAM(5);
    if (IN(6)) {
#if FAST_P6
        moe_tables(F, ps, 4);
        SchedGU S{(const char*)F.h1, (const char*)F.wtgu, F.tokl, F.cnt, ps, F.G, F.bx}; EpiGU E{F.hb};
        pg8::gemm_phase(F.lds, S, E, D, D, D / 64);
#else
        expert_starts(F, ps); FnGateUp f{F, ps}; sgemm(f, F.lds, F.tid, F.bx, F.G);
#endif
    } SEAM(6);
    if (IN(7)) {
#if FAST_P7
        moe_tables(F, ps, 8);
        SchedDown S{(const char*)F.hb, (const char*)F.wtd, F.cnt, ps, F.G, F.bx}; EpiDown E{F.ym, F.out, F.wl, F.z, F.stats1, F.l1g, F.l1b};
        pg8::gemm_phase(F.lds, S, E, DE, DE, DE / 64);
#else
        expert_starts(F, ps); { FnDown f{F, ps}; sgemm(f, F.lds, F.tid, F.bx, F.G); } { FnFinal f{F, ps}; sgemm(f, F.lds, F.tid, F.bx, F.G); }
#endif
    } SEAM(7);
    if (IN(8)) { expert_starts(F, ps); phase_ln2(F, ps); }
#undef IN
#undef SEAM
}

extern "C" void kernel_launch(void* const* d_in, const int* in_sizes, int n_in, void* d_out, int out_size, void* d_ws, size_t ws_size, hipStream_t stream) {
    static int grid = 0;
    if (grid == 0) {
        if (n_in != 23 || in_sizes[0] != NTOK * D || out_size != NTOK * D || ws_size < WS_END) {
            fprintf(stderr, "kernel_launch: built for 23 inputs, x/out of %d floats, >= %zu bytes of workspace; got n_in %d in0 %d out %d ws %zu; nothing launched\n", NTOK * D, (size_t)WS_END, n_in, n_in > 0 ? in_sizes[0] : -1, out_size, ws_size);
            grid = -1; return; }
        int dev = 0, cus = 0, per_cu = 0;
        if (hipGetDevice(&dev) != hipSuccess || hipDeviceGetAttribute(&cus, hipDeviceAttributeMultiprocessorCount, dev) != hipSuccess) { fprintf(stderr, "kernel_launch: device query failed\n"); grid = -1; return; }
        if (hipFuncSetAttribute((const void*)mk_fwd, hipFuncAttributeMaxDynamicSharedMemorySize, LDS_BYTES) != hipSuccess) { fprintf(stderr, "kernel_launch: hipFuncSetAttribute failed\n"); grid = -1; return; }
        if (hipOccupancyMaxActiveBlocksPerMultiprocessor(&per_cu, (const void*)mk_fwd, 512, LDS_BYTES) != hipSuccess || per_cu < 1) fprintf(stderr, "kernel_launch: note: occupancy query reports %d\n", per_cu);
        (void)hipGetLastError();
        grid = cus;
    }
    if (grid < 0) return;
    if (hipMemsetAsync((char*)d_ws + WS_CTL, 0, CTL_BYTES, stream) != hipSuccess) { fprintf(stderr, "kernel_launch: memset failed\n"); return; }
    Args a{};
    for (int i = 0; i < 23; ++i) a.in[i] = (const float*)d_in[i];
    a.out = (float*)d_out; a.ws = (unsigned char*)d_ws;
#if MK_ONE_LAUNCH
    a.ph_lo = 0; a.ph_hi = NPHASE;
    hipLaunchKernelGGL(mk_fwd, dim3(grid), dim3(512), LDS_BYTES, stream, a);
#else
    for (int p = 0; p < NPHASE; ++p) { a.ph_lo = p; a.ph_hi = p + 1; hipLaunchKernelGGL(mk_fwd, dim3(grid), dim3(512), LDS_BYTES, stream, a); }
#endif
    const hipError_t le = hipPeekAtLastError();
    if (le != hipSuccess) fprintf(stderr, "kernel_launch: launch failed: %s\n", hipGetErrorName(le));
}
```

```cpp
#include <hip/hip_runtime.h>
#include <cstdio>
#include <cstdint>

#define LAS __attribute__((address_space(3)))
typedef unsigned short bf16_t;
typedef float f32x4 __attribute__((ext_vector_type(4)));
typedef unsigned u32x4 __attribute__((ext_vector_type(4)));
typedef unsigned u32x2 __attribute__((ext_vector_type(2)));

#ifndef MK_ONE_LAUNCH
#define MK_ONE_LAUNCH 1
#endif

constexpr int D = 2048, SEQ = 8192, NB = 2, NTOK = NB * SEQ;
constexpr int NMETA = 16, INW = 4608, MROWS = NTOK + 256;
constexpr int NE = 64, DE = 512, PMAX = 147456, HBROWS = PMAX + NTOK;
constexpr float ALPHA = 1.189207115002721f;
constexpr float LN_EPS = 1e-5f, RMS_EPS = 1e-6f, LOG2E = 1.4426950408889634f, QSCALE = 0.125f * LOG2E;
constexpr int COL_QA = 0, COL_KA = 1024, COL_VA = 1280, COL_QB = 1536, COL_KB = 2560, COL_VB = 3584;
constexpr int NPHASE = 9;
constexpr int LDS_BYTES = 147456;

constexpr size_t WS_CTL = 0, CTL_BYTES = 32768;
constexpr size_t WS_CNT = 16384;
constexpr size_t WS_STATS0 = WS_CTL + CTL_BYTES;
constexpr size_t WS_STATS1 = WS_STATS0 + (size_t)NTOK * 8;
constexpr size_t WS_SSQ = WS_STATS1 + (size_t)NTOK * 8;
constexpr size_t WS_TOKL = WS_SSQ + (size_t)NTOK * 32 * 4;
constexpr size_t WS_WL = WS_TOKL + (size_t)NE * NTOK * 4;
constexpr size_t WS_TKE = WS_WL + (size_t)NE * NTOK * 4;
constexpr size_t WS_TKR = WS_TKE + (size_t)NTOK * 8 * 4;
constexpr size_t WS_TAB = WS_TKR + (size_t)NTOK * 8 * 4;
constexpr size_t WS_WRT = WS_TAB + 32768;
constexpr size_t WS_Z = WS_WRT + (size_t)NE * D * 2;
constexpr size_t WS_WTD = WS_Z + (size_t)NTOK * D * 4;
constexpr size_t WS_HB = WS_WTD + (size_t)65 * 2048 * 512 * 2;
constexpr size_t WS_B = WS_HB + (size_t)HBROWS * 512 * 2;
constexpr size_t WS_WTGU = WS_B;
constexpr size_t WS_WTIN = WS_WTGU + (size_t)65 * 1024 * 2048 * 2;
constexpr size_t WS_WTOUT = WS_WTIN + (size_t)INW * D * 2;
constexpr size_t WS_H0 = WS_WTOUT + (size_t)D * D * 2;
constexpr size_t WS_U = WS_H0 + (size_t)MROWS * D * 2;
constexpr size_t WS_YA = WS_U + (size_t)MROWS * INW * 2;
constexpr size_t WS_H1 = WS_U;
constexpr size_t WS_YM = WS_B;
constexpr size_t WS_END_A = WS_YA + (size_t)NTOK * D * 2, WS_END_B = WS_YM + (size_t)PMAX * D * 2;
constexpr size_t WS_END = WS_END_A > WS_END_B ? WS_END_A : WS_END_B;
static_assert(WS_END <= ((size_t)1 << 30), "workspace map must fit 1 GiB");

__device__ __forceinline__ float bf2f(bf16_t b) { return __uint_as_float(((unsigned)b) << 16); }
__device__ __forceinline__ bf16_t f2bf(float f) { unsigned u = __float_as_uint(f); u += 0x7FFFu + ((u >> 16) & 1u); return (bf16_t)(u >> 16); }
__device__ __forceinline__ unsigned pack2(float lo, float hi) { return (unsigned)f2bf(lo) | ((unsigned)f2bf(hi) << 16); }
__device__ __forceinline__ float wsum(float v) {
#pragma unroll
    for (int o = 32; o >= 1; o >>= 1) v += __shfl_xor(v, o);
    return v; }
__device__ __forceinline__ float wmax(float v) {
#pragma unroll
    for (int o = 32; o >= 1; o >>= 1) v = fmaxf(v, __shfl_xor(v, o));
    return v; }
__device__ __forceinline__ int t5_bucket(int rel) {
    const int ret = rel > 0 ? 16 : 0, n = rel < 0 ? -rel : rel;
    if (n < 8) return ret + n;
    const int n2 = n > 32768 ? 0x40000000 : n * n; int lg = 31 - __clz(n2) + 2; if (lg > 15) lg = 15;
    return ret + lg; }

#define XB_TMO      128
#define XB_XCNT(j)  (256  + 64 * (j))
#define XB_XSUB(j)  (1280 + 64 * (j))
#define XB_XGEN(j)  (2304 + 64 * (j))
#define XB_TOP      3328
#define XB_TOPGEN   3392
#define XCD_BAR_WORDS 3456
#define XB_SPIN_CAP (1u << 18)
__device__ __forceinline__ unsigned xb_ld(unsigned* p)              { return __hip_atomic_load(p, __ATOMIC_RELAXED, __HIP_MEMORY_SCOPE_AGENT); }
__device__ __forceinline__ unsigned xb_add(unsigned* p, unsigned v) { return __hip_atomic_fetch_add(p, v, __ATOMIC_RELAXED, __HIP_MEMORY_SCOPE_AGENT); }
__device__ __forceinline__ unsigned xb_xcc_id() { return (unsigned)__builtin_amdgcn_s_getreg((3 << 11) | 20) & 0xFu; }
#define XB_SPIN(cond, bar) do { unsigned _sp = 0; while (cond) { __builtin_amdgcn_s_sleep(1); \
    if ((++_sp & 255u) == 0u) { if (xb_ld(&(bar)[XB_TMO])) break; if (_sp > XB_SPIN_CAP) { atomicAdd(&(bar)[XB_TMO], 1u); break; } } } } while (0)
struct XcdBarrier { unsigned* bar; unsigned x; volatile LAS unsigned* st; };
__device__ __forceinline__ XcdBarrier xcd_barrier_post(unsigned* bar, volatile LAS unsigned* st) {
    XcdBarrier b; b.bar = bar; b.x = xb_xcc_id(); b.st = st;
    if (threadIdx.x == 0) (void)xb_add(&bar[XB_XCNT(b.x)], 1u);
    return b;
}
__device__ __forceinline__ void xcd_barrier_complete(unsigned* bar, unsigned x, unsigned& nloc, unsigned& nx) {
    const unsigned G = gridDim.x * gridDim.y * gridDim.z;
    unsigned sum, cnt, mine, sp = 0u;
    for (;;) {
        sum = 0u; cnt = 0u; mine = 0u;
#pragma unroll
        for (unsigned j = 0; j < 16; ++j) { const unsigned c = xb_ld(&bar[XB_XCNT(j)]); sum += c; cnt += (c > 0u) ? 1u : 0u; mine = (j == x) ? c : mine; }
        if (sum == G) break;
        __builtin_amdgcn_s_sleep(1);
        if ((++sp & 255u) == 0u) { if (xb_ld(&bar[XB_TMO])) break; if (sp > XB_SPIN_CAP) { atomicAdd(&bar[XB_TMO], 1u); break; } }
    }
    nloc = mine > 0u ? mine : 1u; nx = cnt > 0u ? cnt : 1u;
}
__device__ __forceinline__ void xcd_barrier(const XcdBarrier& b) {
    asm volatile("s_waitcnt vmcnt(0)" ::: "memory");
    __syncthreads();
    if (threadIdx.x == 0) {
        unsigned* bar = b.bar;
        __builtin_amdgcn_s_waitcnt(0);
        unsigned nloc = b.st[0], nx = b.st[1];
        if (nloc == 0u) { xcd_barrier_complete(bar, b.x, nloc, nx); b.st[0] = nloc; b.st[1] = nx; }
        const unsigned old = xb_add(&bar[XB_XSUB(b.x)], 1u);
        const unsigned gen = old / nloc;
        if (old + 1u == (gen + 1u) * nloc) {
            __builtin_amdgcn_fence(__ATOMIC_RELEASE, "agent");
            asm volatile("s_waitcnt vmcnt(0)" ::: "memory");
            const unsigned og = xb_add(&bar[XB_TOP], 1u);
            const unsigned tg = og / nx;
            if (og + 1u == (tg + 1u) * nx) xb_add(&bar[XB_TOPGEN], 1u);
            else XB_SPIN(xb_ld(&bar[XB_TOPGEN]) == tg, bar);
            __builtin_amdgcn_fence(__ATOMIC_ACQUIRE, "agent");
            xb_add(&bar[XB_XGEN(b.x)], 1u);
            asm volatile("s_waitcnt vmcnt(0)" ::: "memory");
        } else {
            XB_SPIN(xb_ld(&bar[XB_XGEN(b.x)]) == gen, bar);
            __builtin_amdgcn_fence(__ATOMIC_ACQUIRE, "agent");
            asm volatile("s_waitcnt vmcnt(0)" ::: "memory");
        }
    }
    __syncthreads();
}

struct Args { const float* in[23]; float* out; unsigned char* ws; int ph_lo, ph_hi; };
struct Frame {
    LAS unsigned char* lds; int tid, lane, wave, G, bx;
    const float *x, *meta, *lng, *lnb, *t5, *w_in, *sink, *rpb, *ga, *gb, *w_out, *l1g, *l1b, *w_router, *rbias, *w_gate, *w_up, *w_down, *ws_gate, *ws_up, *ws_down, *l2g, *l2b;
    float* out; unsigned char* ws;
    float *stats0, *stats1, *ssq, *wl, *tab, *z; int *cnt, *tokl, *tke, *tkr;
    bf16_t *wtd, *hb, *wtgu, *wtin, *wtout, *h0, *u, *ya, *h1, *ym, *wrt;
};

__device__ __forceinline__ void transpose_item(const float* src, size_t ld_src, bf16_t* dst, size_t ld_dst, LAS float* scr, int lane, const float* kscale, float cscale) {
    f32x4 v[16];
    const int kk = lane & 3, n4 = (lane >> 2) * 4;
#pragma unroll
    for (int p = 0; p < 16; ++p) v[p] = *(const f32x4*)(src + (size_t)(4 * p + kk) * ld_src + n4);
#pragma unroll
    for (int p = 0; p < 16; ++p) { const int k = 4 * p + kk; const float s = kscale ? kscale[k] * cscale : cscale;
        scr[k * 65 + n4] = v[p][0] * s; scr[k * 65 + n4 + 1] = v[p][1] * s; scr[k * 65 + n4 + 2] = v[p][2] * s; scr[k * 65 + n4 + 3] = v[p][3] * s; }
    asm volatile("s_waitcnt lgkmcnt(0)" ::: "memory");
    const int c = lane >> 3;
#pragma unroll
    for (int j = 0; j < 8; ++j) { const int n = (lane & 7) + 8 * j; const LAS float* s = scr + (8 * c) * 65 + n; u32x4 o;
        o.x = pack2(s[0], s[65]); o.y = pack2(s[2 * 65], s[3 * 65]); o.z = pack2(s[4 * 65], s[5 * 65]); o.w = pack2(s[6 * 65], s[7 * 65]);
        *(u32x4*)(dst + (size_t)n * ld_dst + 8 * c) = o; }
    asm volatile("s_waitcnt lgkmcnt(0)" ::: "memory");
}
__device__ __forceinline__ void phase_prologue(Frame& F) {
    LAS float* t = (LAS float*)F.lds + F.wave * (64 * 65);
    const int gw = F.bx * 8 + F.wave, NGW = F.G * 8;
    constexpr int T_IN = 72 * 32, T_OUT = 32 * 32, T_GU = 65 * 2 * 8 * 32, T_D = 65 * 32 * 8, T_R = 32, T_ALL = T_R + T_IN + T_OUT + T_GU + T_D;
    for (int it = gw; it < T_ALL; it += NGW) {
        int r = it; const float* src; bf16_t* dst; int lds_, ldd_; const float* ksc = nullptr; float csc = 1.0f;
        if (r < T_R) { src = F.w_router + (size_t)(r * 64) * NE; lds_ = NE; dst = F.wrt + r * 64; ldd_ = D; }
        else if ((r -= T_R) < T_IN) { const int tn = r % 72, tk = r / 72; const int n0 = tn * 64; const bool isq = (n0 < COL_KA) || (n0 >= COL_QB && n0 < COL_KB);
            src = F.w_in + (size_t)(tk * 64) * INW + n0; lds_ = INW; dst = F.wtin + (size_t)n0 * D + tk * 64; ldd_ = D; csc = isq ? QSCALE : 1.0f; }
        else if ((r -= T_IN) < T_OUT) { const int tn = r % 32, tk = r / 32; const int k0 = tk * 64;
            src = F.w_out + (size_t)k0 * D + tn * 64; lds_ = D; dst = F.wtout + (size_t)(tn * 64) * D + k0; ldd_ = D; ksc = k0 < 1024 ? F.ga + k0 : F.gb + (k0 - 1024); }
        else if ((r -= T_OUT) < T_GU) { const int tn = r % 8, tk = (r / 8) % 32, which = (r / 256) % 2, e = r / 512;
            const float* s0 = e < NE ? (which ? F.w_up : F.w_gate) + (size_t)e * D * DE : (which ? F.ws_up : F.ws_gate);
            const int c0 = tn * 64, nprime = 256 * (c0 / 128) + 128 * which + (c0 % 128);
            src = s0 + (size_t)(tk * 64) * DE + c0; lds_ = DE; dst = F.wtgu + ((size_t)e * 1024 + nprime) * D + tk * 64; ldd_ = D; }
        else { r -= T_GU; const int tn = r % 32, tk = (r / 32) % 8, e = r / 256;
            const float* s0 = e < NE ? F.w_down + (size_t)e * DE * D : F.ws_down;
            src = s0 + (size_t)(tk * 64) * D + tn * 64; lds_ = D; dst = F.wtd + ((size_t)e * D + tn * 64) * DE + tk * 64; ldd_ = DE; }
        transpose_item(src, (size_t)lds_, dst, (size_t)ldd_, t, F.lane, ksc, csc);
    }
    for (int row = gw; row < MROWS; row += NGW) {
        bf16_t* dst = F.h0 + (size_t)row * D;
        if (row >= NTOK + NMETA) {
#pragma unroll
            for (int j = 0; j < 8; ++j) *(u32x2*)(dst + (j * 64 + F.lane) * 4) = (u32x2){0u, 0u};
            continue; }
        const float* src = row < NTOK ? F.x + (size_t)row * D : F.meta + (size_t)(row - NTOK) * D;
        f32x4 v[8]; float s = 0.f;
#pragma unroll
        for (int j = 0; j < 8; ++j) { v[j] = *(const f32x4*)(src + (j * 64 + F.lane) * 4); s += (v[j][0] + v[j][1]) + (v[j][2] + v[j][3]); }
        const float mu = wsum(s) * (1.0f / D); float q = 0.f;
#pragma unroll
        for (int j = 0; j < 8; ++j) { const f32x4 d = v[j] - mu; q += (d[0] * d[0] + d[1] * d[1]) + (d[2] * d[2] + d[3] * d[3]); }
        const float rstd = 1.0f / sqrtf(wsum(q) * (1.0f / D) + LN_EPS);
#pragma unroll
        for (int j = 0; j < 8; ++j) { const int c = (j * 64 + F.lane) * 4; const f32x4 g = *(const f32x4*)(F.lng + c), b = *(const f32x4*)(F.lnb + c); const f32x4 y = (v[j] - mu) * rstd * g + b;
            *(u32x2*)(dst + c) = (u32x2){pack2(y[0], y[1]), pack2(y[2], y[3])}; }
        if (row < NTOK && F.lane == 0) { F.stats0[row * 2] = mu; F.stats0[row * 2 + 1] = rstd; }
    }
    if (F.bx == 0) for (int i = F.tid; i < 16 * 272; i += 512) { const int h = i / 272, r = i % 272; F.tab[i] = r <= 256 ? F.t5[t5_bucket(r - 128) * 16 + h] * LOG2E : 0.f; }
}

template <class Fn> __device__ __forceinline__ void sgemm(const Fn& f, LAS unsigned char* ldsb, int tid, int bx, int G) {
    LAS float* As = (LAS float*)ldsb; LAS float* Bs = As + 32 * 132; LAS float* Bs2 = Bs + 32 * 68;
    const int ntm = f.ntm(), ntn = f.ntn(), K = f.K();
    const int tx = tid & 15, ty = tid >> 4, ar = tid >> 2, akc = (tid & 3) * 8, br = (tid & 255) >> 2;
    for (int tile = bx; tile < ntm * ntn; tile += G) {
        const int tm = tile / ntn, tn = tile % ntn;
        typename Fn::Tile T; if (!f.tile(tm, T)) continue;
        float acc[4][4], acc2[4][4];
#pragma unroll
        for (int i = 0; i < 4; ++i)
#pragma unroll
            for (int j = 0; j < 4; ++j) { acc[i][j] = 0.f; acc2[i][j] = 0.f; }
        const bf16_t* ap = f.arow(T, tm * 128 + ar);
        const bf16_t* bp = tid < 256 ? f.brow(T, tn * 64 + br) : (Fn::DUAL ? f.brow2(T, tn * 64 + br) : nullptr);
        LAS float* Bw = tid < 256 ? Bs : Bs2;
        for (int k0 = 0; k0 < K; k0 += 32) {
            u32x4 av = (u32x4){0u, 0u, 0u, 0u}, bv = (u32x4){0u, 0u, 0u, 0u};
            if (ap) av = *(const u32x4*)(ap + k0 + akc);
            if (bp) bv = *(const u32x4*)(bp + k0 + akc);
            __syncthreads();
#pragma unroll
            for (int i = 0; i < 4; ++i) { As[(akc + 2 * i) * 132 + ar] = __uint_as_float(av[i] << 16); As[(akc + 2 * i + 1) * 132 + ar] = __uint_as_float(av[i] & 0xffff0000u); }
            if (tid < 256 || Fn::DUAL) {
#pragma unroll
                for (int i = 0; i < 4; ++i) { Bw[(akc + 2 * i) * 68 + br] = __uint_as_float(bv[i] << 16); Bw[(akc + 2 * i + 1) * 68 + br] = __uint_as_float(bv[i] & 0xffff0000u); } }
            __syncthreads();
#pragma unroll 8
            for (int kk = 0; kk < 32; ++kk) {
                const f32x4 a = *(const LAS f32x4*)(As + kk * 132 + ty * 4), b = *(const LAS f32x4*)(Bs + kk * 68 + tx * 4);
#pragma unroll
                for (int i = 0; i < 4; ++i)
#pragma unroll
                    for (int j = 0; j < 4; ++j) acc[i][j] += a[i] * b[j];
                if (Fn::DUAL) { const f32x4 b2 = *(const LAS f32x4*)(Bs2 + kk * 68 + tx * 4);
#pragma unroll
                    for (int i = 0; i < 4; ++i)
#pragma unroll
                        for (int j = 0; j < 4; ++j) acc2[i][j] += a[i] * b2[j]; }
            }
        }
#pragma unroll
        for (int i = 0; i < 4; ++i)
#pragma unroll
            for (int j = 0; j < 4; ++j) f.store(T, tm * 128 + ty * 4 + i, tn * 64 + tx * 4 + j, acc[i][j], acc2[i][j]);
    }
}

__device__ __forceinline__ void expert_starts(const Frame& F, LAS int* ps  ) {
    if (F.tid == 0) { int acc = 0; for (int e = 0; e < NE; ++e) { ps[e] = acc; acc += ((F.cnt[e] + 255) >> 8) << 8; } ps[64] = acc; }
    __syncthreads();
}

struct FnInProj {
    static constexpr bool DUAL = false; struct Tile {}; const Frame& F;
    __device__ int ntm() const { return MROWS / 128; } __device__ int ntn() const { return INW / 64; } __device__ int K() const { return D; }
    __device__ bool tile(int, Tile&) const { return true; }
    __device__ const bf16_t* arow(const Tile&, int row) const { return F.h0 + (size_t)row * D; }
    __device__ const bf16_t* brow(const Tile&, int n) const { return F.wtin + (size_t)n * D; }
    __device__ const bf16_t* brow2(const Tile&, int) const { return nullptr; }
    __device__ void store(const Tile&, int row, int n, float a, float) const { F.u[(size_t)row * INW + n] = f2bf(a); }
};
struct FnOutProj {
    static constexpr bool DUAL = false; struct Tile {}; const Frame& F;
    __device__ int ntm() const { return NTOK / 128; } __device__ int ntn() const { return D / 64; } __device__ int K() const { return D; }
    __device__ bool tile(int, Tile&) const { return true; }
    __device__ const bf16_t* arow(const Tile&, int row) const { return F.ya + (size_t)row * D; }
    __device__ const bf16_t* brow(const Tile&, int n) const { return F.wtout + (size_t)n * D; }
    __device__ const bf16_t* brow2(const Tile&, int) const { return nullptr; }
    __device__ void store(const Tile&, int row, int n, float a, float) const {
        const float h0 = (F.x[(size_t)row * D + n] - F.stats0[row * 2]) * F.stats0[row * 2 + 1] * F.lng[n] + F.lnb[n];
        F.z[(size_t)row * D + n] = a + ALPHA * h0; }
};
struct FnGateUp {
    static constexpr bool DUAL = true; struct Tile { int e, r0, n; }; const Frame& F; const LAS int* ps;
    __device__ int ntm() const { return HBROWS / 128; } __device__ int ntn() const { return DE / 64; } __device__ int K() const { return D; }
    __device__ bool tile(int tm, Tile& T) const { const int row0 = tm * 128;
        if (row0 >= PMAX) { T.e = NE; T.r0 = row0 - PMAX; T.n = NTOK; return true; }
        if (row0 >= ps[64]) return false;
        int e = 0; while (e < NE - 1 && row0 >= ps[e + 1]) ++e;
        T.e = e; T.r0 = row0 - ps[e]; T.n = F.cnt[e]; return T.r0 < T.n; }
    __device__ const bf16_t* arow(const Tile& T, int row) const { const int r = T.r0 + (row & 127); if (r >= T.n) return nullptr;
        const int tok = T.e < NE ? F.tokl[(size_t)T.e * NTOK + r] : r; return F.h1 + (size_t)tok * D; }
    __device__ const bf16_t* brow(const Tile& T, int n) const { return F.wtgu + ((size_t)T.e * 1024 + 256 * (n >> 7) + (n & 127)) * D; }
    __device__ const bf16_t* brow2(const Tile& T, int n) const { return F.wtgu + ((size_t)T.e * 1024 + 256 * (n >> 7) + 128 + (n & 127)) * D; }
    __device__ void store(const Tile& T, int row, int n, float g, float u) const { const int r = T.r0 + (row & 127); const float w = T.e < NE ? (r < T.n ? F.wl[(size_t)T.e * NTOK + r] : 0.f) : 1.0f;
        F.hb[(size_t)row * DE + n] = f2bf(g / (1.0f + __expf(-g)) * (u * w)); }
};
struct FnDown {
    static constexpr bool DUAL = false; struct Tile { int e, r0, n; }; const Frame& F; const LAS int* ps;
    __device__ int ntm() const { return PMAX / 128; } __device__ int ntn() const { return D / 64; } __device__ int K() const { return DE; }
    __device__ bool tile(int tm, Tile& T) const { const int row0 = tm * 128; if (row0 >= ps[64]) return false;
        int e = 0; while (e < NE - 1 && row0 >= ps[e + 1]) ++e;
        T.e = e; T.r0 = row0 - ps[e]; T.n = F.cnt[e]; return T.r0 < T.n; }
    __device__ const bf16_t* arow(const Tile&, int row) const { return F.hb + (size_t)row * DE; }
    __device__ const bf16_t* brow(const Tile& T, int n) const { return F.wtd + ((size_t)T.e * D + n) * DE; }
    __device__ const bf16_t* brow2(const Tile&, int) const { return nullptr; }
    __device__ void store(const Tile& T, int row, int n, float a, float) const { const int r = T.r0 + (row & 127);
        (void)r; F.ym[(size_t)row * D + n] = f2bf(a); }
};
struct FnFinal {
    static constexpr bool DUAL = false; struct Tile {}; const Frame& F; const LAS int* ps;
    __device__ int ntm() const { return NTOK / 128; } __device__ int ntn() const { return D / 64; } __device__ int K() const { return DE; }
    __device__ bool tile(int, Tile&) const { return true; }
    __device__ const bf16_t* arow(const Tile&, int row) const { return F.hb + (size_t)(PMAX + row) * DE; }
    __device__ const bf16_t* brow(const Tile&, int n) const { return F.wtd + ((size_t)NE * D + n) * DE; }
    __device__ const bf16_t* brow2(const Tile&, int) const { return nullptr; }
    __device__ void store(const Tile&, int row, int n, float a, float) const {
        const float h1 = (F.z[(size_t)row * D + n] - F.stats1[row * 2]) * F.stats1[row * 2 + 1] * F.l1g[n] + F.l1b[n];
        F.out[(size_t)row * D + n] = a + ALPHA * h1; }
};

__device__ __forceinline__ void phase_attn_simple(Frame& F) {
    LAS float* qs = (LAS float*)F.lds + F.wave * 512; LAS float* psm = qs + 64;
    const int gw = F.bx * 8 + F.wave, NGW = F.G * 8, lane = F.lane;
    for (int item = gw; item < NTOK * 32; item += NGW) {
        const int tok = item >> 5, hh = item & 31, b = tok >> 13, s = tok & 8191;
        const bool isA = hh < 16; const int h = hh & 15;
        const int qcol = isA ? COL_QA + h * 64 : COL_QB + h * 64, kcol = isA ? COL_KA + (h >> 2) * 64 : COL_KB + h * 64, vcol = isA ? COL_VA + (h >> 2) * 64 : COL_VB + h * 64;
        const int r = s >> 6, c = s & 63, rs = min(max(r - 4, 0), 120), cs = min(max(c - 8, 0), 48);
        const int nkeys = isA ? 16 + 257 : 16 + 128;
        asm volatile("s_waitcnt lgkmcnt(0)" ::: "memory");
        qs[lane] = bf2f(F.u[(size_t)tok * INW + qcol + lane]);
        asm volatile("s_waitcnt lgkmcnt(0)" ::: "memory");
        float sc[5]; float mx = -INFINITY;
#pragma unroll
        for (int i = 0; i < 5; ++i) {
            const int j = lane + 64 * i; sc[i] = -INFINITY;
            if (j < nkeys) {
                int krow; float bias; bool valid = true;
                if (j < 16) { krow = NTOK + j; bias = isA ? F.t5[t5_bucket(j - 16 - s) * 16 + h] * LOG2E : 0.f; }
                else if (isA) { const int kpos = s - 128 + (j - 16); valid = kpos >= 0 && kpos < SEQ; krow = b * SEQ + kpos; bias = F.tab[h * 272 + (j - 16)]; }
                else { const int w = j - 16, kr = rs + (w >> 4), kc = cs + (w & 15); krow = b * SEQ + kr * 64 + kc; bias = F.rpb[(h * 15 + (kr - r + 7)) * 31 + (kc - c + 15)] * LOG2E; }
                if (valid) { const bf16_t* kp = F.u + (size_t)krow * INW + kcol; float dot = 0.f;
#pragma unroll
                    for (int d8 = 0; d8 < 8; ++d8) { const u32x4 kv = *(const u32x4*)(kp + d8 * 8);
#pragma unroll
                        for (int i2 = 0; i2 < 4; ++i2) { dot += qs[d8 * 8 + 2 * i2] * __uint_as_float(kv[i2] << 16); dot += qs[d8 * 8 + 2 * i2 + 1] * __uint_as_float(kv[i2] & 0xffff0000u); } }
                    sc[i] = dot + bias; }
            }
            mx = fmaxf(mx, sc[i]);
        }
        const float sinkl = isA ? F.sink[h] * LOG2E : -INFINITY;
        mx = fmaxf(wmax(mx), sinkl);
        float l = 0.f;
#pragma unroll
        for (int i = 0; i < 5; ++i) { const int j = lane + 64 * i; const float p = sc[i] == -INFINITY ? 0.f : exp2f(sc[i] - mx); l += p; if (j < 320) psm[j] = p; }
        l = wsum(l) + (isA ? exp2f(sinkl - mx) : 0.f);
        asm volatile("s_waitcnt lgkmcnt(0)" ::: "memory");
        float o = 0.f;
        for (int j = 0; j < nkeys; ++j) { const float p = psm[j]; if (p == 0.f) continue;
            int krow; if (j < 16) krow = NTOK + j; else if (isA) krow = b * SEQ + s - 128 + (j - 16); else { const int w = j - 16; krow = b * SEQ + (rs + (w >> 4)) * 64 + cs + (w & 15); }
            o += p * bf2f(F.u[(size_t)krow * INW + vcol + lane]); }
        o /= l;
        const bf16_t ob = f2bf(o); F.ya[(size_t)tok * D + hh * 64 + lane] = ob;
        const float of = bf2f(ob), q = wsum(of * of);
        if (lane == 0) F.ssq[tok * 32 + hh] = q;
    }
}
__device__ __forceinline__ void phase_rmsnorm(Frame& F) {
    const int gw = F.bx * 8 + F.wave, NGW = F.G * 8, lane = F.lane;
    for (int tok = gw; tok < NTOK; tok += NGW) {
        const float q = lane < 32 ? F.ssq[tok * 32 + lane] : 0.f;
        float qa = lane < 16 ? q : 0.f, qb = (lane >= 16 && lane < 32) ? q : 0.f; qa = wsum(qa); qb = wsum(qb);
        const float ra = 1.0f / sqrtf(qa * (1.0f / 1024.f) + RMS_EPS), rb = 1.0f / sqrtf(qb * (1.0f / 1024.f) + RMS_EPS);
        bf16_t* p = F.ya + (size_t)tok * D;
#pragma unroll
        for (int j = 0; j < 8; ++j) { const int c = (j * 64 + lane) * 4; const float rr = c < 1024 ? ra : rb; u32x2 w = *(u32x2*)(p + c);
            w.x = pack2(__uint_as_float(w.x << 16) * rr, __uint_as_float(w.x & 0xffff0000u) * rr); w.y = pack2(__uint_as_float(w.y << 16) * rr, __uint_as_float(w.y & 0xffff0000u) * rr); *(u32x2*)(p + c) = w; }
    }
}

__device__ __forceinline__ void phase_ln1_router(Frame& F) {
    LAS float* hs = (LAS float*)F.lds + F.wave * 2048;
    const int gw = F.bx * 8 + F.wave, NGW = F.G * 8, lane = F.lane;
    for (int tok = gw; tok < NTOK; tok += NGW) {
        const float* src = F.z + (size_t)tok * D; f32x4 v[8]; float s = 0.f;
#pragma unroll
        for (int j = 0; j < 8; ++j) { v[j] = *(const f32x4*)(src + (j * 64 + lane) * 4); s += (v[j][0] + v[j][1]) + (v[j][2] + v[j][3]); }
        const float mu = wsum(s) * (1.0f / D); float q = 0.f;
#pragma unroll
        for (int j = 0; j < 8; ++j) { const f32x4 d = v[j] - mu; q += (d[0] * d[0] + d[1] * d[1]) + (d[2] * d[2] + d[3] * d[3]); }
        const float rstd = 1.0f / sqrtf(wsum(q) * (1.0f / D) + LN_EPS);
        asm volatile("s_waitcnt lgkmcnt(0)" ::: "memory");
#pragma unroll
        for (int j = 0; j < 8; ++j) { const int c = (j * 64 + lane) * 4; const f32x4 g = *(const f32x4*)(F.l1g + c), bb = *(const f32x4*)(F.l1b + c); const f32x4 y = (v[j] - mu) * rstd * g + bb;
            *(u32x2*)(F.h1 + (size_t)tok * D + c) = (u32x2){pack2(y[0], y[1]), pack2(y[2], y[3])}; *(LAS f32x4*)(hs + c) = y; }
        if (lane == 0) { F.stats1[tok * 2] = mu; F.stats1[tok * 2 + 1] = rstd; }
        asm volatile("s_waitcnt lgkmcnt(0)" ::: "memory");
        float lg = 0.f;
#pragma unroll 8
        for (int n = 0; n < D; ++n) lg += hs[n] * F.w_router[(size_t)n * NE + lane];
        const float score = 1.0f / (1.0f + expf(-lg)), v0 = score + F.rbias[lane];
        int rk = 0;
#pragma unroll
        for (int j = 0; j < 8; ++j) { const int o = (lane & ~7) + j; const float w = __shfl(v0, o); rk += (w > v0 || (w == v0 && o < lane)) ? 1 : 0; }
        float gs = rk < 2 ? v0 : 0.f; gs += __shfl_xor(gs, 1); gs += __shfl_xor(gs, 2); gs += __shfl_xor(gs, 4);
        int grk = 0; const int myg = lane >> 3;
#pragma unroll
        for (int g = 0; g < 8; ++g) { const float w = __shfl(gs, g * 8); grk += (w > gs || (w == gs && g < myg)) ? 1 : 0; }
        const float mv = grk < 4 ? v0 : -INFINITY;
        int erk = 0;
        for (int o = 0; o < 64; ++o) { const float w = __shfl(mv, o); erk += (w > mv || (w == mv && o < lane)) ? 1 : 0; }
        const bool sel = erk < 8;
        const float wsm = wsum(sel ? score : 0.f), wgt = score / (wsm + 1e-20f) * 2.5f;
        if (sel) { const int rr = atomicAdd(F.cnt + lane, 1); F.tokl[(size_t)lane * NTOK + rr] = tok; F.wl[(size_t)lane * NTOK + rr] = wgt; F.tke[tok * 8 + erk] = lane; F.tkr[tok * 8 + erk] = rr; }
    }
}
__device__ __forceinline__ void phase_ln2(Frame& F, const LAS int* ps) {
    const int gw = F.bx * 8 + F.wave, NGW = F.G * 8, lane = F.lane;
    for (int tok = gw; tok < NTOK; tok += NGW) {
        float* src = F.out + (size_t)tok * D; f32x4 v[8]; float s = 0.f;
#pragma unroll
        for (int j = 0; j < 8; ++j) v[j] = *(const f32x4*)(src + (j * 64 + lane) * 4);
        const int mye = F.tke[tok * 8 + (lane & 7)], myr = F.tkr[tok * 8 + (lane & 7)], mypos = ps[mye] + myr;
#pragma unroll
        for (int k = 0; k < 8; ++k) { const int p = __shfl(mypos, k); const bf16_t* yp = F.ym + (size_t)p * D;
#pragma unroll
            for (int j = 0; j < 8; ++j) { const u32x2 w = *(const u32x2*)(yp + (j * 64 + lane) * 4);
                v[j][0] += __uint_as_float(w.x << 16); v[j][1] += __uint_as_float(w.x & 0xffff0000u); v[j][2] += __uint_as_float(w.y << 16); v[j][3] += __uint_as_float(w.y & 0xffff0000u); } }
#pragma unroll
        for (int j = 0; j < 8; ++j) s += (v[j][0] + v[j][1]) + (v[j][2] + v[j][3]);
        const float mu = wsum(s) * (1.0f / D); float q = 0.f;
#pragma unroll
        for (int j = 0; j < 8; ++j) { const f32x4 d = v[j] - mu; q += (d[0] * d[0] + d[1] * d[1]) + (d[2] * d[2] + d[3] * d[3]); }
        const float rstd = 1.0f / sqrtf(wsum(q) * (1.0f / D) + LN_EPS);
#pragma unroll
        for (int j = 0; j < 8; ++j) { const int c = (j * 64 + lane) * 4; const f32x4 g = *(const f32x4*)(F.l2g + c), bb = *(const f32x4*)(F.l2b + c); *(f32x4*)(src + c) = (v[j] - mu) * rstd * g + bb; }
    }
}

#ifndef FAST_P1
#define FAST_P1 1
#endif
#ifndef FAST_P4
#define FAST_P4 1
#endif
#ifndef FAST_P6
#define FAST_P6 1
#endif
#ifndef FAST_P7
#define FAST_P7 1
#endif
namespace pg8 {
typedef short bf16x8 __attribute__((ext_vector_type(8)));
constexpr int BM = 256, BK = 64, HALF = 128, HTB = HALF * BK * 2, STAGE_BYTES = 8 * HTB, NXCD = 8, WGM = 8;
__host__ __device__ __forceinline__ int lds_byte(int r, int c) { const int st = (r >> 4) * 2 + (c >> 5), rr = r & 15, cc = c & 31, ob = rr * 64 + cc * 2; return st * 1024 + (ob ^ (((ob >> 9) & 1) << 5)); }
__host__ __device__ __forceinline__ void stage_rc(int b, int& R, int& C) { const int st = b / 1024, sb = b % 1024, swz = sb ^ (((sb >> 9) & 1) << 5); R = (st >> 1) * 16 + swz / 64; C = (st & 1) * 32 + (swz % 64) / 2; }
__host__ __device__ __forceinline__ int perm32(int rho) { const int n = rho >> 4, i = rho & 15; return 8 * (i >> 2) + 4 * n + (i & 3); }
__device__ __forceinline__ unsigned cvt_pk_bf16(float lo, float hi) { unsigned r; asm volatile("v_cvt_pk_bf16_f32 %0, %1, %2" : "=v"(r) : "v"(lo), "v"(hi)); return r; }
struct Unit { int pm, pn, e, r0, n, orow; };
__device__ __forceinline__ int xcd_remap(int L, int nwg) { const int q = nwg / NXCD, r = nwg % NXCD, xcd = L % NXCD, off = L / NXCD; return (xcd < r ? xcd * (q + 1) : r * (q + 1) + (xcd - r) * q) + off; }
__device__ __forceinline__ void tile_of(int wgid, int nM, int nN, int& pm, int& pn) { const int nig = WGM * nN, gid = wgid / nig, fm = gid * WGM, gsz = (nM - fm) < WGM ? (nM - fm) : WGM; pm = fm + ((wgid % nig) % gsz); pn = (wgid % nig) / gsz; }

template <class Epi, class Sched>
__device__ __forceinline__ void gemm_phase(LAS unsigned char* lds, const Sched& S, const Epi& E, const int lda, const int ldb, const int nt) {
    const int tid = threadIdx.x, wid = __builtin_amdgcn_readfirstlane(tid >> 6), lane = tid & 63, wr = wid >> 2, wc = wid & 3, fr = lane & 15, fq = lane >> 4;
    unsigned voffA[2], voffB[2], c2[2]; int RA[2];
#pragma unroll
    for (int i = 0; i < 2; ++i) { int R, C; stage_rc(tid * 16 + i * 8192, R, C); const int Rb = Epi::PERM ? ((R & ~31) + perm32(R & 31)) : R;
        voffA[i] = (unsigned)(R * lda + C) * 2u; voffB[i] = (unsigned)(Rb * ldb + C) * 2u; RA[i] = R; c2[i] = (unsigned)C * 2u; }
    const size_t kstep = (size_t)(BK * 2), hstepA = (size_t)HALF * lda * 2, hstepB = (size_t)HALF * ldb * 2;
    const unsigned lda2 = (unsigned)lda * 2u;
    const unsigned ldsw = (unsigned)wid * 1024u;
    const int aoff = lds_byte(wr * 64 + fr, fq * 8), boff = lds_byte(wc * 32 + fr, fq * 8);
#define PG8_SA(b, h) (((b) * 2 + (h)) * HTB)
#define PG8_SB(b, h) ((4 + (b) * 2 + (h)) * HTB)
#define PG8_STAGE(bufoff, gbase, voff) do { _Pragma("unroll") for (int _i = 0; _i < 2; ++_i) \
        __builtin_amdgcn_global_load_lds((const unsigned*)((const char*)(gbase) + (voff)[_i]), (LAS unsigned*)(lds + (bufoff) + ldsw + _i * 8192), 16, 0, 0); } while (0)
#define PG8_STG_A(bufoff, p, h, V) do { if constexpr (Sched::GATHER) { PG8_STAGE(bufoff, p, V[h]); } else { PG8_STAGE(bufoff, (p) + (h) * hstepA, voffA); } } while (0)
#define PG8_STG_B(bufoff, p, h) PG8_STAGE(bufoff, (p) + (h) * hstepB, voffB)
#define PG8_LDA(dst, b, h) do { _Pragma("unroll") for (int m = 0; m < 4; ++m) _Pragma("unroll") for (int k = 0; k < 2; ++k) dst[m][k] = *(const LAS bf16x8*)(lds + PG8_SA(b, h) + aoff + m * 2048 + k * 1024); } while (0)
#define PG8_LDB(dst, b, h) do { _Pragma("unroll") for (int n = 0; n < 2; ++n) _Pragma("unroll") for (int k = 0; k < 2; ++k) dst[n][k] = *(const LAS bf16x8*)(lds + PG8_SB(b, h) + boff + n * 2048 + k * 1024); } while (0)
#define PG8_MMA(ai, bj, At, Bt) do { __builtin_amdgcn_s_setprio(1); _Pragma("unroll") for (int m = 0; m < 4; ++m) _Pragma("unroll") for (int n = 0; n < 2; ++n) _Pragma("unroll") for (int k = 0; k < 2; ++k) \
        acc[ai][bj][m][n] = __builtin_amdgcn_mfma_f32_16x16x32_bf16(Bt[n][k], At[m][k], acc[ai][bj][m][n], 0, 0, 0); __builtin_amdgcn_s_setprio(0); } while (0)
#define PG8_WAIT_V(n) asm volatile("s_waitcnt vmcnt(" #n ")" ::: "memory")
#define PG8_WAIT_L(n) asm volatile("s_waitcnt lgkmcnt(" #n ")" ::: "memory")
#define PG8_BAR __builtin_amdgcn_s_barrier()
#define PG8_SCHED __builtin_amdgcn_sched_barrier(0)
    Unit cur, nxt; int ui = 0;
    if (!S.next(0, cur)) return;
    f32x4 acc[2][2][4][2];
#pragma unroll
    for (int a = 0; a < 2; ++a)
#pragma unroll
        for (int b = 0; b < 2; ++b)
#pragma unroll
            for (int m = 0; m < 4; ++m)
#pragma unroll
                for (int n = 0; n < 2; ++n) acc[a][b][m][n] = (f32x4){0.f, 0.f, 0.f, 0.f};
    bf16x8 At[4][2], B0[2][2], B1[2][2];
    unsigned vac[2][2], van[2][2]; int raw[2][2];
    const char* cA = S.abase(cur); const char* cB = S.bbase(cur);
#pragma unroll
    for (int h = 0; h < 2; ++h)
#pragma unroll
        for (int i = 0; i < 2; ++i) { vac[h][i] = Sched::GATHER ? (unsigned)S.arow(cur, h * HALF + RA[i]) * lda2 + c2[i] : 0u; van[h][i] = vac[h][i]; raw[h][i] = 0; }
    PG8_STG_B(PG8_SB(0, 0), cB, 0); PG8_STG_B(PG8_SB(0, 1), cB, 1); PG8_STG_A(PG8_SA(0, 0), cA, 0, vac); PG8_STG_A(PG8_SA(0, 1), cA, 1, vac);
    if (wr == 1) PG8_BAR;
    PG8_WAIT_V(2); PG8_BAR;
    PG8_STG_B(PG8_SB(1, 0), cB + kstep, 0); PG8_STG_A(PG8_SA(1, 0), cA + kstep, 0, vac); PG8_STG_B(PG8_SB(1, 1), cB + kstep, 1);
    PG8_WAIT_V(6); PG8_BAR;
    for (;;) {
        const bool has_next = S.next(ui + 1, nxt);
        const char* nA = has_next ? S.abase(nxt) : cA; const char* nB = has_next ? S.bbase(nxt) : cB;
        if constexpr (Sched::GATHER) { if (has_next) {
#pragma unroll
            for (int h = 0; h < 2; ++h)
#pragma unroll
                for (int i = 0; i < 2; ++i) raw[h][i] = S.arow(nxt, h * HALF + RA[i]); } }
        for (int t = 0; t < nt; t += 2) {
            const bool last = (t == nt - 2);
            const char* a1 = cA + (size_t)(t + 1) * kstep;
            const char* a2 = last ? nA : cA + (size_t)(t + 2) * kstep; const char* b2 = last ? nB : cB + (size_t)(t + 2) * kstep;
            const char* a3 = a2 + kstep; const char* b3 = b2 + kstep;
            unsigned va2[2][2];
#pragma unroll
            for (int h = 0; h < 2; ++h)
#pragma unroll
                for (int i = 0; i < 2; ++i) va2[h][i] = last ? van[h][i] : vac[h][i];
            PG8_LDB(B0, 0, 0); PG8_LDB(B1, 0, 1); PG8_SCHED; PG8_LDA(At, 0, 0); PG8_STG_A(PG8_SA(1, 1), a1, 1, vac);
            PG8_WAIT_V(8); PG8_WAIT_L(0); PG8_BAR; PG8_MMA(0, 0, At, B0); PG8_MMA(0, 1, At, B1); PG8_BAR; PG8_SCHED;
            PG8_LDA(At, 0, 1); PG8_STG_B(PG8_SB(0, 0), b2, 0); PG8_STG_B(PG8_SB(0, 1), b2, 1); PG8_STG_A(PG8_SA(0, 0), a2, 0, va2);
            PG8_WAIT_V(8); PG8_WAIT_L(0); PG8_BAR; PG8_MMA(1, 0, At, B0); PG8_MMA(1, 1, At, B1); PG8_BAR; PG8_SCHED;
            PG8_LDB(B0, 1, 0); PG8_LDB(B1, 1, 1); PG8_SCHED; PG8_LDA(At, 1, 0); PG8_STG_A(PG8_SA(0, 1), a2, 1, va2);
            PG8_WAIT_V(8); PG8_WAIT_L(0); PG8_BAR; PG8_MMA(0, 0, At, B0); PG8_MMA(0, 1, At, B1); PG8_BAR; PG8_SCHED;
            PG8_LDA(At, 1, 1); PG8_STG_B(PG8_SB(1, 0), b3, 0); PG8_STG_B(PG8_SB(1, 1), b3, 1); PG8_STG_A(PG8_SA(1, 0), a3, 0, va2);
            PG8_WAIT_V(8); PG8_WAIT_L(0); PG8_BAR; PG8_MMA(1, 0, At, B0); PG8_MMA(1, 1, At, B1); PG8_BAR; PG8_SCHED;
            if constexpr (Sched::GATHER) { if (t + 4 == nt && has_next) {
#pragma unroll
                for (int h = 0; h < 2; ++h)
#pragma unroll
                    for (int i = 0; i < 2; ++i) { asm volatile("" : "+v"(raw[h][i])); van[h][i] = (unsigned)raw[h][i] * lda2 + c2[i]; } } }
        }
        if (wr == 0) PG8_BAR;
        E(acc, cur, wr, wc, fr, fq);
        if (!has_next) break;
#pragma unroll
        for (int a = 0; a < 2; ++a)
#pragma unroll
            for (int b = 0; b < 2; ++b)
#pragma unroll
                for (int m = 0; m < 4; ++m)
#pragma unroll
                    for (int n = 0; n < 2; ++n) acc[a][b][m][n] = (f32x4){0.f, 0.f, 0.f, 0.f};
        cur = nxt; cA = nA; cB = nB; ++ui;
#pragma unroll
        for (int h = 0; h < 2; ++h)
#pragma unroll
            for (int i = 0; i < 2; ++i) vac[h][i] = van[h][i];
        if (wr == 1) PG8_BAR;
    }
    PG8_WAIT_V(0);
    PG8_BAR;
#undef PG8_SA
#undef PG8_SB
#undef PG8_STAGE
#undef PG8_STG_A
#undef PG8_STG_B
#undef PG8_LDA
#undef PG8_LDB
#undef PG8_MMA
#undef PG8_WAIT_V
#undef PG8_WAIT_L
#undef PG8_BAR
#undef PG8_SCHED
}
}

struct SchedInProj {
    static constexpr bool GATHER = false; const char* A; const char* B; int G, c;
    __device__ __forceinline__ bool next(int i, pg8::Unit& u) const { const int L = i * G + c; if (L >= 1162) return false;
        if (L < 1152) pg8::tile_of(pg8::xcd_remap(L, 1152), 64, 18, u.pm, u.pn); else { const int k = L - 1152; u.pm = 64; u.pn = k < 2 ? 4 + k : 8 + k; }
        return true; }
    __device__ __forceinline__ const char* abase(const pg8::Unit& u) const { return A + (size_t)u.pm * 256 * D * 2; }
    __device__ __forceinline__ const char* bbase(const pg8::Unit& u) const { return B + (size_t)u.pn * 256 * D * 2; }
    __device__ __forceinline__ int arow(const pg8::Unit&, int) const { return 0; }
};
struct SchedOutProj {
    static constexpr bool GATHER = false; const char* A; const char* B; int G, c;
    __device__ __forceinline__ bool next(int i, pg8::Unit& u) const { const int L = i * G + c; if (L >= 512) return false; pg8::tile_of(pg8::xcd_remap(L, 512), 64, 8, u.pm, u.pn); return true; }
    __device__ __forceinline__ const char* abase(const pg8::Unit& u) const { return A + (size_t)u.pm * 256 * D * 2; }
    __device__ __forceinline__ const char* bbase(const pg8::Unit& u) const { return B + (size_t)u.pn * 256 * D * 2; }
    __device__ __forceinline__ int arow(const pg8::Unit&, int) const { return 0; }
};
__device__ __forceinline__ void moe_tables(const Frame& F, LAS int* ps) {
    if (F.tid < NE) ps[256 + F.tid] = F.cnt[F.tid];
    __syncthreads();
    if (F.tid == 0) { int acc = 0, ta = 0; for (int e = 0; e < NE; ++e) { const int mt = (ps[256 + e] + 255) >> 8; ps[e] = acc; ps[128 + e] = ta; acc += mt * 256; ta += mt; }
        ps[64] = acc; ps[128 + 64] = ta; ps[128 + 65] = ta + NTOK / 256; ps[256 + 64] = NTOK; }
    __syncthreads();
    for (int t = F.tid; t < 640; t += 512) { int e = 0; while (e < NE && t >= ps[128 + e + 1]) ++e; ps[384 + t] = e; }
    __syncthreads();
}
template <int NN> __device__ __forceinline__ bool moe_unit(const LAS int* ps, int L, pg8::Unit& u) {
    const int nU = ps[128 + 65] * NN; if (L >= nU) return false;
    const int wg = pg8::xcd_remap(L, nU), tile = wg / NN; u.pn = wg % NN;
    const int e = ps[384 + tile]; u.e = e; u.pm = tile - ps[128 + e]; u.r0 = u.pm * 256; u.n = ps[256 + e];
    u.orow = (e < NE ? ps[e] : PMAX) + u.r0;
    return true; }
struct SchedGU {
    static constexpr bool GATHER = true; const char* A; const char* B; const int* tokl; const int* cnt; const LAS int* ps; int G, c;
    __device__ __forceinline__ bool next(int i, pg8::Unit& u) const { return moe_unit<4>(ps, i * G + c, u); }
    __device__ __forceinline__ const char* abase(const pg8::Unit&) const { return A; }
    __device__ __forceinline__ const char* bbase(const pg8::Unit& u) const { return B + ((size_t)u.e * 1024 + u.pn * 256) * D * 2; }
    __device__ __forceinline__ int arow(const pg8::Unit& u, int r) const { const int rr = min(u.r0 + r, u.n - 1); return u.e < NE ? tokl[(size_t)u.e * NTOK + rr] : rr; }
};
struct SchedDown {
    static constexpr bool GATHER = false; const char* A; const char* B; const int* cnt; const LAS int* ps; int G, c;
    __device__ __forceinline__ bool next(int i, pg8::Unit& u) const { return moe_unit<8>(ps, i * G + c, u); }
    __device__ __forceinline__ const char* abase(const pg8::Unit& u) const { return A + (size_t)u.orow * DE * 2; }
    __device__ __forceinline__ const char* bbase(const pg8::Unit& u) const { return B + ((size_t)u.e * D + u.pn * 256) * DE * 2; }
    __device__ __forceinline__ int arow(const pg8::Unit&, int) const { return 0; }
};
struct EpiU {
    static constexpr bool PERM = true; bf16_t* U;
    __device__ __forceinline__ void operator()(const f32x4 (&acc)[2][2][4][2], const pg8::Unit& u, int wr, int wc, int fr, int fq) const {
        const int row0 = u.pm * 256 + wr * 64 + fr, col0 = u.pn * 256 + wc * 32 + 8 * fq;
#pragma unroll
        for (int ai = 0; ai < 2; ++ai)
#pragma unroll
            for (int m = 0; m < 4; ++m) { bf16_t* rowp = U + (size_t)(row0 + ai * 128 + m * 16) * INW + col0;
#pragma unroll
                for (int bj = 0; bj < 2; ++bj) { const f32x4 v0 = acc[ai][bj][m][0], v1 = acc[ai][bj][m][1]; u32x4 w;
                    w.x = pg8::cvt_pk_bf16(v0[0], v0[1]); w.y = pg8::cvt_pk_bf16(v0[2], v0[3]); w.z = pg8::cvt_pk_bf16(v1[0], v1[1]); w.w = pg8::cvt_pk_bf16(v1[2], v1[3]);
                    *(u32x4*)(rowp + bj * 128) = w; } }
    }
};
struct EpiZ {
    static constexpr bool PERM = false; float* Z; const float* X; const float* st; const float* g; const float* b;
    __device__ __forceinline__ void operator()(const f32x4 (&acc)[2][2][4][2], const pg8::Unit& u, int wr, int wc, int fr, int fq) const {
        const int row0 = u.pm * 256 + wr * 64 + fr, col0 = u.pn * 256 + wc * 32 + 4 * fq;
        f32x4 gv[2][2], bv[2][2];
#pragma unroll
        for (int bj = 0; bj < 2; ++bj)
#pragma unroll
            for (int n = 0; n < 2; ++n) { gv[bj][n] = *(const f32x4*)(g + col0 + bj * 128 + n * 16) * ALPHA; bv[bj][n] = *(const f32x4*)(b + col0 + bj * 128 + n * 16) * ALPHA; }
#pragma unroll
        for (int am = 0; am < 4; ++am) {
            f32x4 xv[2][2][2]; float mu[2], rs[2];
#pragma unroll
            for (int q = 0; q < 2; ++q) { const int ai = am >> 1, m = (am & 1) * 2 + q; const int row = row0 + ai * 128 + m * 16; mu[q] = st[row * 2]; rs[q] = st[row * 2 + 1]; const size_t off = (size_t)row * D + col0;
#pragma unroll
                for (int bj = 0; bj < 2; ++bj)
#pragma unroll
                    for (int n = 0; n < 2; ++n) xv[q][bj][n] = *(const f32x4*)(X + off + bj * 128 + n * 16); }
#pragma unroll
            for (int q = 0; q < 2; ++q) { const int ai = am >> 1, m = (am & 1) * 2 + q; const size_t off = (size_t)(row0 + ai * 128 + m * 16) * D + col0;
#pragma unroll
                for (int bj = 0; bj < 2; ++bj)
#pragma unroll
                    for (int n = 0; n < 2; ++n) *(f32x4*)(Z + off + bj * 128 + n * 16) = acc[ai][bj][m][n] + ((xv[q][bj][n] - mu[q]) * rs[q] * gv[bj][n] + bv[bj][n]); }
            asm volatile("" ::: "memory"); }
    }
};
__device__ __forceinline__ float silu_mul(float g, float u) { return g * __builtin_amdgcn_rcpf(1.0f + __builtin_amdgcn_exp2f(-g * LOG2E)) * u; }
struct EpiGU {
    static constexpr bool PERM = true; bf16_t* H; const float* wl;
    __device__ __forceinline__ void operator()(const f32x4 (&acc)[2][2][4][2], const pg8::Unit& u, int wr, int wc, int fr, int fq) const {
        const int rl0 = wr * 64 + fr, col0 = u.pn * 128 + wc * 32 + 8 * fq;
        float wv[2][4];
#pragma unroll
        for (int ai = 0; ai < 2; ++ai)
#pragma unroll
            for (int m = 0; m < 4; ++m) { const int r = u.r0 + rl0 + ai * 128 + m * 16; wv[ai][m] = u.e < NE ? (r < u.n ? wl[(size_t)u.e * NTOK + r] : 0.f) : 1.0f; }
#pragma unroll
        for (int ai = 0; ai < 2; ++ai)
#pragma unroll
            for (int m = 0; m < 4; ++m) { const f32x4 g0 = acc[ai][0][m][0], g1 = acc[ai][0][m][1], u0 = acc[ai][1][m][0] * wv[ai][m], u1 = acc[ai][1][m][1] * wv[ai][m]; u32x4 w;
                w.x = pg8::cvt_pk_bf16(silu_mul(g0[0], u0[0]), silu_mul(g0[1], u0[1])); w.y = pg8::cvt_pk_bf16(silu_mul(g0[2], u0[2]), silu_mul(g0[3], u0[3]));
                w.z = pg8::cvt_pk_bf16(silu_mul(g1[0], u1[0]), silu_mul(g1[1], u1[1])); w.w = pg8::cvt_pk_bf16(silu_mul(g1[2], u1[2]), silu_mul(g1[3], u1[3]));
                *(u32x4*)(H + (size_t)(u.orow + rl0 + ai * 128 + m * 16) * DE + col0) = w; }
    }
};
struct EpiDown {
    static constexpr bool PERM = true; bf16_t* Y; float* O; const float* wl; const float* Z; const float* st; const float* g; const float* b; int nostore;
    __device__ __forceinline__ void operator()(const f32x4 (&acc)[2][2][4][2], const pg8::Unit& u, int wr, int wc, int fr, int fq) const {
        const int rl0 = wr * 64 + fr, col0 = u.pn * 256 + wc * 32 + 8 * fq;
        if (u.e < NE) {
            if (nostore) return;
#pragma unroll
            for (int ai = 0; ai < 2; ++ai)
#pragma unroll
                for (int m = 0; m < 4; ++m) { const int rl = rl0 + ai * 128 + m * 16;
                    bf16_t* rowp = Y + (size_t)(u.orow + rl) * D + col0;
#pragma unroll
                    for (int bj = 0; bj < 2; ++bj) { const f32x4 v0 = acc[ai][bj][m][0], v1 = acc[ai][bj][m][1]; u32x4 q;
                        q.x = pg8::cvt_pk_bf16(v0[0], v0[1]); q.y = pg8::cvt_pk_bf16(v0[2], v0[3]); q.z = pg8::cvt_pk_bf16(v1[0], v1[1]); q.w = pg8::cvt_pk_bf16(v1[2], v1[3]);
                        *(u32x4*)(rowp + bj * 128) = q; } }
        } else {
            f32x4 gv[2][2], bv[2][2];
#pragma unroll
            for (int bj = 0; bj < 2; ++bj)
#pragma unroll
                for (int n = 0; n < 2; ++n) { gv[bj][n] = *(const f32x4*)(g + col0 + bj * 128 + n * 4) * ALPHA; bv[bj][n] = *(const f32x4*)(b + col0 + bj * 128 + n * 4) * ALPHA; }
#pragma unroll
            for (int ai = 0; ai < 2; ++ai)
#pragma unroll
                for (int m = 0; m < 4; ++m) { const int row = u.r0 + rl0 + ai * 128 + m * 16; const float mu = st[row * 2], rs = st[row * 2 + 1]; const size_t off = (size_t)row * D + col0;
#pragma unroll
                    for (int bj = 0; bj < 2; ++bj)
#pragma unroll
                        for (int n = 0; n < 2; ++n) { const f32x4 zv = *(const f32x4*)(Z + off + bj * 128 + n * 4);
                            *(f32x4*)(O + off + bj * 128 + n * 4) = acc[ai][bj][m][n] + ((zv - mu) * rs * gv[bj][n] + bv[bj][n]); }
                    asm volatile("" ::: "memory"); }
        }
    }
};

#ifndef FAST_P2
#define FAST_P2 1
#endif
namespace att {
typedef short bf16x8 __attribute__((ext_vector_type(8)));
typedef short s16x4 __attribute__((ext_vector_type(4)));
typedef float f32x16 __attribute__((ext_vector_type(16)));
typedef LAS const char* lds_cptr;
constexpr int SLOT = 16384, RING = 3 * SLOT;
constexpr int TA_W = 452, TA_OFF = 224;
constexpr int TB_W = 468;
constexpr int OFF_TABA = RING, OFF_TABB = OFF_TABA + 16 * TA_W * 4, OFF_WS = OFF_TABB + 16 * TB_W * 4, OFF_OST = OFF_WS + 8 * 256, ATT_LDS = OFF_OST + 8 * 4096;
static_assert(ATT_LDS <= LDS_BYTES - 16 - 1024, "attention LDS map");
constexpr float NEGB = -1e30f, THR = 8.0f;
#define ATT_MFMA(a, b, c) __builtin_amdgcn_mfma_f32_32x32x16_bf16(a, b, c, 0, 0, 0)
__device__ __forceinline__ int crow(int r, int hi) { return (r & 3) + 8 * (r >> 2) + 4 * hi; }
__device__ __forceinline__ s16x4 vtr(lds_cptr p) { typedef short v4i16_t __attribute__((ext_vector_type(4))); return __builtin_bit_cast(s16x4, __builtin_amdgcn_ds_read_tr16_b64_v4i16((LAS v4i16_t*)p)); }
__device__ __forceinline__ float swapmax(float m) { auto rr = __builtin_amdgcn_permlane32_swap(__float_as_uint(m), __float_as_uint(m), false, false); return fmaxf(__uint_as_float(rr[0]), __uint_as_float(rr[1])); }
__device__ __forceinline__ float swapsum(float m) { auto rr = __builtin_amdgcn_permlane32_swap(__float_as_uint(m), __float_as_uint(m), false, false); return __uint_as_float(rr[0]) + __uint_as_float(rr[1]); }

template <int NH, int NS, class BiasFn>
__device__ __forceinline__ void tile_qb(const bf16x8 (&kf)[8], const bf16x8 (&qr)[4], lds_cptr vp, f32x16 (&o)[2], float& m, float& l, LAS float* wsf, int r32, int hi, const BiasFn& bias) {
    f32x16 c[NH];
#pragma unroll
    for (int hf = 0; hf < NH; ++hf) { c[hf] = f32x16{};
#pragma unroll
        for (int d0 = 0; d0 < 4; ++d0) c[hf] = ATT_MFMA(kf[2 * d0 + hf], qr[d0], c[hf]); }
    float mx = NEGB;
#pragma unroll
    for (int hf = 0; hf < NH; ++hf)
#pragma unroll
        for (int r = 0; r < 16; ++r) { c[hf][r] += bias(hf, r); mx = fmaxf(mx, c[hf][r]); }
    mx = swapmax(mx);
    if (__any(mx - m > THR)) {
        const float mn = fmaxf(m, mx), f = __builtin_amdgcn_exp2f(m - mn); m = mn; l *= f;
        if (hi == 0) wsf[r32] = f;
        asm volatile("s_waitcnt lgkmcnt(0)" ::: "memory");
#pragma unroll
        for (int r = 0; r < 16; ++r) { const float fr = wsf[crow(r, hi)]; o[0][r] *= fr; o[1][r] *= fr; }
    }
    float ls = 0.f;
#pragma unroll
    for (int hf = 0; hf < NH; ++hf)
#pragma unroll
        for (int r = 0; r < 16; ++r) { c[hf][r] = __builtin_amdgcn_exp2f(c[hf][r] - m); ls += c[hf][r]; }
    l += ls;
#pragma unroll
    for (int s = 0; s < NS; ++s) {
        const f32x16& cc = c[s >> 1]; const int rb = (s & 1) * 8;
        u32x4 pw; pw.x = pg8::cvt_pk_bf16(cc[rb + 0], cc[rb + 1]); pw.y = pg8::cvt_pk_bf16(cc[rb + 2], cc[rb + 3]); pw.z = pg8::cvt_pk_bf16(cc[rb + 4], cc[rb + 5]); pw.w = pg8::cvt_pk_bf16(cc[rb + 6], cc[rb + 7]);
        const bf16x8 pa = __builtin_bit_cast(bf16x8, pw);
#pragma unroll
        for (int dh = 0; dh < 2; ++dh) { const s16x4 lo = vtr(vp + dh * 4096 + s * 1024), hi4 = vtr(vp + dh * 4096 + s * 1024 + 512);
            const bf16x8 vf = (bf16x8){lo[0], lo[1], lo[2], lo[3], hi4[0], hi4[1], hi4[2], hi4[3]};
            o[dh] = ATT_MFMA(pa, vf, o[dh]); }
    }
}
template <class TokFn>
__device__ __forceinline__ void finish_qb(const Frame& F, f32x16 (&o)[2], float l, LAS float* wsf, LAS bf16_t* stg, int lane, int r32, int hi, int ocol, int hidx, const TokFn& tokq) {
    l = swapsum(l);
    asm volatile("s_waitcnt lgkmcnt(0)" ::: "memory");
    if (hi == 0) wsf[32 + r32] = l;
    asm volatile("s_waitcnt lgkmcnt(0)" ::: "memory");
#pragma unroll
    for (int r = 0; r < 16; ++r) { const int orow = crow(r, hi); const float rl = __builtin_amdgcn_rcpf(wsf[32 + orow]);
        stg[orow * 64 + r32] = f2bf(o[0][r] * rl); stg[orow * 64 + 32 + r32] = f2bf(o[1][r] * rl); }
    asm volatile("s_waitcnt lgkmcnt(0)" ::: "memory");
#pragma unroll
    for (int i = 0; i < 4; ++i) { const int row = i * 8 + (lane >> 3), ch = lane & 7; const u32x4 w = *(const LAS u32x4*)(stg + row * 64 + ch * 8); const int tok = tokq(row);
        *(u32x4*)(F.ya + (size_t)tok * D + ocol + ch * 8) = w;
        float q = 0.f;
#pragma unroll
        for (int j = 0; j < 4; ++j) { const float a = __uint_as_float(w[j] << 16), b = __uint_as_float(w[j] & 0xffff0000u); q += a * a + b * b; }
        q += __shfl_xor(q, 1); q += __shfl_xor(q, 2); q += __shfl_xor(q, 4);
        if (ch == 0) F.ssq[tok * 32 + hidx] = q; }
    asm volatile("s_waitcnt lgkmcnt(0)" ::: "memory");
}

template <int MODE>
__device__ __forceinline__ void attn_unit(const Frame& F, int L) {
    LAS unsigned char* lds = F.lds;
    const int lane = F.lane, wid = F.wave, r32 = lane & 31, hi = lane >> 5;
    LAS float* wsf = (LAS float*)(lds + OFF_WS + wid * 256); LAS bf16_t* stg = (LAS bf16_t*)(lds + OFF_OST + wid * 4096);
    int b, kcol, vcol, qcol, ocol, hidx, nband, trow0, qtok0;
    int hb = 0, qbw = 0, kt0 = 0;
    int R0 = 0, pr = 0, jc = 0, cb = 0, kr0 = 0;
    if (MODE == 0) { const int kvh = L & 3; hb = (L >> 2) & 127; b = L >> 9; const int hq = 4 * kvh + (wid >> 1); qbw = wid & 1;
        qcol = COL_QA + hq * 64; kcol = COL_KA + kvh * 64; vcol = COL_VA + kvh * 64; ocol = hq * 64; hidx = hq;
        kt0 = max(0, hb - 2); const int kt1 = min(127, hb + 2); nband = kt1 - kt0 + 1; trow0 = b * SEQ + 64 * kt0; qtok0 = b * SEQ + 64 * hb + 32 * qbw;
    } else { const int h = L & 15, rb = (L >> 4) & 31; b = L >> 9; R0 = rb * 4; pr = wid >> 2; jc = wid & 3; cb = min(max(16 * jc - 8, 0), 32);
        qcol = COL_QB + h * 64; kcol = COL_KB + h * 64; vcol = COL_VB + h * 64; ocol = 1024 + h * 64; hidx = 16 + h;
        kr0 = min(max(R0 - 4, 0), 120); const int kr1 = min(max(R0 + 3 - 4, 0), 120) + 7; nband = kr1 - kr0 + 1; trow0 = b * SEQ + kr0 * 64; qtok0 = b * SEQ + (R0 + 2 * pr) * 64 + 16 * jc; }
    const int NT = 1 + nband;
    const bf16_t* ksrc = F.u + (size_t)lane * INW + kcol + wid * 8;
    const bf16_t* vsrc = F.u + (size_t)(16 * (wid & 3) + (lane >> 2)) * INW + vcol + (wid >> 2) * 32 + (lane & 3) * 8;
#define ATT_TROW(t) ((t) == 0 ? NTOK : trow0 + ((t) - 1) * 64)
#define ATT_ISSUE(t) do { const size_t ro_ = (size_t)ATT_TROW(t) * INW; const int sl_ = ((t) % 3) * SLOT; \
        __builtin_amdgcn_global_load_lds((const unsigned*)(ksrc + ro_), (LAS unsigned*)(lds + sl_ + wid * 1024), 16, 0, 0); \
        __builtin_amdgcn_global_load_lds((const unsigned*)(vsrc + ro_), (LAS unsigned*)(lds + sl_ + 8192 + wid * 1024), 16, 0, 0); } while (0)
    bf16x8 qr[4];
    { const int tok = MODE == 0 ? qtok0 + r32 : qtok0 + (r32 >> 4) * 64 + (r32 & 15);
#pragma unroll
      for (int d0 = 0; d0 < 4; ++d0) qr[d0] = *(const bf16x8*)(F.u + (size_t)tok * INW + qcol + d0 * 16 + hi * 8); }
    ATT_ISSUE(0); ATT_ISSUE(1);
    f32x16 o[2]; o[0] = f32x16{}; o[1] = f32x16{}; float m = NEGB, l = 0.f;
    const LAS float* tabA = (const LAS float*)(lds + OFF_TABA) + (hidx & 15) * TA_W;
    const LAS float* tabB = (const LAS float*)(lds + OFF_TABB) + (hidx & 15) * TB_W;
    const int qpos = 64 * hb + 32 * qbw + r32;
    const int qrow = R0 + 2 * pr + (r32 >> 4), qc = 16 * jc + (r32 & 15), rs = min(max(qrow - 4, 0), 120), cs = min(max(qc - 8, 0), 48);
    const int rsw0 = min(max(R0 + 2 * pr - 4, 0), 120), rsw1 = min(max(R0 + 2 * pr + 1 - 4, 0), 120);
    for (int t = 0; t < NT; ++t) {
        if (t + 1 < NT) asm volatile("s_waitcnt vmcnt(2)" ::: "memory"); else asm volatile("s_waitcnt vmcnt(0)" ::: "memory");
        __builtin_amdgcn_s_barrier();
        if (t + 2 < NT) ATT_ISSUE(t + 2);
        const int slot = (t % 3) * SLOT;
        if (MODE == 1 && t > 0) { const int kr = kr0 + t - 1; if (kr < rsw0 || kr > rsw1 + 7) continue; }
        const int cbt = (MODE == 1 && t > 0) ? cb : 0;
        const lds_cptr kp = (lds_cptr)lds + slot + hi * 1024 + (r32 + cbt) * 16;
        const lds_cptr vp = (lds_cptr)lds + slot + 8192 + ((lane >> 4) & 1) * 32 + (lane & 3) * 8 + (4 * hi + ((lane & 15) >> 2) + cbt) * 64;
        bf16x8 kf[8];
        if (MODE == 0 && t > 0) {
#pragma unroll
            for (int d0 = 0; d0 < 4; ++d0) { kf[2 * d0] = *(const LAS bf16x8*)(kp + d0 * 2048); kf[2 * d0 + 1] = *(const LAS bf16x8*)(kp + d0 * 2048 + 512); }
        } else {
#pragma unroll
            for (int d0 = 0; d0 < 4; ++d0) { kf[2 * d0] = *(const LAS bf16x8*)(kp + d0 * 2048); kf[2 * d0 + 1] = kf[2 * d0]; }
        }
        if (t == 0) {
            if (MODE == 0) tile_qb<1, 1>(kf, qr, vp, o, m, l, wsf, r32, hi, [&](int, int r) { return r < 8 ? tabA[max(crow(r, hi) - 16 - qpos, -128) + TA_OFF] : NEGB; });
            else tile_qb<1, 1>(kf, qr, vp, o, m, l, wsf, r32, hi, [&](int, int r) { return r < 8 ? 0.f : NEGB; });
        } else if (MODE == 0) { const int base = 64 * (kt0 + t - 1) + 4 * hi - qpos + TA_OFF;
            tile_qb<2, 4>(kf, qr, vp, o, m, l, wsf, r32, hi, [&](int hf, int r) { return tabA[base + 32 * hf + (r & 3) + 8 * (r >> 2)]; });
        } else { const int kr = kr0 + t - 1; const bool rowok = kr >= rs && kr <= rs + 7; const int dr = min(max(kr - qrow + 7, 0), 14), kc0 = cb + 4 * hi;
            tile_qb<1, 2>(kf, qr, vp, o, m, l, wsf, r32, hi, [&](int, int r) { const int kc = kc0 + (r & 3) + 8 * (r >> 2); const bool ok = rowok && kc >= cs && kc < cs + 16;
                return ok ? tabB[dr * 31 + min(max(kc - qc + 15, 0), 30)] : NEGB; });
        }
    }
    if (MODE == 0) { if (hi == 0) l += __builtin_amdgcn_exp2f(F.sink[hidx] * LOG2E - m); }
    if (MODE == 0) finish_qb(F, o, l, wsf, stg, lane, r32, hi, ocol, hidx, [&](int q) { return qtok0 + q; });
    else finish_qb(F, o, l, wsf, stg, lane, r32, hi, ocol, hidx, [&](int q) { return qtok0 + (q >> 4) * 64 + (q & 15); });
    __builtin_amdgcn_s_barrier();
#undef ATT_TROW
#undef ATT_ISSUE
}
__device__ __forceinline__ void attn_phase(const Frame& F) {
    LAS float* tA = (LAS float*)(F.lds + OFF_TABA); LAS float* tB = (LAS float*)(F.lds + OFF_TABB);
    for (int i = F.tid; i < 16 * TA_W; i += 512) { const int h = i / TA_W, rel = i % TA_W - TA_OFF; tA[i] = (rel >= -128 && rel <= 128) ? F.tab[h * 272 + rel + 128] : NEGB; }
    for (int i = F.tid; i < 16 * TB_W; i += 512) { const int h = i / TB_W, k = i % TB_W; tB[i] = k < 465 ? F.rpb[h * 465 + k] * LOG2E : 0.f; }
    __syncthreads();
    for (int L = F.bx; L < 2048; L += F.G) { if (L < 1024) attn_unit<0>(F, L); else attn_unit<1>(F, L - 1024); }
    __syncthreads();
}
}

#ifndef FAST_P5
#define FAST_P5 1
#endif
__device__ __forceinline__ void route_token(const Frame& F, int tok, float lg, int lane) {
    const float score = 1.0f / (1.0f + expf(-lg)), v0 = score + F.rbias[lane];
    int rk = 0;
#pragma unroll
    for (int j = 0; j < 8; ++j) { const int o = (lane & ~7) + j; const float w = __shfl(v0, o); rk += (w > v0 || (w == v0 && o < lane)) ? 1 : 0; }
    float gs = rk < 2 ? v0 : 0.f; gs += __shfl_xor(gs, 1); gs += __shfl_xor(gs, 2); gs += __shfl_xor(gs, 4);
    int grk = 0; const int myg = lane >> 3;
#pragma unroll
    for (int g = 0; g < 8; ++g) { const float w = __shfl(gs, g * 8); grk += (w > gs || (w == gs && g < myg)) ? 1 : 0; }
    const float mv = grk < 4 ? v0 : -INFINITY;
    int erk = 0;
    for (int o = 0; o < 64; ++o) { const float w = __shfl(mv, o); erk += (w > mv || (w == mv && o < lane)) ? 1 : 0; }
    const bool sel = erk < 8;
    const float wsm = wsum(sel ? score : 0.f), wgt = score / (wsm + 1e-20f) * 2.5f;
    if (sel) { const int rr = atomicAdd(F.cnt + lane, 1); F.tokl[(size_t)lane * NTOK + rr] = tok; F.wl[(size_t)lane * NTOK + rr] = wgt; F.tke[tok * 8 + erk] = lane; F.tkr[tok * 8 + erk] = rr; }
}
__device__ __forceinline__ void phase_ln1_router_fast(Frame& F) {
    constexpr int HSTR = 4112;
    LAS unsigned char* hb = F.lds; LAS float* part = (LAS float*)F.lds;
    const int lane = F.lane, w = F.wave, r32 = lane & 31, hi = lane >> 5;
    for (int it = F.bx; it < NTOK / 32; it += F.G) {
        const int t0 = it * 32;
#pragma unroll
        for (int pr = 0; pr < 2; ++pr) {
            f32x4 v[2][8];
#pragma unroll
            for (int q = 0; q < 2; ++q) { const float* src = F.z + (size_t)(t0 + 4 * w + 2 * pr + q) * D;
#pragma unroll
                for (int j = 0; j < 8; ++j) v[q][j] = *(const f32x4*)(src + (j * 64 + lane) * 4); }
#pragma unroll
            for (int q = 0; q < 2; ++q) { const int row = 4 * w + 2 * pr + q, tok = t0 + row; float s = 0.f;
#pragma unroll
                for (int j = 0; j < 8; ++j) s += (v[q][j][0] + v[q][j][1]) + (v[q][j][2] + v[q][j][3]);
                const float mu = wsum(s) * (1.0f / D); float qq = 0.f;
#pragma unroll
                for (int j = 0; j < 8; ++j) { const f32x4 d = v[q][j] - mu; qq += (d[0] * d[0] + d[1] * d[1]) + (d[2] * d[2] + d[3] * d[3]); }
                const float rstd = 1.0f / sqrtf(wsum(qq) * (1.0f / D) + LN_EPS);
#pragma unroll
                for (int j = 0; j < 8; ++j) { const int c = (j * 64 + lane) * 4; const f32x4 g = *(const f32x4*)(F.l1g + c), bb = *(const f32x4*)(F.l1b + c); const f32x4 y = (v[q][j] - mu) * rstd * g + bb;
                    const u32x2 pk = (u32x2){pack2(y[0], y[1]), pack2(y[2], y[3])};
                    *(u32x2*)(F.h1 + (size_t)tok * D + c) = pk; *(LAS u32x2*)(hb + row * HSTR + c * 2) = pk; }
                if (lane == 0) { F.stats1[tok * 2] = mu; F.stats1[tok * 2 + 1] = rstd; } }
        }
        __syncthreads();
        att::f32x16 acc[2]; acc[0] = att::f32x16{}; acc[1] = att::f32x16{};
        const bf16_t* wb = F.wrt + (size_t)r32 * D + 256 * w + hi * 8;
#pragma unroll 4
        for (int s = 0; s < 16; ++s) {
            const att::bf16x8 a = *(const LAS att::bf16x8*)(hb + r32 * HSTR + (256 * w + 16 * s + 8 * hi) * 2);
            const att::bf16x8 b0 = *(const att::bf16x8*)(wb + 16 * s), b1 = *(const att::bf16x8*)(wb + (size_t)32 * D + 16 * s);
            acc[0] = __builtin_amdgcn_mfma_f32_32x32x16_bf16(a, b0, acc[0], 0, 0, 0); acc[1] = __builtin_amdgcn_mfma_f32_32x32x16_bf16(a, b1, acc[1], 0, 0, 0); }
        __syncthreads();
#pragma unroll
        for (int nt = 0; nt < 2; ++nt)
#pragma unroll
            for (int r = 0; r < 16; ++r) part[(w * 32 + att::crow(r, hi)) * 64 + 32 * nt + r32] = acc[nt][r];
        __syncthreads();
        for (int q = 0; q < 4; ++q) { const int row = 4 * w + q; float lg = 0.f;
#pragma unroll
            for (int ww = 0; ww < 8; ++ww) lg += part[(ww * 32 + row) * 64 + lane];
            route_token(F, t0 + row, lg, lane); }
        __syncthreads();
    }
}

__global__ void __launch_bounds__(512, 2) mk_fwd(Args args) {
    extern __shared__ __attribute__((aligned(16))) unsigned char lds_raw[];
    Frame F; F.lds = (LAS unsigned char*)lds_raw; F.tid = threadIdx.x; F.lane = F.tid & 63; F.wave = __builtin_amdgcn_readfirstlane(F.tid >> 6); F.G = gridDim.x; F.bx = blockIdx.x;
    F.x = args.in[0]; F.meta = args.in[1]; F.lng = args.in[2]; F.lnb = args.in[3]; F.t5 = args.in[4]; F.w_in = args.in[5]; F.sink = args.in[6]; F.rpb = args.in[7]; F.ga = args.in[8]; F.gb = args.in[9];
    F.w_out = args.in[10]; F.l1g = args.in[11]; F.l1b = args.in[12]; F.w_router = args.in[13]; F.rbias = args.in[14]; F.w_gate = args.in[15]; F.w_up = args.in[16]; F.w_down = args.in[17];
    F.ws_gate = args.in[18]; F.ws_up = args.in[19]; F.ws_down = args.in[20]; F.l2g = args.in[21]; F.l2b = args.in[22]; F.out = args.out; F.ws = args.ws;
    unsigned char* ws = args.ws;
    F.stats0 = (float*)(ws + WS_STATS0); F.stats1 = (float*)(ws + WS_STATS1); F.ssq = (float*)(ws + WS_SSQ); F.wl = (float*)(ws + WS_WL); F.tab = (float*)(ws + WS_TAB); F.z = (float*)(ws + WS_Z);
    F.cnt = (int*)(ws + WS_CNT); F.tokl = (int*)(ws + WS_TOKL); F.tke = (int*)(ws + WS_TKE); F.tkr = (int*)(ws + WS_TKR);
    F.wtd = (bf16_t*)(ws + WS_WTD); F.hb = (bf16_t*)(ws + WS_HB); F.wtgu = (bf16_t*)(ws + WS_WTGU); F.wtin = (bf16_t*)(ws + WS_WTIN); F.wtout = (bf16_t*)(ws + WS_WTOUT);
    F.h0 = (bf16_t*)(ws + WS_H0); F.u = (bf16_t*)(ws + WS_U); F.ya = (bf16_t*)(ws + WS_YA); F.h1 = (bf16_t*)(ws + WS_H1); F.ym = (bf16_t*)(ws + WS_YM); F.wrt = (bf16_t*)(ws + WS_WRT);
    volatile LAS unsigned* xbw = (volatile LAS unsigned*)(F.lds + LDS_BYTES - 16);
    LAS int* ps = (LAS int*)(F.lds + 131072);
    if (F.tid < 4) xbw[F.tid] = 0u;
    __syncthreads();
    const int lo = args.ph_lo, hi = args.ph_hi;
    XcdBarrier bar; bar.bar = (unsigned*)(ws + WS_CTL); bar.x = 0; bar.st = xbw;
    if (hi - lo > 1) bar = xcd_barrier_post((unsigned*)(ws + WS_CTL), xbw);
#ifndef PROBE_REPEAT
#define PROBE_REPEAT -1
#endif
#define IN(k) (lo <= (k) && (k) < hi)
#define SEAM(k) do { if (IN(k) && IN((k) + 1)) xcd_barrier(bar); } while (0)
    if (IN(0)) { phase_prologue(F); if (PROBE_REPEAT == 0) { xcd_barrier(bar); phase_prologue(F); } } SEAM(0);
    if (IN(1)) for (int rep = 0; rep < (PROBE_REPEAT == 1 ? 2 : 1); ++rep) { if (rep) xcd_barrier(bar);
#if FAST_P1
        SchedInProj S{(const char*)F.h0, (const char*)F.wtin, F.G, F.bx}; EpiU E{F.u};
        pg8::gemm_phase(F.lds, S, E, D, D, D / 64);
#else
        FnInProj f{F}; sgemm(f, F.lds, F.tid, F.bx, F.G);
#endif
    } SEAM(1);
    if (IN(2)) {
#if FAST_P2
        att::attn_phase(F); if (PROBE_REPEAT == 2) { xcd_barrier(bar); att::attn_phase(F); }
#else
        phase_attn_simple(F);
#endif
    } SEAM(2);
    if (IN(3)) for (int rep = 0; rep < 1; rep += 1) { if (rep) xcd_barrier(bar); phase_rmsnorm(F); } SEAM(3);
    if (IN(4)) for (int rep = 0; rep < (PROBE_REPEAT == 4 ? 2 : 1); ++rep) { if (rep) xcd_barrier(bar);
#if FAST_P4
        SchedOutProj S{(const char*)F.ya, (const char*)F.wtout, F.G, F.bx}; EpiZ E{F.z, F.x, F.stats0, F.lng, F.lnb};
        pg8::gemm_phase(F.lds, S, E, D, D, D / 64);
#else
        FnOutProj f{F}; sgemm(f, F.lds, F.tid, F.bx, F.G);
#endif
    } SEAM(4);
#if FAST_P5
#define PH5(F) phase_ln1_router_fast(F)
#else
#define PH5(F) phase_ln1_router(F)
#endif
    if (IN(5)) { PH5(F); if (PROBE_REPEAT == 5) { xcd_barrier(bar); if (F.bx == 0 && F.tid < 64) F.cnt[F.tid] = 0; xcd_barrier(bar); PH5(F); } } SEAM(5);
    if (IN(6)) for (int rep = 0; rep < (PROBE_REPEAT == 6 ? 2 : 1); ++rep) { if (rep) xcd_barrier(bar);
#if FAST_P6
        moe_tables(F, ps);
        SchedGU S{(const char*)F.h1, (const char*)F.wtgu, F.tokl, F.cnt, ps, F.G, F.bx}; EpiGU E{F.hb, F.wl};
        pg8::gemm_phase(F.lds, S, E, D, D, D / 64);
#else
        expert_starts(F, ps); FnGateUp f{F, ps}; sgemm(f, F.lds, F.tid, F.bx, F.G);
#endif
    } SEAM(6);
    if (IN(7)) for (int rep = 0; rep < (PROBE_REPEAT == 7 ? 2 : 1); ++rep) { if (rep) xcd_barrier(bar);
#if FAST_P7
        moe_tables(F, ps);
        SchedDown S{(const char*)F.hb, (const char*)F.wtd, F.cnt, ps, F.G, F.bx}; EpiDown E{F.ym, F.out, F.wl, F.z, F.stats1, F.l1g, F.l1b, rep};
        pg8::gemm_phase(F.lds, S, E, DE, DE, DE / 64);
#else
        expert_starts(F, ps); { FnDown f{F, ps}; sgemm(f, F.lds, F.tid, F.bx, F.G); } { FnFinal f{F, ps}; sgemm(f, F.lds, F.tid, F.bx, F.G); }
#endif
    } SEAM(7);
    if (IN(8)) { expert_starts(F, ps); phase_ln2(F, ps); }
#undef IN
#undef SEAM
}

extern "C" void kernel_launch(void* const* d_in, const int* in_sizes, int n_in, void* d_out, int out_size, void* d_ws, size_t ws_size, hipStream_t stream) {
    static int grid = 0;
    if (grid == 0) {
        if (n_in != 23 || in_sizes[0] != NTOK * D || out_size != NTOK * D || ws_size < WS_END) {
            fprintf(stderr, "kernel_launch: built for 23 inputs, x/out of %d floats, >= %zu bytes of workspace; got n_in %d in0 %d out %d ws %zu; nothing launched\n", NTOK * D, (size_t)WS_END, n_in, n_in > 0 ? in_sizes[0] : -1, out_size, ws_size);
            grid = -1; return; }
        int dev = 0, cus = 0, per_cu = 0;
        if (hipGetDevice(&dev) != hipSuccess || hipDeviceGetAttribute(&cus, hipDeviceAttributeMultiprocessorCount, dev) != hipSuccess) { fprintf(stderr, "kernel_launch: device query failed\n"); grid = -1; return; }
        if (hipFuncSetAttribute((const void*)mk_fwd, hipFuncAttributeMaxDynamicSharedMemorySize, LDS_BYTES) != hipSuccess) { fprintf(stderr, "kernel_launch: hipFuncSetAttribute failed\n"); grid = -1; return; }
        if (hipOccupancyMaxActiveBlocksPerMultiprocessor(&per_cu, (const void*)mk_fwd, 512, LDS_BYTES) != hipSuccess || per_cu < 1) fprintf(stderr, "kernel_launch: note: occupancy query reports %d\n", per_cu);
        (void)hipGetLastError();
        grid = cus;
    }
    if (grid < 0) return;
    if (hipMemsetAsync((char*)d_ws + WS_CTL, 0, CTL_BYTES, stream) != hipSuccess) { fprintf(stderr, "kernel_launch: memset failed\n"); return; }
    Args a{};
    for (int i = 0; i < 23; ++i) a.in[i] = (const float*)d_in[i];
    a.out = (float*)d_out; a.ws = (unsigned char*)d_ws;
#if MK_ONE_LAUNCH
    a.ph_lo = 0; a.ph_hi = NPHASE;
    hipLaunchKernelGGL(mk_fwd, dim3(grid), dim3(512), LDS_BYTES, stream, a);
#else
    for (int p = 0; p < NPHASE; ++p) { a.ph_lo = p; a.ph_hi = p + 1; hipLaunchKernelGGL(mk_fwd, dim3(grid), dim3(512), LDS_BYTES, stream, a); }
#endif
    const hipError_t le = hipPeekAtLastError();
    if (le != hipSuccess) fprintf(stderr, "kernel_launch: launch failed: %s\n", hipGetErrorName(le));
}
```

```cpp
#include <hip/hip_runtime.h>
#include <cstdio>
#include <cstdint>

#define LAS __attribute__((address_space(3)))
typedef unsigned short bf16_t;
typedef float f32x4 __attribute__((ext_vector_type(4)));
typedef unsigned u32x4 __attribute__((ext_vector_type(4)));
typedef unsigned u32x2 __attribute__((ext_vector_type(2)));

#ifndef MK_ONE_LAUNCH
#define MK_ONE_LAUNCH 1
#endif

constexpr int D = 2048, SEQ = 8192, NB = 2, NTOK = NB * SEQ;
constexpr int NMETA = 16, INW = 4608, MROWS = NTOK + 256;
constexpr int NE = 64, DE = 512, PMAX = 147456, HBROWS = PMAX + NTOK;
constexpr float ALPHA = 1.189207115002721f;
constexpr float LN_EPS = 1e-5f, RMS_EPS = 1e-6f, LOG2E = 1.4426950408889634f, QSCALE = 0.125f * LOG2E;
constexpr int COL_QA = 0, COL_KA = 1024, COL_VA = 1280, COL_QB = 1536, COL_KB = 2560, COL_VB = 3584;
constexpr int NPHASE = 9;
constexpr int LDS_BYTES = 147456;

constexpr size_t WS_CTL = 0, CTL_BYTES = 32768;
constexpr size_t WS_CNT = 16384;
constexpr size_t WS_STATS0 = WS_CTL + CTL_BYTES;
constexpr size_t WS_STATS1 = WS_STATS0 + (size_t)NTOK * 8;
constexpr size_t WS_SSQ = WS_STATS1 + (size_t)NTOK * 8;
constexpr size_t WS_TOKL = WS_SSQ + (size_t)NTOK * 32 * 4;
constexpr size_t WS_WL = WS_TOKL + (size_t)NE * NTOK * 4;
constexpr size_t WS_TKE = WS_WL + (size_t)NE * NTOK * 4;
constexpr size_t WS_TKR = WS_TKE + (size_t)NTOK * 8 * 4;
constexpr size_t WS_TAB = WS_TKR + (size_t)NTOK * 8 * 4;
constexpr size_t WS_WRT = WS_TAB + 32768;
constexpr size_t WS_Z = WS_WRT + (size_t)NE * D * 2;
constexpr size_t WS_O2 = WS_Z + (size_t)NTOK * D * 2;
constexpr size_t WS_WTD = WS_Z + (size_t)NTOK * D * 4;
constexpr size_t WS_HB = WS_WTD + (size_t)65 * 2048 * 512 * 2;
constexpr size_t WS_B = WS_HB + (size_t)HBROWS * 512 * 2;
constexpr size_t WS_WTGU = WS_B;
constexpr size_t WS_WTIN = WS_WTGU + (size_t)65 * 1024 * 2048 * 2;
constexpr size_t WS_WTOUT = WS_WTIN + (size_t)INW * D * 2;
constexpr size_t WS_H0 = WS_WTOUT + (size_t)D * D * 2;
constexpr size_t WS_U = WS_H0 + (size_t)MROWS * D * 2;
constexpr size_t WS_YA = WS_U + (size_t)MROWS * INW * 2;
constexpr size_t WS_H1 = WS_Z;
constexpr size_t WS_YM = WS_B;
constexpr size_t WS_END_A = WS_YA + (size_t)NTOK * D * 2, WS_END_B = WS_YM + (size_t)PMAX * D * 2;
constexpr size_t WS_END = WS_END_A > WS_END_B ? WS_END_A : WS_END_B;
static_assert(WS_END <= ((size_t)1 << 30), "workspace map must fit 1 GiB");

__device__ __forceinline__ float bf2f(bf16_t b) { return __uint_as_float(((unsigned)b) << 16); }
__device__ __forceinline__ bf16_t f2bf(float f) { unsigned u = __float_as_uint(f); u += 0x7FFFu + ((u >> 16) & 1u); return (bf16_t)(u >> 16); }
__device__ __forceinline__ unsigned pack2(float lo, float hi) { return (unsigned)f2bf(lo) | ((unsigned)f2bf(hi) << 16); }
__device__ __forceinline__ float wsum(float v) {
#pragma unroll
    for (int o = 32; o >= 1; o >>= 1) v += __shfl_xor(v, o);
    return v; }
__device__ __forceinline__ float wmax(float v) {
#pragma unroll
    for (int o = 32; o >= 1; o >>= 1) v = fmaxf(v, __shfl_xor(v, o));
    return v; }
__device__ __forceinline__ int t5_bucket(int rel) {
    const int ret = rel > 0 ? 16 : 0, n = rel < 0 ? -rel : rel;
    if (n < 8) return ret + n;
    const int n2 = n > 32768 ? 0x40000000 : n * n; int lg = 31 - __clz(n2) + 2; if (lg > 15) lg = 15;
    return ret + lg; }

#define XB_TMO      128
#define XB_XCNT(j)  (256  + 64 * (j))
#define XB_XSUB(j)  (1280 + 64 * (j))
#define XB_XGEN(j)  (2304 + 64 * (j))
#define XB_TOP      3328
#define XB_TOPGEN   3392
#define XCD_BAR_WORDS 3456
#define XB_SPIN_CAP (1u << 18)
__device__ __forceinline__ unsigned xb_ld(unsigned* p)              { return __hip_atomic_load(p, __ATOMIC_RELAXED, __HIP_MEMORY_SCOPE_AGENT); }
__device__ __forceinline__ unsigned xb_add(unsigned* p, unsigned v) { return __hip_atomic_fetch_add(p, v, __ATOMIC_RELAXED, __HIP_MEMORY_SCOPE_AGENT); }
__device__ __forceinline__ unsigned xb_xcc_id() { return (unsigned)__builtin_amdgcn_s_getreg((3 << 11) | 20) & 0xFu; }
#define XB_SPIN(cond, bar) do { unsigned _sp = 0; while (cond) { __builtin_amdgcn_s_sleep(1); \
    if ((++_sp & 255u) == 0u) { if (xb_ld(&(bar)[XB_TMO])) break; if (_sp > XB_SPIN_CAP) { atomicAdd(&(bar)[XB_TMO], 1u); break; } } } } while (0)
struct XcdBarrier { unsigned* bar; unsigned x; volatile LAS unsigned* st; };
__device__ __forceinline__ XcdBarrier xcd_barrier_post(unsigned* bar, volatile LAS unsigned* st) {
    XcdBarrier b; b.bar = bar; b.x = xb_xcc_id(); b.st = st;
    if (threadIdx.x == 0) (void)xb_add(&bar[XB_XCNT(b.x)], 1u);
    return b;
}
__device__ __forceinline__ void xcd_barrier_complete(unsigned* bar, unsigned x, unsigned& nloc, unsigned& nx) {
    const unsigned G = gridDim.x * gridDim.y * gridDim.z;
    unsigned sum, cnt, mine, sp = 0u;
    for (;;) {
        sum = 0u; cnt = 0u; mine = 0u;
#pragma unroll
        for (unsigned j = 0; j < 16; ++j) { const unsigned c = xb_ld(&bar[XB_XCNT(j)]); sum += c; cnt += (c > 0u) ? 1u : 0u; mine = (j == x) ? c : mine; }
        if (sum == G) break;
        __builtin_amdgcn_s_sleep(1);
        if ((++sp & 255u) == 0u) { if (xb_ld(&bar[XB_TMO])) break; if (sp > XB_SPIN_CAP) { atomicAdd(&bar[XB_TMO], 1u); break; } }
    }
    nloc = mine > 0u ? mine : 1u; nx = cnt > 0u ? cnt : 1u;
}
__device__ __forceinline__ void xcd_barrier(const XcdBarrier& b) {
    asm volatile("s_waitcnt vmcnt(0)" ::: "memory");
    __syncthreads();
    if (threadIdx.x == 0) {
        unsigned* bar = b.bar;
        __builtin_amdgcn_s_waitcnt(0);
        unsigned nloc = b.st[0], nx = b.st[1];
        if (nloc == 0u) { xcd_barrier_complete(bar, b.x, nloc, nx); b.st[0] = nloc; b.st[1] = nx; }
        const unsigned old = xb_add(&bar[XB_XSUB(b.x)], 1u);
        const unsigned gen = old / nloc;
        if (old + 1u == (gen + 1u) * nloc) {
            __builtin_amdgcn_fence(__ATOMIC_RELEASE, "agent");
            asm volatile("s_waitcnt vmcnt(0)" ::: "memory");
            const unsigned og = xb_add(&bar[XB_TOP], 1u);
            const unsigned tg = og / nx;
            if (og + 1u == (tg + 1u) * nx) xb_add(&bar[XB_TOPGEN], 1u);
            else XB_SPIN(xb_ld(&bar[XB_TOPGEN]) == tg, bar);
            __builtin_amdgcn_fence(__ATOMIC_ACQUIRE, "agent");
            xb_add(&bar[XB_XGEN(b.x)], 1u);
            asm volatile("s_waitcnt vmcnt(0)" ::: "memory");
        } else {
            XB_SPIN(xb_ld(&bar[XB_XGEN(b.x)]) == gen, bar);
            __builtin_amdgcn_fence(__ATOMIC_ACQUIRE, "agent");
            asm volatile("s_waitcnt vmcnt(0)" ::: "memory");
        }
    }
    __syncthreads();
}

struct Args { const float* in[23]; float* out; unsigned char* ws; int ph_lo, ph_hi; };
struct Frame {
    LAS unsigned char* lds; int tid, lane, wave, G, bx;
    const float *x, *meta, *lng, *lnb, *t5, *w_in, *sink, *rpb, *ga, *gb, *w_out, *l1g, *l1b, *w_router, *rbias, *w_gate, *w_up, *w_down, *ws_gate, *ws_up, *ws_down, *l2g, *l2b;
    float* out; unsigned char* ws;
    __device__ __forceinline__ void fresh() { int t = threadIdx.x; asm volatile("" : "+v"(t)); tid = t; lane = t & 63; wave = __builtin_amdgcn_readfirstlane(t >> 6); }
    __device__ __forceinline__ float* stats0() const { return (float*)(ws + WS_STATS0); }
    __device__ __forceinline__ float* stats1() const { return (float*)(ws + WS_STATS1); }
    __device__ __forceinline__ float* ssq() const { return (float*)(ws + WS_SSQ); }
    __device__ __forceinline__ float* wl() const { return (float*)(ws + WS_WL); }
    __device__ __forceinline__ float* tab() const { return (float*)(ws + WS_TAB); }
    __device__ __forceinline__ int* cnt() const { return (int*)(ws + WS_CNT); }
    __device__ __forceinline__ int* tokl() const { return (int*)(ws + WS_TOKL); }
    __device__ __forceinline__ int* tke() const { return (int*)(ws + WS_TKE); }
    __device__ __forceinline__ int* tkr() const { return (int*)(ws + WS_TKR); }
    __device__ __forceinline__ bf16_t* wtd() const { return (bf16_t*)(ws + WS_WTD); }
    __device__ __forceinline__ bf16_t* hb() const { return (bf16_t*)(ws + WS_HB); }
    __device__ __forceinline__ bf16_t* wtgu() const { return (bf16_t*)(ws + WS_WTGU); }
    __device__ __forceinline__ bf16_t* wtin() const { return (bf16_t*)(ws + WS_WTIN); }
    __device__ __forceinline__ bf16_t* wtout() const { return (bf16_t*)(ws + WS_WTOUT); }
    __device__ __forceinline__ bf16_t* h0() const { return (bf16_t*)(ws + WS_H0); }
    __device__ __forceinline__ bf16_t* u() const { return (bf16_t*)(ws + WS_U); }
    __device__ __forceinline__ bf16_t* ya() const { return (bf16_t*)(ws + WS_YA); }
    __device__ __forceinline__ bf16_t* h1() const { return (bf16_t*)(ws + WS_H1); }
    __device__ __forceinline__ bf16_t* ym() const { return (bf16_t*)(ws + WS_YM); }
    __device__ __forceinline__ bf16_t* wrt() const { return (bf16_t*)(ws + WS_WRT); }
    __device__ __forceinline__ bf16_t* z() const { return (bf16_t*)(ws + WS_Z); }
    __device__ __forceinline__ bf16_t* o2() const { return (bf16_t*)(ws + WS_O2); }
};

__device__ __forceinline__ void transpose_item(const float* src, size_t ld_src, bf16_t* dst, size_t ld_dst, LAS float* scr, int lane, const float* kscale, float cscale) {
    f32x4 v[16];
    const int kk = lane & 3, n4 = (lane >> 2) * 4;
#pragma unroll
    for (int p = 0; p < 16; ++p) v[p] = *(const f32x4*)(src + (size_t)(4 * p + kk) * ld_src + n4);
#pragma unroll
    for (int p = 0; p < 16; ++p) { const int k = 4 * p + kk; const float s = kscale ? kscale[k] * cscale : cscale;
        scr[k * 65 + n4] = v[p][0] * s; scr[k * 65 + n4 + 1] = v[p][1] * s; scr[k * 65 + n4 + 2] = v[p][2] * s; scr[k * 65 + n4 + 3] = v[p][3] * s; }
    asm volatile("s_waitcnt lgkmcnt(0)" ::: "memory");
    const int c = lane >> 3;
#pragma unroll
    for (int j = 0; j < 8; ++j) { const int n = (lane & 7) + 8 * j; const LAS float* s = scr + (8 * c) * 65 + n; u32x4 o;
        o.x = pack2(s[0], s[65]); o.y = pack2(s[2 * 65], s[3 * 65]); o.z = pack2(s[4 * 65], s[5 * 65]); o.w = pack2(s[6 * 65], s[7 * 65]);
        *(u32x4*)(dst + (size_t)n * ld_dst + 8 * c) = o; }
    asm volatile("s_waitcnt lgkmcnt(0)" ::: "memory");
}
constexpr int T_R = 32, T_IN = 72 * 32, T_OUT = 32 * 32, T_GU = 65 * 2 * 8 * 32, T_D = 65 * 32 * 8;
constexpr int IT_P0 = T_R + T_IN, IT_ALL = IT_P0 + T_OUT + T_GU + T_D, IT_P6 = IT_ALL - 6400;
__device__ __forceinline__ void conv_item(const Frame& F, int it, LAS float* t) {
    int r = it; const float* src; bf16_t* dst; int lds_, ldd_; const float* ksc = nullptr; float csc = 1.0f;
    if (r < T_R) { src = F.w_router + (size_t)(r * 64) * NE; lds_ = NE; dst = F.wrt() + r * 64; ldd_ = D; }
    else if ((r -= T_R) < T_IN) { const int tn = r % 72, tk = r / 72; const int n0 = tn * 64; const bool isq = (n0 < COL_KA) || (n0 >= COL_QB && n0 < COL_KB);
        src = F.w_in + (size_t)(tk * 64) * INW + n0; lds_ = INW; dst = F.wtin() + (size_t)n0 * D + tk * 64; ldd_ = D; csc = isq ? QSCALE : 1.0f; }
    else if ((r -= T_IN) < T_OUT) { const int tn = r % 32, tk = r / 32; const int k0 = tk * 64;
        src = F.w_out + (size_t)k0 * D + tn * 64; lds_ = D; dst = F.wtout() + (size_t)(tn * 64) * D + k0; ldd_ = D; ksc = k0 < 1024 ? F.ga + k0 : F.gb + (k0 - 1024); }
    else if ((r -= T_OUT) < T_GU) { const int tn = r % 8, tk = (r / 8) % 32, which = (r / 256) % 2, e = r / 512;
        const float* s0 = e < NE ? (which ? F.w_up : F.w_gate) + (size_t)e * D * DE : (which ? F.ws_up : F.ws_gate);
        const int c0 = tn * 64, nprime = 256 * (c0 / 128) + 128 * which + (c0 % 128);
        src = s0 + (size_t)(tk * 64) * DE + c0; lds_ = DE; dst = F.wtgu() + ((size_t)e * 1024 + nprime) * D + tk * 64; ldd_ = D; }
    else { r -= T_GU; const int tn = r % 32, tk = (r / 32) % 8, e = r / 256;
        const float* s0 = e < NE ? F.w_down + (size_t)e * DE * D : F.ws_down;
        src = s0 + (size_t)(tk * 64) * D + tn * 64; lds_ = D; dst = F.wtd() + ((size_t)e * D + tn * 64) * DE + tk * 64; ldd_ = DE; }
    transpose_item(src, (size_t)lds_, dst, (size_t)ldd_, t, F.lane, ksc, csc);
}
__device__ __forceinline__ void conv_range(const Frame& F, int first, int last) {
    LAS float* t = (LAS float*)F.lds + F.wave * (64 * 65);
    for (int it = first + F.wave; it < last; it += 8) conv_item(F, it, t);
}
__device__ __forceinline__ void conv_inproj_share(const Frame& F) {
    constexpr int N1 = IT_P6 - IT_P0; int a, n;
    if (F.G == 256) { if (F.bx < 138) { a = F.bx * 128; n = 128; } else { a = 138 * 128 + (F.bx - 138) * 228; n = 228; } }
    else { n = (N1 + F.G - 1) / F.G; a = F.bx * n; }
    const int e = a + n < N1 ? a + n : N1;
    if (a < e) conv_range(F, IT_P0 + a, IT_P0 + e);
}
__device__ __forceinline__ void conv_tail(const Frame& F, int first, int last, int c0) {
    int nw = F.G - c0, me = F.bx - c0; if (nw <= 0) { nw = F.G; me = F.bx; }
    if (me < 0) return;
    LAS float* t = (LAS float*)F.lds + F.wave * (64 * 65);
    for (int r = first + me * 8 + F.wave; r < last; r += nw * 8) conv_item(F, r, t);
}
__device__ __forceinline__ void phase_prologue(Frame& F) {
    LAS float* t = (LAS float*)F.lds + F.wave * (64 * 65);
    const int gw = F.bx * 8 + F.wave, NGW = F.G * 8;
    for (int it = gw; it < IT_P0; it += NGW) conv_item(F, it, t);
    for (int row = gw; row < MROWS; row += NGW) {
        bf16_t* dst = F.h0() + (size_t)row * D;
        if (row >= NTOK + NMETA) {
#pragma unroll
            for (int j = 0; j < 8; ++j) *(u32x2*)(dst + (j * 64 + F.lane) * 4) = (u32x2){0u, 0u};
            continue; }
        const float* src = row < NTOK ? F.x + (size_t)row * D : F.meta + (size_t)(row - NTOK) * D;
        f32x4 v[8]; float s = 0.f;
#pragma unroll
        for (int j = 0; j < 8; ++j) { v[j] = *(const f32x4*)(src + (j * 64 + F.lane) * 4); s += (v[j][0] + v[j][1]) + (v[j][2] + v[j][3]); }
        const float mu = wsum(s) * (1.0f / D); float q = 0.f;
#pragma unroll
        for (int j = 0; j < 8; ++j) { const f32x4 d = v[j] - mu; q += (d[0] * d[0] + d[1] * d[1]) + (d[2] * d[2] + d[3] * d[3]); }
        const float rstd = 1.0f / sqrtf(wsum(q) * (1.0f / D) + LN_EPS);
#pragma unroll
        for (int j = 0; j < 8; ++j) { const int c = (j * 64 + F.lane) * 4; const f32x4 g = *(const f32x4*)(F.lng + c), b = *(const f32x4*)(F.lnb + c); const f32x4 y = (v[j] - mu) * rstd * g + b;
            *(u32x2*)(dst + c) = (u32x2){pack2(y[0], y[1]), pack2(y[2], y[3])}; }
        if (row < NTOK && F.lane == 0) { F.stats0()[row * 2] = mu; F.stats0()[row * 2 + 1] = rstd; }
    }
    if (F.bx == 0) for (int i = F.tid; i < 16 * 272; i += 512) { const int h = i / 272, r = i % 272; F.tab()[i] = r <= 256 ? F.t5[t5_bucket(r - 128) * 16 + h] * LOG2E : 0.f; }
}

template <class Fn> __device__ __forceinline__ void sgemm(const Fn& f, LAS unsigned char* ldsb, int tid, int bx, int G) {
    LAS float* As = (LAS float*)ldsb; LAS float* Bs = As + 32 * 132; LAS float* Bs2 = Bs + 32 * 68;
    const int ntm = f.ntm(), ntn = f.ntn(), K = f.K();
    const int tx = tid & 15, ty = tid >> 4, ar = tid >> 2, akc = (tid & 3) * 8, br = (tid & 255) >> 2;
    for (int tile = bx; tile < ntm * ntn; tile += G) {
        const int tm = tile / ntn, tn = tile % ntn;
        typename Fn::Tile T; if (!f.tile(tm, T)) continue;
        float acc[4][4], acc2[4][4];
#pragma unroll
        for (int i = 0; i < 4; ++i)
#pragma unroll
            for (int j = 0; j < 4; ++j) { acc[i][j] = 0.f; acc2[i][j] = 0.f; }
        const bf16_t* ap = f.arow(T, tm * 128 + ar);
        const bf16_t* bp = tid < 256 ? f.brow(T, tn * 64 + br) : (Fn::DUAL ? f.brow2(T, tn * 64 + br) : nullptr);
        LAS float* Bw = tid < 256 ? Bs : Bs2;
        for (int k0 = 0; k0 < K; k0 += 32) {
            u32x4 av = (u32x4){0u, 0u, 0u, 0u}, bv = (u32x4){0u, 0u, 0u, 0u};
            if (ap) av = *(const u32x4*)(ap + k0 + akc);
            if (bp) bv = *(const u32x4*)(bp + k0 + akc);
            __syncthreads();
#pragma unroll
            for (int i = 0; i < 4; ++i) { As[(akc + 2 * i) * 132 + ar] = __uint_as_float(av[i] << 16); As[(akc + 2 * i + 1) * 132 + ar] = __uint_as_float(av[i] & 0xffff0000u); }
            if (tid < 256 || Fn::DUAL) {
#pragma unroll
                for (int i = 0; i < 4; ++i) { Bw[(akc + 2 * i) * 68 + br] = __uint_as_float(bv[i] << 16); Bw[(akc + 2 * i + 1) * 68 + br] = __uint_as_float(bv[i] & 0xffff0000u); } }
            __syncthreads();
#pragma unroll 8
            for (int kk = 0; kk < 32; ++kk) {
                const f32x4 a = *(const LAS f32x4*)(As + kk * 132 + ty * 4), b = *(const LAS f32x4*)(Bs + kk * 68 + tx * 4);
#pragma unroll
                for (int i = 0; i < 4; ++i)
#pragma unroll
                    for (int j = 0; j < 4; ++j) acc[i][j] += a[i] * b[j];
                if (Fn::DUAL) { const f32x4 b2 = *(const LAS f32x4*)(Bs2 + kk * 68 + tx * 4);
#pragma unroll
                    for (int i = 0; i < 4; ++i)
#pragma unroll
                        for (int j = 0; j < 4; ++j) acc2[i][j] += a[i] * b2[j]; }
            }
        }
#pragma unroll
        for (int i = 0; i < 4; ++i)
#pragma unroll
            for (int j = 0; j < 4; ++j) f.store(T, tm * 128 + ty * 4 + i, tn * 64 + tx * 4 + j, acc[i][j], acc2[i][j]);
    }
}

__device__ __forceinline__ void expert_starts(const Frame& F, LAS int* ps  ) {
    if (F.tid == 0) { int acc = 0; for (int e = 0; e < NE; ++e) { ps[e] = acc; acc += ((F.cnt()[e] + 255) >> 8) << 8; } ps[64] = acc; }
    __syncthreads();
}

struct FnInProj {
    static constexpr bool DUAL = false; struct Tile {}; const Frame& F;
    __device__ int ntm() const { return MROWS / 128; } __device__ int ntn() const { return INW / 64; } __device__ int K() const { return D; }
    __device__ bool tile(int, Tile&) const { return true; }
    __device__ const bf16_t* arow(const Tile&, int row) const { return F.h0() + (size_t)row * D; }
    __device__ const bf16_t* brow(const Tile&, int n) const { return F.wtin() + (size_t)n * D; }
    __device__ const bf16_t* brow2(const Tile&, int) const { return nullptr; }
    __device__ void store(const Tile&, int row, int n, float a, float) const { F.u()[(size_t)row * INW + n] = f2bf(a); }
};
struct FnOutProj {
    static constexpr bool DUAL = false; struct Tile {}; const Frame& F;
    __device__ int ntm() const { return NTOK / 128; } __device__ int ntn() const { return D / 64; } __device__ int K() const { return D; }
    __device__ bool tile(int, Tile&) const { return true; }
    __device__ const bf16_t* arow(const Tile&, int row) const { return F.ya() + (size_t)row * D; }
    __device__ const bf16_t* brow(const Tile&, int n) const { return F.wtout() + (size_t)n * D; }
    __device__ const bf16_t* brow2(const Tile&, int) const { return nullptr; }
    __device__ void store(const Tile&, int row, int n, float a, float) const {
        const float h0 = (F.x[(size_t)row * D + n] - F.stats0()[row * 2]) * F.stats0()[row * 2 + 1] * F.lng[n] + F.lnb[n];
        F.z()[(size_t)row * D + n] = f2bf(a + ALPHA * h0); }
};
struct FnGateUp {
    static constexpr bool DUAL = true; struct Tile { int e, r0, n; }; const Frame& F; const LAS int* ps;
    __device__ int ntm() const { return HBROWS / 128; } __device__ int ntn() const { return DE / 64; } __device__ int K() const { return D; }
    __device__ bool tile(int tm, Tile& T) const { const int row0 = tm * 128;
        if (row0 >= PMAX) { T.e = NE; T.r0 = row0 - PMAX; T.n = NTOK; return true; }
        if (row0 >= ps[64]) return false;
        int e = 0; while (e < NE - 1 && row0 >= ps[e + 1]) ++e;
        T.e = e; T.r0 = row0 - ps[e]; T.n = F.cnt()[e]; return T.r0 < T.n; }
    __device__ const bf16_t* arow(const Tile& T, int row) const { const int r = T.r0 + (row & 127); if (r >= T.n) return nullptr;
        const int tok = T.e < NE ? F.tokl()[(size_t)T.e * NTOK + r] : r; return F.h1() + (size_t)tok * D; }
    __device__ const bf16_t* brow(const Tile& T, int n) const { return F.wtgu() + ((size_t)T.e * 1024 + 256 * (n >> 7) + (n & 127)) * D; }
    __device__ const bf16_t* brow2(const Tile& T, int n) const { return F.wtgu() + ((size_t)T.e * 1024 + 256 * (n >> 7) + 128 + (n & 127)) * D; }
    __device__ void store(const Tile& T, int row, int n, float g, float u) const { const int r = T.r0 + (row & 127); const float w = T.e < NE ? (r < T.n ? F.wl()[(size_t)T.e * NTOK + r] : 0.f) : 1.0f;
        F.hb()[(size_t)row * DE + n] = f2bf(g / (1.0f + __expf(-g)) * (u * w)); }
};
struct FnDown {
    static constexpr bool DUAL = false; struct Tile { int e, r0, n; }; const Frame& F; const LAS int* ps;
    __device__ int ntm() const { return PMAX / 128; } __device__ int ntn() const { return D / 64; } __device__ int K() const { return DE; }
    __device__ bool tile(int tm, Tile& T) const { const int row0 = tm * 128; if (row0 >= ps[64]) return false;
        int e = 0; while (e < NE - 1 && row0 >= ps[e + 1]) ++e;
        T.e = e; T.r0 = row0 - ps[e]; T.n = F.cnt()[e]; return T.r0 < T.n; }
    __device__ const bf16_t* arow(const Tile&, int row) const { return F.hb() + (size_t)row * DE; }
    __device__ const bf16_t* brow(const Tile& T, int n) const { return F.wtd() + ((size_t)T.e * D + n) * DE; }
    __device__ const bf16_t* brow2(const Tile&, int) const { return nullptr; }
    __device__ void store(const Tile& T, int row, int n, float a, float) const { const int r = T.r0 + (row & 127);
        (void)r; F.ym()[(size_t)row * D + n] = f2bf(a); }
};
struct FnFinal {
    static constexpr bool DUAL = false; struct Tile {}; const Frame& F; const LAS int* ps;
    __device__ int ntm() const { return NTOK / 128; } __device__ int ntn() const { return D / 64; } __device__ int K() const { return DE; }
    __device__ bool tile(int, Tile&) const { return true; }
    __device__ const bf16_t* arow(const Tile&, int row) const { return F.hb() + (size_t)(PMAX + row) * DE; }
    __device__ const bf16_t* brow(const Tile&, int n) const { return F.wtd() + ((size_t)NE * D + n) * DE; }
    __device__ const bf16_t* brow2(const Tile&, int) const { return nullptr; }
    __device__ void store(const Tile&, int row, int n, float a, float) const {
        const float h1 = bf2f(F.h1()[(size_t)row * D + n]);
        F.o2()[(size_t)row * D + n] = f2bf(a + ALPHA * h1); }
};

__device__ __forceinline__ void phase_attn_simple(Frame& F) {
    LAS float* qs = (LAS float*)F.lds + F.wave * 512; LAS float* psm = qs + 64;
    const int gw = F.bx * 8 + F.wave, NGW = F.G * 8, lane = F.lane;
    for (int item = gw; item < NTOK * 32; item += NGW) {
        const int tok = item >> 5, hh = item & 31, b = tok >> 13, s = tok & 8191;
        const bool isA = hh < 16; const int h = hh & 15;
        const int qcol = isA ? COL_QA + h * 64 : COL_QB + h * 64, kcol = isA ? COL_KA + (h >> 2) * 64 : COL_KB + h * 64, vcol = isA ? COL_VA + (h >> 2) * 64 : COL_VB + h * 64;
        const int r = s >> 6, c = s & 63, rs = min(max(r - 4, 0), 120), cs = min(max(c - 8, 0), 48);
        const int nkeys = isA ? 16 + 257 : 16 + 128;
        asm volatile("s_waitcnt lgkmcnt(0)" ::: "memory");
        qs[lane] = bf2f(F.u()[(size_t)tok * INW + qcol + lane]);
        asm volatile("s_waitcnt lgkmcnt(0)" ::: "memory");
        float sc[5]; float mx = -INFINITY;
#pragma unroll
        for (int i = 0; i < 5; ++i) {
            const int j = lane + 64 * i; sc[i] = -INFINITY;
            if (j < nkeys) {
                int krow; float bias; bool valid = true;
                if (j < 16) { krow = NTOK + j; bias = isA ? F.t5[t5_bucket(j - 16 - s) * 16 + h] * LOG2E : 0.f; }
                else if (isA) { const int kpos = s - 128 + (j - 16); valid = kpos >= 0 && kpos < SEQ; krow = b * SEQ + kpos; bias = F.tab()[h * 272 + (j - 16)]; }
                else { const int w = j - 16, kr = rs + (w >> 4), kc = cs + (w & 15); krow = b * SEQ + kr * 64 + kc; bias = F.rpb[(h * 15 + (kr - r + 7)) * 31 + (kc - c + 15)] * LOG2E; }
                if (valid) { const bf16_t* kp = F.u() + (size_t)krow * INW + kcol; float dot = 0.f;
#pragma unroll
                    for (int d8 = 0; d8 < 8; ++d8) { const u32x4 kv = *(const u32x4*)(kp + d8 * 8);
#pragma unroll
                        for (int i2 = 0; i2 < 4; ++i2) { dot += qs[d8 * 8 + 2 * i2] * __uint_as_float(kv[i2] << 16); dot += qs[d8 * 8 + 2 * i2 + 1] * __uint_as_float(kv[i2] & 0xffff0000u); } }
                    sc[i] = dot + bias; }
            }
            mx = fmaxf(mx, sc[i]);
        }
        const float sinkl = isA ? F.sink[h] * LOG2E : -INFINITY;
        mx = fmaxf(wmax(mx), sinkl);
        float l = 0.f;
#pragma unroll
        for (int i = 0; i < 5; ++i) { const int j = lane + 64 * i; const float p = sc[i] == -INFINITY ? 0.f : exp2f(sc[i] - mx); l += p; if (j < 320) psm[j] = p; }
        l = wsum(l) + (isA ? exp2f(sinkl - mx) : 0.f);
        asm volatile("s_waitcnt lgkmcnt(0)" ::: "memory");
        float o = 0.f;
        for (int j = 0; j < nkeys; ++j) { const float p = psm[j]; if (p == 0.f) continue;
            int krow; if (j < 16) krow = NTOK + j; else if (isA) krow = b * SEQ + s - 128 + (j - 16); else { const int w = j - 16; krow = b * SEQ + (rs + (w >> 4)) * 64 + cs + (w & 15); }
            o += p * bf2f(F.u()[(size_t)krow * INW + vcol + lane]); }
        o /= l;
        const bf16_t ob = f2bf(o); F.ya()[(size_t)tok * D + hh * 64 + lane] = ob;
        const float of = bf2f(ob), q = wsum(of * of);
        if (lane == 0) F.ssq()[tok * 32 + hh] = q;
    }
}
__device__ __forceinline__ void phase_rmsnorm(Frame& F) {
    const int gw = F.bx * 8 + F.wave, NGW = F.G * 8, lane = F.lane;
    for (int tok = gw; tok < NTOK; tok += NGW) {
        const float q = lane < 32 ? F.ssq()[tok * 32 + lane] : 0.f;
        float qa = lane < 16 ? q : 0.f, qb = (lane >= 16 && lane < 32) ? q : 0.f; qa = wsum(qa); qb = wsum(qb);
        const float ra = 1.0f / sqrtf(qa * (1.0f / 1024.f) + RMS_EPS), rb = 1.0f / sqrtf(qb * (1.0f / 1024.f) + RMS_EPS);
        bf16_t* p = F.ya() + (size_t)tok * D;
#pragma unroll
        for (int j = 0; j < 8; ++j) { const int c = (j * 64 + lane) * 4; const float rr = c < 1024 ? ra : rb; u32x2 w = *(u32x2*)(p + c);
            w.x = pack2(__uint_as_float(w.x << 16) * rr, __uint_as_float(w.x & 0xffff0000u) * rr); w.y = pack2(__uint_as_float(w.y << 16) * rr, __uint_as_float(w.y & 0xffff0000u) * rr); *(u32x2*)(p + c) = w; }
    }
}

__device__ __forceinline__ void phase_ln1_router(Frame& F) {
    LAS float* hs = (LAS float*)F.lds + F.wave * 2048;
    const int gw = F.bx * 8 + F.wave, NGW = F.G * 8, lane = F.lane;
    for (int tok = gw; tok < NTOK; tok += NGW) {
        const bf16_t* src = F.z() + (size_t)tok * D; f32x4 v[8]; float s = 0.f;
#pragma unroll
        for (int j = 0; j < 8; ++j) { const u32x2 w = *(const u32x2*)(src + (j * 64 + lane) * 4); v[j] = (f32x4){__uint_as_float(w.x << 16), __uint_as_float(w.x & 0xffff0000u), __uint_as_float(w.y << 16), __uint_as_float(w.y & 0xffff0000u)}; s += (v[j][0] + v[j][1]) + (v[j][2] + v[j][3]); }
        const float mu = wsum(s) * (1.0f / D); float q = 0.f;
#pragma unroll
        for (int j = 0; j < 8; ++j) { const f32x4 d = v[j] - mu; q += (d[0] * d[0] + d[1] * d[1]) + (d[2] * d[2] + d[3] * d[3]); }
        const float rstd = 1.0f / sqrtf(wsum(q) * (1.0f / D) + LN_EPS);
        asm volatile("s_waitcnt lgkmcnt(0)" ::: "memory");
#pragma unroll
        for (int j = 0; j < 8; ++j) { const int c = (j * 64 + lane) * 4; const f32x4 g = *(const f32x4*)(F.l1g + c), bb = *(const f32x4*)(F.l1b + c); const f32x4 y = (v[j] - mu) * rstd * g + bb;
            *(u32x2*)(F.h1() + (size_t)tok * D + c) = (u32x2){pack2(y[0], y[1]), pack2(y[2], y[3])}; *(LAS f32x4*)(hs + c) = y; }
        if (lane == 0) { F.stats1()[tok * 2] = mu; F.stats1()[tok * 2 + 1] = rstd; }
        asm volatile("s_waitcnt lgkmcnt(0)" ::: "memory");
        float lg = 0.f;
#pragma unroll 8
        for (int n = 0; n < D; ++n) lg += hs[n] * F.w_router[(size_t)n * NE + lane];
        const float score = 1.0f / (1.0f + expf(-lg)), v0 = score + F.rbias[lane];
        int rk = 0;
#pragma unroll
        for (int j = 0; j < 8; ++j) { const int o = (lane & ~7) + j; const float w = __shfl(v0, o); rk += (w > v0 || (w == v0 && o < lane)) ? 1 : 0; }
        float gs = rk < 2 ? v0 : 0.f; gs += __shfl_xor(gs, 1); gs += __shfl_xor(gs, 2); gs += __shfl_xor(gs, 4);
        int grk = 0; const int myg = lane >> 3;
#pragma unroll
        for (int g = 0; g < 8; ++g) { const float w = __shfl(gs, g * 8); grk += (w > gs || (w == gs && g < myg)) ? 1 : 0; }
        const float mv = grk < 4 ? v0 : -INFINITY;
        int erk = 0;
        for (int o = 0; o < 64; ++o) { const float w = __shfl(mv, o); erk += (w > mv || (w == mv && o < lane)) ? 1 : 0; }
        const bool sel = erk < 8;
        const float wsm = wsum(sel ? score : 0.f), wgt = score / (wsm + 1e-20f) * 2.5f;
        if (sel) { const int rr = atomicAdd(F.cnt() + lane, 1); F.tokl()[(size_t)lane * NTOK + rr] = tok; F.wl()[(size_t)lane * NTOK + rr] = wgt; F.tke()[tok * 8 + erk] = lane; F.tkr()[tok * 8 + erk] = rr; }
    }
}
__device__ __forceinline__ void phase_ln2(Frame& F, const LAS int* ps) {
    const int gw = F.bx * 8 + F.wave, NGW = F.G * 8, lane = F.lane;
    for (int tok = gw; tok < NTOK; tok += NGW) {
        float* src = F.out + (size_t)tok * D; const bf16_t* o2p = F.o2() + (size_t)tok * D; f32x4 v[8]; float s = 0.f;
#pragma unroll
        for (int j = 0; j < 8; ++j) { const u32x2 w = *(const u32x2*)(o2p + (j * 64 + lane) * 4); v[j] = (f32x4){__uint_as_float(w.x << 16), __uint_as_float(w.x & 0xffff0000u), __uint_as_float(w.y << 16), __uint_as_float(w.y & 0xffff0000u)}; }
        const int mye = F.tke()[tok * 8 + (lane & 7)], myr = F.tkr()[tok * 8 + (lane & 7)], mypos = ps[mye] + myr;
#pragma unroll
        for (int k = 0; k < 8; ++k) { const int p = __shfl(mypos, k); const bf16_t* yp = F.ym() + (size_t)p * D;
#pragma unroll
            for (int j = 0; j < 8; ++j) { const u32x2 w = *(const u32x2*)(yp + (j * 64 + lane) * 4);
                v[j][0] += __uint_as_float(w.x << 16); v[j][1] += __uint_as_float(w.x & 0xffff0000u); v[j][2] += __uint_as_float(w.y << 16); v[j][3] += __uint_as_float(w.y & 0xffff0000u); } }
#pragma unroll
        for (int j = 0; j < 8; ++j) s += (v[j][0] + v[j][1]) + (v[j][2] + v[j][3]);
        const float mu = wsum(s) * (1.0f / D); float q = 0.f;
#pragma unroll
        for (int j = 0; j < 8; ++j) { const f32x4 d = v[j] - mu; q += (d[0] * d[0] + d[1] * d[1]) + (d[2] * d[2] + d[3] * d[3]); }
        const float rstd = 1.0f / sqrtf(wsum(q) * (1.0f / D) + LN_EPS);
#pragma unroll
        for (int j = 0; j < 8; ++j) { const int c = (j * 64 + lane) * 4; const f32x4 g = *(const f32x4*)(F.l2g + c), bb = *(const f32x4*)(F.l2b + c); *(f32x4*)(src + c) = (v[j] - mu) * rstd * g + bb; }
    }
}

#ifndef FAST_P1
#define FAST_P1 1
#endif
#ifndef STAGGER7
#define STAGGER7 0
#endif
#ifndef STAGGER4
#define STAGGER4 0
#endif
#ifndef XCD_TRUE
#define XCD_TRUE 1
#endif
#ifndef DOWN_REV
#define DOWN_REV false
#endif
#ifndef YM_NT
#define YM_NT 0
#endif
#ifndef FAST_P4
#define FAST_P4 1
#endif
#ifndef FAST_P6
#define FAST_P6 1
#endif
#ifndef FAST_P7
#define FAST_P7 1
#endif
namespace pg8 {
typedef short bf16x8 __attribute__((ext_vector_type(8)));
constexpr int BM = 256, BK = 64, HALF = 128, HTB = HALF * BK * 2, STAGE_BYTES = 8 * HTB, NXCD = 8, WGM = 8;
__host__ __device__ __forceinline__ int lds_byte(int r, int c) { const int st = (r >> 4) * 2 + (c >> 5), rr = r & 15, cc = c & 31, ob = rr * 64 + cc * 2; return st * 1024 + (ob ^ (((ob >> 9) & 1) << 5)); }
__host__ __device__ __forceinline__ void stage_rc(int b, int& R, int& C) { const int st = b / 1024, sb = b % 1024, swz = sb ^ (((sb >> 9) & 1) << 5); R = (st >> 1) * 16 + swz / 64; C = (st & 1) * 32 + (swz % 64) / 2; }
__host__ __device__ __forceinline__ int perm32(int rho) { const int n = rho >> 4, i = rho & 15; return 8 * (i >> 2) + 4 * n + (i & 3); }
__device__ __forceinline__ unsigned cvt_pk_bf16(float lo, float hi) { unsigned r; asm volatile("v_cvt_pk_bf16_f32 %0, %1, %2" : "=v"(r) : "v"(lo), "v"(hi)); return r; }
struct Unit { int pm, pn, e, r0, n, orow, tb; };
__device__ __forceinline__ int xcd_remap(int L, int nwg) { const int q = nwg / NXCD, r = nwg % NXCD, xcd = L % NXCD, off = L / NXCD; return (xcd < r ? xcd * (q + 1) : r * (q + 1) + (xcd - r) * q) + off; }
__device__ __forceinline__ void tile_of(int wgid, int nM, int nN, int& pm, int& pn) { const int nig = WGM * nN, gid = wgid / nig, fm = gid * WGM, gsz = (nM - fm) < WGM ? (nM - fm) : WGM; pm = fm + ((wgid % nig) % gsz); pn = (wgid % nig) / gsz; }

template <class Epi, class Sched>
__device__ __forceinline__ void gemm_phase(LAS unsigned char* lds, const Sched& S, const Epi& E, const int lda, const int ldb, const int nt, const int stagger_ticks = 0) {
    int tid = threadIdx.x; asm volatile("" : "+v"(tid));
    const int wid = __builtin_amdgcn_readfirstlane(tid >> 6), lane = tid & 63, wr = wid >> 2, wc = wid & 3, fr = lane & 15, fq = lane >> 4;
    unsigned voffA[2], voffB[2], c2[2]; int RA[2];
#pragma unroll
    for (int i = 0; i < 2; ++i) { int R, C; stage_rc(tid * 16 + i * 8192, R, C); const int Rb = Epi::PERM ? ((R & ~31) + perm32(R & 31)) : R;
        voffA[i] = (unsigned)(R * lda + C) * 2u; voffB[i] = (unsigned)(Rb * ldb + C) * 2u; RA[i] = R; c2[i] = (unsigned)C * 2u; }
    const size_t kstep = (size_t)(BK * 2), hstepA = (size_t)HALF * lda * 2, hstepB = (size_t)HALF * ldb * 2;
    const unsigned lda2 = (unsigned)lda * 2u;
    const unsigned ldsw = (unsigned)wid * 1024u;
    const int aoff = lds_byte(wr * 64 + fr, fq * 8), boff = lds_byte(wc * 32 + fr, fq * 8);
#define PG8_SA(b, h) (((b) * 2 + (h)) * HTB)
#define PG8_SB(b, h) ((4 + (b) * 2 + (h)) * HTB)
#define PG8_STAGE(bufoff, gbase, voff) do { _Pragma("unroll") for (int _i = 0; _i < 2; ++_i) \
        __builtin_amdgcn_global_load_lds((const unsigned*)((const char*)(gbase) + (voff)[_i]), (LAS unsigned*)(lds + (bufoff) + ldsw + _i * 8192), 16, 0, 0); } while (0)
#define PG8_STG_A(bufoff, p, h, V) do { if constexpr (Sched::GATHER) { PG8_STAGE(bufoff, p, V[h]); } else { PG8_STAGE(bufoff, (p) + (h) * hstepA, voffA); } } while (0)
#define PG8_STG_B(bufoff, p, h) PG8_STAGE(bufoff, (p) + (h) * hstepB, voffB)
#define PG8_LDA(dst, b, h) do { _Pragma("unroll") for (int m = 0; m < 4; ++m) _Pragma("unroll") for (int k = 0; k < 2; ++k) dst[m][k] = *(const LAS bf16x8*)(lds + PG8_SA(b, h) + aoff + m * 2048 + k * 1024); } while (0)
#define PG8_LDB(dst, b, h) do { _Pragma("unroll") for (int n = 0; n < 2; ++n) _Pragma("unroll") for (int k = 0; k < 2; ++k) dst[n][k] = *(const LAS bf16x8*)(lds + PG8_SB(b, h) + boff + n * 2048 + k * 1024); } while (0)
#define PG8_MMA(ai, bj, At, Bt) do { __builtin_amdgcn_s_setprio(1); _Pragma("unroll") for (int m = 0; m < 4; ++m) _Pragma("unroll") for (int n = 0; n < 2; ++n) _Pragma("unroll") for (int k = 0; k < 2; ++k) \
        acc[ai][bj][m][n] = __builtin_amdgcn_mfma_f32_16x16x32_bf16(Bt[n][k], At[m][k], acc[ai][bj][m][n], 0, 0, 0); __builtin_amdgcn_s_setprio(0); } while (0)
#define PG8_WAIT_V(n) asm volatile("s_waitcnt vmcnt(" #n ")" ::: "memory")
#define PG8_WAIT_L(n) asm volatile("s_waitcnt lgkmcnt(" #n ")" ::: "memory")
#define PG8_BAR __builtin_amdgcn_s_barrier()
#define PG8_SCHED __builtin_amdgcn_sched_barrier(0)
    Unit cur, nxt; int ui = 0;
    if (stagger_ticks) {
        const unsigned long long t0 = __builtin_amdgcn_s_memrealtime(), dl = (unsigned long long)((blockIdx.x >> 3) & 15) * (unsigned)stagger_ticks;
        while (__builtin_amdgcn_s_memrealtime() - t0 < dl) __builtin_amdgcn_s_sleep(4);
        __syncthreads(); }
    if (!S.next(0, cur)) return;
    cur.tb = 0;
    f32x4 acc[2][2][4][2];
#pragma unroll
    for (int a = 0; a < 2; ++a)
#pragma unroll
        for (int b = 0; b < 2; ++b)
#pragma unroll
            for (int m = 0; m < 4; ++m)
#pragma unroll
                for (int n = 0; n < 2; ++n) acc[a][b][m][n] = (f32x4){0.f, 0.f, 0.f, 0.f};
    bf16x8 At[4][2], B0[2][2], B1[2][2];
    unsigned vac[2][2], van[2][2]; int raw[2][2];
    const char* cA = S.abase(cur); const char* cB = S.bbase(cur);
#pragma unroll
    for (int h = 0; h < 2; ++h)
#pragma unroll
        for (int i = 0; i < 2; ++i) { vac[h][i] = Sched::GATHER ? (unsigned)S.arow(cur, h * HALF + RA[i]) * lda2 + c2[i] : 0u; van[h][i] = vac[h][i]; raw[h][i] = 0; }
    PG8_STG_B(PG8_SB(0, 0), cB, 0); PG8_STG_B(PG8_SB(0, 1), cB, 1); PG8_STG_A(PG8_SA(0, 0), cA, 0, vac); PG8_STG_A(PG8_SA(0, 1), cA, 1, vac);
    if (wr == 1) PG8_BAR;
    PG8_WAIT_V(2); PG8_BAR;
    PG8_STG_B(PG8_SB(1, 0), cB + kstep, 0); PG8_STG_A(PG8_SA(1, 0), cA + kstep, 0, vac); PG8_STG_B(PG8_SB(1, 1), cB + kstep, 1);
    PG8_WAIT_V(6); PG8_BAR;
    for (;;) {
        const bool has_next = S.next(ui + 1, nxt); nxt.tb = (ui + 1) & 1;
        if constexpr (Epi::MIDK) E.unit_begin(cur, tid);
        const char* nA = has_next ? S.abase(nxt) : cA; const char* nB = has_next ? S.bbase(nxt) : cB;
        if constexpr (Sched::GATHER) { if (has_next) {
#pragma unroll
            for (int h = 0; h < 2; ++h)
#pragma unroll
                for (int i = 0; i < 2; ++i) raw[h][i] = S.arow(nxt, h * HALF + RA[i]); } }
        for (int t = 0; t < nt; t += 2) {
            const bool last = (t == nt - 2);
            const char* a1 = cA + (size_t)(t + 1) * kstep;
            const char* a2 = last ? nA : cA + (size_t)(t + 2) * kstep; const char* b2 = last ? nB : cB + (size_t)(t + 2) * kstep;
            const char* a3 = a2 + kstep; const char* b3 = b2 + kstep;
            unsigned va2[2][2];
#pragma unroll
            for (int h = 0; h < 2; ++h)
#pragma unroll
                for (int i = 0; i < 2; ++i) va2[h][i] = last ? van[h][i] : vac[h][i];
            PG8_LDB(B0, 0, 0); PG8_LDB(B1, 0, 1); PG8_SCHED; PG8_LDA(At, 0, 0); PG8_STG_A(PG8_SA(1, 1), a1, 1, vac);
            PG8_WAIT_V(8); PG8_WAIT_L(0); PG8_BAR; PG8_MMA(0, 0, At, B0); PG8_MMA(0, 1, At, B1); PG8_BAR; PG8_SCHED;
            PG8_LDA(At, 0, 1); PG8_STG_B(PG8_SB(0, 0), b2, 0); PG8_STG_B(PG8_SB(0, 1), b2, 1); PG8_STG_A(PG8_SA(0, 0), a2, 0, va2);
            PG8_WAIT_V(8); PG8_WAIT_L(0); PG8_BAR; PG8_MMA(1, 0, At, B0); PG8_MMA(1, 1, At, B1); PG8_BAR; PG8_SCHED;
            PG8_LDB(B0, 1, 0); PG8_LDB(B1, 1, 1); PG8_SCHED; PG8_LDA(At, 1, 0); PG8_STG_A(PG8_SA(0, 1), a2, 1, va2);
            PG8_WAIT_V(8); PG8_WAIT_L(0); PG8_BAR; PG8_MMA(0, 0, At, B0); PG8_MMA(0, 1, At, B1); PG8_BAR; PG8_SCHED;
            PG8_LDA(At, 1, 1); PG8_STG_B(PG8_SB(1, 0), b3, 0); PG8_STG_B(PG8_SB(1, 1), b3, 1); PG8_STG_A(PG8_SA(1, 0), a3, 0, va2);
            PG8_WAIT_V(8); PG8_WAIT_L(0); PG8_BAR; PG8_MMA(1, 0, At, B0); PG8_MMA(1, 1, At, B1); PG8_BAR; PG8_SCHED;
            if constexpr (Epi::MIDK) { if (2 * (t + 2) == nt) E.mid(acc, cur, wr, fr); }
            if constexpr (Sched::GATHER) { if (t + 4 == nt && has_next) {
#pragma unroll
                for (int h = 0; h < 2; ++h)
#pragma unroll
                    for (int i = 0; i < 2; ++i) { asm volatile("" : "+v"(raw[h][i])); van[h][i] = (unsigned)raw[h][i] * lda2 + c2[i]; } } }
        }
        if (wr == 0) PG8_BAR;
        E(acc, cur, wr, wc, fr, fq);
        if (!has_next) break;
#pragma unroll
        for (int a = 0; a < 2; ++a)
#pragma unroll
            for (int b = 0; b < 2; ++b)
#pragma unroll
                for (int m = 0; m < 4; ++m)
#pragma unroll
                    for (int n = 0; n < 2; ++n) acc[a][b][m][n] = (f32x4){0.f, 0.f, 0.f, 0.f};
        cur = nxt; cA = nA; cB = nB; ++ui;
#pragma unroll
        for (int h = 0; h < 2; ++h)
#pragma unroll
            for (int i = 0; i < 2; ++i) vac[h][i] = van[h][i];
        if (wr == 1) PG8_BAR;
    }
    PG8_WAIT_V(0);
    PG8_BAR;
#undef PG8_SA
#undef PG8_SB
#undef PG8_STAGE
#undef PG8_STG_A
#undef PG8_STG_B
#undef PG8_LDA
#undef PG8_LDB
#undef PG8_MMA
#undef PG8_WAIT_V
#undef PG8_WAIT_L
#undef PG8_BAR
#undef PG8_SCHED
}
}

struct SchedInProj {
    static constexpr bool GATHER = false; const char* A; const char* B; int G, c, i0, i1;
    __device__ __forceinline__ bool next(int i, pg8::Unit& u) const { const int ii = i0 + i; if (ii >= i1) return false; const int L = ii * G + c; if (L >= 1162) return false;
        if (L < 1152) pg8::tile_of(pg8::xcd_remap(L, 1152), 64, 18, u.pm, u.pn); else { const int k = L - 1152; u.pm = 64; u.pn = k < 2 ? 4 + k : 8 + k; }
        return true; }
    __device__ __forceinline__ const char* abase(const pg8::Unit& u) const { return A + (size_t)u.pm * 256 * D * 2; }
    __device__ __forceinline__ const char* bbase(const pg8::Unit& u) const { return B + (size_t)u.pn * 256 * D * 2; }
    __device__ __forceinline__ int arow(const pg8::Unit&, int) const { return 0; }
};
struct SchedOutProj {
    static constexpr bool GATHER = false; const char* A; const char* B; int G, c;
    __device__ __forceinline__ bool next(int i, pg8::Unit& u) const { const int L = i * G + c; if (L >= 512) return false; pg8::tile_of(pg8::xcd_remap(L, 512), 64, 8, u.pm, u.pn); return true; }
    __device__ __forceinline__ const char* abase(const pg8::Unit& u) const { return A + (size_t)u.pm * 256 * D * 2; }
    __device__ __forceinline__ const char* bbase(const pg8::Unit& u) const { return B + (size_t)u.pn * 256 * D * 2; }
    __device__ __forceinline__ int arow(const pg8::Unit&, int) const { return 0; }
};
__device__ __forceinline__ void moe_tables(const Frame& F, LAS int* ps) {
    if (F.tid < NE) ps[256 + F.tid] = F.cnt()[F.tid];
    __syncthreads();
    if (F.tid == 0) { int acc = 0, ta = 0; for (int e = 0; e < NE; ++e) { const int mt = (ps[256 + e] + 255) >> 8; ps[e] = acc; ps[128 + e] = ta; acc += mt * 256; ta += mt; }
        ps[64] = acc; ps[128 + 64] = ta; ps[128 + 65] = ta + NTOK / 256; ps[256 + 64] = NTOK; }
    __syncthreads();
    for (int t = F.tid; t < 640; t += 512) { int e = 0; while (e < NE && t >= ps[128 + e + 1]) ++e; ps[384 + t] = e; }
    __syncthreads();
}
template <int NN, bool REV> __device__ __forceinline__ bool moe_unit(const LAS int* ps, int L, pg8::Unit& u, int noshared = 0) {
    const int nU = (noshared ? ps[128 + 64] : ps[128 + 65]) * NN; if (L >= nU) return false;
    const int wg0 = pg8::xcd_remap(L, nU), wg = REV ? nU - 1 - wg0 : wg0, tile = wg / NN; u.pn = wg % NN;
    const int e = ps[384 + tile]; u.e = e; u.pm = tile - ps[128 + e]; u.r0 = u.pm * 256; u.n = ps[256 + e];
    u.orow = (e < NE ? ps[e] : PMAX) + u.r0;
    return true; }
struct SchedGU {
    static constexpr bool GATHER = true; const char* A; const char* B; const int* tokl; const int* cnt; const LAS int* ps; int G, c;
    __device__ __forceinline__ bool next(int i, pg8::Unit& u) const { return moe_unit<4, false>(ps, i * G + c, u); }
    __device__ __forceinline__ const char* abase(const pg8::Unit&) const { return A; }
    __device__ __forceinline__ const char* bbase(const pg8::Unit& u) const { return B + ((size_t)u.e * 1024 + u.pn * 256) * D * 2; }
    __device__ __forceinline__ int arow(const pg8::Unit& u, int r) const { const int rr = min(u.r0 + r, u.n - 1); return u.e < NE ? tokl[(size_t)u.e * NTOK + rr] : rr; }
};
struct SchedDown {
    static constexpr bool GATHER = false; const char* A; const char* B; const int* cnt; const LAS int* ps; int G, c; int hot;
    __device__ __forceinline__ bool next(int i, pg8::Unit& u) const { return moe_unit<8, DOWN_REV>(ps, i * G + c, u, 1); }
    __device__ __forceinline__ const char* abase(const pg8::Unit& u) const { return A + (size_t)(((hot & 1) && u.e < NE) ? (u.orow & 0x3ff) : u.orow) * DE * 2; }
    __device__ __forceinline__ const char* bbase(const pg8::Unit& u) const { return B + ((size_t)(((hot & 1) && u.e < NE) ? 0 : u.e) * D + u.pn * 256) * DE * 2; }
    __device__ __forceinline__ int arow(const pg8::Unit&, int) const { return 0; }
};
struct SchedDownShared {
    static constexpr bool GATHER = false; const char* A; const char* B; int G, c;
    __device__ __forceinline__ bool next(int i, pg8::Unit& u) const { const int L = i * G + c; if (L >= 512) return false; pg8::tile_of(pg8::xcd_remap(L, 512), 64, 8, u.pm, u.pn);
        u.e = NE; u.r0 = u.pm * 256; u.n = NTOK; u.orow = PMAX + u.r0; return true; }
    __device__ __forceinline__ const char* abase(const pg8::Unit& u) const { return A + (size_t)u.orow * DE * 2; }
    __device__ __forceinline__ const char* bbase(const pg8::Unit& u) const { return B + ((size_t)NE * D + u.pn * 256) * DE * 2; }
    __device__ __forceinline__ int arow(const pg8::Unit&, int) const { return 0; }
};
struct EpiU {
    static constexpr bool MIDK = false; static constexpr bool PERM = true; bf16_t* U; int nostore;
    __device__ __forceinline__ void operator()(const f32x4 (&acc)[2][2][4][2], const pg8::Unit& u, int wr, int wc, int fr, int fq) const {
        const int row0 = u.pm * 256 + wr * 64 + fr, col0 = u.pn * 256 + wc * 32 + 8 * fq;
        if (nostore) {
#pragma unroll
            for (int ai = 0; ai < 2; ++ai)
#pragma unroll
                for (int bj = 0; bj < 2; ++bj)
#pragma unroll
                    for (int m = 0; m < 4; ++m)
#pragma unroll
                        for (int n = 0; n < 2; ++n) asm volatile("" :: "v"(acc[ai][bj][m][n]));
            return; }
#pragma unroll
        for (int ai = 0; ai < 2; ++ai)
#pragma unroll
            for (int m = 0; m < 4; ++m) { bf16_t* rowp = U + (size_t)(row0 + ai * 128 + m * 16) * INW + col0;
#pragma unroll
                for (int bj = 0; bj < 2; ++bj) { const f32x4 v0 = acc[ai][bj][m][0], v1 = acc[ai][bj][m][1]; u32x4 w;
                    w.x = pg8::cvt_pk_bf16(v0[0], v0[1]); w.y = pg8::cvt_pk_bf16(v0[2], v0[3]); w.z = pg8::cvt_pk_bf16(v1[0], v1[1]); w.w = pg8::cvt_pk_bf16(v1[2], v1[3]);
                    *(u32x4*)(rowp + bj * 128) = w; } }
    }
};
struct EpiZ {
    static constexpr bool MIDK = true; static constexpr bool PERM = true; bf16_t* Z; const bf16_t* H0; const float* ssq; LAS float* tab;
    __device__ __forceinline__ void unit_begin(const pg8::Unit& u, int tid) const {
        const int row = tid >> 1, grp = tid & 1; const float* p = ssq + (size_t)(u.pm * 256 + row) * 32 + 16 * grp;
        const f32x4 a = *(const f32x4*)p, b4 = *(const f32x4*)(p + 4), c = *(const f32x4*)(p + 8), d = *(const f32x4*)(p + 12);
        const float s = (((a[0] + a[1]) + (a[2] + a[3])) + ((b4[0] + b4[1]) + (b4[2] + b4[3]))) + (((c[0] + c[1]) + (c[2] + c[3])) + ((d[0] + d[1]) + (d[2] + d[3])));
        tab[(u.tb * 256 + row) * 2 + grp] = 1.0f / sqrtf(s * (1.0f / 1024.f) + RMS_EPS);
    }
    __device__ __forceinline__ void mid(f32x4 (&acc)[2][2][4][2], const pg8::Unit& u, int wr, int fr) const {
#pragma unroll
        for (int ai = 0; ai < 2; ++ai)
#pragma unroll
            for (int m = 0; m < 4; ++m) { const int r = ai * 128 + wr * 64 + m * 16 + fr; const float f = tab[(u.tb * 256 + r) * 2] / tab[(u.tb * 256 + r) * 2 + 1];
#pragma unroll
                for (int bj = 0; bj < 2; ++bj)
#pragma unroll
                    for (int n = 0; n < 2; ++n) acc[ai][bj][m][n] *= f; }
    }
    __device__ __forceinline__ void operator()(const f32x4 (&acc)[2][2][4][2], const pg8::Unit& u, int wr, int wc, int fr, int fq) const {
        const int row0 = u.pm * 256 + wr * 64 + fr, col0 = u.pn * 256 + wc * 32 + 8 * fq;
#pragma unroll
        for (int am = 0; am < 4; ++am) {
            u32x4 hv[2][2]; float rb[2];
#pragma unroll
            for (int q = 0; q < 2; ++q) { const int ai = am >> 1, m = (am & 1) * 2 + q; const size_t off = (size_t)(row0 + ai * 128 + m * 16) * D + col0;
                rb[q] = tab[(u.tb * 256 + ai * 128 + wr * 64 + m * 16 + fr) * 2 + 1];
#pragma unroll
                for (int bj = 0; bj < 2; ++bj) hv[q][bj] = *(const u32x4*)(H0 + off + bj * 128); }
#pragma unroll
            for (int q = 0; q < 2; ++q) { const int ai = am >> 1, m = (am & 1) * 2 + q; const size_t off = (size_t)(row0 + ai * 128 + m * 16) * D + col0;
#pragma unroll
                for (int bj = 0; bj < 2; ++bj) { const u32x4 h4 = hv[q][bj];
                    const f32x4 h0v = (f32x4){__uint_as_float(h4.x << 16), __uint_as_float(h4.x & 0xffff0000u), __uint_as_float(h4.y << 16), __uint_as_float(h4.y & 0xffff0000u)};
                    const f32x4 h1v = (f32x4){__uint_as_float(h4.z << 16), __uint_as_float(h4.z & 0xffff0000u), __uint_as_float(h4.w << 16), __uint_as_float(h4.w & 0xffff0000u)};
                    const f32x4 v0 = acc[ai][bj][m][0] * rb[q] + h0v * ALPHA, v1 = acc[ai][bj][m][1] * rb[q] + h1v * ALPHA; u32x4 w;
                    w.x = pg8::cvt_pk_bf16(v0[0], v0[1]); w.y = pg8::cvt_pk_bf16(v0[2], v0[3]); w.z = pg8::cvt_pk_bf16(v1[0], v1[1]); w.w = pg8::cvt_pk_bf16(v1[2], v1[3]);
                    *(u32x4*)(Z + off + bj * 128) = w; } }
            asm volatile("" ::: "memory"); }
    }
};
__device__ __forceinline__ float silu_mul(float g, float u) { return g * __builtin_amdgcn_rcpf(1.0f + __builtin_amdgcn_exp2f(-g * LOG2E)) * u; }
struct EpiGU {
    static constexpr bool MIDK = false; static constexpr bool PERM = true; bf16_t* H; const float* wl;
    __device__ __forceinline__ void operator()(const f32x4 (&acc)[2][2][4][2], const pg8::Unit& u, int wr, int wc, int fr, int fq) const {
        const int rl0 = wr * 64 + fr, col0 = u.pn * 128 + wc * 32 + 8 * fq;
        float wv[2][4];
#pragma unroll
        for (int ai = 0; ai < 2; ++ai)
#pragma unroll
            for (int m = 0; m < 4; ++m) { const int r = u.r0 + rl0 + ai * 128 + m * 16; wv[ai][m] = u.e < NE ? (r < u.n ? wl[(size_t)u.e * NTOK + r] : 0.f) : 1.0f; }
#pragma unroll
        for (int ai = 0; ai < 2; ++ai)
#pragma unroll
            for (int m = 0; m < 4; ++m) { const f32x4 g0 = acc[ai][0][m][0], g1 = acc[ai][0][m][1], u0 = acc[ai][1][m][0] * wv[ai][m], u1 = acc[ai][1][m][1] * wv[ai][m]; u32x4 w;
                w.x = pg8::cvt_pk_bf16(silu_mul(g0[0], u0[0]), silu_mul(g0[1], u0[1])); w.y = pg8::cvt_pk_bf16(silu_mul(g0[2], u0[2]), silu_mul(g0[3], u0[3]));
                w.z = pg8::cvt_pk_bf16(silu_mul(g1[0], u1[0]), silu_mul(g1[1], u1[1])); w.w = pg8::cvt_pk_bf16(silu_mul(g1[2], u1[2]), silu_mul(g1[3], u1[3]));
                *(u32x4*)(H + (size_t)(u.orow + rl0 + ai * 128 + m * 16) * DE + col0) = w; }
    }
};
struct EpiDownR {
    static constexpr bool MIDK = false; static constexpr bool PERM = true; bf16_t* Y; int nostore;
    __device__ __forceinline__ void operator()(const f32x4 (&acc)[2][2][4][2], const pg8::Unit& u, int wr, int wc, int fr, int fq) const {
        const int rl0 = wr * 64 + fr, col0 = u.pn * 256 + wc * 32 + 8 * fq;
        if (nostore) {
#pragma unroll
            for (int ai = 0; ai < 2; ++ai)
#pragma unroll
                for (int bj = 0; bj < 2; ++bj)
#pragma unroll
                    for (int m = 0; m < 4; ++m)
#pragma unroll
                        for (int n = 0; n < 2; ++n) asm volatile("" :: "v"(acc[ai][bj][m][n]));
            return; }
#pragma unroll
        for (int ai = 0; ai < 2; ++ai)
#pragma unroll
            for (int m = 0; m < 4; ++m) { const int rl = rl0 + ai * 128 + m * 16; if (u.r0 + rl >= u.n) continue;
                bf16_t* rowp = Y + (size_t)(u.orow + rl) * D + col0;
#pragma unroll
                for (int bj = 0; bj < 2; ++bj) { const f32x4 v0 = acc[ai][bj][m][0], v1 = acc[ai][bj][m][1]; u32x4 q;
                    q.x = pg8::cvt_pk_bf16(v0[0], v0[1]); q.y = pg8::cvt_pk_bf16(v0[2], v0[3]); q.z = pg8::cvt_pk_bf16(v1[0], v1[1]); q.w = pg8::cvt_pk_bf16(v1[2], v1[3]);
                    *(u32x4*)(rowp + bj * 128) = q; } }
    }
};
struct EpiDownS {
    static constexpr bool MIDK = false; static constexpr bool PERM = true; bf16_t* O; const bf16_t* H1;
    __device__ __forceinline__ void operator()(const f32x4 (&acc)[2][2][4][2], const pg8::Unit& u, int wr, int wc, int fr, int fq) const {
        const int rl0 = wr * 64 + fr, col0 = u.pn * 256 + wc * 32 + 8 * fq;
#pragma unroll
        for (int am = 0; am < 4; ++am) {
            u32x4 hv[2][2];
#pragma unroll
            for (int q = 0; q < 2; ++q) { const int ai = am >> 1, m = (am & 1) * 2 + q; const size_t off = (size_t)(u.r0 + rl0 + ai * 128 + m * 16) * D + col0;
#pragma unroll
                for (int bj = 0; bj < 2; ++bj) hv[q][bj] = *(const u32x4*)(H1 + off + bj * 128); }
#pragma unroll
            for (int q = 0; q < 2; ++q) { const int ai = am >> 1, m = (am & 1) * 2 + q; const size_t off = (size_t)(u.r0 + rl0 + ai * 128 + m * 16) * D + col0;
#pragma unroll
                for (int bj = 0; bj < 2; ++bj) { const u32x4 h4 = hv[q][bj];
                    const f32x4 h0v = (f32x4){__uint_as_float(h4.x << 16), __uint_as_float(h4.x & 0xffff0000u), __uint_as_float(h4.y << 16), __uint_as_float(h4.y & 0xffff0000u)};
                    const f32x4 h1v = (f32x4){__uint_as_float(h4.z << 16), __uint_as_float(h4.z & 0xffff0000u), __uint_as_float(h4.w << 16), __uint_as_float(h4.w & 0xffff0000u)};
                    const f32x4 v0 = acc[ai][bj][m][0] + h0v * ALPHA, v1 = acc[ai][bj][m][1] + h1v * ALPHA; u32x4 w;
                    w.x = pg8::cvt_pk_bf16(v0[0], v0[1]); w.y = pg8::cvt_pk_bf16(v0[2], v0[3]); w.z = pg8::cvt_pk_bf16(v1[0], v1[1]); w.w = pg8::cvt_pk_bf16(v1[2], v1[3]);
                    *(u32x4*)(O + off + bj * 128) = w; } }
            asm volatile("" ::: "memory"); }
    }
};

#ifndef FAST_P2
#define FAST_P2 1
#endif
namespace att {
typedef short bf16x8 __attribute__((ext_vector_type(8)));
typedef short s16x4 __attribute__((ext_vector_type(4)));
typedef float f32x16 __attribute__((ext_vector_type(16)));
typedef LAS const char* lds_cptr;
constexpr int SLOT = 16384, NSLOT = 6, RING = NSLOT * SLOT;
constexpr int TA_W = 452, TA_OFF = 224;
constexpr int TB_W = 468;
constexpr int OFF_TABA = RING, OFF_TABB = OFF_TABA, OFF_WS = OFF_TABA + 4 * TA_W * 4, OFF_OST = OFF_WS + 8 * 256, ATT_LDS = OFF_OST + 8 * 4096;
static_assert(ATT_LDS <= LDS_BYTES - 16 - 1024, "attention LDS map");
constexpr float NEGB = -1e30f, THR = 8.0f;
#define ATT_MFMA(a, b, c) __builtin_amdgcn_mfma_f32_32x32x16_bf16(a, b, c, 0, 0, 0)
__device__ __forceinline__ int crow(int r, int hi) { return (r & 3) + 8 * (r >> 2) + 4 * hi; }
__device__ __forceinline__ s16x4 vtr(lds_cptr p) { typedef short v4i16_t __attribute__((ext_vector_type(4))); return __builtin_bit_cast(s16x4, __builtin_amdgcn_ds_read_tr16_b64_v4i16((LAS v4i16_t*)p)); }
__device__ __forceinline__ float swapmax(float m) { auto rr = __builtin_amdgcn_permlane32_swap(__float_as_uint(m), __float_as_uint(m), false, false); return fmaxf(__uint_as_float(rr[0]), __uint_as_float(rr[1])); }
__device__ __forceinline__ float swapsum(float m) { auto rr = __builtin_amdgcn_permlane32_swap(__float_as_uint(m), __float_as_uint(m), false, false); return __uint_as_float(rr[0]) + __uint_as_float(rr[1]); }

__device__ __forceinline__ float bf16r(float x) { return __uint_as_float(pg8::cvt_pk_bf16(x, 0.f) << 16); }
__device__ __forceinline__ bf16x8 frag_k0(unsigned bits16, int hi) { const u32x4 w = (u32x4){hi == 0 ? bits16 : 0u, 0u, 0u, 0u}; return __builtin_bit_cast(bf16x8, w); }
template <int NH, int NS, class BiasFn>
__device__ __forceinline__ void tile_qb(const bf16x8 (&kf)[8], const bf16x8 (&qr)[4], bf16x8& mq, const bf16x8& ones, lds_cptr vp, f32x16 (&o)[2], float& m, float& l, LAS float* wsf, int r32, int hi, const BiasFn& bias) {
    f32x16 c[NH];
#pragma unroll
    for (int hf = 0; hf < NH; ++hf)
#pragma unroll
        for (int r = 0; r < 16; ++r) c[hf][r] = bias(hf, r);
    s16x4 vlo[NS][2], vhi[NS][2];
#pragma unroll
    for (int dh = 0; dh < 2; ++dh) { vlo[0][dh] = vtr(vp + dh * 4096); vhi[0][dh] = vtr(vp + dh * 4096 + 512); }
    __builtin_amdgcn_sched_barrier(0);
#pragma unroll
    for (int hf = 0; hf < NH; ++hf) { c[hf] = ATT_MFMA(ones, mq, c[hf]);
#pragma unroll
        for (int d0 = 0; d0 < 4; ++d0) c[hf] = ATT_MFMA(kf[2 * d0 + hf], qr[d0], c[hf]); }
    float mx = NEGB;
#pragma unroll
    for (int hf = 0; hf < NH; ++hf)
#pragma unroll
        for (int r = 0; r < 16; ++r) mx = fmaxf(mx, c[hf][r]);
    mx = swapmax(mx);
    if (__any(mx > THR)) {
        const float mn = bf16r(m + fmaxf(mx, 0.f)), dl = mn - m, f = __builtin_amdgcn_exp2f(-dl); m = mn; l *= f;
        mq = frag_k0(__float_as_uint(-mn) >> 16, hi);
        if (hi == 0) wsf[r32] = f;
        asm volatile("s_waitcnt lgkmcnt(0)" ::: "memory");
#pragma unroll
        for (int r = 0; r < 16; ++r) { const float fr = wsf[crow(r, hi)]; o[0][r] *= fr; o[1][r] *= fr; }
#pragma unroll
        for (int hf = 0; hf < NH; ++hf)
#pragma unroll
            for (int r = 0; r < 16; ++r) c[hf][r] -= dl;
    }
#pragma unroll
    for (int s = 1; s < NS; ++s)
#pragma unroll
        for (int dh = 0; dh < 2; ++dh) { vlo[s][dh] = vtr(vp + dh * 4096 + s * 1024); vhi[s][dh] = vtr(vp + dh * 4096 + s * 1024 + 512); }
    __builtin_amdgcn_sched_barrier(0);
    float ls = 0.f;
#pragma unroll
    for (int hf = 0; hf < NH; ++hf)
#pragma unroll
        for (int r = 0; r < 16; ++r) { c[hf][r] = __builtin_amdgcn_exp2f(c[hf][r]); ls += c[hf][r]; }
    l += ls;
#pragma unroll
    for (int s = 0; s < NS; ++s) {
        const f32x16& cc = c[s >> 1]; const int rb = (s & 1) * 8;
        u32x4 pw; pw.x = pg8::cvt_pk_bf16(cc[rb + 0], cc[rb + 1]); pw.y = pg8::cvt_pk_bf16(cc[rb + 2], cc[rb + 3]); pw.z = pg8::cvt_pk_bf16(cc[rb + 4], cc[rb + 5]); pw.w = pg8::cvt_pk_bf16(cc[rb + 6], cc[rb + 7]);
        const bf16x8 pa = __builtin_bit_cast(bf16x8, pw);
#pragma unroll
        for (int dh = 0; dh < 2; ++dh) { const s16x4 lo = vlo[s][dh], hi4 = vhi[s][dh];
            const bf16x8 vf = (bf16x8){lo[0], lo[1], lo[2], lo[3], hi4[0], hi4[1], hi4[2], hi4[3]};
            o[dh] = ATT_MFMA(pa, vf, o[dh]); }
    }
}
template <class TokFn>
__device__ __forceinline__ void finish_qb(const Frame& F, f32x16 (&o)[2], float l, LAS float* wsf, LAS bf16_t* stg, int lane, int r32, int hi, int ocol, int hidx, const TokFn& tokq) {
    l = swapsum(l);
    asm volatile("s_waitcnt lgkmcnt(0)" ::: "memory");
    if (hi == 0) wsf[32 + r32] = l;
    asm volatile("s_waitcnt lgkmcnt(0)" ::: "memory");
#pragma unroll
    for (int r = 0; r < 16; ++r) { const int orow = crow(r, hi); const float rl = __builtin_amdgcn_rcpf(wsf[32 + orow]);
        stg[orow * 64 + r32] = f2bf(o[0][r] * rl); stg[orow * 64 + 32 + r32] = f2bf(o[1][r] * rl); }
    asm volatile("s_waitcnt lgkmcnt(0)" ::: "memory");
#pragma unroll
    for (int i = 0; i < 4; ++i) { const int row = i * 8 + (lane >> 3), ch = lane & 7; const u32x4 w = *(const LAS u32x4*)(stg + row * 64 + ch * 8); const int tok = tokq(row);
        *(u32x4*)(F.ya() + (size_t)tok * D + ocol + ch * 8) = w;
        float q = 0.f;
#pragma unroll
        for (int j = 0; j < 4; ++j) { const float a = __uint_as_float(w[j] << 16), b = __uint_as_float(w[j] & 0xffff0000u); q += a * a + b * b; }
        q += __shfl_xor(q, 1); q += __shfl_xor(q, 2); q += __shfl_xor(q, 4);
        if (ch == 0) F.ssq()[tok * 32 + hidx] = q; }
    asm volatile("s_waitcnt lgkmcnt(0)" ::: "memory");
}

template <int MODE>
__device__ __forceinline__ void attn_unit(const Frame& F, int L) {
    LAS unsigned char* lds = F.lds;
    const int lane = F.lane, wid = F.wave, r32 = lane & 31, hi = lane >> 5;
    LAS float* wsf = (LAS float*)(lds + OFF_WS + wid * 256); LAS bf16_t* stg = (LAS bf16_t*)(lds + OFF_OST + wid * 4096);
    int b, kcol, vcol, qcol, ocol, hidx, nband, trow0, qtok0;
    int hb = 0, qbw = 0, kt0 = 0;
    int R0 = 0, pr = 0, jc = 0, cb = 0, kr0 = 0;
    if (MODE == 0) { const int kvh = L & 3; hb = (L >> 2) & 127; b = L >> 9; const int hq = 4 * kvh + (wid >> 1); qbw = wid & 1;
        qcol = COL_QA + hq * 64; kcol = COL_KA + kvh * 64; vcol = COL_VA + kvh * 64; ocol = hq * 64; hidx = hq;
        kt0 = max(0, hb - 2); const int kt1 = min(127, hb + 2); nband = kt1 - kt0 + 1; trow0 = b * SEQ + 64 * kt0; qtok0 = b * SEQ + 64 * hb + 32 * qbw;
    } else { const int h = L & 15, rb = (L >> 4) & 31; b = L >> 9; R0 = rb * 4; pr = wid >> 2; jc = wid & 3; cb = min(max(16 * jc - 8, 0), 32);
        qcol = COL_QB + h * 64; kcol = COL_KB + h * 64; vcol = COL_VB + h * 64; ocol = 1024 + h * 64; hidx = 16 + h;
        kr0 = min(max(R0 - 4, 0), 120); const int kr1 = min(max(R0 + 3 - 4, 0), 120) + 7; nband = kr1 - kr0 + 1; trow0 = b * SEQ + kr0 * 64; qtok0 = b * SEQ + (R0 + 2 * pr) * 64 + 16 * jc; }
    const int NT = 1 + nband;
    const bf16_t* ksrc = F.u() + (size_t)lane * INW + kcol + wid * 8;
    const bf16_t* vsrc = F.u() + (size_t)(16 * (wid & 3) + (lane >> 2)) * INW + vcol + (wid >> 2) * 32 + (lane & 3) * 8;
#define ATT_TROW(t) ((t) == 0 ? NTOK : trow0 + ((t) - 1) * 64)
#define ATT_ISSUE(t) do { const size_t ro_ = (size_t)ATT_TROW(t) * INW; const int sl_ = ((t) % NSLOT) * SLOT; \
        __builtin_amdgcn_global_load_lds((const unsigned*)(ksrc + ro_), (LAS unsigned*)(lds + sl_ + wid * 1024), 16, 0, 0); \
        __builtin_amdgcn_global_load_lds((const unsigned*)(vsrc + ro_), (LAS unsigned*)(lds + sl_ + 8192 + wid * 1024), 16, 0, 0); } while (0)
    bf16x8 qr[4];
    { const int tok = MODE == 0 ? qtok0 + r32 : qtok0 + (r32 >> 4) * 64 + (r32 & 15);
#pragma unroll
      for (int d0 = 0; d0 < 4; ++d0) qr[d0] = *(const bf16x8*)(F.u() + (size_t)tok * INW + qcol + d0 * 16 + hi * 8); }
    if (MODE == 0) { LAS float* tA = (LAS float*)(lds + OFF_TABA); const int h0 = 4 * (L & 3);
        for (int i = F.tid; i < 4 * TA_W; i += 512) { const int g = i / TA_W, rel = i % TA_W - TA_OFF; tA[i] = (rel >= -128 && rel <= 128) ? F.tab()[(h0 + g) * 272 + rel + 128] : NEGB; } }
    else { LAS float* tB = (LAS float*)(lds + OFF_TABB); const int h = L & 15;
        for (int i = F.tid; i < 576; i += 512) { const int k = i - 16; tB[i] = (k >= 0 && k < 465) ? F.rpb[h * 465 + k] * LOG2E : ((k >= 465 && k < 496) ? NEGB : 0.f); } }
#pragma unroll
    for (int t = 0; t < 5; ++t) if (t < NT) ATT_ISSUE(t);
    f32x16 o[2]; o[0] = f32x16{}; o[1] = f32x16{}; float m = 0.f, l = 0.f;
    bf16x8 mq = frag_k0(0u, hi); const bf16x8 ones = frag_k0(0x3F80u, hi);
    const LAS float* tabA = (const LAS float*)(lds + OFF_TABA) + (MODE == 0 ? (wid >> 1) : 0) * TA_W;
    const LAS float* tabB = (const LAS float*)(lds + OFF_TABB);
    const int qpos = 64 * hb + 32 * qbw + r32;
    const int qrow = R0 + 2 * pr + (r32 >> 4), qc = 16 * jc + (r32 & 15), rs = min(max(qrow - 4, 0), 120), cs = min(max(qc - 8, 0), 48);
    const int rsw0 = min(max(R0 + 2 * pr - 4, 0), 120), rsw1 = min(max(R0 + 2 * pr + 1 - 4, 0), 120);
    float cm[16];
#pragma unroll
    for (int r = 0; r < 16; ++r) { const int kc = cb + 4 * hi + (r & 3) + 8 * (r >> 2); cm[r] = (MODE == 1 && !(kc >= cs && kc < cs + 16)) ? NEGB : 0.f; }
    const int dc0 = cb + 4 * hi - qc + 15 + 16;
    for (int t = 0; t < NT; ++t) {
        { const int ahead = NT - 1 - t;
          if (ahead >= 4) asm volatile("s_waitcnt vmcnt(8)" ::: "memory"); else if (ahead == 3) asm volatile("s_waitcnt vmcnt(6)" ::: "memory");
          else if (ahead == 2) asm volatile("s_waitcnt vmcnt(4)" ::: "memory"); else if (ahead == 1) asm volatile("s_waitcnt vmcnt(2)" ::: "memory"); else asm volatile("s_waitcnt vmcnt(0)" ::: "memory"); }
        asm volatile("s_waitcnt lgkmcnt(0)" ::: "memory");
        __builtin_amdgcn_s_barrier();
        if (t + 5 < NT) ATT_ISSUE(t + 5);
        const int slot = (t % NSLOT) * SLOT;
        if (MODE == 1 && t > 0) { const int kr = kr0 + t - 1; if (kr < rsw0 || kr > rsw1 + 7) continue; }
        const int cbt = (MODE == 1 && t > 0) ? cb : 0;
        const lds_cptr kp = (lds_cptr)lds + slot + hi * 1024 + (r32 + cbt) * 16;
        const lds_cptr vp = (lds_cptr)lds + slot + 8192 + ((lane >> 4) & 1) * 32 + (lane & 3) * 8 + (4 * hi + ((lane & 15) >> 2) + cbt) * 64;
        bf16x8 kf[8];
        if (MODE == 0 && t > 0) {
#pragma unroll
            for (int d0 = 0; d0 < 4; ++d0) { kf[2 * d0] = *(const LAS bf16x8*)(kp + d0 * 2048); kf[2 * d0 + 1] = *(const LAS bf16x8*)(kp + d0 * 2048 + 512); }
        } else {
#pragma unroll
            for (int d0 = 0; d0 < 4; ++d0) { kf[2 * d0] = *(const LAS bf16x8*)(kp + d0 * 2048); kf[2 * d0 + 1] = kf[2 * d0]; }
        }
        if (t == 0) {
            if (MODE == 0) tile_qb<1, 1>(kf, qr, mq, ones, vp, o, m, l, wsf, r32, hi, [&](int, int r) { return r < 8 ? tabA[max(crow(r, hi) - 16 - qpos, -128) + TA_OFF] : NEGB; });
            else tile_qb<1, 1>(kf, qr, mq, ones, vp, o, m, l, wsf, r32, hi, [&](int, int r) { return r < 8 ? 0.f : NEGB; });
        } else if (MODE == 0) { const volatile LAS float* bp = tabA + 64 * (kt0 + t - 1) + 4 * hi - qpos + TA_OFF;
            tile_qb<2, 4>(kf, qr, mq, ones, vp, o, m, l, wsf, r32, hi, [&](int hf, int r) { return bp[32 * hf + (r & 3) + 8 * (r >> 2)]; });
        } else { const int kr = kr0 + t - 1; const bool rowok = kr >= rs && kr <= rs + 7; const volatile LAS float* bp = tabB + (rowok ? kr - qrow + 7 : 15) * 31 + dc0;
            tile_qb<1, 2>(kf, qr, mq, ones, vp, o, m, l, wsf, r32, hi, [&](int, int r) { return bp[(r & 3) + 8 * (r >> 2)] + cm[r]; });
        }
    }
    if (MODE == 0) { if (hi == 0) l += __builtin_amdgcn_exp2f(F.sink[hidx] * LOG2E - m); }
    if (MODE == 0) finish_qb(F, o, l, wsf, stg, lane, r32, hi, ocol, hidx, [&](int q) { return qtok0 + q; });
    else finish_qb(F, o, l, wsf, stg, lane, r32, hi, ocol, hidx, [&](int q) { return qtok0 + (q >> 4) * 64 + (q & 15); });
    __builtin_amdgcn_s_barrier();
#undef ATT_TROW
#undef ATT_ISSUE
}
__device__ __forceinline__ void attn_phase(const Frame& F, int mask = 3) {
    __syncthreads();
    for (int L = F.bx; L < 2048; L += F.G) { if (L < 1024) { if (mask & 1) attn_unit<0>(F, L); } else if (mask & 2) attn_unit<1>(F, L - 1024); }
    __syncthreads();
}
}

#ifndef FAST_P5
#define FAST_P5 1
#endif
__device__ __forceinline__ void route_token(const Frame& F, int tok, float lg, int lane) {
    const float score = 1.0f / (1.0f + expf(-lg)), v0 = score + F.rbias[lane];
    int rk = 0;
#pragma unroll
    for (int j = 0; j < 8; ++j) { const int o = (lane & ~7) + j; const float w = __shfl(v0, o); rk += (w > v0 || (w == v0 && o < lane)) ? 1 : 0; }
    float gs = rk < 2 ? v0 : 0.f; gs += __shfl_xor(gs, 1); gs += __shfl_xor(gs, 2); gs += __shfl_xor(gs, 4);
    int grk = 0; const int myg = lane >> 3;
#pragma unroll
    for (int g = 0; g < 8; ++g) { const float w = __shfl(gs, g * 8); grk += (w > gs || (w == gs && g < myg)) ? 1 : 0; }
    const float mv = grk < 4 ? v0 : -INFINITY;
    int erk = 0;
    for (int o = 0; o < 64; ++o) { const float w = __shfl(mv, o); erk += (w > mv || (w == mv && o < lane)) ? 1 : 0; }
    const bool sel = erk < 8;
    const float wsm = wsum(sel ? score : 0.f), wgt = score / (wsm + 1e-20f) * 2.5f;
    if (sel) { const int rr = atomicAdd(F.cnt() + lane, 1); F.tokl()[(size_t)lane * NTOK + rr] = tok; F.wl()[(size_t)lane * NTOK + rr] = wgt; F.tke()[tok * 8 + erk] = lane; F.tkr()[tok * 8 + erk] = rr; }
}
__device__ __forceinline__ void route_token_local(const Frame& F, int tl  , float lg, int lane, LAS int* lcnt, LAS int* sel_e, LAS int* sel_lr, LAS float* sel_w) {
    lg = (lg == lg) ? lg : 0.f;
    const float score = 1.0f / (1.0f + expf(-lg)), v0 = score + F.rbias[lane];
    int rk = 0;
#pragma unroll
    for (int j = 0; j < 8; ++j) { const int o = (lane & ~7) + j; const float w = __shfl(v0, o); rk += (w > v0 || (w == v0 && o < lane)) ? 1 : 0; }
    float gs = rk < 2 ? v0 : 0.f; gs += __shfl_xor(gs, 1); gs += __shfl_xor(gs, 2); gs += __shfl_xor(gs, 4);
    int grk = 0; const int myg = lane >> 3;
#pragma unroll
    for (int g = 0; g < 8; ++g) { const float w = __shfl(gs, g * 8); grk += (w > gs || (w == gs && g < myg)) ? 1 : 0; }
    const float mv = grk < 4 ? v0 : -INFINITY;
    int erk = 0;
#pragma unroll 16
    for (int o = 0; o < 64; ++o) { const float w = __shfl(mv, o); erk += (w > mv || (w == mv && o < lane)) ? 1 : 0; }
    const bool sel = erk < 8;
    const float wsm = wsum(sel ? score : 0.f), wgt = score / (wsm + 1e-20f) * 2.5f;
    if (sel) { const int lr = __hip_atomic_fetch_add(lcnt + lane, 1, __ATOMIC_RELAXED, __HIP_MEMORY_SCOPE_WORKGROUP); sel_e[tl * 8 + erk] = lane; sel_lr[tl * 8 + erk] = lr; sel_w[tl * 8 + erk] = wgt; }
}
__device__ __forceinline__ void phase_ln1_router_fast(Frame& F) {
    constexpr int HSTR = 4112;
    LAS unsigned char* hb = F.lds; LAS float* part = (LAS float*)F.lds;
    LAS int* lcnt = (LAS int*)(F.lds + 132096); LAS int* lbase = lcnt + 64; LAS int* sel_e = lcnt + 128; LAS int* sel_lr = sel_e + 512; LAS float* sel_w = (LAS float*)(sel_lr + 512);
    const int lane = F.lane, w = F.wave, r32 = lane & 31, hi = lane >> 5;
    for (int it2 = F.bx; it2 < NTOK / 64; it2 += F.G) {
        if (F.tid < 64) lcnt[F.tid] = 0;
        for (int sub = 0; sub < 2; ++sub) {
            const int t0 = it2 * 64 + sub * 32;
            u32x4 raw[4][4];
#pragma unroll
            for (int q = 0; q < 4; ++q) { const bf16_t* src = F.z() + (size_t)(t0 + 4 * w + q) * D;
#pragma unroll
                for (int j = 0; j < 4; ++j) raw[q][j] = *(const u32x4*)(src + (lane + 64 * j) * 8); }
#pragma unroll
            for (int q = 0; q < 4; ++q) { const int row = 4 * w + q, tok = t0 + row; float v[4][8]; float s = 0.f;
#pragma unroll
                for (int j = 0; j < 4; ++j)
#pragma unroll
                    for (int i = 0; i < 4; ++i) { v[j][2 * i] = __uint_as_float(raw[q][j][i] << 16); v[j][2 * i + 1] = __uint_as_float(raw[q][j][i] & 0xffff0000u); s += v[j][2 * i] + v[j][2 * i + 1]; }
                const float mu = wsum(s) * (1.0f / D); float qq = 0.f;
#pragma unroll
                for (int j = 0; j < 4; ++j)
#pragma unroll
                    for (int i = 0; i < 8; ++i) { const float d = v[j][i] - mu; qq += d * d; }
                const float rstd = 1.0f / sqrtf(wsum(qq) * (1.0f / D) + LN_EPS);
#pragma unroll
                for (int j = 0; j < 4; ++j) { const int c = (lane + 64 * j) * 8; const f32x4 g0 = *(const f32x4*)(F.l1g + c), g1 = *(const f32x4*)(F.l1g + c + 4), b0 = *(const f32x4*)(F.l1b + c), b1 = *(const f32x4*)(F.l1b + c + 4);
                    u32x4 pk;
                    pk.x = pack2((v[j][0] - mu) * rstd * g0[0] + b0[0], (v[j][1] - mu) * rstd * g0[1] + b0[1]); pk.y = pack2((v[j][2] - mu) * rstd * g0[2] + b0[2], (v[j][3] - mu) * rstd * g0[3] + b0[3]);
                    pk.z = pack2((v[j][4] - mu) * rstd * g1[0] + b1[0], (v[j][5] - mu) * rstd * g1[1] + b1[1]); pk.w = pack2((v[j][6] - mu) * rstd * g1[2] + b1[2], (v[j][7] - mu) * rstd * g1[3] + b1[3]);
                    *(u32x4*)(F.h1() + (size_t)tok * D + c) = pk; *(LAS u32x4*)(hb + row * HSTR + c * 2) = pk; }
                if (lane == 0) { F.stats1()[tok * 2] = mu; F.stats1()[tok * 2 + 1] = rstd; } }
            __syncthreads();
            att::f32x16 acc[2]; acc[0] = att::f32x16{}; acc[1] = att::f32x16{};
            const bf16_t* wb = F.wrt() + (size_t)r32 * D + 256 * w + hi * 8;
#pragma unroll 8
            for (int s = 0; s < 16; ++s) {
                const att::bf16x8 a = *(const LAS att::bf16x8*)(hb + r32 * HSTR + (256 * w + 16 * s + 8 * hi) * 2);
                const att::bf16x8 b0 = *(const att::bf16x8*)(wb + 16 * s), b1 = *(const att::bf16x8*)(wb + (size_t)32 * D + 16 * s);
                acc[0] = __builtin_amdgcn_mfma_f32_32x32x16_bf16(a, b0, acc[0], 0, 0, 0); acc[1] = __builtin_amdgcn_mfma_f32_32x32x16_bf16(a, b1, acc[1], 0, 0, 0); }
            __syncthreads();
#pragma unroll
            for (int nt = 0; nt < 2; ++nt)
#pragma unroll
                for (int r = 0; r < 16; ++r) part[(w * 32 + att::crow(r, hi)) * 64 + 32 * nt + r32] = acc[nt][r];
            __syncthreads();
            for (int q = 0; q < 4; ++q) { const int row = 4 * w + q; float lg = 0.f;
#pragma unroll
                for (int ww = 0; ww < 8; ++ww) lg += part[(ww * 32 + row) * 64 + lane];
                route_token_local(F, sub * 32 + row, lg, lane, lcnt, sel_e, sel_lr, sel_w); }
            __syncthreads();
        }
        if (F.tid < 64) { const int n = lcnt[F.tid]; lbase[F.tid] = n > 0 ? atomicAdd(F.cnt() + F.tid, n) : 0; }
        __syncthreads();
        { const int tl = F.tid >> 3, slot = F.tid & 7, e = sel_e[F.tid], rr = lbase[e] + sel_lr[F.tid], tok = it2 * 64 + tl;
          F.tokl()[(size_t)e * NTOK + rr] = tok; F.wl()[(size_t)e * NTOK + rr] = sel_w[F.tid]; F.tke()[tok * 8 + slot] = e; F.tkr()[tok * 8 + slot] = rr; }
        __syncthreads();
    }
}

__global__ void __launch_bounds__(512, 2) mk_fwd(Args args) {
    extern __shared__ __attribute__((aligned(16))) unsigned char lds_raw[];
    Frame F; F.lds = (LAS unsigned char*)lds_raw; F.tid = threadIdx.x; F.lane = F.tid & 63; F.wave = __builtin_amdgcn_readfirstlane(F.tid >> 6); F.G = gridDim.x; F.bx = blockIdx.x;
    F.x = args.in[0]; F.meta = args.in[1]; F.lng = args.in[2]; F.lnb = args.in[3]; F.t5 = args.in[4]; F.w_in = args.in[5]; F.sink = args.in[6]; F.rpb = args.in[7]; F.ga = args.in[8]; F.gb = args.in[9];
    F.w_out = args.in[10]; F.l1g = args.in[11]; F.l1b = args.in[12]; F.w_router = args.in[13]; F.rbias = args.in[14]; F.w_gate = args.in[15]; F.w_up = args.in[16]; F.w_down = args.in[17];
    F.ws_gate = args.in[18]; F.ws_up = args.in[19]; F.ws_down = args.in[20]; F.l2g = args.in[21]; F.l2b = args.in[22]; F.out = args.out; F.ws = args.ws;
    unsigned char* ws = args.ws;
    volatile LAS unsigned* xbw = (volatile LAS unsigned*)(F.lds + LDS_BYTES - 16);
    LAS int* ps = (LAS int*)(F.lds + 131072);
    if (F.tid < 4) xbw[F.tid] = 0u;
    __syncthreads();
    const int lo = args.ph_lo, hi = args.ph_hi;
    XcdBarrier bar; bar.bar = (unsigned*)(ws + WS_CTL); bar.x = 0; bar.st = xbw;
    if (hi - lo > 1) bar = xcd_barrier_post((unsigned*)(ws + WS_CTL), xbw);
    unsigned* xcen = (unsigned*)(ws + WS_CTL + 20480);
    if (XCD_TRUE && hi - lo > 1 && F.tid == 0) { const unsigned x = xb_xcc_id(); xbw[2] = x; xbw[3] = xb_add(&xcen[x * 16], 1u); }
#ifndef PROBE_REPEAT
#define PROBE_REPEAT -1
#endif
#ifndef PROBE_SUB
#define PROBE_SUB 3
#endif
#ifndef PROBE_NOSTORE
#define PROBE_NOSTORE 0
#endif
#ifndef PROBE_HOT
#define PROBE_HOT 0
#endif
#ifndef PROBE_NT
#define PROBE_NT 32
#ifndef PROBE_LD
#define PROBE_LD 2048
#endif
#endif
#define IN(k) (lo <= (k) && (k) < hi)
#define SEAM(k) do { if (IN(k) && IN((k) + 1)) xcd_barrier(bar); } while (0)
    if (IN(0)) { F.fresh(); phase_prologue(F);
#if PROBE_REPEAT == 0
        xcd_barrier(bar); phase_prologue(F);
#endif
    } SEAM(0);
#define P1_BODY(rep) do { const int s_ = (rep) ? 0 : F.bx % 5; EpiU E{F.u(), rep}; { SchedInProj S{(const char*)F.h0(), (const char*)F.wtin(), F.G, F.bx, 0, s_}; pg8::gemm_phase(F.lds, S, E, D, D, D / 64); } if (!(rep)) { conv_inproj_share(F); __syncthreads(); } { SchedInProj S{(const char*)F.h0(), (const char*)F.wtin(), F.G, F.bx, s_, 1 << 20}; pg8::gemm_phase(F.lds, S, E, D, D, D / 64); } } while (0)
#define P4_BODY(rep) do { SchedOutProj S{(const char*)F.ya(), (const char*)F.wtout(), F.G, F.bx}; EpiZ E{F.z(), F.h0(), F.ssq(), (LAS float*)(F.lds + 131072 + 6144)}; pg8::gemm_phase(F.lds, S, E, D, D, D / 64, STAGGER4); } while (0)
#define P6_BODY(rep) do { moe_tables(F, ps); SchedGU S{(const char*)F.h1(), (const char*)F.wtgu(), F.tokl(), F.cnt(), ps, F.G, F.bx}; EpiGU E{F.hb(), F.wl()}; pg8::gemm_phase(F.lds, S, E, D, D, D / 64); if (!(rep)) conv_tail(F, IT_P6, IT_ALL, (ps[128 + 65] * 4) % F.G); } while (0)
#define P7_BODY(rep) do { moe_tables(F, ps); SchedDown S{(const char*)F.hb(), (const char*)F.wtd(), F.cnt(), ps, F.G, F.bx, (rep) ? PROBE_HOT : 0}; EpiDownR E{F.ym(), rep}; pg8::gemm_phase(F.lds, S, E, DE, DE, DE / 64, STAGGER7); SchedDownShared S2{(const char*)F.hb(), (const char*)F.wtd(), F.G, F.bx}; EpiDownS E2{F.o2(), F.h1()}; pg8::gemm_phase(F.lds, S2, E2, DE, DE, DE / 64); } while (0)
    if (XCD_TRUE && hi - lo > 1 && IN(0)) {
        if (F.tid == 0) { unsigned idx = 0, ok = 1, npop = 0; const unsigned x = xbw[2];
            for (unsigned j = 0; j < 16; ++j) { const unsigned cj = xb_ld(&xcen[j * 16]); if (cj) { ++npop; if (cj * 8u != (unsigned)F.G) ok = 0; if (j < x) ++idx; } }
            xbw[2] = (ok && npop == 8) ? xbw[3] * 8u + idx : (unsigned)blockIdx.x; }
        __syncthreads();
        F.bx = (int)xbw[2];
    }
    if (IN(1)) { F.fresh();
#if FAST_P1
        P1_BODY(0);
#if PROBE_REPEAT == 1
        xcd_barrier(bar); P1_BODY(PROBE_NOSTORE);
#endif
#else
        FnInProj f{F}; sgemm(f, F.lds, F.tid, F.bx, F.G);
#endif
    } SEAM(1);
    if (IN(2)) { F.fresh();
#if FAST_P2
        att::attn_phase(F);
#if PROBE_REPEAT == 2
        xcd_barrier(bar); att::attn_phase(F, PROBE_SUB);
#endif
#else
        phase_attn_simple(F);
#endif
    } SEAM(2);
#if !FAST_P4
    if (IN(3)) { phase_rmsnorm(F); } SEAM(3);
#endif
    if (IN(4)) { F.fresh();
#if FAST_P4
        P4_BODY(0);
#if PROBE_REPEAT == 4
        xcd_barrier(bar); P4_BODY(1);
#endif
#else
        FnOutProj f{F}; sgemm(f, F.lds, F.tid, F.bx, F.G);
#endif
    } SEAM(4);
#if FAST_P5
#define PH5(F) phase_ln1_router_fast(F)
#else
#define PH5(F) phase_ln1_router(F)
#endif
    if (IN(5)) { F.fresh(); PH5(F);
#if PROBE_REPEAT == 5
        xcd_barrier(bar); if (F.bx == 0 && F.tid < 64) F.cnt()[F.tid] = 0; xcd_barrier(bar); PH5(F);
#endif
    } SEAM(5);
    if (IN(6)) { F.fresh();
#if FAST_P6
        P6_BODY(0);
#if PROBE_REPEAT == 6
        xcd_barrier(bar); P6_BODY(1);
#endif
#else
        expert_starts(F, ps); FnGateUp f{F, ps}; sgemm(f, F.lds, F.tid, F.bx, F.G);
#endif
    } SEAM(6);
    if (IN(7)) { F.fresh();
#if FAST_P7
        P7_BODY(0);
#if PROBE_REPEAT == 7
        xcd_barrier(bar); P7_BODY(PROBE_NOSTORE);
#endif
#else
        expert_starts(F, ps); { FnDown f{F, ps}; sgemm(f, F.lds, F.tid, F.bx, F.G); } { FnFinal f{F, ps}; sgemm(f, F.lds, F.tid, F.bx, F.G); }
#endif
    } SEAM(7);
    if (IN(8)) { F.fresh(); expert_starts(F, ps); phase_ln2(F, ps);
#if PROBE_REPEAT == 8
        xcd_barrier(bar); phase_ln2(F, ps);
#endif
    }
#undef IN
#undef SEAM
}

extern "C" void kernel_launch(void* const* d_in, const int* in_sizes, int n_in, void* d_out, int out_size, void* d_ws, size_t ws_size, hipStream_t stream) {
    static int grid = 0;
    if (grid == 0) {
        if (n_in != 23 || in_sizes[0] != NTOK * D || out_size != NTOK * D || ws_size < WS_END) {
            fprintf(stderr, "kernel_launch: built for 23 inputs, x/out of %d floats, >= %zu bytes of workspace; got n_in %d in0 %d out %d ws %zu; nothing launched\n", NTOK * D, (size_t)WS_END, n_in, n_in > 0 ? in_sizes[0] : -1, out_size, ws_size);
            grid = -1; return; }
        int dev = 0, cus = 0, per_cu = 0;
        if (hipGetDevice(&dev) != hipSuccess || hipDeviceGetAttribute(&cus, hipDeviceAttributeMultiprocessorCount, dev) != hipSuccess) { fprintf(stderr, "kernel_launch: device query failed\n"); grid = -1; return; }
        if (hipFuncSetAttribute((const void*)mk_fwd, hipFuncAttributeMaxDynamicSharedMemorySize, LDS_BYTES) != hipSuccess) { fprintf(stderr, "kernel_launch: hipFuncSetAttribute failed\n"); grid = -1; return; }
        if (hipOccupancyMaxActiveBlocksPerMultiprocessor(&per_cu, (const void*)mk_fwd, 512, LDS_BYTES) != hipSuccess || per_cu < 1) fprintf(stderr, "kernel_launch: note: occupancy query reports %d\n", per_cu);
        (void)hipGetLastError();
        grid = cus;
    }
    if (grid < 0) return;
    if (hipMemsetAsync((char*)d_ws + WS_CTL, 0, CTL_BYTES, stream) != hipSuccess) { fprintf(stderr, "kernel_launch: memset failed\n"); return; }
    Args a{};
    for (int i = 0; i < 23; ++i) a.in[i] = (const float*)d_in[i];
    a.out = (float*)d_out; a.ws = (unsigned char*)d_ws;
#if MK_ONE_LAUNCH
    a.ph_lo = 0; a.ph_hi = NPHASE;
    hipLaunchKernelGGL(mk_fwd, dim3(grid), dim3(512), LDS_BYTES, stream, a);
#else
    for (int p = 0; p < NPHASE; ++p) { a.ph_lo = p; a.ph_hi = p + 1; hipLaunchKernelGGL(mk_fwd, dim3(grid), dim3(512), LDS_BYTES, stream, a); }
#endif
    const hipError_t le = hipPeekAtLastError();
    if (le != hipSuccess) fprintf(stderr, "kernel_launch: launch failed: %s\n", hipGetErrorName(le));
}
```

```cpp
#include <hip/hip_runtime.h>
#include <cstdio>
#include <cstdint>

#define LAS __attribute__((address_space(3)))
typedef unsigned short bf16_t;
typedef float f32x4 __attribute__((ext_vector_type(4)));
typedef unsigned u32x4 __attribute__((ext_vector_type(4)));
typedef unsigned u32x2 __attribute__((ext_vector_type(2)));

#ifndef CONV_P2
#define CONV_P2 28160
#endif
#ifndef CONV_NT
#define CONV_NT 1
#endif
#ifndef MK_ONE_LAUNCH
#define MK_ONE_LAUNCH 1
#endif

constexpr int D = 2048, SEQ = 8192, NB = 2, NTOK = NB * SEQ;
constexpr int NMETA = 16, INW = 4608, MROWS = NTOK + 256;
constexpr int NE = 64, DE = 512, PMAX = 147456, HBROWS = PMAX + NTOK;
constexpr float ALPHA = 1.189207115002721f;
constexpr float LN_EPS = 1e-5f, RMS_EPS = 1e-6f, LOG2E = 1.4426950408889634f, QSCALE = 0.125f * LOG2E;
constexpr int COL_QA = 0, COL_KA = 1024, COL_VA = 1280, COL_QB = 1536, COL_KB = 2560, COL_VB = 3584;
constexpr int NPHASE = 9;
constexpr int LDS_BYTES = 147456;

constexpr size_t WS_CTL = 0, CTL_BYTES = 32768;
constexpr size_t WS_CNT = 16384;
constexpr size_t WS_STATS0 = WS_CTL + CTL_BYTES;
constexpr size_t WS_STATS1 = WS_STATS0 + (size_t)NTOK * 8;
constexpr size_t WS_SSQ = WS_STATS1 + (size_t)NTOK * 8;
constexpr size_t WS_TOKL = WS_SSQ + (size_t)NTOK * 32 * 4;
constexpr size_t WS_WL = WS_TOKL + (size_t)NE * NTOK * 4;
constexpr size_t WS_TKE = WS_WL + (size_t)NE * NTOK * 4;
constexpr size_t WS_TKR = WS_TKE + (size_t)NTOK * 8 * 4;
constexpr size_t WS_TAB = WS_TKR + (size_t)NTOK * 8 * 4;
constexpr size_t WS_WRT = WS_TAB + 32768;
constexpr size_t WS_Z = WS_WRT + (size_t)NE * D * 2;
constexpr size_t WS_O2 = WS_Z + (size_t)NTOK * D * 2;
constexpr size_t WS_WTD = WS_Z + (size_t)NTOK * D * 4;
constexpr size_t WS_HB = WS_WTD + (size_t)65 * 2048 * 512 * 2;
constexpr size_t WS_B = WS_HB + (size_t)HBROWS * 512 * 2;
constexpr size_t WS_WTGU = WS_B;
constexpr size_t WS_WTIN = WS_WTGU + (size_t)65 * 1024 * 2048 * 2;
constexpr size_t WS_WTOUT = WS_WTIN + (size_t)INW * D * 2;
constexpr size_t WS_H0 = WS_WTOUT + (size_t)D * D * 2;
constexpr size_t WS_U = WS_H0 + (size_t)MROWS * D * 2;
constexpr size_t WS_YA = WS_U + (size_t)MROWS * INW * 2;
constexpr size_t WS_H1 = WS_Z;
constexpr size_t WS_YM = WS_B;
constexpr size_t WS_END_A = WS_YA + (size_t)NTOK * D * 2, WS_END_B = WS_YM + (size_t)PMAX * D * 2;
constexpr size_t WS_END = WS_END_A > WS_END_B ? WS_END_A : WS_END_B;
static_assert(WS_END <= ((size_t)1 << 30), "workspace map must fit 1 GiB");

__device__ __forceinline__ float bf2f(bf16_t b) { return __uint_as_float(((unsigned)b) << 16); }
__device__ __forceinline__ bf16_t f2bf(float f) { unsigned u = __float_as_uint(f); u += 0x7FFFu + ((u >> 16) & 1u); return (bf16_t)(u >> 16); }
__device__ __forceinline__ unsigned pack2(float lo, float hi) { return (unsigned)f2bf(lo) | ((unsigned)f2bf(hi) << 16); }
__device__ __forceinline__ float wsum(float v) {
#pragma unroll
    for (int o = 32; o >= 1; o >>= 1) v += __shfl_xor(v, o);
    return v; }
__device__ __forceinline__ float wmax(float v) {
#pragma unroll
    for (int o = 32; o >= 1; o >>= 1) v = fmaxf(v, __shfl_xor(v, o));
    return v; }
__device__ __forceinline__ int t5_bucket(int rel) {
    const int ret = rel > 0 ? 16 : 0, n = rel < 0 ? -rel : rel;
    if (n < 8) return ret + n;
    const int n2 = n > 32768 ? 0x40000000 : n * n; int lg = 31 - __clz(n2) + 2; if (lg > 15) lg = 15;
    return ret + lg; }

#define XB_TMO      128
#define XB_XCNT(j)  (256  + 64 * (j))
#define XB_XSUB(j)  (1280 + 64 * (j))
#define XB_XGEN(j)  (2304 + 64 * (j))
#define XB_TOP      3328
#define XB_TOPGEN   3392
#define XCD_BAR_WORDS 3456
#define XB_SPIN_CAP (1u << 18)
__device__ __forceinline__ unsigned xb_ld(unsigned* p)              { return __hip_atomic_load(p, __ATOMIC_RELAXED, __HIP_MEMORY_SCOPE_AGENT); }
__device__ __forceinline__ unsigned xb_add(unsigned* p, unsigned v) { return __hip_atomic_fetch_add(p, v, __ATOMIC_RELAXED, __HIP_MEMORY_SCOPE_AGENT); }
__device__ __forceinline__ unsigned xb_xcc_id() { return (unsigned)__builtin_amdgcn_s_getreg((3 << 11) | 20) & 0xFu; }
#define XB_SPIN(cond, bar) do { unsigned _sp = 0; while (cond) { __builtin_amdgcn_s_sleep(1); \
    if ((++_sp & 255u) == 0u) { if (xb_ld(&(bar)[XB_TMO])) break; if (_sp > XB_SPIN_CAP) { atomicAdd(&(bar)[XB_TMO], 1u); break; } } } } while (0)
struct XcdBarrier { unsigned* bar; unsigned x; volatile LAS unsigned* st; };
__device__ __forceinline__ XcdBarrier xcd_barrier_post(unsigned* bar, volatile LAS unsigned* st) {
    XcdBarrier b; b.bar = bar; b.x = xb_xcc_id(); b.st = st;
    if (threadIdx.x == 0) (void)xb_add(&bar[XB_XCNT(b.x)], 1u);
    return b;
}
__device__ __forceinline__ void xcd_barrier_complete(unsigned* bar, unsigned x, unsigned& nloc, unsigned& nx) {
    const unsigned G = gridDim.x * gridDim.y * gridDim.z;
    unsigned sum, cnt, mine, sp = 0u;
    for (;;) {
        sum = 0u; cnt = 0u; mine = 0u;
#pragma unroll
        for (unsigned j = 0; j < 16; ++j) { const unsigned c = xb_ld(&bar[XB_XCNT(j)]); sum += c; cnt += (c > 0u) ? 1u : 0u; mine = (j == x) ? c : mine; }
        if (sum == G) break;
        __builtin_amdgcn_s_sleep(1);
        if ((++sp & 255u) == 0u) { if (xb_ld(&bar[XB_TMO])) break; if (sp > XB_SPIN_CAP) { atomicAdd(&bar[XB_TMO], 1u); break; } }
    }
    nloc = mine > 0u ? mine : 1u; nx = cnt > 0u ? cnt : 1u;
}
__device__ __forceinline__ void xcd_barrier(const XcdBarrier& b) {
    asm volatile("s_waitcnt vmcnt(0)" ::: "memory");
    __syncthreads();
    if (threadIdx.x == 0) {
        unsigned* bar = b.bar;
        __builtin_amdgcn_s_waitcnt(0);
        unsigned nloc = b.st[0], nx = b.st[1];
        if (nloc == 0u) { xcd_barrier_complete(bar, b.x, nloc, nx); b.st[0] = nloc; b.st[1] = nx; }
        const unsigned old = xb_add(&bar[XB_XSUB(b.x)], 1u);
        const unsigned gen = old / nloc;
        if (old + 1u == (gen + 1u) * nloc) {
            __builtin_amdgcn_fence(__ATOMIC_RELEASE, "agent");
            asm volatile("s_waitcnt vmcnt(0)" ::: "memory");
            const unsigned og = xb_add(&bar[XB_TOP], 1u);
            const unsigned tg = og / nx;
            if (og + 1u == (tg + 1u) * nx) xb_add(&bar[XB_TOPGEN], 1u);
            else XB_SPIN(xb_ld(&bar[XB_TOPGEN]) == tg, bar);
            __builtin_amdgcn_fence(__ATOMIC_ACQUIRE, "agent");
            xb_add(&bar[XB_XGEN(b.x)], 1u);
            asm volatile("s_waitcnt vmcnt(0)" ::: "memory");
        } else {
            XB_SPIN(xb_ld(&bar[XB_XGEN(b.x)]) == gen, bar);
            __builtin_amdgcn_fence(__ATOMIC_ACQUIRE, "agent");
            asm volatile("s_waitcnt vmcnt(0)" ::: "memory");
        }
    }
    __syncthreads();
}

struct Args { const float* in[23]; float* out; unsigned char* ws; int ph_lo, ph_hi; };
struct Frame {
    LAS unsigned char* lds; int tid, lane, wave, G, bx;
    const float *x, *meta, *lng, *lnb, *t5, *w_in, *sink, *rpb, *ga, *gb, *w_out, *l1g, *l1b, *w_router, *rbias, *w_gate, *w_up, *w_down, *ws_gate, *ws_up, *ws_down, *l2g, *l2b;
    float* out; unsigned char* ws;
    __device__ __forceinline__ void fresh() { int t = threadIdx.x; asm volatile("" : "+v"(t)); tid = t; lane = t & 63; wave = __builtin_amdgcn_readfirstlane(t >> 6); }
    __device__ __forceinline__ float* stats0() const { return (float*)(ws + WS_STATS0); }
    __device__ __forceinline__ float* stats1() const { return (float*)(ws + WS_STATS1); }
    __device__ __forceinline__ float* ssq() const { return (float*)(ws + WS_SSQ); }
    __device__ __forceinline__ float* wl() const { return (float*)(ws + WS_WL); }
    __device__ __forceinline__ float* tab() const { return (float*)(ws + WS_TAB); }
    __device__ __forceinline__ int* cnt() const { return (int*)(ws + WS_CNT); }
    __device__ __forceinline__ int* tokl() const { return (int*)(ws + WS_TOKL); }
    __device__ __forceinline__ int* tke() const { return (int*)(ws + WS_TKE); }
    __device__ __forceinline__ int* tkr() const { return (int*)(ws + WS_TKR); }
    __device__ __forceinline__ bf16_t* wtd() const { return (bf16_t*)(ws + WS_WTD); }
    __device__ __forceinline__ bf16_t* hb() const { return (bf16_t*)(ws + WS_HB); }
    __device__ __forceinline__ bf16_t* wtgu() const { return (bf16_t*)(ws + WS_WTGU); }
    __device__ __forceinline__ bf16_t* wtin() const { return (bf16_t*)(ws + WS_WTIN); }
    __device__ __forceinline__ bf16_t* wtout() const { return (bf16_t*)(ws + WS_WTOUT); }
    __device__ __forceinline__ bf16_t* h0() const { return (bf16_t*)(ws + WS_H0); }
    __device__ __forceinline__ bf16_t* u() const { return (bf16_t*)(ws + WS_U); }
    __device__ __forceinline__ bf16_t* ya() const { return (bf16_t*)(ws + WS_YA); }
    __device__ __forceinline__ bf16_t* h1() const { return (bf16_t*)(ws + WS_H1); }
    __device__ __forceinline__ bf16_t* ym() const { return (bf16_t*)(ws + WS_YM); }
    __device__ __forceinline__ bf16_t* wrt() const { return (bf16_t*)(ws + WS_WRT); }
    __device__ __forceinline__ bf16_t* z() const { return (bf16_t*)(ws + WS_Z); }
    __device__ __forceinline__ bf16_t* o2() const { return (bf16_t*)(ws + WS_O2); }
};

struct ConvDesc { const float* src; bf16_t* dst; int lds_, ldd_; const float* ksc; float csc; };
__device__ __forceinline__ void conv_load(const ConvDesc& d, f32x4 (&v)[16], int lane) {
    const int kk = lane & 3, n4 = (lane >> 2) * 4;
#pragma unroll
    for (int p = 0; p < 16; ++p) v[p] = __builtin_nontemporal_load((const f32x4*)(d.src + (size_t)(4 * p + kk) * d.lds_ + n4));
}
__device__ __forceinline__ void conv_finish(const ConvDesc& d, const f32x4 (&v)[16], LAS float* scr, int lane) {
    const int kk = lane & 3, n4 = (lane >> 2) * 4;
#pragma unroll
    for (int p = 0; p < 16; ++p) { const int k = 4 * p + kk; const float s = d.ksc ? d.ksc[k] * d.csc : d.csc;
        scr[k * 65 + n4] = v[p][0] * s; scr[k * 65 + n4 + 1] = v[p][1] * s; scr[k * 65 + n4 + 2] = v[p][2] * s; scr[k * 65 + n4 + 3] = v[p][3] * s; }
    asm volatile("s_waitcnt lgkmcnt(0)" ::: "memory");
    const int c = lane >> 3;
#pragma unroll
    for (int j = 0; j < 8; ++j) { const int n = (lane & 7) + 8 * j; const LAS float* s = scr + (8 * c) * 65 + n; u32x4 o;
        o.x = pack2(s[0], s[65]); o.y = pack2(s[2 * 65], s[3 * 65]); o.z = pack2(s[4 * 65], s[5 * 65]); o.w = pack2(s[6 * 65], s[7 * 65]);
        __builtin_nontemporal_store(o, (u32x4*)(d.dst + (size_t)n * d.ldd_ + 8 * c)); }
    asm volatile("s_waitcnt lgkmcnt(0)" ::: "memory");
}
constexpr int T_R = 32, T_IN = 72 * 32, T_OUT = 32 * 32, T_GU = 65 * 2 * 8 * 32, T_D = 65 * 32 * 8;
constexpr int IT_P0 = T_R + T_IN, IT_ALL = IT_P0 + T_OUT + T_GU + T_D, IT_P6 = IT_ALL - 6400, IT_MID = IT_P6 - CONV_P2;
__device__ __forceinline__ ConvDesc conv_desc(const Frame& F, int it) {
    int r = it; const float* src; bf16_t* dst; int lds_, ldd_; const float* ksc = nullptr; float csc = 1.0f;
    if (r < T_R) { src = F.w_router + (size_t)(r * 64) * NE; lds_ = NE; dst = F.wrt() + r * 64; ldd_ = D; }
    else if ((r -= T_R) < T_IN) { const int tn = r % 72, tk = r / 72; const int n0 = tn * 64; const bool isq = (n0 < COL_KA) || (n0 >= COL_QB && n0 < COL_KB);
        src = F.w_in + (size_t)(tk * 64) * INW + n0; lds_ = INW; dst = F.wtin() + (size_t)n0 * D + tk * 64; ldd_ = D; csc = isq ? QSCALE : 1.0f; }
    else if ((r -= T_IN) < T_OUT) { const int tn = r % 32, tk = r / 32; const int k0 = tk * 64;
        src = F.w_out + (size_t)k0 * D + tn * 64; lds_ = D; dst = F.wtout() + (size_t)(tn * 64) * D + k0; ldd_ = D; ksc = k0 < 1024 ? F.ga + k0 : F.gb + (k0 - 1024); }
    else if ((r -= T_OUT) < T_GU) { const int tn = r % 8, tk = (r / 8) % 32, which = (r / 256) % 2, e = r / 512;
        const float* s0 = e < NE ? (which ? F.w_up : F.w_gate) + (size_t)e * D * DE : (which ? F.ws_up : F.ws_gate);
        const int c0 = tn * 64, nprime = 256 * (c0 / 128) + 128 * which + (c0 % 128);
        src = s0 + (size_t)(tk * 64) * DE + c0; lds_ = DE; dst = F.wtgu() + ((size_t)e * 1024 + nprime) * D + tk * 64; ldd_ = D; }
    else { r -= T_GU; const int tn = r % 32, tk = (r / 32) % 8, e = r / 256;
        const float* s0 = e < NE ? F.w_down + (size_t)e * DE * D : F.ws_down;
        src = s0 + (size_t)(tk * 64) * D + tn * 64; lds_ = D; dst = F.wtd() + ((size_t)e * D + tn * 64) * DE + tk * 64; ldd_ = DE; }
    return ConvDesc{src, dst, lds_, ldd_, ksc, csc};
}
__device__ __forceinline__ void conv_items(const Frame& F, int first, int last, int step) {
    LAS float* t = (LAS float*)F.lds + F.wave * (64 * 65);
    if (first >= last) return;
    f32x4 va[16], vb[16]; ConvDesc da = conv_desc(F, first), db = da;
    conv_load(da, va, F.lane);
    for (int it = first; it < last; it += 2 * step) {
        const bool hb = it + step < last; if (hb) { db = conv_desc(F, it + step); conv_load(db, vb, F.lane); }
        conv_finish(da, va, t, F.lane);
        if (!hb) break;
        const bool ha = it + 2 * step < last; if (ha) { da = conv_desc(F, it + 2 * step); conv_load(da, va, F.lane); }
        conv_finish(db, vb, t, F.lane);
        if (!ha) break;
    }
}
__device__ __forceinline__ void conv_range(const Frame& F, int first, int last) { conv_items(F, first + F.wave, last, 8); }
__device__ __forceinline__ void conv_inproj_share(const Frame& F) {
    constexpr int N1 = IT_MID - IT_P0, CY = (N1 - 118 * 100 + 255) / 256, CX = CY + 100; int a, n;
    if (F.G == 256) { if (F.bx < 138) { a = F.bx * CY; n = CY; } else { a = 138 * CY + (F.bx - 138) * CX; n = CX; } }
    else { n = (N1 + F.G - 1) / F.G; a = F.bx * n; }
    const int e = a + n < N1 ? a + n : N1;
    if (a < e) conv_range(F, IT_P0 + a, IT_P0 + e);
}
__device__ __forceinline__ void conv_tail(const Frame& F, int first, int last, int c0) {
    int nw = F.G - c0, me = F.bx - c0; if (nw <= 0) { nw = F.G; me = F.bx; }
    if (me < 0) return;
    conv_items(F, first + me * 8 + F.wave, last, nw * 8);
}
__device__ __forceinline__ void phase_prologue(Frame& F) {
    const int gw = F.bx * 8 + F.wave, NGW = F.G * 8;
    conv_items(F, gw, IT_P0, NGW);
    for (int row = gw; row < MROWS; row += NGW) {
        bf16_t* dst = F.h0() + (size_t)row * D;
        if (row >= NTOK + NMETA) {
#pragma unroll
            for (int j = 0; j < 8; ++j) *(u32x2*)(dst + (j * 64 + F.lane) * 4) = (u32x2){0u, 0u};
            continue; }
        const float* src = row < NTOK ? F.x + (size_t)row * D : F.meta + (size_t)(row - NTOK) * D;
        f32x4 v[8]; float s = 0.f;
#pragma unroll
        for (int j = 0; j < 8; ++j) { v[j] = *(const f32x4*)(src + (j * 64 + F.lane) * 4); s += (v[j][0] + v[j][1]) + (v[j][2] + v[j][3]); }
        const float mu = wsum(s) * (1.0f / D); float q = 0.f;
#pragma unroll
        for (int j = 0; j < 8; ++j) { const f32x4 d = v[j] - mu; q += (d[0] * d[0] + d[1] * d[1]) + (d[2] * d[2] + d[3] * d[3]); }
        const float rstd = 1.0f / sqrtf(wsum(q) * (1.0f / D) + LN_EPS);
#pragma unroll
        for (int j = 0; j < 8; ++j) { const int c = (j * 64 + F.lane) * 4; const f32x4 g = *(const f32x4*)(F.lng + c), b = *(const f32x4*)(F.lnb + c); const f32x4 y = (v[j] - mu) * rstd * g + b;
            *(u32x2*)(dst + c) = (u32x2){pack2(y[0], y[1]), pack2(y[2], y[3])}; }
        if (row < NTOK && F.lane == 0) { F.stats0()[row * 2] = mu; F.stats0()[row * 2 + 1] = rstd; }
    }
    if (F.bx == 0) for (int i = F.tid; i < 16 * 272; i += 512) { const int h = i / 272, r = i % 272; F.tab()[i] = r <= 256 ? F.t5[t5_bucket(r - 128) * 16 + h] * LOG2E : 0.f; }
}

template <class Fn> __device__ __forceinline__ void sgemm(const Fn& f, LAS unsigned char* ldsb, int tid, int bx, int G) {
    LAS float* As = (LAS float*)ldsb; LAS float* Bs = As + 32 * 132; LAS float* Bs2 = Bs + 32 * 68;
    const int ntm = f.ntm(), ntn = f.ntn(), K = f.K();
    const int tx = tid & 15, ty = tid >> 4, ar = tid >> 2, akc = (tid & 3) * 8, br = (tid & 255) >> 2;
    for (int tile = bx; tile < ntm * ntn; tile += G) {
        const int tm = tile / ntn, tn = tile % ntn;
        typename Fn::Tile T; if (!f.tile(tm, T)) continue;
        float acc[4][4], acc2[4][4];
#pragma unroll
        for (int i = 0; i < 4; ++i)
#pragma unroll
            for (int j = 0; j < 4; ++j) { acc[i][j] = 0.f; acc2[i][j] = 0.f; }
        const bf16_t* ap = f.arow(T, tm * 128 + ar);
        const bf16_t* bp = tid < 256 ? f.brow(T, tn * 64 + br) : (Fn::DUAL ? f.brow2(T, tn * 64 + br) : nullptr);
        LAS float* Bw = tid < 256 ? Bs : Bs2;
        for (int k0 = 0; k0 < K; k0 += 32) {
            u32x4 av = (u32x4){0u, 0u, 0u, 0u}, bv = (u32x4){0u, 0u, 0u, 0u};
            if (ap) av = *(const u32x4*)(ap + k0 + akc);
            if (bp) bv = *(const u32x4*)(bp + k0 + akc);
            __syncthreads();
#pragma unroll
            for (int i = 0; i < 4; ++i) { As[(akc + 2 * i) * 132 + ar] = __uint_as_float(av[i] << 16); As[(akc + 2 * i + 1) * 132 + ar] = __uint_as_float(av[i] & 0xffff0000u); }
            if (tid < 256 || Fn::DUAL) {
#pragma unroll
                for (int i = 0; i < 4; ++i) { Bw[(akc + 2 * i) * 68 + br] = __uint_as_float(bv[i] << 16); Bw[(akc + 2 * i + 1) * 68 + br] = __uint_as_float(bv[i] & 0xffff0000u); } }
            __syncthreads();
#pragma unroll 8
            for (int kk = 0; kk < 32; ++kk) {
                const f32x4 a = *(const LAS f32x4*)(As + kk * 132 + ty * 4), b = *(const LAS f32x4*)(Bs + kk * 68 + tx * 4);
#pragma unroll
                for (int i = 0; i < 4; ++i)
#pragma unroll
                    for (int j = 0; j < 4; ++j) acc[i][j] += a[i] * b[j];
                if (Fn::DUAL) { const f32x4 b2 = *(const LAS f32x4*)(Bs2 + kk * 68 + tx * 4);
#pragma unroll
                    for (int i = 0; i < 4; ++i)
#pragma unroll
                        for (int j = 0; j < 4; ++j) acc2[i][j] += a[i] * b2[j]; }
            }
        }
#pragma unroll
        for (int i = 0; i < 4; ++i)
#pragma unroll
            for (int j = 0; j < 4; ++j) f.store(T, tm * 128 + ty * 4 + i, tn * 64 + tx * 4 + j, acc[i][j], acc2[i][j]);
    }
}

__device__ __forceinline__ void expert_starts(const Frame& F, LAS int* ps  ) {
    if (F.tid == 0) { int acc = 0; for (int e = 0; e < NE; ++e) { ps[e] = acc; acc += ((F.cnt()[e] + 255) >> 8) << 8; } ps[64] = acc; }
    __syncthreads();
}

struct FnInProj {
    static constexpr bool DUAL = false; struct Tile {}; const Frame& F;
    __device__ int ntm() const { return MROWS / 128; } __device__ int ntn() const { return INW / 64; } __device__ int K() const { return D; }
    __device__ bool tile(int, Tile&) const { return true; }
    __device__ const bf16_t* arow(const Tile&, int row) const { return F.h0() + (size_t)row * D; }
    __device__ const bf16_t* brow(const Tile&, int n) const { return F.wtin() + (size_t)n * D; }
    __device__ const bf16_t* brow2(const Tile&, int) const { return nullptr; }
    __device__ void store(const Tile&, int row, int n, float a, float) const { F.u()[(size_t)row * INW + n] = f2bf(a); }
};
struct FnOutProj {
    static constexpr bool DUAL = false; struct Tile {}; const Frame& F;
    __device__ int ntm() const { return NTOK / 128; } __device__ int ntn() const { return D / 64; } __device__ int K() const { return D; }
    __device__ bool tile(int, Tile&) const { return true; }
    __device__ const bf16_t* arow(const Tile&, int row) const { return F.ya() + (size_t)row * D; }
    __device__ const bf16_t* brow(const Tile&, int n) const { return F.wtout() + (size_t)n * D; }
    __device__ const bf16_t* brow2(const Tile&, int) const { return nullptr; }
    __device__ void store(const Tile&, int row, int n, float a, float) const {
        const float h0 = (F.x[(size_t)row * D + n] - F.stats0()[row * 2]) * F.stats0()[row * 2 + 1] * F.lng[n] + F.lnb[n];
        F.z()[(size_t)row * D + n] = f2bf(a + ALPHA * h0); }
};
struct FnGateUp {
    static constexpr bool DUAL = true; struct Tile { int e, r0, n; }; const Frame& F; const LAS int* ps;
    __device__ int ntm() const { return HBROWS / 128; } __device__ int ntn() const { return DE / 64; } __device__ int K() const { return D; }
    __device__ bool tile(int tm, Tile& T) const { const int row0 = tm * 128;
        if (row0 >= PMAX) { T.e = NE; T.r0 = row0 - PMAX; T.n = NTOK; return true; }
        if (row0 >= ps[64]) return false;
        int e = 0; while (e < NE - 1 && row0 >= ps[e + 1]) ++e;
        T.e = e; T.r0 = row0 - ps[e]; T.n = F.cnt()[e]; return T.r0 < T.n; }
    __device__ const bf16_t* arow(const Tile& T, int row) const { const int r = T.r0 + (row & 127); if (r >= T.n) return nullptr;
        const int tok = T.e < NE ? F.tokl()[(size_t)T.e * NTOK + r] : r; return F.h1() + (size_t)tok * D; }
    __device__ const bf16_t* brow(const Tile& T, int n) const { return F.wtgu() + ((size_t)T.e * 1024 + 256 * (n >> 7) + (n & 127)) * D; }
    __device__ const bf16_t* brow2(const Tile& T, int n) const { return F.wtgu() + ((size_t)T.e * 1024 + 256 * (n >> 7) + 128 + (n & 127)) * D; }
    __device__ void store(const Tile& T, int row, int n, float g, float u) const { const int r = T.r0 + (row & 127); const float w = T.e < NE ? (r < T.n ? F.wl()[(size_t)T.e * NTOK + r] : 0.f) : 1.0f;
        F.hb()[(size_t)row * DE + n] = f2bf(g / (1.0f + __expf(-g)) * (u * w)); }
};
struct FnDown {
    static constexpr bool DUAL = false; struct Tile { int e, r0, n; }; const Frame& F; const LAS int* ps;
    __device__ int ntm() const { return PMAX / 128; } __device__ int ntn() const { return D / 64; } __device__ int K() const { return DE; }
    __device__ bool tile(int tm, Tile& T) const { const int row0 = tm * 128; if (row0 >= ps[64]) return false;
        int e = 0; while (e < NE - 1 && row0 >= ps[e + 1]) ++e;
        T.e = e; T.r0 = row0 - ps[e]; T.n = F.cnt()[e]; return T.r0 < T.n; }
    __device__ const bf16_t* arow(const Tile&, int row) const { return F.hb() + (size_t)row * DE; }
    __device__ const bf16_t* brow(const Tile& T, int n) const { return F.wtd() + ((size_t)T.e * D + n) * DE; }
    __device__ const bf16_t* brow2(const Tile&, int) const { return nullptr; }
    __device__ void store(const Tile& T, int row, int n, float a, float) const { const int r = T.r0 + (row & 127);
        (void)r; F.ym()[(size_t)row * D + n] = f2bf(a); }
};
struct FnFinal {
    static constexpr bool DUAL = false; struct Tile {}; const Frame& F; const LAS int* ps;
    __device__ int ntm() const { return NTOK / 128; } __device__ int ntn() const { return D / 64; } __device__ int K() const { return DE; }
    __device__ bool tile(int, Tile&) const { return true; }
    __device__ const bf16_t* arow(const Tile&, int row) const { return F.hb() + (size_t)(PMAX + row) * DE; }
    __device__ const bf16_t* brow(const Tile&, int n) const { return F.wtd() + ((size_t)NE * D + n) * DE; }
    __device__ const bf16_t* brow2(const Tile&, int) const { return nullptr; }
    __device__ void store(const Tile&, int row, int n, float a, float) const {
        const float h1 = bf2f(F.h1()[(size_t)row * D + n]);
        F.o2()[(size_t)row * D + n] = f2bf(a + ALPHA * h1); }
};

__device__ __forceinline__ void phase_attn_simple(Frame& F) {
    LAS float* qs = (LAS float*)F.lds + F.wave * 512; LAS float* psm = qs + 64;
    const int gw = F.bx * 8 + F.wave, NGW = F.G * 8, lane = F.lane;
    for (int item = gw; item < NTOK * 32; item += NGW) {
        const int tok = item >> 5, hh = item & 31, b = tok >> 13, s = tok & 8191;
        const bool isA = hh < 16; const int h = hh & 15;
        const int qcol = isA ? COL_QA + h * 64 : COL_QB + h * 64, kcol = isA ? COL_KA + (h >> 2) * 64 : COL_KB + h * 64, vcol = isA ? COL_VA + (h >> 2) * 64 : COL_VB + h * 64;
        const int r = s >> 6, c = s & 63, rs = min(max(r - 4, 0), 120), cs = min(max(c - 8, 0), 48);
        const int nkeys = isA ? 16 + 257 : 16 + 128;
        asm volatile("s_waitcnt lgkmcnt(0)" ::: "memory");
        qs[lane] = bf2f(F.u()[(size_t)tok * INW + qcol + lane]);
        asm volatile("s_waitcnt lgkmcnt(0)" ::: "memory");
        float sc[5]; float mx = -INFINITY;
#pragma unroll
        for (int i = 0; i < 5; ++i) {
            const int j = lane + 64 * i; sc[i] = -INFINITY;
            if (j < nkeys) {
                int krow; float bias; bool valid = true;
                if (j < 16) { krow = NTOK + j; bias = isA ? F.t5[t5_bucket(j - 16 - s) * 16 + h] * LOG2E : 0.f; }
                else if (isA) { const int kpos = s - 128 + (j - 16); valid = kpos >= 0 && kpos < SEQ; krow = b * SEQ + kpos; bias = F.tab()[h * 272 + (j - 16)]; }
                else { const int w = j - 16, kr = rs + (w >> 4), kc = cs + (w & 15); krow = b * SEQ + kr * 64 + kc; bias = F.rpb[(h * 15 + (kr - r + 7)) * 31 + (kc - c + 15)] * LOG2E; }
                if (valid) { const bf16_t* kp = F.u() + (size_t)krow * INW + kcol; float dot = 0.f;
#pragma unroll
                    for (int d8 = 0; d8 < 8; ++d8) { const u32x4 kv = *(const u32x4*)(kp + d8 * 8);
#pragma unroll
                        for (int i2 = 0; i2 < 4; ++i2) { dot += qs[d8 * 8 + 2 * i2] * __uint_as_float(kv[i2] << 16); dot += qs[d8 * 8 + 2 * i2 + 1] * __uint_as_float(kv[i2] & 0xffff0000u); } }
                    sc[i] = dot + bias; }
            }
            mx = fmaxf(mx, sc[i]);
        }
        const float sinkl = isA ? F.sink[h] * LOG2E : -INFINITY;
        mx = fmaxf(wmax(mx), sinkl);
        float l = 0.f;
#pragma unroll
        for (int i = 0; i < 5; ++i) { const int j = lane + 64 * i; const float p = sc[i] == -INFINITY ? 0.f : exp2f(sc[i] - mx); l += p; if (j < 320) psm[j] = p; }
        l = wsum(l) + (isA ? exp2f(sinkl - mx) : 0.f);
        asm volatile("s_waitcnt lgkmcnt(0)" ::: "memory");
        float o = 0.f;
        for (int j = 0; j < nkeys; ++j) { const float p = psm[j]; if (p == 0.f) continue;
            int krow; if (j < 16) krow = NTOK + j; else if (isA) krow = b * SEQ + s - 128 + (j - 16); else { const int w = j - 16; krow = b * SEQ + (rs + (w >> 4)) * 64 + cs + (w & 15); }
            o += p * bf2f(F.u()[(size_t)krow * INW + vcol + lane]); }
        o /= l;
        const bf16_t ob = f2bf(o); F.ya()[(size_t)tok * D + hh * 64 + lane] = ob;
        const float of = bf2f(ob), q = wsum(of * of);
        if (lane == 0) F.ssq()[tok * 32 + hh] = q;
    }
}
__device__ __forceinline__ void phase_rmsnorm(Frame& F) {
    const int gw = F.bx * 8 + F.wave, NGW = F.G * 8, lane = F.lane;
    for (int tok = gw; tok < NTOK; tok += NGW) {
        const float q = lane < 32 ? F.ssq()[tok * 32 + lane] : 0.f;
        float qa = lane < 16 ? q : 0.f, qb = (lane >= 16 && lane < 32) ? q : 0.f; qa = wsum(qa); qb = wsum(qb);
        const float ra = 1.0f / sqrtf(qa * (1.0f / 1024.f) + RMS_EPS), rb = 1.0f / sqrtf(qb * (1.0f / 1024.f) + RMS_EPS);
        bf16_t* p = F.ya() + (size_t)tok * D;
#pragma unroll
        for (int j = 0; j < 8; ++j) { const int c = (j * 64 + lane) * 4; const float rr = c < 1024 ? ra : rb; u32x2 w = *(u32x2*)(p + c);
            w.x = pack2(__uint_as_float(w.x << 16) * rr, __uint_as_float(w.x & 0xffff0000u) * rr); w.y = pack2(__uint_as_float(w.y << 16) * rr, __uint_as_float(w.y & 0xffff0000u) * rr); *(u32x2*)(p + c) = w; }
    }
}

__device__ __forceinline__ void phase_ln1_router(Frame& F) {
    LAS float* hs = (LAS float*)F.lds + F.wave * 2048;
    const int gw = F.bx * 8 + F.wave, NGW = F.G * 8, lane = F.lane;
    for (int tok = gw; tok < NTOK; tok += NGW) {
        const bf16_t* src = F.z() + (size_t)tok * D; f32x4 v[8]; float s = 0.f;
#pragma unroll
        for (int j = 0; j < 8; ++j) { const u32x2 w = *(const u32x2*)(src + (j * 64 + lane) * 4); v[j] = (f32x4){__uint_as_float(w.x << 16), __uint_as_float(w.x & 0xffff0000u), __uint_as_float(w.y << 16), __uint_as_float(w.y & 0xffff0000u)}; s += (v[j][0] + v[j][1]) + (v[j][2] + v[j][3]); }
        const float mu = wsum(s) * (1.0f / D); float q = 0.f;
#pragma unroll
        for (int j = 0; j < 8; ++j) { const f32x4 d = v[j] - mu; q += (d[0] * d[0] + d[1] * d[1]) + (d[2] * d[2] + d[3] * d[3]); }
        const float rstd = 1.0f / sqrtf(wsum(q) * (1.0f / D) + LN_EPS);
        asm volatile("s_waitcnt lgkmcnt(0)" ::: "memory");
#pragma unroll
        for (int j = 0; j < 8; ++j) { const int c = (j * 64 + lane) * 4; const f32x4 g = *(const f32x4*)(F.l1g + c), bb = *(const f32x4*)(F.l1b + c); const f32x4 y = (v[j] - mu) * rstd * g + bb;
            *(u32x2*)(F.h1() + (size_t)tok * D + c) = (u32x2){pack2(y[0], y[1]), pack2(y[2], y[3])}; *(LAS f32x4*)(hs + c) = y; }
        if (lane == 0) { F.stats1()[tok * 2] = mu; F.stats1()[tok * 2 + 1] = rstd; }
        asm volatile("s_waitcnt lgkmcnt(0)" ::: "memory");
        float lg = 0.f;
#pragma unroll 8
        for (int n = 0; n < D; ++n) lg += hs[n] * F.w_router[(size_t)n * NE + lane];
        const float score = 1.0f / (1.0f + expf(-lg)), v0 = score + F.rbias[lane];
        int rk = 0;
#pragma unroll
        for (int j = 0; j < 8; ++j) { const int o = (lane & ~7) + j; const float w = __shfl(v0, o); rk += (w > v0 || (w == v0 && o < lane)) ? 1 : 0; }
        float gs = rk < 2 ? v0 : 0.f; gs += __shfl_xor(gs, 1); gs += __shfl_xor(gs, 2); gs += __shfl_xor(gs, 4);
        int grk = 0; const int myg = lane >> 3;
#pragma unroll
        for (int g = 0; g < 8; ++g) { const float w = __shfl(gs, g * 8); grk += (w > gs || (w == gs && g < myg)) ? 1 : 0; }
        const float mv = grk < 4 ? v0 : -INFINITY;
        int erk = 0;
        for (int o = 0; o < 64; ++o) { const float w = __shfl(mv, o); erk += (w > mv || (w == mv && o < lane)) ? 1 : 0; }
        const bool sel = erk < 8;
        const float wsm = wsum(sel ? score : 0.f), wgt = score / (wsm + 1e-20f) * 2.5f;
        if (sel) { const int rr = atomicAdd(F.cnt() + lane, 1); F.tokl()[(size_t)lane * NTOK + rr] = tok; F.wl()[(size_t)lane * NTOK + rr] = wgt; F.tke()[tok * 8 + erk] = lane; F.tkr()[tok * 8 + erk] = rr; }
    }
}
__device__ __forceinline__ void phase_ln2(Frame& F, const LAS int* ps) {
    const int gw = F.bx * 8 + F.wave, NGW = F.G * 8, lane = F.lane;
    for (int tok = gw; tok < NTOK; tok += NGW) {
        float* src = F.out + (size_t)tok * D; const bf16_t* o2p = F.o2() + (size_t)tok * D; f32x4 v[8]; float s = 0.f;
#pragma unroll
        for (int j = 0; j < 8; ++j) { const u32x2 w = *(const u32x2*)(o2p + (j * 64 + lane) * 4); v[j] = (f32x4){__uint_as_float(w.x << 16), __uint_as_float(w.x & 0xffff0000u), __uint_as_float(w.y << 16), __uint_as_float(w.y & 0xffff0000u)}; }
        const int mye = F.tke()[tok * 8 + (lane & 7)], myr = F.tkr()[tok * 8 + (lane & 7)], mypos = ps[mye] + myr;
#pragma unroll
        for (int k = 0; k < 8; ++k) { const int p = __shfl(mypos, k); const bf16_t* yp = F.ym() + (size_t)p * D;
#pragma unroll
            for (int j = 0; j < 8; ++j) { const u32x2 w = *(const u32x2*)(yp + (j * 64 + lane) * 4);
                v[j][0] += __uint_as_float(w.x << 16); v[j][1] += __uint_as_float(w.x & 0xffff0000u); v[j][2] += __uint_as_float(w.y << 16); v[j][3] += __uint_as_float(w.y & 0xffff0000u); } }
#pragma unroll
        for (int j = 0; j < 8; ++j) s += (v[j][0] + v[j][1]) + (v[j][2] + v[j][3]);
        const float mu = wsum(s) * (1.0f / D); float q = 0.f;
#pragma unroll
        for (int j = 0; j < 8; ++j) { const f32x4 d = v[j] - mu; q += (d[0] * d[0] + d[1] * d[1]) + (d[2] * d[2] + d[3] * d[3]); }
        const float rstd = 1.0f / sqrtf(wsum(q) * (1.0f / D) + LN_EPS);
#pragma unroll
        for (int j = 0; j < 8; ++j) { const int c = (j * 64 + lane) * 4; const f32x4 g = *(const f32x4*)(F.l2g + c), bb = *(const f32x4*)(F.l2b + c); *(f32x4*)(src + c) = (v[j] - mu) * rstd * g + bb; }
    }
}

#ifndef FAST_P1
#define FAST_P1 1
#endif
#ifndef STAGGER7
#define STAGGER7 0
#endif
#ifndef CONV_NT
#define CONV_NT 1
#endif
#ifndef STAGGER4
#define STAGGER4 0
#endif
#ifndef XCD_TRUE
#define XCD_TRUE 1
#endif
#ifndef DOWN_REV
#define DOWN_REV false
#endif
#ifndef YM_NT
#define YM_NT 0
#endif
#ifndef FAST_P4
#define FAST_P4 1
#endif
#ifndef FAST_P6
#define FAST_P6 1
#endif
#ifndef FAST_P7
#define FAST_P7 1
#endif
namespace pg8 {
typedef short bf16x8 __attribute__((ext_vector_type(8)));
constexpr int BM = 256, BK = 64, HALF = 128, HTB = HALF * BK * 2, STAGE_BYTES = 8 * HTB, NXCD = 8, WGM = 8;
__host__ __device__ __forceinline__ int lds_byte(int r, int c) { const int st = (r >> 4) * 2 + (c >> 5), rr = r & 15, cc = c & 31, ob = rr * 64 + cc * 2; return st * 1024 + (ob ^ (((ob >> 9) & 1) << 5)); }
__host__ __device__ __forceinline__ void stage_rc(int b, int& R, int& C) { const int st = b / 1024, sb = b % 1024, swz = sb ^ (((sb >> 9) & 1) << 5); R = (st >> 1) * 16 + swz / 64; C = (st & 1) * 32 + (swz % 64) / 2; }
__host__ __device__ __forceinline__ int perm32(int rho) { const int n = rho >> 4, i = rho & 15; return 8 * (i >> 2) + 4 * n + (i & 3); }
__device__ __forceinline__ unsigned cvt_pk_bf16(float lo, float hi) { unsigned r; asm volatile("v_cvt_pk_bf16_f32 %0, %1, %2" : "=v"(r) : "v"(lo), "v"(hi)); return r; }
struct Unit { int pm, pn, e, r0, n, orow, tb; };
__device__ __forceinline__ int xcd_remap(int L, int nwg) { const int q = nwg / NXCD, r = nwg % NXCD, xcd = L % NXCD, off = L / NXCD; return (xcd < r ? xcd * (q + 1) : r * (q + 1) + (xcd - r) * q) + off; }
__device__ __forceinline__ void tile_of(int wgid, int nM, int nN, int& pm, int& pn) { const int nig = WGM * nN, gid = wgid / nig, fm = gid * WGM, gsz = (nM - fm) < WGM ? (nM - fm) : WGM; pm = fm + ((wgid % nig) % gsz); pn = (wgid % nig) / gsz; }

template <class Epi, class Sched>
__device__ __forceinline__ void gemm_phase(LAS unsigned char* lds, const Sched& S, const Epi& E, const int lda, const int ldb, const int nt, const int stagger_ticks = 0) {
    int tid = threadIdx.x; asm volatile("" : "+v"(tid));
    const int wid = __builtin_amdgcn_readfirstlane(tid >> 6), lane = tid & 63, wr = wid >> 2, wc = wid & 3, fr = lane & 15, fq = lane >> 4;
    unsigned voffA[2], voffB[2], c2[2]; int RA[2];
#pragma unroll
    for (int i = 0; i < 2; ++i) { int R, C; stage_rc(tid * 16 + i * 8192, R, C); const int Rb = Epi::PERM ? ((R & ~31) + perm32(R & 31)) : R;
        voffA[i] = (unsigned)(R * lda + C) * 2u; voffB[i] = (unsigned)(Rb * ldb + C) * 2u; RA[i] = R; c2[i] = (unsigned)C * 2u; }
    const size_t kstep = (size_t)(BK * 2), hstepA = (size_t)HALF * lda * 2, hstepB = (size_t)HALF * ldb * 2;
    const unsigned lda2 = (unsigned)lda * 2u;
    const unsigned ldsw = (unsigned)wid * 1024u;
    const int aoff = lds_byte(wr * 64 + fr, fq * 8), boff = lds_byte(wc * 32 + fr, fq * 8);
#define PG8_SA(b, h) (((b) * 2 + (h)) * HTB)
#define PG8_SB(b, h) ((4 + (b) * 2 + (h)) * HTB)
#define PG8_STAGE(bufoff, gbase, voff) do { _Pragma("unroll") for (int _i = 0; _i < 2; ++_i) \
        __builtin_amdgcn_global_load_lds((const unsigned*)((const char*)(gbase) + (voff)[_i]), (LAS unsigned*)(lds + (bufoff) + ldsw + _i * 8192), 16, 0, 0); } while (0)
#define PG8_STG_A(bufoff, p, h, V) do { if constexpr (Sched::GATHER) { PG8_STAGE(bufoff, p, V[h]); } else { PG8_STAGE(bufoff, (p) + (h) * hstepA, voffA); } } while (0)
#define PG8_STG_B(bufoff, p, h) PG8_STAGE(bufoff, (p) + (h) * hstepB, voffB)
#define PG8_LDA(dst, b, h) do { _Pragma("unroll") for (int m = 0; m < 4; ++m) _Pragma("unroll") for (int k = 0; k < 2; ++k) dst[m][k] = *(const LAS bf16x8*)(lds + PG8_SA(b, h) + aoff + m * 2048 + k * 1024); } while (0)
#define PG8_LDB(dst, b, h) do { _Pragma("unroll") for (int n = 0; n < 2; ++n) _Pragma("unroll") for (int k = 0; k < 2; ++k) dst[n][k] = *(const LAS bf16x8*)(lds + PG8_SB(b, h) + boff + n * 2048 + k * 1024); } while (0)
#define PG8_MMA(ai, bj, At, Bt) do { __builtin_amdgcn_s_setprio(1); _Pragma("unroll") for (int m = 0; m < 4; ++m) _Pragma("unroll") for (int n = 0; n < 2; ++n) _Pragma("unroll") for (int k = 0; k < 2; ++k) \
        acc[ai][bj][m][n] = __builtin_amdgcn_mfma_f32_16x16x32_bf16(Bt[n][k], At[m][k], acc[ai][bj][m][n], 0, 0, 0); __builtin_amdgcn_s_setprio(0); } while (0)
#define PG8_WAIT_V(n) asm volatile("s_waitcnt vmcnt(" #n ")" ::: "memory")
#define PG8_WAIT_L(n) asm volatile("s_waitcnt lgkmcnt(" #n ")" ::: "memory")
#define PG8_BAR __builtin_amdgcn_s_barrier()
#define PG8_SCHED __builtin_amdgcn_sched_barrier(0)
    Unit cur, nxt; int ui = 0;
    if (stagger_ticks) {
        const unsigned long long t0 = __builtin_amdgcn_s_memrealtime(), dl = (unsigned long long)((blockIdx.x >> 3) & 15) * (unsigned)stagger_ticks;
        while (__builtin_amdgcn_s_memrealtime() - t0 < dl) __builtin_amdgcn_s_sleep(4);
        __syncthreads(); }
    if (!S.next(0, cur)) return;
    cur.tb = 0;
    f32x4 acc[2][2][4][2];
#pragma unroll
    for (int a = 0; a < 2; ++a)
#pragma unroll
        for (int b = 0; b < 2; ++b)
#pragma unroll
            for (int m = 0; m < 4; ++m)
#pragma unroll
                for (int n = 0; n < 2; ++n) acc[a][b][m][n] = (f32x4){0.f, 0.f, 0.f, 0.f};
    bf16x8 At[4][2], B0[2][2], B1[2][2];
    unsigned vac[2][2], van[2][2]; int raw[2][2];
    const char* cA = S.abase(cur); const char* cB = S.bbase(cur);
#pragma unroll
    for (int h = 0; h < 2; ++h)
#pragma unroll
        for (int i = 0; i < 2; ++i) { vac[h][i] = Sched::GATHER ? (unsigned)S.arow(cur, h * HALF + RA[i]) * lda2 + c2[i] : 0u; van[h][i] = vac[h][i]; raw[h][i] = 0; }
    PG8_STG_B(PG8_SB(0, 0), cB, 0); PG8_STG_B(PG8_SB(0, 1), cB, 1); PG8_STG_A(PG8_SA(0, 0), cA, 0, vac); PG8_STG_A(PG8_SA(0, 1), cA, 1, vac);
    if (wr == 1) PG8_BAR;
    PG8_WAIT_V(2); PG8_BAR;
    PG8_STG_B(PG8_SB(1, 0), cB + kstep, 0); PG8_STG_A(PG8_SA(1, 0), cA + kstep, 0, vac); PG8_STG_B(PG8_SB(1, 1), cB + kstep, 1);
    PG8_WAIT_V(6); PG8_BAR;
    for (;;) {
        const bool has_next = S.next(ui + 1, nxt); nxt.tb = (ui + 1) & 1;
        if constexpr (Epi::MIDK) E.unit_begin(cur, tid);
        const char* nA = has_next ? S.abase(nxt) : cA; const char* nB = has_next ? S.bbase(nxt) : cB;
        if constexpr (Sched::GATHER) { if (has_next) {
#pragma unroll
            for (int h = 0; h < 2; ++h)
#pragma unroll
                for (int i = 0; i < 2; ++i) raw[h][i] = S.arow(nxt, h * HALF + RA[i]); } }
        for (int t = 0; t < nt; t += 2) {
            const bool last = (t == nt - 2);
            const char* a1 = cA + (size_t)(t + 1) * kstep;
            const char* a2 = last ? nA : cA + (size_t)(t + 2) * kstep; const char* b2 = last ? nB : cB + (size_t)(t + 2) * kstep;
            const char* a3 = a2 + kstep; const char* b3 = b2 + kstep;
            unsigned va2[2][2];
#pragma unroll
            for (int h = 0; h < 2; ++h)
#pragma unroll
                for (int i = 0; i < 2; ++i) va2[h][i] = last ? van[h][i] : vac[h][i];
            PG8_LDB(B0, 0, 0); PG8_LDB(B1, 0, 1); PG8_SCHED; PG8_LDA(At, 0, 0); PG8_STG_A(PG8_SA(1, 1), a1, 1, vac);
            PG8_WAIT_V(8); PG8_WAIT_L(0); PG8_BAR; PG8_MMA(0, 0, At, B0); PG8_MMA(0, 1, At, B1); PG8_BAR; PG8_SCHED;
            PG8_LDA(At, 0, 1); PG8_STG_B(PG8_SB(0, 0), b2, 0); PG8_STG_B(PG8_SB(0, 1), b2, 1); PG8_STG_A(PG8_SA(0, 0), a2, 0, va2);
            PG8_WAIT_V(8); PG8_WAIT_L(0); PG8_BAR; PG8_MMA(1, 0, At, B0); PG8_MMA(1, 1, At, B1); PG8_BAR; PG8_SCHED;
            PG8_LDB(B0, 1, 0); PG8_LDB(B1, 1, 1); PG8_SCHED; PG8_LDA(At, 1, 0); PG8_STG_A(PG8_SA(0, 1), a2, 1, va2);
            PG8_WAIT_V(8); PG8_WAIT_L(0); PG8_BAR; PG8_MMA(0, 0, At, B0); PG8_MMA(0, 1, At, B1); PG8_BAR; PG8_SCHED;
            PG8_LDA(At, 1, 1); PG8_STG_B(PG8_SB(1, 0), b3, 0); PG8_STG_B(PG8_SB(1, 1), b3, 1); PG8_STG_A(PG8_SA(1, 0), a3, 0, va2);
            PG8_WAIT_V(8); PG8_WAIT_L(0); PG8_BAR; PG8_MMA(1, 0, At, B0); PG8_MMA(1, 1, At, B1); PG8_BAR; PG8_SCHED;
            if constexpr (Epi::MIDK) { if (2 * (t + 2) == nt) E.mid(acc, cur, wr, fr); }
            if constexpr (Sched::GATHER) { if (t + 4 == nt && has_next) {
#pragma unroll
                for (int h = 0; h < 2; ++h)
#pragma unroll
                    for (int i = 0; i < 2; ++i) { asm volatile("" : "+v"(raw[h][i])); van[h][i] = (unsigned)raw[h][i] * lda2 + c2[i]; } } }
        }
        if (wr == 0) PG8_BAR;
        E(acc, cur, wr, wc, fr, fq);
        if (!has_next) break;
#pragma unroll
        for (int a = 0; a < 2; ++a)
#pragma unroll
            for (int b = 0; b < 2; ++b)
#pragma unroll
                for (int m = 0; m < 4; ++m)
#pragma unroll
                    for (int n = 0; n < 2; ++n) acc[a][b][m][n] = (f32x4){0.f, 0.f, 0.f, 0.f};
        cur = nxt; cA = nA; cB = nB; ++ui;
#pragma unroll
        for (int h = 0; h < 2; ++h)
#pragma unroll
            for (int i = 0; i < 2; ++i) vac[h][i] = van[h][i];
        if (wr == 1) PG8_BAR;
    }
    PG8_WAIT_V(0);
    PG8_BAR;
#undef PG8_SA
#undef PG8_SB
#undef PG8_STAGE
#undef PG8_STG_A
#undef PG8_STG_B
#undef PG8_LDA
#undef PG8_LDB
#undef PG8_MMA
#undef PG8_WAIT_V
#undef PG8_WAIT_L
#undef PG8_BAR
#undef PG8_SCHED
}
}

struct SchedInProj {
    static constexpr bool GATHER = false; const char* A; const char* B; int G, c, i0, i1;
    __device__ __forceinline__ bool next(int i, pg8::Unit& u) const { const int ii = i0 + i; if (ii >= i1) return false; const int L = ii * G + c; if (L >= 1162) return false;
        if (L < 1152) pg8::tile_of(pg8::xcd_remap(L, 1152), 64, 18, u.pm, u.pn); else { const int k = L - 1152; u.pm = 64; u.pn = k < 2 ? 4 + k : 8 + k; }
        return true; }
    __device__ __forceinline__ const char* abase(const pg8::Unit& u) const { return A + (size_t)u.pm * 256 * D * 2; }
    __device__ __forceinline__ const char* bbase(const pg8::Unit& u) const { return B + (size_t)u.pn * 256 * D * 2; }
    __device__ __forceinline__ int arow(const pg8::Unit&, int) const { return 0; }
};
struct SchedOutProj {
    static constexpr bool GATHER = false; const char* A; const char* B; int G, c;
    __device__ __forceinline__ bool next(int i, pg8::Unit& u) const { const int L = i * G + c; if (L >= 512) return false; pg8::tile_of(pg8::xcd_remap(L, 512), 64, 8, u.pm, u.pn); return true; }
    __device__ __forceinline__ const char* abase(const pg8::Unit& u) const { return A + (size_t)u.pm * 256 * D * 2; }
    __device__ __forceinline__ const char* bbase(const pg8::Unit& u) const { return B + (size_t)u.pn * 256 * D * 2; }
    __device__ __forceinline__ int arow(const pg8::Unit&, int) const { return 0; }
};
__device__ __forceinline__ void moe_tables(const Frame& F, LAS int* ps) {
    if (F.tid < NE) ps[256 + F.tid] = F.cnt()[F.tid];
    __syncthreads();
    if (F.tid == 0) { int acc = 0, ta = 0; for (int e = 0; e < NE; ++e) { const int mt = (ps[256 + e] + 255) >> 8; ps[e] = acc; ps[128 + e] = ta; acc += mt * 256; ta += mt; }
        ps[64] = acc; ps[128 + 64] = ta; ps[128 + 65] = ta + NTOK / 256; ps[256 + 64] = NTOK; }
    __syncthreads();
    for (int t = F.tid; t < 640; t += 512) { int e = 0; while (e < NE && t >= ps[128 + e + 1]) ++e; ps[384 + t] = e; }
    __syncthreads();
}
template <int NN, bool REV> __device__ __forceinline__ bool moe_unit(const LAS int* ps, int L, pg8::Unit& u, int noshared = 0) {
    const int nU = (noshared ? ps[128 + 64] : ps[128 + 65]) * NN; if (L >= nU) return false;
    const int wg0 = pg8::xcd_remap(L, nU), wg = REV ? nU - 1 - wg0 : wg0, tile = wg / NN; u.pn = wg % NN;
    const int e = ps[384 + tile]; u.e = e; u.pm = tile - ps[128 + e]; u.r0 = u.pm * 256; u.n = ps[256 + e];
    u.orow = (e < NE ? ps[e] : PMAX) + u.r0;
    return true; }
struct SchedGU {
    static constexpr bool GATHER = true; const char* A; const char* B; const int* tokl; const int* cnt; const LAS int* ps; int G, c;
    __device__ __forceinline__ bool next(int i, pg8::Unit& u) const { return moe_unit<4, false>(ps, i * G + c, u); }
    __device__ __forceinline__ const char* abase(const pg8::Unit&) const { return A; }
    __device__ __forceinline__ const char* bbase(const pg8::Unit& u) const { return B + ((size_t)u.e * 1024 + u.pn * 256) * D * 2; }
    __device__ __forceinline__ int arow(const pg8::Unit& u, int r) const { const int rr = min(u.r0 + r, u.n - 1); return u.e < NE ? tokl[(size_t)u.e * NTOK + rr] : rr; }
};
struct SchedDown {
    static constexpr bool GATHER = false; const char* A; const char* B; const int* cnt; const LAS int* ps; int G, c; int hot;
    __device__ __forceinline__ bool next(int i, pg8::Unit& u) const { return moe_unit<8, DOWN_REV>(ps, i * G + c, u, 1); }
    __device__ __forceinline__ const char* abase(const pg8::Unit& u) const { return A + (size_t)(((hot & 1) && u.e < NE) ? (u.orow & 0x3ff) : u.orow) * DE * 2; }
    __device__ __forceinline__ const char* bbase(const pg8::Unit& u) const { return B + ((size_t)(((hot & 1) && u.e < NE) ? 0 : u.e) * D + u.pn * 256) * DE * 2; }
    __device__ __forceinline__ int arow(const pg8::Unit&, int) const { return 0; }
};
struct SchedDownShared {
    static constexpr bool GATHER = false; const char* A; const char* B; int G, c;
    __device__ __forceinline__ bool next(int i, pg8::Unit& u) const { const int L = i * G + c; if (L >= 512) return false; pg8::tile_of(pg8::xcd_remap(L, 512), 64, 8, u.pm, u.pn);
        u.e = NE; u.r0 = u.pm * 256; u.n = NTOK; u.orow = PMAX + u.r0; return true; }
    __device__ __forceinline__ const char* abase(const pg8::Unit& u) const { return A + (size_t)u.orow * DE * 2; }
    __device__ __forceinline__ const char* bbase(const pg8::Unit& u) const { return B + ((size_t)NE * D + u.pn * 256) * DE * 2; }
    __device__ __forceinline__ int arow(const pg8::Unit&, int) const { return 0; }
};
struct EpiU {
    static constexpr bool MIDK = false; static constexpr bool PERM = true; bf16_t* U; int nostore;
    __device__ __forceinline__ void operator()(const f32x4 (&acc)[2][2][4][2], const pg8::Unit& u, int wr, int wc, int fr, int fq) const {
        const int row0 = u.pm * 256 + wr * 64 + fr, col0 = u.pn * 256 + wc * 32 + 8 * fq;
        if (nostore) {
#pragma unroll
            for (int ai = 0; ai < 2; ++ai)
#pragma unroll
                for (int bj = 0; bj < 2; ++bj)
#pragma unroll
                    for (int m = 0; m < 4; ++m)
#pragma unroll
                        for (int n = 0; n < 2; ++n) asm volatile("" :: "v"(acc[ai][bj][m][n]));
            return; }
#pragma unroll
        for (int ai = 0; ai < 2; ++ai)
#pragma unroll
            for (int m = 0; m < 4; ++m) { bf16_t* rowp = U + (size_t)(row0 + ai * 128 + m * 16) * INW + col0;
#pragma unroll
                for (int bj = 0; bj < 2; ++bj) { const f32x4 v0 = acc[ai][bj][m][0], v1 = acc[ai][bj][m][1]; u32x4 w;
                    w.x = pg8::cvt_pk_bf16(v0[0], v0[1]); w.y = pg8::cvt_pk_bf16(v0[2], v0[3]); w.z = pg8::cvt_pk_bf16(v1[0], v1[1]); w.w = pg8::cvt_pk_bf16(v1[2], v1[3]);
                    *(u32x4*)(rowp + bj * 128) = w; } }
    }
};
struct EpiZ {
    static constexpr bool MIDK = true; static constexpr bool PERM = true; bf16_t* Z; const bf16_t* H0; const float* ssq; LAS float* tab;
    __device__ __forceinline__ void unit_begin(const pg8::Unit& u, int tid) const {
        const int row = tid >> 1, grp = tid & 1; const float* p = ssq + (size_t)(u.pm * 256 + row) * 32 + 16 * grp;
        const f32x4 a = *(const f32x4*)p, b4 = *(const f32x4*)(p + 4), c = *(const f32x4*)(p + 8), d = *(const f32x4*)(p + 12);
        const float s = (((a[0] + a[1]) + (a[2] + a[3])) + ((b4[0] + b4[1]) + (b4[2] + b4[3]))) + (((c[0] + c[1]) + (c[2] + c[3])) + ((d[0] + d[1]) + (d[2] + d[3])));
        tab[(u.tb * 256 + row) * 2 + grp] = 1.0f / sqrtf(s * (1.0f / 1024.f) + RMS_EPS);
    }
    __device__ __forceinline__ void mid(f32x4 (&acc)[2][2][4][2], const pg8::Unit& u, int wr, int fr) const {
#pragma unroll
        for (int ai = 0; ai < 2; ++ai)
#pragma unroll
            for (int m = 0; m < 4; ++m) { const int r = ai * 128 + wr * 64 + m * 16 + fr; const float f = tab[(u.tb * 256 + r) * 2] / tab[(u.tb * 256 + r) * 2 + 1];
#pragma unroll
                for (int bj = 0; bj < 2; ++bj)
#pragma unroll
                    for (int n = 0; n < 2; ++n) acc[ai][bj][m][n] *= f; }
    }
    __device__ __forceinline__ void operator()(const f32x4 (&acc)[2][2][4][2], const pg8::Unit& u, int wr, int wc, int fr, int fq) const {
        const int row0 = u.pm * 256 + wr * 64 + fr, col0 = u.pn * 256 + wc * 32 + 8 * fq;
#pragma unroll
        for (int am = 0; am < 4; ++am) {
            u32x4 hv[2][2]; float rb[2];
#pragma unroll
            for (int q = 0; q < 2; ++q) { const int ai = am >> 1, m = (am & 1) * 2 + q; const size_t off = (size_t)(row0 + ai * 128 + m * 16) * D + col0;
                rb[q] = tab[(u.tb * 256 + ai * 128 + wr * 64 + m * 16 + fr) * 2 + 1];
#pragma unroll
                for (int bj = 0; bj < 2; ++bj) hv[q][bj] = *(const u32x4*)(H0 + off + bj * 128); }
#pragma unroll
            for (int q = 0; q < 2; ++q) { const int ai = am >> 1, m = (am & 1) * 2 + q; const size_t off = (size_t)(row0 + ai * 128 + m * 16) * D + col0;
#pragma unroll
                for (int bj = 0; bj < 2; ++bj) { const u32x4 h4 = hv[q][bj];
                    const f32x4 h0v = (f32x4){__uint_as_float(h4.x << 16), __uint_as_float(h4.x & 0xffff0000u), __uint_as_float(h4.y << 16), __uint_as_float(h4.y & 0xffff0000u)};
                    const f32x4 h1v = (f32x4){__uint_as_float(h4.z << 16), __uint_as_float(h4.z & 0xffff0000u), __uint_as_float(h4.w << 16), __uint_as_float(h4.w & 0xffff0000u)};
                    const f32x4 v0 = acc[ai][bj][m][0] * rb[q] + h0v * ALPHA, v1 = acc[ai][bj][m][1] * rb[q] + h1v * ALPHA; u32x4 w;
                    w.x = pg8::cvt_pk_bf16(v0[0], v0[1]); w.y = pg8::cvt_pk_bf16(v0[2], v0[3]); w.z = pg8::cvt_pk_bf16(v1[0], v1[1]); w.w = pg8::cvt_pk_bf16(v1[2], v1[3]);
                    *(u32x4*)(Z + off + bj * 128) = w; } }
            asm volatile("" ::: "memory"); }
    }
};
__device__ __forceinline__ float silu_mul(float g, float u) { return g * __builtin_amdgcn_rcpf(1.0f + __builtin_amdgcn_exp2f(-g * LOG2E)) * u; }
struct EpiGU {
    static constexpr bool MIDK = false; static constexpr bool PERM = true; bf16_t* H; const float* wl;
    __device__ __forceinline__ void operator()(const f32x4 (&acc)[2][2][4][2], const pg8::Unit& u, int wr, int wc, int fr, int fq) const {
        const int rl0 = wr * 64 + fr, col0 = u.pn * 128 + wc * 32 + 8 * fq;
        float wv[2][4];
#pragma unroll
        for (int ai = 0; ai < 2; ++ai)
#pragma unroll
            for (int m = 0; m < 4; ++m) { const int r = u.r0 + rl0 + ai * 128 + m * 16; wv[ai][m] = u.e < NE ? (r < u.n ? wl[(size_t)u.e * NTOK + r] : 0.f) : 1.0f; }
#pragma unroll
        for (int ai = 0; ai < 2; ++ai)
#pragma unroll
            for (int m = 0; m < 4; ++m) { const f32x4 g0 = acc[ai][0][m][0], g1 = acc[ai][0][m][1], u0 = acc[ai][1][m][0] * wv[ai][m], u1 = acc[ai][1][m][1] * wv[ai][m]; u32x4 w;
                w.x = pg8::cvt_pk_bf16(silu_mul(g0[0], u0[0]), silu_mul(g0[1], u0[1])); w.y = pg8::cvt_pk_bf16(silu_mul(g0[2], u0[2]), silu_mul(g0[3], u0[3]));
                w.z = pg8::cvt_pk_bf16(silu_mul(g1[0], u1[0]), silu_mul(g1[1], u1[1])); w.w = pg8::cvt_pk_bf16(silu_mul(g1[2], u1[2]), silu_mul(g1[3], u1[3]));
                *(u32x4*)(H + (size_t)(u.orow + rl0 + ai * 128 + m * 16) * DE + col0) = w; }
    }
};
struct EpiDownR {
    static constexpr bool MIDK = false; static constexpr bool PERM = true; bf16_t* Y; int nostore;
    __device__ __forceinline__ void operator()(const f32x4 (&acc)[2][2][4][2], const pg8::Unit& u, int wr, int wc, int fr, int fq) const {
        const int rl0 = wr * 64 + fr, col0 = u.pn * 256 + wc * 32 + 8 * fq;
        if (nostore) {
#pragma unroll
            for (int ai = 0; ai < 2; ++ai)
#pragma unroll
                for (int bj = 0; bj < 2; ++bj)
#pragma unroll
                    for (int m = 0; m < 4; ++m)
#pragma unroll
                        for (int n = 0; n < 2; ++n) asm volatile("" :: "v"(acc[ai][bj][m][n]));
            return; }
#pragma unroll
        for (int ai = 0; ai < 2; ++ai)
#pragma unroll
            for (int m = 0; m < 4; ++m) { const int rl = rl0 + ai * 128 + m * 16; if (u.r0 + rl >= u.n) continue;
                bf16_t* rowp = Y + (size_t)(u.orow + rl) * D + col0;
#pragma unroll
                for (int bj = 0; bj < 2; ++bj) { const f32x4 v0 = acc[ai][bj][m][0], v1 = acc[ai][bj][m][1]; u32x4 q;
                    q.x = pg8::cvt_pk_bf16(v0[0], v0[1]); q.y = pg8::cvt_pk_bf16(v0[2], v0[3]); q.z = pg8::cvt_pk_bf16(v1[0], v1[1]); q.w = pg8::cvt_pk_bf16(v1[2], v1[3]);
                    *(u32x4*)(rowp + bj * 128) = q; } }
    }
};
struct EpiDownS {
    static constexpr bool MIDK = false; static constexpr bool PERM = true; bf16_t* O; const bf16_t* H1;
    __device__ __forceinline__ void operator()(const f32x4 (&acc)[2][2][4][2], const pg8::Unit& u, int wr, int wc, int fr, int fq) const {
        const int rl0 = wr * 64 + fr, col0 = u.pn * 256 + wc * 32 + 8 * fq;
#pragma unroll
        for (int am = 0; am < 4; ++am) {
            u32x4 hv[2][2];
#pragma unroll
            for (int q = 0; q < 2; ++q) { const int ai = am >> 1, m = (am & 1) * 2 + q; const size_t off = (size_t)(u.r0 + rl0 + ai * 128 + m * 16) * D + col0;
#pragma unroll
                for (int bj = 0; bj < 2; ++bj) hv[q][bj] = *(const u32x4*)(H1 + off + bj * 128); }
#pragma unroll
            for (int q = 0; q < 2; ++q) { const int ai = am >> 1, m = (am & 1) * 2 + q; const size_t off = (size_t)(u.r0 + rl0 + ai * 128 + m * 16) * D + col0;
#pragma unroll
                for (int bj = 0; bj < 2; ++bj) { const u32x4 h4 = hv[q][bj];
                    const f32x4 h0v = (f32x4){__uint_as_float(h4.x << 16), __uint_as_float(h4.x & 0xffff0000u), __uint_as_float(h4.y << 16), __uint_as_float(h4.y & 0xffff0000u)};
                    const f32x4 h1v = (f32x4){__uint_as_float(h4.z << 16), __uint_as_float(h4.z & 0xffff0000u), __uint_as_float(h4.w << 16), __uint_as_float(h4.w & 0xffff0000u)};
                    const f32x4 v0 = acc[ai][bj][m][0] + h0v * ALPHA, v1 = acc[ai][bj][m][1] + h1v * ALPHA; u32x4 w;
                    w.x = pg8::cvt_pk_bf16(v0[0], v0[1]); w.y = pg8::cvt_pk_bf16(v0[2], v0[3]); w.z = pg8::cvt_pk_bf16(v1[0], v1[1]); w.w = pg8::cvt_pk_bf16(v1[2], v1[3]);
                    *(u32x4*)(O + off + bj * 128) = w; } }
            asm volatile("" ::: "memory"); }
    }
};

#ifndef FAST_P2
#define FAST_P2 1
#endif
namespace att {
typedef short bf16x8 __attribute__((ext_vector_type(8)));
typedef short s16x4 __attribute__((ext_vector_type(4)));
typedef float f32x16 __attribute__((ext_vector_type(16)));
typedef LAS const char* lds_cptr;
constexpr int SLOT = 16384, NSLOT = 6, RING = NSLOT * SLOT;
constexpr int TA_W = 452, TA_OFF = 224;
constexpr int TB_W = 468;
constexpr int OFF_TABA = RING, OFF_TABB = OFF_TABA, OFF_WS = OFF_TABA + 4 * TA_W * 4, OFF_OST = OFF_WS + 8 * 256, ATT_LDS = OFF_OST + 8 * 4096;
static_assert(ATT_LDS <= LDS_BYTES - 16 - 1024, "attention LDS map");
constexpr float NEGB = -1e30f, THR = 8.0f;
#define ATT_MFMA(a, b, c) __builtin_amdgcn_mfma_f32_32x32x16_bf16(a, b, c, 0, 0, 0)
__device__ __forceinline__ int crow(int r, int hi) { return (r & 3) + 8 * (r >> 2) + 4 * hi; }
__device__ __forceinline__ s16x4 vtr(lds_cptr p) { typedef short v4i16_t __attribute__((ext_vector_type(4))); return __builtin_bit_cast(s16x4, __builtin_amdgcn_ds_read_tr16_b64_v4i16((LAS v4i16_t*)p)); }
__device__ __forceinline__ float swapmax(float m) { auto rr = __builtin_amdgcn_permlane32_swap(__float_as_uint(m), __float_as_uint(m), false, false); return fmaxf(__uint_as_float(rr[0]), __uint_as_float(rr[1])); }
__device__ __forceinline__ float swapsum(float m) { auto rr = __builtin_amdgcn_permlane32_swap(__float_as_uint(m), __float_as_uint(m), false, false); return __uint_as_float(rr[0]) + __uint_as_float(rr[1]); }

__device__ __forceinline__ float bf16r(float x) { return __uint_as_float(pg8::cvt_pk_bf16(x, 0.f) << 16); }
__device__ __forceinline__ bf16x8 frag_k0(unsigned bits16, int hi) { const u32x4 w = (u32x4){hi == 0 ? bits16 : 0u, 0u, 0u, 0u}; return __builtin_bit_cast(bf16x8, w); }
template <int NH, int NS, class BiasFn>
__device__ __forceinline__ void tile_qb(const bf16x8 (&kf)[8], const bf16x8 (&qr)[4], bf16x8& mq, const bf16x8& ones, lds_cptr vp, f32x16 (&o)[2], float& m, float& l, LAS float* wsf, int r32, int hi, const BiasFn& bias) {
    f32x16 c[NH];
#pragma unroll
    for (int hf = 0; hf < NH; ++hf)
#pragma unroll
        for (int r = 0; r < 16; ++r) c[hf][r] = bias(hf, r);
    s16x4 vlo[NS][2], vhi[NS][2];
#pragma unroll
    for (int dh = 0; dh < 2; ++dh) { vlo[0][dh] = vtr(vp + dh * 4096); vhi[0][dh] = vtr(vp + dh * 4096 + 512); }
    __builtin_amdgcn_sched_barrier(0);
#pragma unroll
    for (int hf = 0; hf < NH; ++hf) { c[hf] = ATT_MFMA(ones, mq, c[hf]);
#pragma unroll
        for (int d0 = 0; d0 < 4; ++d0) c[hf] = ATT_MFMA(kf[2 * d0 + hf], qr[d0], c[hf]); }
    float mx = NEGB;
#pragma unroll
    for (int hf = 0; hf < NH; ++hf)
#pragma unroll
        for (int r = 0; r < 16; ++r) mx = fmaxf(mx, c[hf][r]);
    mx = swapmax(mx);
    if (__any(mx > THR)) {
        const float mn = bf16r(m + fmaxf(mx, 0.f)), dl = mn - m, f = __builtin_amdgcn_exp2f(-dl); m = mn; l *= f;
        mq = frag_k0(__float_as_uint(-mn) >> 16, hi);
        if (hi == 0) wsf[r32] = f;
        asm volatile("s_waitcnt lgkmcnt(0)" ::: "memory");
#pragma unroll
        for (int r = 0; r < 16; ++r) { const float fr = wsf[crow(r, hi)]; o[0][r] *= fr; o[1][r] *= fr; }
#pragma unroll
        for (int hf = 0; hf < NH; ++hf)
#pragma unroll
            for (int r = 0; r < 16; ++r) c[hf][r] -= dl;
    }
#pragma unroll
    for (int s = 1; s < NS; ++s)
#pragma unroll
        for (int dh = 0; dh < 2; ++dh) { vlo[s][dh] = vtr(vp + dh * 4096 + s * 1024); vhi[s][dh] = vtr(vp + dh * 4096 + s * 1024 + 512); }
    __builtin_amdgcn_sched_barrier(0);
    float ls = 0.f;
#pragma unroll
    for (int hf = 0; hf < NH; ++hf)
#pragma unroll
        for (int r = 0; r < 16; ++r) { c[hf][r] = __builtin_amdgcn_exp2f(c[hf][r]); ls += c[hf][r]; }
    l += ls;
#pragma unroll
    for (int s = 0; s < NS; ++s) {
        const f32x16& cc = c[s >> 1]; const int rb = (s & 1) * 8;
        u32x4 pw; pw.x = pg8::cvt_pk_bf16(cc[rb + 0], cc[rb + 1]); pw.y = pg8::cvt_pk_bf16(cc[rb + 2], cc[rb + 3]); pw.z = pg8::cvt_pk_bf16(cc[rb + 4], cc[rb + 5]); pw.w = pg8::cvt_pk_bf16(cc[rb + 6], cc[rb + 7]);
        const bf16x8 pa = __builtin_bit_cast(bf16x8, pw);
#pragma unroll
        for (int dh = 0; dh < 2; ++dh) { const s16x4 lo = vlo[s][dh], hi4 = vhi[s][dh];
            const bf16x8 vf = (bf16x8){lo[0], lo[1], lo[2], lo[3], hi4[0], hi4[1], hi4[2], hi4[3]};
            o[dh] = ATT_MFMA(pa, vf, o[dh]); }
    }
}
template <class TokFn>
__device__ __forceinline__ void finish_qb(const Frame& F, f32x16 (&o)[2], float l, LAS float* wsf, LAS bf16_t* stg, int lane, int r32, int hi, int ocol, int hidx, const TokFn& tokq) {
    l = swapsum(l);
    asm volatile("s_waitcnt lgkmcnt(0)" ::: "memory");
    if (hi == 0) wsf[32 + r32] = l;
    asm volatile("s_waitcnt lgkmcnt(0)" ::: "memory");
#pragma unroll
    for (int r = 0; r < 16; ++r) { const int orow = crow(r, hi); const float rl = __builtin_amdgcn_rcpf(wsf[32 + orow]);
        stg[orow * 64 + r32] = f2bf(o[0][r] * rl); stg[orow * 64 + 32 + r32] = f2bf(o[1][r] * rl); }
    asm volatile("s_waitcnt lgkmcnt(0)" ::: "memory");
#pragma unroll
    for (int i = 0; i < 4; ++i) { const int row = i * 8 + (lane >> 3), ch = lane & 7; const u32x4 w = *(const LAS u32x4*)(stg + row * 64 + ch * 8); const int tok = tokq(row);
        *(u32x4*)(F.ya() + (size_t)tok * D + ocol + ch * 8) = w;
        float q = 0.f;
#pragma unroll
        for (int j = 0; j < 4; ++j) { const float a = __uint_as_float(w[j] << 16), b = __uint_as_float(w[j] & 0xffff0000u); q += a * a + b * b; }
        q += __shfl_xor(q, 1); q += __shfl_xor(q, 2); q += __shfl_xor(q, 4);
        if (ch == 0) F.ssq()[tok * 32 + hidx] = q; }
    asm volatile("s_waitcnt lgkmcnt(0)" ::: "memory");
}

template <int MODE>
__device__ __forceinline__ void attn_unit(const Frame& F, int L) {
    LAS unsigned char* lds = F.lds;
    const int lane = F.lane, wid = F.wave, r32 = lane & 31, hi = lane >> 5;
    LAS float* wsf = (LAS float*)(lds + OFF_WS + wid * 256); LAS bf16_t* stg = (LAS bf16_t*)(lds + OFF_OST + wid * 4096);
    int b, kcol, vcol, qcol, ocol, hidx, nband, trow0, qtok0;
    int hb = 0, qbw = 0, kt0 = 0;
    int R0 = 0, pr = 0, jc = 0, cb = 0, kr0 = 0;
    if (MODE == 0) { const int kvh = L & 3; hb = (L >> 2) & 127; b = L >> 9; const int hq = 4 * kvh + (wid >> 1); qbw = wid & 1;
        qcol = COL_QA + hq * 64; kcol = COL_KA + kvh * 64; vcol = COL_VA + kvh * 64; ocol = hq * 64; hidx = hq;
        kt0 = max(0, hb - 2); const int kt1 = min(127, hb + 2); nband = kt1 - kt0 + 1; trow0 = b * SEQ + 64 * kt0; qtok0 = b * SEQ + 64 * hb + 32 * qbw;
    } else { const int h = L & 15, rb = (L >> 4) & 31; b = L >> 9; R0 = rb * 4; pr = wid >> 2; jc = wid & 3; cb = min(max(16 * jc - 8, 0), 32);
        qcol = COL_QB + h * 64; kcol = COL_KB + h * 64; vcol = COL_VB + h * 64; ocol = 1024 + h * 64; hidx = 16 + h;
        kr0 = min(max(R0 - 4, 0), 120); const int kr1 = min(max(R0 + 3 - 4, 0), 120) + 7; nband = kr1 - kr0 + 1; trow0 = b * SEQ + kr0 * 64; qtok0 = b * SEQ + (R0 + 2 * pr) * 64 + 16 * jc; }
    const int NT = 1 + nband;
    const bf16_t* ksrc = F.u() + (size_t)lane * INW + kcol + wid * 8;
    const bf16_t* vsrc = F.u() + (size_t)(16 * (wid & 3) + (lane >> 2)) * INW + vcol + (wid >> 2) * 32 + (lane & 3) * 8;
#define ATT_TROW(t) ((t) == 0 ? NTOK : trow0 + ((t) - 1) * 64)
#define ATT_ISSUE(t) do { const size_t ro_ = (size_t)ATT_TROW(t) * INW; const int sl_ = ((t) % NSLOT) * SLOT; \
        __builtin_amdgcn_global_load_lds((const unsigned*)(ksrc + ro_), (LAS unsigned*)(lds + sl_ + wid * 1024), 16, 0, 0); \
        __builtin_amdgcn_global_load_lds((const unsigned*)(vsrc + ro_), (LAS unsigned*)(lds + sl_ + 8192 + wid * 1024), 16, 0, 0); } while (0)
    bf16x8 qr[4];
    { const int tok = MODE == 0 ? qtok0 + r32 : qtok0 + (r32 >> 4) * 64 + (r32 & 15);
#pragma unroll
      for (int d0 = 0; d0 < 4; ++d0) qr[d0] = *(const bf16x8*)(F.u() + (size_t)tok * INW + qcol + d0 * 16 + hi * 8); }
    if (MODE == 0) { LAS float* tA = (LAS float*)(lds + OFF_TABA); const int h0 = 4 * (L & 3);
        for (int i = F.tid; i < 4 * TA_W; i += 512) { const int g = i / TA_W, rel = i % TA_W - TA_OFF; tA[i] = (rel >= -128 && rel <= 128) ? F.tab()[(h0 + g) * 272 + rel + 128] : NEGB; } }
    else { LAS float* tB = (LAS float*)(lds + OFF_TABB); const int h = L & 15;
        for (int i = F.tid; i < 576; i += 512) { const int k = i - 16; tB[i] = (k >= 0 && k < 465) ? F.rpb[h * 465 + k] * LOG2E : ((k >= 465 && k < 496) ? NEGB : 0.f); } }
#pragma unroll
    for (int t = 0; t < 5; ++t) if (t < NT) ATT_ISSUE(t);
    f32x16 o[2]; o[0] = f32x16{}; o[1] = f32x16{}; float m = 0.f, l = 0.f;
    bf16x8 mq = frag_k0(0u, hi); const bf16x8 ones = frag_k0(0x3F80u, hi);
    const LAS float* tabA = (const LAS float*)(lds + OFF_TABA) + (MODE == 0 ? (wid >> 1) : 0) * TA_W;
    const LAS float* tabB = (const LAS float*)(lds + OFF_TABB);
    const int qpos = 64 * hb + 32 * qbw + r32;
    const int qrow = R0 + 2 * pr + (r32 >> 4), qc = 16 * jc + (r32 & 15), rs = min(max(qrow - 4, 0), 120), cs = min(max(qc - 8, 0), 48);
    const int rsw0 = min(max(R0 + 2 * pr - 4, 0), 120), rsw1 = min(max(R0 + 2 * pr + 1 - 4, 0), 120);
    float cm[16];
#pragma unroll
    for (int r = 0; r < 16; ++r) { const int kc = cb + 4 * hi + (r & 3) + 8 * (r >> 2); cm[r] = (MODE == 1 && !(kc >= cs && kc < cs + 16)) ? NEGB : 0.f; }
    const int dc0 = cb + 4 * hi - qc + 15 + 16;
    for (int t = 0; t < NT; ++t) {
        { const int ahead = NT - 1 - t;
          if (ahead >= 4) asm volatile("s_waitcnt vmcnt(8)" ::: "memory"); else if (ahead == 3) asm volatile("s_waitcnt vmcnt(6)" ::: "memory");
          else if (ahead == 2) asm volatile("s_waitcnt vmcnt(4)" ::: "memory"); else if (ahead == 1) asm volatile("s_waitcnt vmcnt(2)" ::: "memory"); else asm volatile("s_waitcnt vmcnt(0)" ::: "memory"); }
        asm volatile("s_waitcnt lgkmcnt(0)" ::: "memory");
        __builtin_amdgcn_s_barrier();
        if (t + 5 < NT) ATT_ISSUE(t + 5);
        const int slot = (t % NSLOT) * SLOT;
        if (MODE == 1 && t > 0) { const int kr = kr0 + t - 1; if (kr < rsw0 || kr > rsw1 + 7) continue; }
        const int cbt = (MODE == 1 && t > 0) ? cb : 0;
        const lds_cptr kp = (lds_cptr)lds + slot + hi * 1024 + (r32 + cbt) * 16;
        const lds_cptr vp = (lds_cptr)lds + slot + 8192 + ((lane >> 4) & 1) * 32 + (lane & 3) * 8 + (4 * hi + ((lane & 15) >> 2) + cbt) * 64;
        bf16x8 kf[8];
        if (MODE == 0 && t > 0) {
#pragma unroll
            for (int d0 = 0; d0 < 4; ++d0) { kf[2 * d0] = *(const LAS bf16x8*)(kp + d0 * 2048); kf[2 * d0 + 1] = *(const LAS bf16x8*)(kp + d0 * 2048 + 512); }
        } else {
#pragma unroll
            for (int d0 = 0; d0 < 4; ++d0) { kf[2 * d0] = *(const LAS bf16x8*)(kp + d0 * 2048); kf[2 * d0 + 1] = kf[2 * d0]; }
        }
        if (t == 0) {
            if (MODE == 0) tile_qb<1, 1>(kf, qr, mq, ones, vp, o, m, l, wsf, r32, hi, [&](int, int r) { return r < 8 ? tabA[max(crow(r, hi) - 16 - qpos, -128) + TA_OFF] : NEGB; });
            else tile_qb<1, 1>(kf, qr, mq, ones, vp, o, m, l, wsf, r32, hi, [&](int, int r) { return r < 8 ? 0.f : NEGB; });
        } else if (MODE == 0) { const volatile LAS float* bp = tabA + 64 * (kt0 + t - 1) + 4 * hi - qpos + TA_OFF;
            tile_qb<2, 4>(kf, qr, mq, ones, vp, o, m, l, wsf, r32, hi, [&](int hf, int r) { return bp[32 * hf + (r & 3) + 8 * (r >> 2)]; });
        } else { const int kr = kr0 + t - 1; const bool rowok = kr >= rs && kr <= rs + 7; const volatile LAS float* bp = tabB + (rowok ? kr - qrow + 7 : 15) * 31 + dc0;
            tile_qb<1, 2>(kf, qr, mq, ones, vp, o, m, l, wsf, r32, hi, [&](int, int r) { return bp[(r & 3) + 8 * (r >> 2)] + cm[r]; });
        }
    }
    if (MODE == 0) { if (hi == 0) l += __builtin_amdgcn_exp2f(F.sink[hidx] * LOG2E - m); }
    if (MODE == 0) finish_qb(F, o, l, wsf, stg, lane, r32, hi, ocol, hidx, [&](int q) { return qtok0 + q; });
    else finish_qb(F, o, l, wsf, stg, lane, r32, hi, ocol, hidx, [&](int q) { return qtok0 + (q >> 4) * 64 + (q & 15); });
    __builtin_amdgcn_s_barrier();
#undef ATT_TROW
#undef ATT_ISSUE
}
__device__ __forceinline__ void attn_phase(const Frame& F, int mask = 3) {
    __syncthreads();
    int L = F.bx, un = 0; const int slot = (mask & 8) ? (F.bx & 7) : 0;
    for (; L < 2048 && un < slot; L += F.G, ++un) { if (L < 1024) { if (mask & 1) attn_unit<0>(F, L); } else if (mask & 2) attn_unit<1>(F, L - 1024); }
    if (mask & 8) { __syncthreads(); const int n = (IT_P6 - IT_MID + F.G - 1) / F.G, a = IT_MID + F.bx * n, e = a + n < IT_P6 ? a + n : IT_P6; if (a < e) conv_range(F, a, e); __syncthreads(); }
    for (; L < 2048; L += F.G) { if (L < 1024) { if (mask & 1) attn_unit<0>(F, L); } else if (mask & 2) attn_unit<1>(F, L - 1024); }
    __syncthreads();
}
}

#ifndef FAST_P5
#define FAST_P5 1
#endif
__device__ __forceinline__ void route_token(const Frame& F, int tok, float lg, int lane) {
    const float score = 1.0f / (1.0f + expf(-lg)), v0 = score + F.rbias[lane];
    int rk = 0;
#pragma unroll
    for (int j = 0; j < 8; ++j) { const int o = (lane & ~7) + j; const float w = __shfl(v0, o); rk += (w > v0 || (w == v0 && o < lane)) ? 1 : 0; }
    float gs = rk < 2 ? v0 : 0.f; gs += __shfl_xor(gs, 1); gs += __shfl_xor(gs, 2); gs += __shfl_xor(gs, 4);
    int grk = 0; const int myg = lane >> 3;
#pragma unroll
    for (int g = 0; g < 8; ++g) { const float w = __shfl(gs, g * 8); grk += (w > gs || (w == gs && g < myg)) ? 1 : 0; }
    const float mv = grk < 4 ? v0 : -INFINITY;
    int erk = 0;
    for (int o = 0; o < 64; ++o) { const float w = __shfl(mv, o); erk += (w > mv || (w == mv && o < lane)) ? 1 : 0; }
    const bool sel = erk < 8;
    const float wsm = wsum(sel ? score : 0.f), wgt = score / (wsm + 1e-20f) * 2.5f;
    if (sel) { const int rr = atomicAdd(F.cnt() + lane, 1); F.tokl()[(size_t)lane * NTOK + rr] = tok; F.wl()[(size_t)lane * NTOK + rr] = wgt; F.tke()[tok * 8 + erk] = lane; F.tkr()[tok * 8 + erk] = rr; }
}
__device__ __forceinline__ void route_token_local(const Frame& F, int tl  , float lg, int lane, LAS int* lcnt, LAS int* sel_e, LAS int* sel_lr, LAS float* sel_w) {
    lg = (lg == lg) ? lg : 0.f;
    const float score = 1.0f / (1.0f + expf(-lg)), v0 = score + F.rbias[lane];
    int rk = 0;
#pragma unroll
    for (int j = 0; j < 8; ++j) { const int o = (lane & ~7) + j; const float w = __shfl(v0, o); rk += (w > v0 || (w == v0 && o < lane)) ? 1 : 0; }
    float gs = rk < 2 ? v0 : 0.f; gs += __shfl_xor(gs, 1); gs += __shfl_xor(gs, 2); gs += __shfl_xor(gs, 4);
    int grk = 0; const int myg = lane >> 3;
#pragma unroll
    for (int g = 0; g < 8; ++g) { const float w = __shfl(gs, g * 8); grk += (w > gs || (w == gs && g < myg)) ? 1 : 0; }
    const float mv = grk < 4 ? v0 : -INFINITY;
    int erk = 0;
#pragma unroll 16
    for (int o = 0; o < 64; ++o) { const float w = __shfl(mv, o); erk += (w > mv || (w == mv && o < lane)) ? 1 : 0; }
    const bool sel = erk < 8;
    const float wsm = wsum(sel ? score : 0.f), wgt = score / (wsm + 1e-20f) * 2.5f;
    if (sel) { const int lr = __hip_atomic_fetch_add(lcnt + lane, 1, __ATOMIC_RELAXED, __HIP_MEMORY_SCOPE_WORKGROUP); sel_e[tl * 8 + erk] = lane; sel_lr[tl * 8 + erk] = lr; sel_w[tl * 8 + erk] = wgt; }
}
__device__ __forceinline__ void phase_ln1_router_fast(Frame& F) {
    constexpr int HSTR = 4112;
    LAS unsigned char* hb = F.lds; LAS float* part = (LAS float*)F.lds;
    LAS int* lcnt = (LAS int*)(F.lds + 132096); LAS int* lbase = lcnt + 64; LAS int* sel_e = lcnt + 128; LAS int* sel_lr = sel_e + 512; LAS float* sel_w = (LAS float*)(sel_lr + 512);
    const int lane = F.lane, w = F.wave, r32 = lane & 31, hi = lane >> 5;
    for (int it2 = F.bx; it2 < NTOK / 64; it2 += F.G) {
        if (F.tid < 64) lcnt[F.tid] = 0;
        for (int sub = 0; sub < 2; ++sub) {
            const int t0 = it2 * 64 + sub * 32;
            u32x4 raw[4][4];
#pragma unroll
            for (int q = 0; q < 4; ++q) { const bf16_t* src = F.z() + (size_t)(t0 + 4 * w + q) * D;
#pragma unroll
                for (int j = 0; j < 4; ++j) raw[q][j] = *(const u32x4*)(src + (lane + 64 * j) * 8); }
#pragma unroll
            for (int q = 0; q < 4; ++q) { const int row = 4 * w + q, tok = t0 + row; float v[4][8]; float s = 0.f;
#pragma unroll
                for (int j = 0; j < 4; ++j)
#pragma unroll
                    for (int i = 0; i < 4; ++i) { v[j][2 * i] = __uint_as_float(raw[q][j][i] << 16); v[j][2 * i + 1] = __uint_as_float(raw[q][j][i] & 0xffff0000u); s += v[j][2 * i] + v[j][2 * i + 1]; }
                const float mu = wsum(s) * (1.0f / D); float qq = 0.f;
#pragma unroll
                for (int j = 0; j < 4; ++j)
#pragma unroll
                    for (int i = 0; i < 8; ++i) { const float d = v[j][i] - mu; qq += d * d; }
                const float rstd = 1.0f / sqrtf(wsum(qq) * (1.0f / D) + LN_EPS);
#pragma unroll
                for (int j = 0; j < 4; ++j) { const int c = (lane + 64 * j) * 8; const f32x4 g0 = *(const f32x4*)(F.l1g + c), g1 = *(const f32x4*)(F.l1g + c + 4), b0 = *(const f32x4*)(F.l1b + c), b1 = *(const f32x4*)(F.l1b + c + 4);
                    u32x4 pk;
                    pk.x = pack2((v[j][0] - mu) * rstd * g0[0] + b0[0], (v[j][1] - mu) * rstd * g0[1] + b0[1]); pk.y = pack2((v[j][2] - mu) * rstd * g0[2] + b0[2], (v[j][3] - mu) * rstd * g0[3] + b0[3]);
                    pk.z = pack2((v[j][4] - mu) * rstd * g1[0] + b1[0], (v[j][5] - mu) * rstd * g1[1] + b1[1]); pk.w = pack2((v[j][6] - mu) * rstd * g1[2] + b1[2], (v[j][7] - mu) * rstd * g1[3] + b1[3]);
                    *(u32x4*)(F.h1() + (size_t)tok * D + c) = pk; *(LAS u32x4*)(hb + row * HSTR + c * 2) = pk; }
                if (lane == 0) { F.stats1()[tok * 2] = mu; F.stats1()[tok * 2 + 1] = rstd; } }
            __syncthreads();
            att::f32x16 acc[2]; acc[0] = att::f32x16{}; acc[1] = att::f32x16{};
            const bf16_t* wb = F.wrt() + (size_t)r32 * D + 256 * w + hi * 8;
#pragma unroll 8
            for (int s = 0; s < 16; ++s) {
                const att::bf16x8 a = *(const LAS att::bf16x8*)(hb + r32 * HSTR + (256 * w + 16 * s + 8 * hi) * 2);
                const att::bf16x8 b0 = *(const att::bf16x8*)(wb + 16 * s), b1 = *(const att::bf16x8*)(wb + (size_t)32 * D + 16 * s);
                acc[0] = __builtin_amdgcn_mfma_f32_32x32x16_bf16(a, b0, acc[0], 0, 0, 0); acc[1] = __builtin_amdgcn_mfma_f32_32x32x16_bf16(a, b1, acc[1], 0, 0, 0); }
            __syncthreads();
#pragma unroll
            for (int nt = 0; nt < 2; ++nt)
#pragma unroll
                for (int r = 0; r < 16; ++r) part[(w * 32 + att::crow(r, hi)) * 64 + 32 * nt + r32] = acc[nt][r];
            __syncthreads();
            for (int q = 0; q < 4; ++q) { const int row = 4 * w + q; float lg = 0.f;
#pragma unroll
                for (int ww = 0; ww < 8; ++ww) lg += part[(ww * 32 + row) * 64 + lane];
                route_token_local(F, sub * 32 + row, lg, lane, lcnt, sel_e, sel_lr, sel_w); }
            __syncthreads();
        }
        if (F.tid < 64) { const int n = lcnt[F.tid]; lbase[F.tid] = n > 0 ? atomicAdd(F.cnt() + F.tid, n) : 0; }
        __syncthreads();
        { const int tl = F.tid >> 3, slot = F.tid & 7, e = sel_e[F.tid], rr = lbase[e] + sel_lr[F.tid], tok = it2 * 64 + tl;
          F.tokl()[(size_t)e * NTOK + rr] = tok; F.wl()[(size_t)e * NTOK + rr] = sel_w[F.tid]; F.tke()[tok * 8 + slot] = e; F.tkr()[tok * 8 + slot] = rr; }
        __syncthreads();
    }
}

__global__ void __launch_bounds__(512, 2) mk_fwd(Args args) {
    extern __shared__ __attribute__((aligned(16))) unsigned char lds_raw[];
    Frame F; F.lds = (LAS unsigned char*)lds_raw; F.tid = threadIdx.x; F.lane = F.tid & 63; F.wave = __builtin_amdgcn_readfirstlane(F.tid >> 6); F.G = gridDim.x; F.bx = blockIdx.x;
    F.x = args.in[0]; F.meta = args.in[1]; F.lng = args.in[2]; F.lnb = args.in[3]; F.t5 = args.in[4]; F.w_in = args.in[5]; F.sink = args.in[6]; F.rpb = args.in[7]; F.ga = args.in[8]; F.gb = args.in[9];
    F.w_out = args.in[10]; F.l1g = args.in[11]; F.l1b = args.in[12]; F.w_router = args.in[13]; F.rbias = args.in[14]; F.w_gate = args.in[15]; F.w_up = args.in[16]; F.w_down = args.in[17];
    F.ws_gate = args.in[18]; F.ws_up = args.in[19]; F.ws_down = args.in[20]; F.l2g = args.in[21]; F.l2b = args.in[22]; F.out = args.out; F.ws = args.ws;
    unsigned char* ws = args.ws;
    volatile LAS unsigned* xbw = (volatile LAS unsigned*)(F.lds + LDS_BYTES - 16);
    LAS int* ps = (LAS int*)(F.lds + 131072);
    if (F.tid < 4) xbw[F.tid] = 0u;
    __syncthreads();
    const int lo = args.ph_lo, hi = args.ph_hi;
    XcdBarrier bar; bar.bar = (unsigned*)(ws + WS_CTL); bar.x = 0; bar.st = xbw;
    if (hi - lo > 1) bar = xcd_barrier_post((unsigned*)(ws + WS_CTL), xbw);
    unsigned* xcen = (unsigned*)(ws + WS_CTL + 20480);
    if (XCD_TRUE && hi - lo > 1 && F.tid == 0) { const unsigned x = xb_xcc_id(); xbw[2] = x; xbw[3] = xb_add(&xcen[x * 16], 1u); }
#ifndef PROBE_REPEAT
#define PROBE_REPEAT -1
#endif
#ifndef PROBE_SUB
#define PROBE_SUB 3
#endif
#ifndef PROBE_NOSTORE
#define PROBE_NOSTORE 0
#endif
#ifndef PROBE_HOT
#define PROBE_HOT 0
#endif
#ifndef PROBE_NT
#define PROBE_NT 32
#ifndef PROBE_LD
#define PROBE_LD 2048
#endif
#endif
#define IN(k) (lo <= (k) && (k) < hi)
#define SEAM(k) do { if (IN(k) && IN((k) + 1)) xcd_barrier(bar); } while (0)
    if (IN(0)) { F.fresh(); phase_prologue(F);
#if PROBE_REPEAT == 0
        xcd_barrier(bar); phase_prologue(F);
#endif
    } SEAM(0);
#define P1_BODY(rep) do { const int s_ = (rep) ? 0 : F.bx % 5; EpiU E{F.u(), rep}; { SchedInProj S{(const char*)F.h0(), (const char*)F.wtin(), F.G, F.bx, 0, s_}; pg8::gemm_phase(F.lds, S, E, D, D, D / 64); } if (!(rep)) { conv_inproj_share(F); __syncthreads(); } { SchedInProj S{(const char*)F.h0(), (const char*)F.wtin(), F.G, F.bx, s_, 1 << 20}; pg8::gemm_phase(F.lds, S, E, D, D, D / 64); } } while (0)
#define P4_BODY(rep) do { SchedOutProj S{(const char*)F.ya(), (const char*)F.wtout(), F.G, F.bx}; EpiZ E{F.z(), F.h0(), F.ssq(), (LAS float*)(F.lds + 131072 + 6144)}; pg8::gemm_phase(F.lds, S, E, D, D, D / 64, STAGGER4); } while (0)
#define P6_BODY(rep) do { moe_tables(F, ps); SchedGU S{(const char*)F.h1(), (const char*)F.wtgu(), F.tokl(), F.cnt(), ps, F.G, F.bx}; EpiGU E{F.hb(), F.wl()}; pg8::gemm_phase(F.lds, S, E, D, D, D / 64); if (!(rep)) conv_tail(F, IT_P6, IT_ALL, (ps[128 + 65] * 4) % F.G); } while (0)
#define P7_BODY(rep) do { moe_tables(F, ps); SchedDown S{(const char*)F.hb(), (const char*)F.wtd(), F.cnt(), ps, F.G, F.bx, (rep) ? PROBE_HOT : 0}; EpiDownR E{F.ym(), rep}; pg8::gemm_phase(F.lds, S, E, DE, DE, DE / 64, STAGGER7); SchedDownShared S2{(const char*)F.hb(), (const char*)F.wtd(), F.G, F.bx}; EpiDownS E2{F.o2(), F.h1()}; pg8::gemm_phase(F.lds, S2, E2, DE, DE, DE / 64); } while (0)
    if (XCD_TRUE && hi - lo > 1 && IN(0)) {
        if (F.tid == 0) { unsigned idx = 0, ok = 1, npop = 0; const unsigned x = xbw[2];
            for (unsigned j = 0; j < 16; ++j) { const unsigned cj = xb_ld(&xcen[j * 16]); if (cj) { ++npop; if (cj * 8u != (unsigned)F.G) ok = 0; if (j < x) ++idx; } }
            xbw[2] = (ok && npop == 8) ? xbw[3] * 8u + idx : (unsigned)blockIdx.x; }
        __syncthreads();
        F.bx = (int)xbw[2];
    }
    if (IN(1)) { F.fresh();
#if FAST_P1
        P1_BODY(0);
#if PROBE_REPEAT == 1
        xcd_barrier(bar); P1_BODY(PROBE_NOSTORE);
#endif
#else
        FnInProj f{F}; sgemm(f, F.lds, F.tid, F.bx, F.G);
#endif
#if PROBE_REPEAT == 9
        xcd_barrier(bar); if (F.bx % 8 == 0) { conv_range(F, IT_P0 + T_OUT, IT_P0 + T_OUT + 512); __syncthreads(); }
#endif
    } SEAM(1);
    if (IN(2)) { F.fresh();
#if FAST_P2
        att::attn_phase(F, 3 | 8);
#if PROBE_REPEAT == 2
        xcd_barrier(bar); att::attn_phase(F, PROBE_SUB);
#endif
#else
        phase_attn_simple(F);
#endif
    } SEAM(2);
#if !FAST_P4
    if (IN(3)) { phase_rmsnorm(F); } SEAM(3);
#endif
    if (IN(4)) { F.fresh();
#if FAST_P4
        P4_BODY(0);
#if PROBE_REPEAT == 4
        xcd_barrier(bar); P4_BODY(1);
#endif
#else
        FnOutProj f{F}; sgemm(f, F.lds, F.tid, F.bx, F.G);
#endif
    } SEAM(4);
#if FAST_P5
#define PH5(F) phase_ln1_router_fast(F)
#else
#define PH5(F) phase_ln1_router(F)
#endif
    if (IN(5)) { F.fresh(); PH5(F);
#if PROBE_REPEAT == 5
        xcd_barrier(bar); if (F.bx == 0 && F.tid < 64) F.cnt()[F.tid] = 0; xcd_barrier(bar); PH5(F);
#endif
    } SEAM(5);
    if (IN(6)) { F.fresh();
#if FAST_P6
        P6_BODY(0);
#if PROBE_REPEAT == 6
        xcd_barrier(bar); P6_BODY(1);
#endif
#else
        expert_starts(F, ps); FnGateUp f{F, ps}; sgemm(f, F.lds, F.tid, F.bx, F.G);
#endif
    } SEAM(6);
    if (IN(7)) { F.fresh();
#if FAST_P7
        P7_BODY(0);
#if PROBE_REPEAT == 7
        xcd_barrier(bar); P7_BODY(PROBE_NOSTORE);
#endif
#else
        expert_starts(F, ps); { FnDown f{F, ps}; sgemm(f, F.lds, F.tid, F.bx, F.G); } { FnFinal f{F, ps}; sgemm(f, F.lds, F.tid, F.bx, F.G); }
#endif
    } SEAM(7);
    if (IN(8)) { F.fresh(); expert_starts(F, ps); phase_ln2(F, ps);
#if PROBE_REPEAT == 8
        xcd_barrier(bar); phase_ln2(F, ps);
#endif
    }
#undef IN
#undef SEAM
}

extern "C" void kernel_launch(void* const* d_in, const int* in_sizes, int n_in, void* d_out, int out_size, void* d_ws, size_t ws_size, hipStream_t stream) {
    static int grid = 0;
    if (grid == 0) {
        if (n_in != 23 || in_sizes[0] != NTOK * D || out_size != NTOK * D || ws_size < WS_END) {
            fprintf(stderr, "kernel_launch: built for 23 inputs, x/out of %d floats, >= %zu bytes of workspace; got n_in %d in0 %d out %d ws %zu; nothing launched\n", NTOK * D, (size_t)WS_END, n_in, n_in > 0 ? in_sizes[0] : -1, out_size, ws_size);
            grid = -1; return; }
        int dev = 0, cus = 0, per_cu = 0;
        if (hipGetDevice(&dev) != hipSuccess || hipDeviceGetAttribute(&cus, hipDeviceAttributeMultiprocessorCount, dev) != hipSuccess) { fprintf(stderr, "kernel_launch: device query failed\n"); grid = -1; return; }
        if (hipFuncSetAttribute((const void*)mk_fwd, hipFuncAttributeMaxDynamicSharedMemorySize, LDS_BYTES) != hipSuccess) { fprintf(stderr, "kernel_launch: hipFuncSetAttribute failed\n"); grid = -1; return; }
        if (hipOccupancyMaxActiveBlocksPerMultiprocessor(&per_cu, (const void*)mk_fwd, 512, LDS_BYTES) != hipSuccess || per_cu < 1) fprintf(stderr, "kernel_launch: note: occupancy query reports %d\n", per_cu);
        (void)hipGetLastError();
        grid = cus;
    }
    if (grid < 0) return;
    if (hipMemsetAsync((char*)d_ws + WS_CTL, 0, CTL_BYTES, stream) != hipSuccess) { fprintf(stderr, "kernel_launch: memset failed\n"); return; }
    Args a{};
    for (int i = 0; i < 23; ++i) a.in[i] = (const float*)d_in[i];
    a.out = (float*)d_out; a.ws = (unsigned char*)d_ws;
#if MK_ONE_LAUNCH
    a.ph_lo = 0; a.ph_hi = NPHASE;
    hipLaunchKernelGGL(mk_fwd, dim3(grid), dim3(512), LDS_BYTES, stream, a);
#else
    for (int p = 0; p < NPHASE; ++p) { a.ph_lo = p; a.ph_hi = p + 1; hipLaunchKernelGGL(mk_fwd, dim3(grid), dim3(512), LDS_BYTES, stream, a); }
#endif
    const hipError_t le = hipPeekAtLastError();
    if (le != hipSuccess) fprintf(stderr, "kernel_launch: launch failed: %s\n", hipGetErrorName(le));
}
```

```cpp
#include <hip/hip_runtime.h>
#include <cstdio>
#include <cstdint>

#define LAS __attribute__((address_space(3)))
typedef unsigned short bf16_t;
typedef float f32x4 __attribute__((ext_vector_type(4)));
typedef unsigned u32x4 __attribute__((ext_vector_type(4)));
typedef unsigned u32x2 __attribute__((ext_vector_type(2)));

#ifndef CONV_P2
#define CONV_P2 28160
#endif
#ifndef CONV_NT
#define CONV_NT 1
#endif
#ifndef MK_ONE_LAUNCH
#define MK_ONE_LAUNCH 1
#endif

constexpr int D = 2048, SEQ = 8192, NB = 2, NTOK = NB * SEQ;
constexpr int NMETA = 16, INW = 4608, MROWS = NTOK + 256;
constexpr int NE = 64, DE = 512, PMAX = 147456, HBROWS = PMAX + NTOK;
constexpr float ALPHA = 1.189207115002721f;
constexpr float LN_EPS = 1e-5f, RMS_EPS = 1e-6f, LOG2E = 1.4426950408889634f, QSCALE = 0.125f * LOG2E;
constexpr int COL_QA = 0, COL_KA = 1024, COL_VA = 1280, COL_QB = 1536, COL_KB = 2560, COL_VB = 3584;
constexpr int NPHASE = 9;
constexpr int LDS_BYTES = 147456;

constexpr size_t WS_CTL = 0, CTL_BYTES = 32768;
constexpr size_t WS_CNT = 16384;
constexpr size_t WS_STATS0 = WS_CTL + CTL_BYTES;
constexpr size_t WS_STATS1 = WS_STATS0 + (size_t)NTOK * 8;
constexpr size_t WS_SSQ = WS_STATS1 + (size_t)NTOK * 8;
constexpr size_t WS_TOKL = WS_SSQ + (size_t)NTOK * 32 * 4;
constexpr size_t WS_WL = WS_TOKL + (size_t)NE * NTOK * 4;
constexpr size_t WS_TKE = WS_WL + (size_t)NE * NTOK * 4;
constexpr size_t WS_TKR = WS_TKE + (size_t)NTOK * 8 * 4;
constexpr size_t WS_TAB = WS_TKR + (size_t)NTOK * 8 * 4;
constexpr size_t WS_WRT = WS_TAB + 32768;
constexpr size_t WS_Z = WS_WRT + (size_t)NE * D * 2;
constexpr size_t WS_O2 = WS_Z + (size_t)NTOK * D * 2;
constexpr size_t WS_WTD = WS_Z + (size_t)NTOK * D * 4;
constexpr size_t WS_HB = WS_WTD + (size_t)65 * 2048 * 512 * 2;
constexpr size_t WS_B = WS_HB + (size_t)HBROWS * 512 * 2;
constexpr size_t WS_WTGU = WS_B;
constexpr size_t WS_WTIN = WS_WTGU + (size_t)65 * 1024 * 2048 * 2;
constexpr size_t WS_WTOUT = WS_WTIN + (size_t)INW * D * 2;
constexpr size_t WS_H0 = WS_WTOUT + (size_t)D * D * 2;
constexpr size_t WS_U = WS_H0 + (size_t)MROWS * D * 2;
constexpr size_t WS_YA = WS_U + (size_t)MROWS * INW * 2;
constexpr size_t WS_H1 = WS_Z;
constexpr size_t WS_YM = WS_B;
constexpr size_t WS_END_A = WS_YA + (size_t)NTOK * D * 2, WS_END_B = WS_YM + (size_t)PMAX * D * 2;
constexpr size_t WS_END = WS_END_A > WS_END_B ? WS_END_A : WS_END_B;
static_assert(WS_END <= ((size_t)1 << 30), "workspace map must fit 1 GiB");

__device__ __forceinline__ float bf2f(bf16_t b) { return __uint_as_float(((unsigned)b) << 16); }
__device__ __forceinline__ bf16_t f2bf(float f) { unsigned u = __float_as_uint(f); u += 0x7FFFu + ((u >> 16) & 1u); return (bf16_t)(u >> 16); }
__device__ __forceinline__ unsigned pack2(float lo, float hi) { return (unsigned)f2bf(lo) | ((unsigned)f2bf(hi) << 16); }
__device__ __forceinline__ unsigned enc8(float x) {
    const unsigned u = __float_as_uint(x); int t = (int)(u & 0x7fffffffu) - 0x00F80000;
    t = t < 0x38000000 ? 0x38000000 : (t > 0x3FF00000 ? 0x3FF00000 : t);
    return (((unsigned)t >> 20) & 0x7fu) | ((u >> 24) & 0x80u); }
__device__ __forceinline__ unsigned enc8x4(float a, float b, float c, float d) { return enc8(a) | (enc8(b) << 8) | (enc8(c) << 16) | (enc8(d) << 24); }
__device__ __forceinline__ float dec8(unsigned b) { return __uint_as_float(((b & 0x7fu) << 20) + 0x39000000u + ((b & 0x80u) << 24)); }
__device__ __forceinline__ float wsum(float v) {
#pragma unroll
    for (int o = 32; o >= 1; o >>= 1) v += __shfl_xor(v, o);
    return v; }
__device__ __forceinline__ float wmax(float v) {
#pragma unroll
    for (int o = 32; o >= 1; o >>= 1) v = fmaxf(v, __shfl_xor(v, o));
    return v; }
__device__ __forceinline__ int t5_bucket(int rel) {
    const int ret = rel > 0 ? 16 : 0, n = rel < 0 ? -rel : rel;
    if (n < 8) return ret + n;
    const int n2 = n > 32768 ? 0x40000000 : n * n; int lg = 31 - __clz(n2) + 2; if (lg > 15) lg = 15;
    return ret + lg; }

#define XB_TMO      128
#define XB_XCNT(j)  (256  + 64 * (j))
#define XB_XSUB(j)  (1280 + 64 * (j))
#define XB_XGEN(j)  (2304 + 64 * (j))
#define XB_TOP      3328
#define XB_TOPGEN   3392
#define XCD_BAR_WORDS 3456
#define XB_SPIN_CAP (1u << 18)
__device__ __forceinline__ unsigned xb_ld(unsigned* p)              { return __hip_atomic_load(p, __ATOMIC_RELAXED, __HIP_MEMORY_SCOPE_AGENT); }
__device__ __forceinline__ unsigned xb_add(unsigned* p, unsigned v) { return __hip_atomic_fetch_add(p, v, __ATOMIC_RELAXED, __HIP_MEMORY_SCOPE_AGENT); }
__device__ __forceinline__ unsigned xb_xcc_id() { return (unsigned)__builtin_amdgcn_s_getreg((3 << 11) | 20) & 0xFu; }
#define XB_SPIN(cond, bar) do { unsigned _sp = 0; while (cond) { __builtin_amdgcn_s_sleep(1); \
    if ((++_sp & 255u) == 0u) { if (xb_ld(&(bar)[XB_TMO])) break; if (_sp > XB_SPIN_CAP) { atomicAdd(&(bar)[XB_TMO], 1u); break; } } } } while (0)
struct XcdBarrier { unsigned* bar; unsigned x; volatile LAS unsigned* st; };
__device__ __forceinline__ XcdBarrier xcd_barrier_post(unsigned* bar, volatile LAS unsigned* st) {
    XcdBarrier b; b.bar = bar; b.x = xb_xcc_id(); b.st = st;
    if (threadIdx.x == 0) (void)xb_add(&bar[XB_XCNT(b.x)], 1u);
    return b;
}
__device__ __forceinline__ void xcd_barrier_complete(unsigned* bar, unsigned x, unsigned& nloc, unsigned& nx) {
    const unsigned G = gridDim.x * gridDim.y * gridDim.z;
    unsigned sum, cnt, mine, sp = 0u;
    for (;;) {
        sum = 0u; cnt = 0u; mine = 0u;
#pragma unroll
        for (unsigned j = 0; j < 16; ++j) { const unsigned c = xb_ld(&bar[XB_XCNT(j)]); sum += c; cnt += (c > 0u) ? 1u : 0u; mine = (j == x) ? c : mine; }
        if (sum == G) break;
        __builtin_amdgcn_s_sleep(1);
        if ((++sp & 255u) == 0u) { if (xb_ld(&bar[XB_TMO])) break; if (sp > XB_SPIN_CAP) { atomicAdd(&bar[XB_TMO], 1u); break; } }
    }
    nloc = mine > 0u ? mine : 1u; nx = cnt > 0u ? cnt : 1u;
}
__device__ __forceinline__ void xcd_barrier(const XcdBarrier& b) {
    asm volatile("s_waitcnt vmcnt(0)" ::: "memory");
    __syncthreads();
    if (threadIdx.x == 0) {
        unsigned* bar = b.bar;
        __builtin_amdgcn_s_waitcnt(0);
        unsigned nloc = b.st[0], nx = b.st[1];
        if (nloc == 0u) { xcd_barrier_complete(bar, b.x, nloc, nx); b.st[0] = nloc; b.st[1] = nx; }
        const unsigned old = xb_add(&bar[XB_XSUB(b.x)], 1u);
        const unsigned gen = old / nloc;
        if (old + 1u == (gen + 1u) * nloc) {
            __builtin_amdgcn_fence(__ATOMIC_RELEASE, "agent");
            asm volatile("s_waitcnt vmcnt(0)" ::: "memory");
            const unsigned og = xb_add(&bar[XB_TOP], 1u);
            const unsigned tg = og / nx;
            if (og + 1u == (tg + 1u) * nx) xb_add(&bar[XB_TOPGEN], 1u);
            else XB_SPIN(xb_ld(&bar[XB_TOPGEN]) == tg, bar);
            __builtin_amdgcn_fence(__ATOMIC_ACQUIRE, "agent");
            xb_add(&bar[XB_XGEN(b.x)], 1u);
            asm volatile("s_waitcnt vmcnt(0)" ::: "memory");
        } else {
            XB_SPIN(xb_ld(&bar[XB_XGEN(b.x)]) == gen, bar);
            __builtin_amdgcn_fence(__ATOMIC_ACQUIRE, "agent");
            asm volatile("s_waitcnt vmcnt(0)" ::: "memory");
        }
    }
    __syncthreads();
}

struct Args { const float* in[23]; float* out; unsigned char* ws; int ph_lo, ph_hi; };
struct Frame {
    LAS unsigned char* lds; int tid, lane, wave, G, bx;
    const float *x, *meta, *lng, *lnb, *t5, *w_in, *sink, *rpb, *ga, *gb, *w_out, *l1g, *l1b, *w_router, *rbias, *w_gate, *w_up, *w_down, *ws_gate, *ws_up, *ws_down, *l2g, *l2b;
    float* out; unsigned char* ws;
    __device__ __forceinline__ void fresh() { int t = threadIdx.x; asm volatile("" : "+v"(t)); tid = t; lane = t & 63; wave = __builtin_amdgcn_readfirstlane(t >> 6); }
    __device__ __forceinline__ float* stats0() const { return (float*)(ws + WS_STATS0); }
    __device__ __forceinline__ float* stats1() const { return (float*)(ws + WS_STATS1); }
    __device__ __forceinline__ float* ssq() const { return (float*)(ws + WS_SSQ); }
    __device__ __forceinline__ float* wl() const { return (float*)(ws + WS_WL); }
    __device__ __forceinline__ float* tab() const { return (float*)(ws + WS_TAB); }
    __device__ __forceinline__ int* cnt() const { return (int*)(ws + WS_CNT); }
    __device__ __forceinline__ int* tokl() const { return (int*)(ws + WS_TOKL); }
    __device__ __forceinline__ int* tke() const { return (int*)(ws + WS_TKE); }
    __device__ __forceinline__ int* tkr() const { return (int*)(ws + WS_TKR); }
    __device__ __forceinline__ bf16_t* wtd() const { return (bf16_t*)(ws + WS_WTD); }
    __device__ __forceinline__ bf16_t* hb() const { return (bf16_t*)(ws + WS_HB); }
    __device__ __forceinline__ bf16_t* wtgu() const { return (bf16_t*)(ws + WS_WTGU); }
    __device__ __forceinline__ bf16_t* wtin() const { return (bf16_t*)(ws + WS_WTIN); }
    __device__ __forceinline__ bf16_t* wtout() const { return (bf16_t*)(ws + WS_WTOUT); }
    __device__ __forceinline__ bf16_t* h0() const { return (bf16_t*)(ws + WS_H0); }
    __device__ __forceinline__ bf16_t* u() const { return (bf16_t*)(ws + WS_U); }
    __device__ __forceinline__ bf16_t* ya() const { return (bf16_t*)(ws + WS_YA); }
    __device__ __forceinline__ bf16_t* h1() const { return (bf16_t*)(ws + WS_H1); }
    __device__ __forceinline__ bf16_t* ym() const { return (bf16_t*)(ws + WS_YM); }
    __device__ __forceinline__ bf16_t* wrt() const { return (bf16_t*)(ws + WS_WRT); }
    __device__ __forceinline__ bf16_t* z() const { return (bf16_t*)(ws + WS_Z); }
    __device__ __forceinline__ bf16_t* o2() const { return (bf16_t*)(ws + WS_O2); }
};

struct ConvDesc { const float* src; bf16_t* dst; int lds_, ldd_; const float* ksc; float csc; };
__device__ __forceinline__ void conv_load(const ConvDesc& d, f32x4 (&v)[16], int lane) {
    const int kk = lane & 3, n4 = (lane >> 2) * 4;
#pragma unroll
    for (int p = 0; p < 16; ++p) v[p] = __builtin_nontemporal_load((const f32x4*)(d.src + (size_t)(4 * p + kk) * d.lds_ + n4));
}
__device__ __forceinline__ void conv_finish(const ConvDesc& d, const f32x4 (&v)[16], LAS float* scr, int lane) {
    const int kk = lane & 3, n4 = (lane >> 2) * 4;
#pragma unroll
    for (int p = 0; p < 16; ++p) { const int k = 4 * p + kk; const float s = d.ksc ? d.ksc[k] * d.csc : d.csc;
        scr[k * 65 + n4] = v[p][0] * s; scr[k * 65 + n4 + 1] = v[p][1] * s; scr[k * 65 + n4 + 2] = v[p][2] * s; scr[k * 65 + n4 + 3] = v[p][3] * s; }
    asm volatile("s_waitcnt lgkmcnt(0)" ::: "memory");
    const int c = lane >> 3;
#pragma unroll
    for (int j = 0; j < 8; ++j) { const int n = (lane & 7) + 8 * j; const LAS float* s = scr + (8 * c) * 65 + n; u32x4 o;
        o.x = pack2(s[0], s[65]); o.y = pack2(s[2 * 65], s[3 * 65]); o.z = pack2(s[4 * 65], s[5 * 65]); o.w = pack2(s[6 * 65], s[7 * 65]);
        __builtin_nontemporal_store(o, (u32x4*)(d.dst + (size_t)n * d.ldd_ + 8 * c)); }
    asm volatile("s_waitcnt lgkmcnt(0)" ::: "memory");
}
constexpr int T_R = 32, T_IN = 72 * 32, T_OUT = 32 * 32, T_GU = 65 * 2 * 8 * 32, T_D = 65 * 32 * 8;
constexpr int IT_P0 = T_R + T_IN, IT_ALL = IT_P0 + T_OUT + T_GU + T_D, IT_P6 = IT_ALL - 6400, IT_MID = IT_P6 - CONV_P2;
__device__ __forceinline__ ConvDesc conv_desc(const Frame& F, int it) {
    int r = it; const float* src; bf16_t* dst; int lds_, ldd_; const float* ksc = nullptr; float csc = 1.0f;
    if (r < T_R) { src = F.w_router + (size_t)(r * 64) * NE; lds_ = NE; dst = F.wrt() + r * 64; ldd_ = D; }
    else if ((r -= T_R) < T_IN) { const int tn = r % 72, tk = r / 72; const int n0 = tn * 64; const bool isq = (n0 < COL_KA) || (n0 >= COL_QB && n0 < COL_KB);
        src = F.w_in + (size_t)(tk * 64) * INW + n0; lds_ = INW; dst = F.wtin() + (size_t)n0 * D + tk * 64; ldd_ = D; csc = isq ? QSCALE : 1.0f; }
    else if ((r -= T_IN) < T_OUT) { const int tn = r % 32, tk = r / 32; const int k0 = tk * 64;
        src = F.w_out + (size_t)k0 * D + tn * 64; lds_ = D; dst = F.wtout() + (size_t)(tn * 64) * D + k0; ldd_ = D; ksc = k0 < 1024 ? F.ga + k0 : F.gb + (k0 - 1024); }
    else if ((r -= T_OUT) < T_GU) { const int tn = r % 8, tk = (r / 8) % 32, which = (r / 256) % 2, e = r / 512;
        const float* s0 = e < NE ? (which ? F.w_up : F.w_gate) + (size_t)e * D * DE : (which ? F.ws_up : F.ws_gate);
        const int c0 = tn * 64, nprime = 256 * (c0 / 128) + 128 * which + (c0 % 128);
        src = s0 + (size_t)(tk * 64) * DE + c0; lds_ = DE; dst = F.wtgu() + ((size_t)e * 1024 + nprime) * D + tk * 64; ldd_ = D; }
    else { r -= T_GU; const int tn = r % 32, tk = (r / 32) % 8, e = r / 256;
        const float* s0 = e < NE ? F.w_down + (size_t)e * DE * D : F.ws_down;
        src = s0 + (size_t)(tk * 64) * D + tn * 64; lds_ = D; dst = F.wtd() + ((size_t)e * D + tn * 64) * DE + tk * 64; ldd_ = DE; }
    return ConvDesc{src, dst, lds_, ldd_, ksc, csc};
}
__device__ __forceinline__ void conv_items(const Frame& F, int first, int last, int step) {
    LAS float* t = (LAS float*)F.lds + F.wave * (64 * 65);
    if (first >= last) return;
    f32x4 va[16], vb[16]; ConvDesc da = conv_desc(F, first), db = da;
    conv_load(da, va, F.lane);
    for (int it = first; it < last; it += 2 * step) {
        const bool hb = it + step < last; if (hb) { db = conv_desc(F, it + step); conv_load(db, vb, F.lane); }
        conv_finish(da, va, t, F.lane);
        if (!hb) break;
        const bool ha = it + 2 * step < last; if (ha) { da = conv_desc(F, it + 2 * step); conv_load(da, va, F.lane); }
        conv_finish(db, vb, t, F.lane);
        if (!ha) break;
    }
}
__device__ __forceinline__ void conv_range(const Frame& F, int first, int last) { conv_items(F, first + F.wave, last, 8); }
__device__ __forceinline__ void conv_inproj_share(const Frame& F) {
    constexpr int N1 = IT_MID - IT_P0, CY = (N1 - 118 * 100 + 255) / 256, CX = CY + 100; int a, n;
    if (F.G == 256) { if (F.bx < 138) { a = F.bx * CY; n = CY; } else { a = 138 * CY + (F.bx - 138) * CX; n = CX; } }
    else { n = (N1 + F.G - 1) / F.G; a = F.bx * n; }
    const int e = a + n < N1 ? a + n : N1;
    if (a < e) conv_range(F, IT_P0 + a, IT_P0 + e);
}
__device__ __forceinline__ void conv_tail(const Frame& F, int first, int last, int c0) {
    int nw = F.G - c0, me = F.bx - c0; if (nw <= 0) { nw = F.G; me = F.bx; }
    if (me < 0) return;
    conv_items(F, first + me * 8 + F.wave, last, nw * 8);
}
__device__ __forceinline__ void phase_prologue(Frame& F) {
    const int gw = F.bx * 8 + F.wave, NGW = F.G * 8;
    conv_items(F, gw, IT_P0, NGW);
    for (int row = gw; row < MROWS; row += NGW) {
        bf16_t* dst = F.h0() + (size_t)row * D;
        if (row >= NTOK + NMETA) {
#pragma unroll
            for (int j = 0; j < 8; ++j) *(u32x2*)(dst + (j * 64 + F.lane) * 4) = (u32x2){0u, 0u};
            continue; }
        const float* src = row < NTOK ? F.x + (size_t)row * D : F.meta + (size_t)(row - NTOK) * D;
        f32x4 v[8]; float s = 0.f;
#pragma unroll
        for (int j = 0; j < 8; ++j) { v[j] = *(const f32x4*)(src + (j * 64 + F.lane) * 4); s += (v[j][0] + v[j][1]) + (v[j][2] + v[j][3]); }
        const float mu = wsum(s) * (1.0f / D); float q = 0.f;
#pragma unroll
        for (int j = 0; j < 8; ++j) { const f32x4 d = v[j] - mu; q += (d[0] * d[0] + d[1] * d[1]) + (d[2] * d[2] + d[3] * d[3]); }
        const float rstd = 1.0f / sqrtf(wsum(q) * (1.0f / D) + LN_EPS);
#pragma unroll
        for (int j = 0; j < 8; ++j) { const int c = (j * 64 + F.lane) * 4; const f32x4 g = *(const f32x4*)(F.lng + c), b = *(const f32x4*)(F.lnb + c); const f32x4 y = (v[j] - mu) * rstd * g + b;
            *(u32x2*)(dst + c) = (u32x2){pack2(y[0], y[1]), pack2(y[2], y[3])}; }
        if (row < NTOK && F.lane == 0) { F.stats0()[row * 2] = mu; F.stats0()[row * 2 + 1] = rstd; }
    }
    if (F.bx == 0) for (int i = F.tid; i < 16 * 272; i += 512) { const int h = i / 272, r = i % 272; F.tab()[i] = r <= 256 ? F.t5[t5_bucket(r - 128) * 16 + h] * LOG2E : 0.f; }
}

template <class Fn> __device__ __forceinline__ void sgemm(const Fn& f, LAS unsigned char* ldsb, int tid, int bx, int G) {
    LAS float* As = (LAS float*)ldsb; LAS float* Bs = As + 32 * 132; LAS float* Bs2 = Bs + 32 * 68;
    const int ntm = f.ntm(), ntn = f.ntn(), K = f.K();
    const int tx = tid & 15, ty = tid >> 4, ar = tid >> 2, akc = (tid & 3) * 8, br = (tid & 255) >> 2;
    for (int tile = bx; tile < ntm * ntn; tile += G) {
        const int tm = tile / ntn, tn = tile % ntn;
        typename Fn::Tile T; if (!f.tile(tm, T)) continue;
        float acc[4][4], acc2[4][4];
#pragma unroll
        for (int i = 0; i < 4; ++i)
#pragma unroll
            for (int j = 0; j < 4; ++j) { acc[i][j] = 0.f; acc2[i][j] = 0.f; }
        const bf16_t* ap = f.arow(T, tm * 128 + ar);
        const bf16_t* bp = tid < 256 ? f.brow(T, tn * 64 + br) : (Fn::DUAL ? f.brow2(T, tn * 64 + br) : nullptr);
        LAS float* Bw = tid < 256 ? Bs : Bs2;
        for (int k0 = 0; k0 < K; k0 += 32) {
            u32x4 av = (u32x4){0u, 0u, 0u, 0u}, bv = (u32x4){0u, 0u, 0u, 0u};
            if (ap) av = *(const u32x4*)(ap + k0 + akc);
            if (bp) bv = *(const u32x4*)(bp + k0 + akc);
            __syncthreads();
#pragma unroll
            for (int i = 0; i < 4; ++i) { As[(akc + 2 * i) * 132 + ar] = __uint_as_float(av[i] << 16); As[(akc + 2 * i + 1) * 132 + ar] = __uint_as_float(av[i] & 0xffff0000u); }
            if (tid < 256 || Fn::DUAL) {
#pragma unroll
                for (int i = 0; i < 4; ++i) { Bw[(akc + 2 * i) * 68 + br] = __uint_as_float(bv[i] << 16); Bw[(akc + 2 * i + 1) * 68 + br] = __uint_as_float(bv[i] & 0xffff0000u); } }
            __syncthreads();
#pragma unroll 8
            for (int kk = 0; kk < 32; ++kk) {
                const f32x4 a = *(const LAS f32x4*)(As + kk * 132 + ty * 4), b = *(const LAS f32x4*)(Bs + kk * 68 + tx * 4);
#pragma unroll
                for (int i = 0; i < 4; ++i)
#pragma unroll
                    for (int j = 0; j < 4; ++j) acc[i][j] += a[i] * b[j];
                if (Fn::DUAL) { const f32x4 b2 = *(const LAS f32x4*)(Bs2 + kk * 68 + tx * 4);
#pragma unroll
                    for (int i = 0; i < 4; ++i)
#pragma unroll
                        for (int j = 0; j < 4; ++j) acc2[i][j] += a[i] * b2[j]; }
            }
        }
#pragma unroll
        for (int i = 0; i < 4; ++i)
#pragma unroll
            for (int j = 0; j < 4; ++j) f.store(T, tm * 128 + ty * 4 + i, tn * 64 + tx * 4 + j, acc[i][j], acc2[i][j]);
    }
}

__device__ __forceinline__ void expert_starts(const Frame& F, LAS int* ps  ) {
    if (F.tid == 0) { int acc = 0; for (int e = 0; e < NE; ++e) { ps[e] = acc; acc += ((F.cnt()[e] + 255) >> 8) << 8; } ps[64] = acc; }
    __syncthreads();
}

struct FnInProj {
    static constexpr bool DUAL = false; struct Tile {}; const Frame& F;
    __device__ int ntm() const { return MROWS / 128; } __device__ int ntn() const { return INW / 64; } __device__ int K() const { return D; }
    __device__ bool tile(int, Tile&) const { return true; }
    __device__ const bf16_t* arow(const Tile&, int row) const { return F.h0() + (size_t)row * D; }
    __device__ const bf16_t* brow(const Tile&, int n) const { return F.wtin() + (size_t)n * D; }
    __device__ const bf16_t* brow2(const Tile&, int) const { return nullptr; }
    __device__ void store(const Tile&, int row, int n, float a, float) const { F.u()[(size_t)row * INW + n] = f2bf(a); }
};
struct FnOutProj {
    static constexpr bool DUAL = false; struct Tile {}; const Frame& F;
    __device__ int ntm() const { return NTOK / 128; } __device__ int ntn() const { return D / 64; } __device__ int K() const { return D; }
    __device__ bool tile(int, Tile&) const { return true; }
    __device__ const bf16_t* arow(const Tile&, int row) const { return F.ya() + (size_t)row * D; }
    __device__ const bf16_t* brow(const Tile&, int n) const { return F.wtout() + (size_t)n * D; }
    __device__ const bf16_t* brow2(const Tile&, int) const { return nullptr; }
    __device__ void store(const Tile&, int row, int n, float a, float) const {
        const float h0 = (F.x[(size_t)row * D + n] - F.stats0()[row * 2]) * F.stats0()[row * 2 + 1] * F.lng[n] + F.lnb[n];
        F.z()[(size_t)row * D + n] = f2bf(a + ALPHA * h0); }
};
struct FnGateUp {
    static constexpr bool DUAL = true; struct Tile { int e, r0, n; }; const Frame& F; const LAS int* ps;
    __device__ int ntm() const { return HBROWS / 128; } __device__ int ntn() const { return DE / 64; } __device__ int K() const { return D; }
    __device__ bool tile(int tm, Tile& T) const { const int row0 = tm * 128;
        if (row0 >= PMAX) { T.e = NE; T.r0 = row0 - PMAX; T.n = NTOK; return true; }
        if (row0 >= ps[64]) return false;
        int e = 0; while (e < NE - 1 && row0 >= ps[e + 1]) ++e;
        T.e = e; T.r0 = row0 - ps[e]; T.n = F.cnt()[e]; return T.r0 < T.n; }
    __device__ const bf16_t* arow(const Tile& T, int row) const { const int r = T.r0 + (row & 127); if (r >= T.n) return nullptr;
        const int tok = T.e < NE ? F.tokl()[(size_t)T.e * NTOK + r] : r; return F.h1() + (size_t)tok * D; }
    __device__ const bf16_t* brow(const Tile& T, int n) const { return F.wtgu() + ((size_t)T.e * 1024 + 256 * (n >> 7) + (n & 127)) * D; }
    __device__ const bf16_t* brow2(const Tile& T, int n) const { return F.wtgu() + ((size_t)T.e * 1024 + 256 * (n >> 7) + 128 + (n & 127)) * D; }
    __device__ void store(const Tile& T, int row, int n, float g, float u) const { const int r = T.r0 + (row & 127); const float w = T.e < NE ? (r < T.n ? F.wl()[(size_t)T.e * NTOK + r] : 0.f) : 1.0f;
        F.hb()[(size_t)row * DE + n] = f2bf(g / (1.0f + __expf(-g)) * (u * w)); }
};
struct FnDown {
    static constexpr bool DUAL = false; struct Tile { int e, r0, n; }; const Frame& F; const LAS int* ps;
    __device__ int ntm() const { return PMAX / 128; } __device__ int ntn() const { return D / 64; } __device__ int K() const { return DE; }
    __device__ bool tile(int tm, Tile& T) const { const int row0 = tm * 128; if (row0 >= ps[64]) return false;
        int e = 0; while (e < NE - 1 && row0 >= ps[e + 1]) ++e;
        T.e = e; T.r0 = row0 - ps[e]; T.n = F.cnt()[e]; return T.r0 < T.n; }
    __device__ const bf16_t* arow(const Tile&, int row) const { return F.hb() + (size_t)row * DE; }
    __device__ const bf16_t* brow(const Tile& T, int n) const { return F.wtd() + ((size_t)T.e * D + n) * DE; }
    __device__ const bf16_t* brow2(const Tile&, int) const { return nullptr; }
    __device__ void store(const Tile& T, int row, int n, float a, float) const { const int r = T.r0 + (row & 127);
        (void)r; ((unsigned char*)F.ym())[(size_t)row * D + n] = (unsigned char)enc8(a); }
};
struct FnFinal {
    static constexpr bool DUAL = false; struct Tile {}; const Frame& F; const LAS int* ps;
    __device__ int ntm() const { return NTOK / 128; } __device__ int ntn() const { return D / 64; } __device__ int K() const { return DE; }
    __device__ bool tile(int, Tile&) const { return true; }
    __device__ const bf16_t* arow(const Tile&, int row) const { return F.hb() + (size_t)(PMAX + row) * DE; }
    __device__ const bf16_t* brow(const Tile&, int n) const { return F.wtd() + ((size_t)NE * D + n) * DE; }
    __device__ const bf16_t* brow2(const Tile&, int) const { return nullptr; }
    __device__ void store(const Tile&, int row, int n, float a, float) const {
        const float h1 = bf2f(F.h1()[(size_t)row * D + n]);
        F.o2()[(size_t)row * D + n] = f2bf(a + ALPHA * h1); }
};

__device__ __forceinline__ void phase_attn_simple(Frame& F) {
    LAS float* qs = (LAS float*)F.lds + F.wave * 512; LAS float* psm = qs + 64;
    const int gw = F.bx * 8 + F.wave, NGW = F.G * 8, lane = F.lane;
    for (int item = gw; item < NTOK * 32; item += NGW) {
        const int tok = item >> 5, hh = item & 31, b = tok >> 13, s = tok & 8191;
        const bool isA = hh < 16; const int h = hh & 15;
        const int qcol = isA ? COL_QA + h * 64 : COL_QB + h * 64, kcol = isA ? COL_KA + (h >> 2) * 64 : COL_KB + h * 64, vcol = isA ? COL_VA + (h >> 2) * 64 : COL_VB + h * 64;
        const int r = s >> 6, c = s & 63, rs = min(max(r - 4, 0), 120), cs = min(max(c - 8, 0), 48);
        const int nkeys = isA ? 16 + 257 : 16 + 128;
        asm volatile("s_waitcnt lgkmcnt(0)" ::: "memory");
        qs[lane] = bf2f(F.u()[(size_t)tok * INW + qcol + lane]);
        asm volatile("s_waitcnt lgkmcnt(0)" ::: "memory");
        float sc[5]; float mx = -INFINITY;
#pragma unroll
        for (int i = 0; i < 5; ++i) {
            const int j = lane + 64 * i; sc[i] = -INFINITY;
            if (j < nkeys) {
                int krow; float bias; bool valid = true;
                if (j < 16) { krow = NTOK + j; bias = isA ? F.t5[t5_bucket(j - 16 - s) * 16 + h] * LOG2E : 0.f; }
                else if (isA) { const int kpos = s - 128 + (j - 16); valid = kpos >= 0 && kpos < SEQ; krow = b * SEQ + kpos; bias = F.tab()[h * 272 + (j - 16)]; }
                else { const int w = j - 16, kr = rs + (w >> 4), kc = cs + (w & 15); krow = b * SEQ + kr * 64 + kc; bias = F.rpb[(h * 15 + (kr - r + 7)) * 31 + (kc - c + 15)] * LOG2E; }
                if (valid) { const bf16_t* kp = F.u() + (size_t)krow * INW + kcol; float dot = 0.f;
#pragma unroll
                    for (int d8 = 0; d8 < 8; ++d8) { const u32x4 kv = *(const u32x4*)(kp + d8 * 8);
#pragma unroll
                        for (int i2 = 0; i2 < 4; ++i2) { dot += qs[d8 * 8 + 2 * i2] * __uint_as_float(kv[i2] << 16); dot += qs[d8 * 8 + 2 * i2 + 1] * __uint_as_float(kv[i2] & 0xffff0000u); } }
                    sc[i] = dot + bias; }
            }
            mx = fmaxf(mx, sc[i]);
        }
        const float sinkl = isA ? F.sink[h] * LOG2E : -INFINITY;
        mx = fmaxf(wmax(mx), sinkl);
        float l = 0.f;
#pragma unroll
        for (int i = 0; i < 5; ++i) { const int j = lane + 64 * i; const float p = sc[i] == -INFINITY ? 0.f : exp2f(sc[i] - mx); l += p; if (j < 320) psm[j] = p; }
        l = wsum(l) + (isA ? exp2f(sinkl - mx) : 0.f);
        asm volatile("s_waitcnt lgkmcnt(0)" ::: "memory");
        float o = 0.f;
        for (int j = 0; j < nkeys; ++j) { const float p = psm[j]; if (p == 0.f) continue;
            int krow; if (j < 16) krow = NTOK + j; else if (isA) krow = b * SEQ + s - 128 + (j - 16); else { const int w = j - 16; krow = b * SEQ + (rs + (w >> 4)) * 64 + cs + (w & 15); }
            o += p * bf2f(F.u()[(size_t)krow * INW + vcol + lane]); }
        o /= l;
        const bf16_t ob = f2bf(o); F.ya()[(size_t)tok * D + hh * 64 + lane] = ob;
        const float of = bf2f(ob), q = wsum(of * of);
        if (lane == 0) F.ssq()[tok * 32 + hh] = q;
    }
}
__device__ __forceinline__ void phase_rmsnorm(Frame& F) {
    const int gw = F.bx * 8 + F.wave, NGW = F.G * 8, lane = F.lane;
    for (int tok = gw; tok < NTOK; tok += NGW) {
        const float q = lane < 32 ? F.ssq()[tok * 32 + lane] : 0.f;
        float qa = lane < 16 ? q : 0.f, qb = (lane >= 16 && lane < 32) ? q : 0.f; qa = wsum(qa); qb = wsum(qb);
        const float ra = 1.0f / sqrtf(qa * (1.0f / 1024.f) + RMS_EPS), rb = 1.0f / sqrtf(qb * (1.0f / 1024.f) + RMS_EPS);
        bf16_t* p = F.ya() + (size_t)tok * D;
#pragma unroll
        for (int j = 0; j < 8; ++j) { const int c = (j * 64 + lane) * 4; const float rr = c < 1024 ? ra : rb; u32x2 w = *(u32x2*)(p + c);
            w.x = pack2(__uint_as_float(w.x << 16) * rr, __uint_as_float(w.x & 0xffff0000u) * rr); w.y = pack2(__uint_as_float(w.y << 16) * rr, __uint_as_float(w.y & 0xffff0000u) * rr); *(u32x2*)(p + c) = w; }
    }
}

__device__ __forceinline__ void phase_ln1_router(Frame& F) {
    LAS float* hs = (LAS float*)F.lds + F.wave * 2048;
    const int gw = F.bx * 8 + F.wave, NGW = F.G * 8, lane = F.lane;
    for (int tok = gw; tok < NTOK; tok += NGW) {
        const bf16_t* src = F.z() + (size_t)tok * D; f32x4 v[8]; float s = 0.f;
#pragma unroll
        for (int j = 0; j < 8; ++j) { const u32x2 w = *(const u32x2*)(src + (j * 64 + lane) * 4); v[j] = (f32x4){__uint_as_float(w.x << 16), __uint_as_float(w.x & 0xffff0000u), __uint_as_float(w.y << 16), __uint_as_float(w.y & 0xffff0000u)}; s += (v[j][0] + v[j][1]) + (v[j][2] + v[j][3]); }
        const float mu = wsum(s) * (1.0f / D); float q = 0.f;
#pragma unroll
        for (int j = 0; j < 8; ++j) { const f32x4 d = v[j] - mu; q += (d[0] * d[0] + d[1] * d[1]) + (d[2] * d[2] + d[3] * d[3]); }
        const float rstd = 1.0f / sqrtf(wsum(q) * (1.0f / D) + LN_EPS);
        asm volatile("s_waitcnt lgkmcnt(0)" ::: "memory");
#pragma unroll
        for (int j = 0; j < 8; ++j) { const int c = (j * 64 + lane) * 4; const f32x4 g = *(const f32x4*)(F.l1g + c), bb = *(const f32x4*)(F.l1b + c); const f32x4 y = (v[j] - mu) * rstd * g + bb;
            *(u32x2*)(F.h1() + (size_t)tok * D + c) = (u32x2){pack2(y[0], y[1]), pack2(y[2], y[3])}; *(LAS f32x4*)(hs + c) = y; }
        if (lane == 0) { F.stats1()[tok * 2] = mu; F.stats1()[tok * 2 + 1] = rstd; }
        asm volatile("s_waitcnt lgkmcnt(0)" ::: "memory");
        float lg = 0.f;
#pragma unroll 8
        for (int n = 0; n < D; ++n) lg += hs[n] * F.w_router[(size_t)n * NE + lane];
        const float score = 1.0f / (1.0f + expf(-lg)), v0 = score + F.rbias[lane];
        int rk = 0;
#pragma unroll
        for (int j = 0; j < 8; ++j) { const int o = (lane & ~7) + j; const float w = __shfl(v0, o); rk += (w > v0 || (w == v0 && o < lane)) ? 1 : 0; }
        float gs = rk < 2 ? v0 : 0.f; gs += __shfl_xor(gs, 1); gs += __shfl_xor(gs, 2); gs += __shfl_xor(gs, 4);
        int grk = 0; const int myg = lane >> 3;
#pragma unroll
        for (int g = 0; g < 8; ++g) { const float w = __shfl(gs, g * 8); grk += (w > gs || (w == gs && g < myg)) ? 1 : 0; }
        const float mv = grk < 4 ? v0 : -INFINITY;
        int erk = 0;
        for (int o = 0; o < 64; ++o) { const float w = __shfl(mv, o); erk += (w > mv || (w == mv && o < lane)) ? 1 : 0; }
        const bool sel = erk < 8;
        const float wsm = wsum(sel ? score : 0.f), wgt = score / (wsm + 1e-20f) * 2.5f;
        if (sel) { const int rr = atomicAdd(F.cnt() + lane, 1); F.tokl()[(size_t)lane * NTOK + rr] = tok; F.wl()[(size_t)lane * NTOK + rr] = wgt; F.tke()[tok * 8 + erk] = lane; F.tkr()[tok * 8 + erk] = rr; }
    }
}
__device__ __forceinline__ void phase_ln2(Frame& F, const LAS int* ps) {
    const int gw = F.bx * 8 + F.wave, NGW = F.G * 8, lane = F.lane;
#pragma unroll 1
    for (int tok = gw; tok < NTOK; tok += NGW) {
        float* dst = F.out + (size_t)tok * D; const bf16_t* o2p = F.o2() + (size_t)tok * D; float v[2][16]; float s = 0.f;
        const int mye = F.tke()[tok * 8 + (lane & 7)], myr = F.tkr()[tok * 8 + (lane & 7)], mypos = ps[mye] + myr;
        u32x4 o[2][2];
#pragma unroll
        for (int k = 0; k < 2; ++k) { o[k][0] = *(const u32x4*)(o2p + (lane + 64 * k) * 16); o[k][1] = *(const u32x4*)(o2p + (lane + 64 * k) * 16 + 8); }
#pragma unroll
        for (int k = 0; k < 2; ++k)
#pragma unroll
            for (int h = 0; h < 2; ++h)
#pragma unroll
                for (int i = 0; i < 4; ++i) { v[k][8 * h + 2 * i] = __uint_as_float(o[k][h][i] << 16); v[k][8 * h + 2 * i + 1] = __uint_as_float(o[k][h][i] & 0xffff0000u); }
        u32x4 y[8][2];
#pragma unroll
        for (int j = 0; j < 8; ++j) { const int p = __shfl(mypos, j); const unsigned char* yp = (const unsigned char*)F.ym() + (size_t)p * D;
#pragma unroll
            for (int k = 0; k < 2; ++k) y[j][k] = *(const u32x4*)(yp + (lane + 64 * k) * 16); }
#pragma unroll
        for (int j = 0; j < 8; ++j)
#pragma unroll
            for (int k = 0; k < 2; ++k)
#pragma unroll
                for (int i = 0; i < 4; ++i) { unsigned w = y[j][k][i]; asm volatile("" : "+v"(w));
                    const unsigned w1 = w >> 8;
                    const unsigned p02 = ((w & 0x007f007fu) << 4) + 0x39003900u + ((w & 0x00800080u) << 8), p13 = ((w1 & 0x007f007fu) << 4) + 0x39003900u + ((w1 & 0x00800080u) << 8);
                    v[k][4 * i] += __uint_as_float(p02 << 16); v[k][4 * i + 2] += __uint_as_float(p02 & 0xffff0000u);
                    v[k][4 * i + 1] += __uint_as_float(p13 << 16); v[k][4 * i + 3] += __uint_as_float(p13 & 0xffff0000u);
                    asm volatile("" : "+v"(v[k][4 * i]), "+v"(v[k][4 * i + 1]), "+v"(v[k][4 * i + 2]), "+v"(v[k][4 * i + 3])); }
#pragma unroll
        for (int k = 0; k < 2; ++k)
#pragma unroll
            for (int i = 0; i < 16; ++i) s += v[k][i];
        const float mu = wsum(s) * (1.0f / D); float q = 0.f;
#pragma unroll
        for (int k = 0; k < 2; ++k)
#pragma unroll
            for (int i = 0; i < 16; ++i) { const float d = v[k][i] - mu; q += d * d; }
        const float rstd = 1.0f / sqrtf(wsum(q) * (1.0f / D) + LN_EPS);
        asm volatile("" ::: "memory");
#pragma unroll
        for (int k = 0; k < 2; ++k)
#pragma unroll
            for (int h = 0; h < 4; ++h) { const int c = (lane + 64 * k) * 16 + 4 * h; const f32x4 g = *(const f32x4*)(F.l2g + c), bb = *(const f32x4*)(F.l2b + c);
                *(f32x4*)(dst + c) = (f32x4){(v[k][4 * h] - mu) * rstd * g[0] + bb[0], (v[k][4 * h + 1] - mu) * rstd * g[1] + bb[1], (v[k][4 * h + 2] - mu) * rstd * g[2] + bb[2], (v[k][4 * h + 3] - mu) * rstd * g[3] + bb[3]}; }
    }
}

#ifndef FAST_P1
#define FAST_P1 1
#endif
#ifndef STAGGER7
#define STAGGER7 0
#endif
#ifndef CONV_NT
#define CONV_NT 1
#endif
#ifndef STAGGER4
#define STAGGER4 0
#endif
#ifndef XCD_TRUE
#define XCD_TRUE 1
#endif
#ifndef DOWN_REV
#define DOWN_REV false
#endif
#ifndef YM_NT
#define YM_NT 0
#endif
#ifndef FAST_P4
#define FAST_P4 1
#endif
#ifndef FAST_P6
#define FAST_P6 1
#endif
#ifndef FAST_P7
#define FAST_P7 1
#endif
namespace pg8 {
typedef short bf16x8 __attribute__((ext_vector_type(8)));
constexpr int BM = 256, BK = 64, HALF = 128, HTB = HALF * BK * 2, STAGE_BYTES = 8 * HTB, NXCD = 8, WGM = 8;
__host__ __device__ __forceinline__ int lds_byte(int r, int c) { const int st = (r >> 4) * 2 + (c >> 5), rr = r & 15, cc = c & 31, ob = rr * 64 + cc * 2; return st * 1024 + (ob ^ (((ob >> 9) & 1) << 5)); }
__host__ __device__ __forceinline__ void stage_rc(int b, int& R, int& C) { const int st = b / 1024, sb = b % 1024, swz = sb ^ (((sb >> 9) & 1) << 5); R = (st >> 1) * 16 + swz / 64; C = (st & 1) * 32 + (swz % 64) / 2; }
__host__ __device__ __forceinline__ int perm32(int rho) { const int n = rho >> 4, i = rho & 15; return 8 * (i >> 2) + 4 * n + (i & 3); }
__device__ __forceinline__ unsigned cvt_pk_bf16(float lo, float hi) { unsigned r; asm volatile("v_cvt_pk_bf16_f32 %0, %1, %2" : "=v"(r) : "v"(lo), "v"(hi)); return r; }
struct Unit { int pm, pn, e, r0, n, orow, tb; };
__device__ __forceinline__ int xcd_remap(int L, int nwg) { const int q = nwg / NXCD, r = nwg % NXCD, xcd = L % NXCD, off = L / NXCD; return (xcd < r ? xcd * (q + 1) : r * (q + 1) + (xcd - r) * q) + off; }
__device__ __forceinline__ void tile_of(int wgid, int nM, int nN, int& pm, int& pn) { const int nig = WGM * nN, gid = wgid / nig, fm = gid * WGM, gsz = (nM - fm) < WGM ? (nM - fm) : WGM; pm = fm + ((wgid % nig) % gsz); pn = (wgid % nig) / gsz; }

template <class Epi, class Sched>
__device__ __forceinline__ void gemm_phase(LAS unsigned char* lds, const Sched& S, const Epi& E, const int lda, const int ldb, const int nt, const int stagger_ticks = 0) {
    int tid = threadIdx.x; asm volatile("" : "+v"(tid));
    const int wid = __builtin_amdgcn_readfirstlane(tid >> 6), lane = tid & 63, wr = wid >> 2, wc = wid & 3, fr = lane & 15, fq = lane >> 4;
    unsigned voffA[2], voffB[2], voffB2[2], c2[2]; int RA[2];
#pragma unroll
    for (int i = 0; i < 2; ++i) { int R, C; stage_rc(tid * 16 + i * 8192, R, C); const int Rb = Epi::PERM ? ((R & ~31) + perm32(R & 31)) : R;
        voffA[i] = (unsigned)(R * lda + C) * 2u; voffB[i] = (unsigned)(Rb * ldb + C) * 2u; RA[i] = R; c2[i] = (unsigned)C * 2u;
        voffB2[i] = (unsigned)((64 * (R >> 5) + 16 * ((R >> 2) & 3) + 4 * ((R >> 4) & 1) + (R & 3)) * ldb + C) * 2u; }
    const size_t kstep = (size_t)(BK * 2), hstepA = (size_t)HALF * lda * 2, hstepB = (size_t)HALF * ldb * 2, hstepB2 = (size_t)8 * ldb * 2;
    const unsigned lda2 = (unsigned)lda * 2u;
    const unsigned ldsw = (unsigned)wid * 1024u;
    const int aoff = lds_byte(wr * 64 + fr, fq * 8), boff = lds_byte(wc * 32 + fr, fq * 8);
#define PG8_SA(b, h) (((b) * 2 + (h)) * HTB)
#define PG8_SB(b, h) ((4 + (b) * 2 + (h)) * HTB)
#define PG8_STAGE(bufoff, gbase, voff) do { _Pragma("unroll") for (int _i = 0; _i < 2; ++_i) \
        __builtin_amdgcn_global_load_lds((const unsigned*)((const char*)(gbase) + (voff)[_i]), (LAS unsigned*)(lds + (bufoff) + ldsw + _i * 8192), 16, 0, 0); } while (0)
#define PG8_STG_A(bufoff, p, h, V) do { if constexpr (Sched::GATHER) { PG8_STAGE(bufoff, p, V[h]); } else { PG8_STAGE(bufoff, (p) + (h) * hstepA, voffA); } } while (0)
#define PG8_STG_B(bufoff, p, h) do { if constexpr (Epi::PERM2) { PG8_STAGE(bufoff, (p) + (h) * hstepB2, voffB2); } else { PG8_STAGE(bufoff, (p) + (h) * hstepB, voffB); } } while (0)
#define PG8_LDA(dst, b, h) do { _Pragma("unroll") for (int m = 0; m < 4; ++m) _Pragma("unroll") for (int k = 0; k < 2; ++k) dst[m][k] = *(const LAS bf16x8*)(lds + PG8_SA(b, h) + aoff + m * 2048 + k * 1024); } while (0)
#define PG8_LDB(dst, b, h) do { _Pragma("unroll") for (int n = 0; n < 2; ++n) _Pragma("unroll") for (int k = 0; k < 2; ++k) dst[n][k] = *(const LAS bf16x8*)(lds + PG8_SB(b, h) + boff + n * 2048 + k * 1024); } while (0)
#define PG8_MMA(ai, bj, At, Bt) do { __builtin_amdgcn_s_setprio(1); _Pragma("unroll") for (int m = 0; m < 4; ++m) _Pragma("unroll") for (int n = 0; n < 2; ++n) _Pragma("unroll") for (int k = 0; k < 2; ++k) \
        acc[ai][bj][m][n] = __builtin_amdgcn_mfma_f32_16x16x32_bf16(Bt[n][k], At[m][k], acc[ai][bj][m][n], 0, 0, 0); __builtin_amdgcn_s_setprio(0); } while (0)
#define PG8_WAIT_V(n) asm volatile("s_waitcnt vmcnt(" #n ")" ::: "memory")
#define PG8_WAIT_L(n) asm volatile("s_waitcnt lgkmcnt(" #n ")" ::: "memory")
#define PG8_BAR __builtin_amdgcn_s_barrier()
#define PG8_SCHED __builtin_amdgcn_sched_barrier(0)
    Unit cur, nxt; int ui = 0;
    if (stagger_ticks) {
        const unsigned long long t0 = __builtin_amdgcn_s_memrealtime(), dl = (unsigned long long)((blockIdx.x >> 3) & 15) * (unsigned)stagger_ticks;
        while (__builtin_amdgcn_s_memrealtime() - t0 < dl) __builtin_amdgcn_s_sleep(4);
        __syncthreads(); }
    if (!S.next(0, cur)) return;
    cur.tb = 0;
    f32x4 acc[2][2][4][2];
#pragma unroll
    for (int a = 0; a < 2; ++a)
#pragma unroll
        for (int b = 0; b < 2; ++b)
#pragma unroll
            for (int m = 0; m < 4; ++m)
#pragma unroll
                for (int n = 0; n < 2; ++n) acc[a][b][m][n] = (f32x4){0.f, 0.f, 0.f, 0.f};
    bf16x8 At[4][2], B0[2][2], B1[2][2];
    unsigned vac[2][2], van[2][2]; int raw[2][2];
    const char* cA = S.abase(cur); const char* cB = S.bbase(cur);
#pragma unroll
    for (int h = 0; h < 2; ++h)
#pragma unroll
        for (int i = 0; i < 2; ++i) { vac[h][i] = Sched::GATHER ? (unsigned)S.arow(cur, h * HALF + RA[i]) * lda2 + c2[i] : 0u; van[h][i] = vac[h][i]; raw[h][i] = 0; }
    PG8_STG_B(PG8_SB(0, 0), cB, 0); PG8_STG_B(PG8_SB(0, 1), cB, 1); PG8_STG_A(PG8_SA(0, 0), cA, 0, vac); PG8_STG_A(PG8_SA(0, 1), cA, 1, vac);
    if (wr == 1) PG8_BAR;
    PG8_WAIT_V(2); PG8_BAR;
    PG8_STG_B(PG8_SB(1, 0), cB + kstep, 0); PG8_STG_A(PG8_SA(1, 0), cA + kstep, 0, vac); PG8_STG_B(PG8_SB(1, 1), cB + kstep, 1);
    PG8_WAIT_V(6); PG8_BAR;
    for (;;) {
        const bool has_next = S.next(ui + 1, nxt); nxt.tb = (ui + 1) & 1;
        if constexpr (Epi::MIDK) E.unit_begin(cur, tid);
        const char* nA = has_next ? S.abase(nxt) : cA; const char* nB = has_next ? S.bbase(nxt) : cB;
        if constexpr (Sched::GATHER) { if (has_next) {
#pragma unroll
            for (int h = 0; h < 2; ++h)
#pragma unroll
                for (int i = 0; i < 2; ++i) raw[h][i] = S.arow(nxt, h * HALF + RA[i]); } }
        for (int t = 0; t < nt; t += 2) {
            const bool last = (t == nt - 2);
            const char* a1 = cA + (size_t)(t + 1) * kstep;
            const char* a2 = last ? nA : cA + (size_t)(t + 2) * kstep; const char* b2 = last ? nB : cB + (size_t)(t + 2) * kstep;
            const char* a3 = a2 + kstep; const char* b3 = b2 + kstep;
            unsigned va2[2][2];
#pragma unroll
            for (int h = 0; h < 2; ++h)
#pragma unroll
                for (int i = 0; i < 2; ++i) va2[h][i] = last ? van[h][i] : vac[h][i];
            PG8_LDB(B0, 0, 0); PG8_LDB(B1, 0, 1); PG8_SCHED; PG8_LDA(At, 0, 0); PG8_STG_A(PG8_SA(1, 1), a1, 1, vac);
            PG8_WAIT_V(8); PG8_WAIT_L(0); PG8_BAR; PG8_MMA(0, 0, At, B0); PG8_MMA(0, 1, At, B1); PG8_BAR; PG8_SCHED;
            PG8_LDA(At, 0, 1); PG8_STG_B(PG8_SB(0, 0), b2, 0); PG8_STG_B(PG8_SB(0, 1), b2, 1); PG8_STG_A(PG8_SA(0, 0), a2, 0, va2);
            PG8_WAIT_V(8); PG8_WAIT_L(0); PG8_BAR; PG8_MMA(1, 0, At, B0); PG8_MMA(1, 1, At, B1); PG8_BAR; PG8_SCHED;
            PG8_LDB(B0, 1, 0); PG8_LDB(B1, 1, 1); PG8_SCHED; PG8_LDA(At, 1, 0); PG8_STG_A(PG8_SA(0, 1), a2, 1, va2);
            PG8_WAIT_V(8); PG8_WAIT_L(0); PG8_BAR; PG8_MMA(0, 0, At, B0); PG8_MMA(0, 1, At, B1); PG8_BAR; PG8_SCHED;
            PG8_LDA(At, 1, 1); PG8_STG_B(PG8_SB(1, 0), b3, 0); PG8_STG_B(PG8_SB(1, 1), b3, 1); PG8_STG_A(PG8_SA(1, 0), a3, 0, va2);
            PG8_WAIT_V(8); PG8_WAIT_L(0); PG8_BAR; PG8_MMA(1, 0, At, B0); PG8_MMA(1, 1, At, B1); PG8_BAR; PG8_SCHED;
            if constexpr (Epi::MIDK) { if (2 * (t + 2) == nt) E.mid(acc, cur, wr, fr); }
            if constexpr (Sched::GATHER) { if (t + 4 == nt && has_next) {
#pragma unroll
                for (int h = 0; h < 2; ++h)
#pragma unroll
                    for (int i = 0; i < 2; ++i) { asm volatile("" : "+v"(raw[h][i])); van[h][i] = (unsigned)raw[h][i] * lda2 + c2[i]; } } }
        }
        if (wr == 0) PG8_BAR;
        E(acc, cur, wr, wc, fr, fq);
        if (!has_next) break;
#pragma unroll
        for (int a = 0; a < 2; ++a)
#pragma unroll
            for (int b = 0; b < 2; ++b)
#pragma unroll
                for (int m = 0; m < 4; ++m)
#pragma unroll
                    for (int n = 0; n < 2; ++n) acc[a][b][m][n] = (f32x4){0.f, 0.f, 0.f, 0.f};
        cur = nxt; cA = nA; cB = nB; ++ui;
#pragma unroll
        for (int h = 0; h < 2; ++h)
#pragma unroll
            for (int i = 0; i < 2; ++i) vac[h][i] = van[h][i];
        if (wr == 1) PG8_BAR;
    }
    PG8_WAIT_V(0);
    PG8_BAR;
#undef PG8_SA
#undef PG8_SB
#undef PG8_STAGE
#undef PG8_STG_A
#undef PG8_STG_B
#undef PG8_LDA
#undef PG8_LDB
#undef PG8_MMA
#undef PG8_WAIT_V
#undef PG8_WAIT_L
#undef PG8_BAR
#undef PG8_SCHED
}
}

struct SchedInProj {
    static constexpr bool GATHER = false; const char* A; const char* B; int G, c, i0, i1;
    __device__ __forceinline__ bool next(int i, pg8::Unit& u) const { const int ii = i0 + i; if (ii >= i1) return false; const int L = ii * G + c; if (L >= 1162) return false;
        if (L < 1152) pg8::tile_of(pg8::xcd_remap(L, 1152), 64, 18, u.pm, u.pn); else { const int k = L - 1152; u.pm = 64; u.pn = k < 2 ? 4 + k : 8 + k; }
        return true; }
    __device__ __forceinline__ const char* abase(const pg8::Unit& u) const { return A + (size_t)u.pm * 256 * D * 2; }
    __device__ __forceinline__ const char* bbase(const pg8::Unit& u) const { return B + (size_t)u.pn * 256 * D * 2; }
    __device__ __forceinline__ int arow(const pg8::Unit&, int) const { return 0; }
};
struct SchedOutProj {
    static constexpr bool GATHER = false; const char* A; const char* B; int G, c;
    __device__ __forceinline__ bool next(int i, pg8::Unit& u) const { const int L = i * G + c; if (L >= 512) return false; pg8::tile_of(pg8::xcd_remap(L, 512), 64, 8, u.pm, u.pn); return true; }
    __device__ __forceinline__ const char* abase(const pg8::Unit& u) const { return A + (size_t)u.pm * 256 * D * 2; }
    __device__ __forceinline__ const char* bbase(const pg8::Unit& u) const { return B + (size_t)u.pn * 256 * D * 2; }
    __device__ __forceinline__ int arow(const pg8::Unit&, int) const { return 0; }
};
__device__ __forceinline__ void moe_tables(const Frame& F, LAS int* ps) {
    if (F.tid < NE) ps[256 + F.tid] = F.cnt()[F.tid];
    __syncthreads();
    if (F.tid == 0) { int acc = 0, ta = 0; for (int e = 0; e < NE; ++e) { const int mt = (ps[256 + e] + 255) >> 8; ps[e] = acc; ps[128 + e] = ta; acc += mt * 256; ta += mt; }
        ps[64] = acc; ps[128 + 64] = ta; ps[128 + 65] = ta + NTOK / 256; ps[256 + 64] = NTOK; }
    __syncthreads();
    for (int t = F.tid; t < 640; t += 512) { int e = 0; while (e < NE && t >= ps[128 + e + 1]) ++e; ps[384 + t] = e; }
    __syncthreads();
}
template <int NN, bool REV> __device__ __forceinline__ bool moe_unit(const LAS int* ps, int L, pg8::Unit& u, int noshared = 0) {
    const int nU = (noshared ? ps[128 + 64] : ps[128 + 65]) * NN; if (L >= nU) return false;
    const int wg0 = pg8::xcd_remap(L, nU), wg = REV ? nU - 1 - wg0 : wg0, tile = wg / NN; u.pn = wg % NN;
    const int e = ps[384 + tile]; u.e = e; u.pm = tile - ps[128 + e]; u.r0 = u.pm * 256; u.n = ps[256 + e];
    u.orow = (e < NE ? ps[e] : PMAX) + u.r0;
    return true; }
struct SchedGU {
    static constexpr bool GATHER = true; const char* A; const char* B; const int* tokl; const int* cnt; const LAS int* ps; int G, c;
    __device__ __forceinline__ bool next(int i, pg8::Unit& u) const { return moe_unit<4, false>(ps, i * G + c, u); }
    __device__ __forceinline__ const char* abase(const pg8::Unit&) const { return A; }
    __device__ __forceinline__ const char* bbase(const pg8::Unit& u) const { return B + ((size_t)u.e * 1024 + u.pn * 256) * D * 2; }
    __device__ __forceinline__ int arow(const pg8::Unit& u, int r) const { const int rr = min(u.r0 + r, u.n - 1); return u.e < NE ? tokl[(size_t)u.e * NTOK + rr] : rr; }
};
struct SchedDown {
    static constexpr bool GATHER = false; const char* A; const char* B; const int* cnt; const LAS int* ps; int G, c; int hot;
    __device__ __forceinline__ bool next(int i, pg8::Unit& u) const { return moe_unit<8, DOWN_REV>(ps, i * G + c, u, 1); }
    __device__ __forceinline__ const char* abase(const pg8::Unit& u) const { return A + (size_t)(((hot & 1) && u.e < NE) ? (u.orow & 0x3ff) : u.orow) * DE * 2; }
    __device__ __forceinline__ const char* bbase(const pg8::Unit& u) const { return B + ((size_t)(((hot & 1) && u.e < NE) ? 0 : u.e) * D + u.pn * 256) * DE * 2; }
    __device__ __forceinline__ int arow(const pg8::Unit&, int) const { return 0; }
};
struct SchedDownShared {
    static constexpr bool GATHER = false; const char* A; const char* B; int G, c;
    __device__ __forceinline__ bool next(int i, pg8::Unit& u) const { const int L = i * G + c; if (L >= 512) return false; pg8::tile_of(pg8::xcd_remap(L, 512), 64, 8, u.pm, u.pn);
        u.e = NE; u.r0 = u.pm * 256; u.n = NTOK; u.orow = PMAX + u.r0; return true; }
    __device__ __forceinline__ const char* abase(const pg8::Unit& u) const { return A + (size_t)u.orow * DE * 2; }
    __device__ __forceinline__ const char* bbase(const pg8::Unit& u) const { return B + ((size_t)NE * D + u.pn * 256) * DE * 2; }
    __device__ __forceinline__ int arow(const pg8::Unit&, int) const { return 0; }
};
struct EpiU {
    static constexpr bool PERM2 = false; static constexpr bool MIDK = false; static constexpr bool PERM = true; bf16_t* U; int nostore;
    __device__ __forceinline__ void operator()(const f32x4 (&acc)[2][2][4][2], const pg8::Unit& u, int wr, int wc, int fr, int fq) const {
        const int row0 = u.pm * 256 + wr * 64 + fr, col0 = u.pn * 256 + wc * 32 + 8 * fq;
        if (nostore) {
#pragma unroll
            for (int ai = 0; ai < 2; ++ai)
#pragma unroll
                for (int bj = 0; bj < 2; ++bj)
#pragma unroll
                    for (int m = 0; m < 4; ++m)
#pragma unroll
                        for (int n = 0; n < 2; ++n) asm volatile("" :: "v"(acc[ai][bj][m][n]));
            return; }
#pragma unroll
        for (int ai = 0; ai < 2; ++ai)
#pragma unroll
            for (int m = 0; m < 4; ++m) { bf16_t* rowp = U + (size_t)(row0 + ai * 128 + m * 16) * INW + col0;
#pragma unroll
                for (int bj = 0; bj < 2; ++bj) { const f32x4 v0 = acc[ai][bj][m][0], v1 = acc[ai][bj][m][1]; u32x4 w;
                    w.x = pg8::cvt_pk_bf16(v0[0], v0[1]); w.y = pg8::cvt_pk_bf16(v0[2], v0[3]); w.z = pg8::cvt_pk_bf16(v1[0], v1[1]); w.w = pg8::cvt_pk_bf16(v1[2], v1[3]);
                    *(u32x4*)(rowp + bj * 128) = w; } }
    }
};
struct EpiZ {
    static constexpr bool PERM2 = false; static constexpr bool MIDK = true; static constexpr bool PERM = true; bf16_t* Z; const bf16_t* H0; const float* ssq; LAS float* tab;
    __device__ __forceinline__ void unit_begin(const pg8::Unit& u, int tid) const {
        const int row = tid >> 1, grp = tid & 1; const float* p = ssq + (size_t)(u.pm * 256 + row) * 32 + 16 * grp;
        const f32x4 a = *(const f32x4*)p, b4 = *(const f32x4*)(p + 4), c = *(const f32x4*)(p + 8), d = *(const f32x4*)(p + 12);
        const float s = (((a[0] + a[1]) + (a[2] + a[3])) + ((b4[0] + b4[1]) + (b4[2] + b4[3]))) + (((c[0] + c[1]) + (c[2] + c[3])) + ((d[0] + d[1]) + (d[2] + d[3])));
        tab[(u.tb * 256 + row) * 2 + grp] = 1.0f / sqrtf(s * (1.0f / 1024.f) + RMS_EPS);
    }
    __device__ __forceinline__ void mid(f32x4 (&acc)[2][2][4][2], const pg8::Unit& u, int wr, int fr) const {
#pragma unroll
        for (int ai = 0; ai < 2; ++ai)
#pragma unroll
            for (int m = 0; m < 4; ++m) { const int r = ai * 128 + wr * 64 + m * 16 + fr; const float f = tab[(u.tb * 256 + r) * 2] / tab[(u.tb * 256 + r) * 2 + 1];
#pragma unroll
                for (int bj = 0; bj < 2; ++bj)
#pragma unroll
                    for (int n = 0; n < 2; ++n) acc[ai][bj][m][n] *= f; }
    }
    __device__ __forceinline__ void operator()(const f32x4 (&acc)[2][2][4][2], const pg8::Unit& u, int wr, int wc, int fr, int fq) const {
        const int row0 = u.pm * 256 + wr * 64 + fr, col0 = u.pn * 256 + wc * 32 + 8 * fq;
#pragma unroll
        for (int am = 0; am < 4; ++am) {
            u32x4 hv[2][2]; float rb[2];
#pragma unroll
            for (int q = 0; q < 2; ++q) { const int ai = am >> 1, m = (am & 1) * 2 + q; const size_t off = (size_t)(row0 + ai * 128 + m * 16) * D + col0;
                rb[q] = tab[(u.tb * 256 + ai * 128 + wr * 64 + m * 16 + fr) * 2 + 1];
#pragma unroll
                for (int bj = 0; bj < 2; ++bj) hv[q][bj] = *(const u32x4*)(H0 + off + bj * 128); }
#pragma unroll
            for (int q = 0; q < 2; ++q) { const int ai = am >> 1, m = (am & 1) * 2 + q; const size_t off = (size_t)(row0 + ai * 128 + m * 16) * D + col0;
#pragma unroll
                for (int bj = 0; bj < 2; ++bj) { const u32x4 h4 = hv[q][bj];
                    const f32x4 h0v = (f32x4){__uint_as_float(h4.x << 16), __uint_as_float(h4.x & 0xffff0000u), __uint_as_float(h4.y << 16), __uint_as_float(h4.y & 0xffff0000u)};
                    const f32x4 h1v = (f32x4){__uint_as_float(h4.z << 16), __uint_as_float(h4.z & 0xffff0000u), __uint_as_float(h4.w << 16), __uint_as_float(h4.w & 0xffff0000u)};
                    const f32x4 v0 = acc[ai][bj][m][0] * rb[q] + h0v * ALPHA, v1 = acc[ai][bj][m][1] * rb[q] + h1v * ALPHA; u32x4 w;
                    w.x = pg8::cvt_pk_bf16(v0[0], v0[1]); w.y = pg8::cvt_pk_bf16(v0[2], v0[3]); w.z = pg8::cvt_pk_bf16(v1[0], v1[1]); w.w = pg8::cvt_pk_bf16(v1[2], v1[3]);
                    *(u32x4*)(Z + off + bj * 128) = w; } }
            asm volatile("" ::: "memory"); }
    }
};
__device__ __forceinline__ float silu_mul(float g, float u) { return g * __builtin_amdgcn_rcpf(1.0f + __builtin_amdgcn_exp2f(-g * LOG2E)) * u; }
struct EpiGU {
    static constexpr bool PERM2 = false; static constexpr bool MIDK = false; static constexpr bool PERM = true; bf16_t* H; const float* wl;
    __device__ __forceinline__ void operator()(const f32x4 (&acc)[2][2][4][2], const pg8::Unit& u, int wr, int wc, int fr, int fq) const {
        const int rl0 = wr * 64 + fr, col0 = u.pn * 128 + wc * 32 + 8 * fq;
        float wv[2][4];
#pragma unroll
        for (int ai = 0; ai < 2; ++ai)
#pragma unroll
            for (int m = 0; m < 4; ++m) { const int r = u.r0 + rl0 + ai * 128 + m * 16; wv[ai][m] = u.e < NE ? (r < u.n ? wl[(size_t)u.e * NTOK + r] : 0.f) : 1.0f; }
#pragma unroll
        for (int ai = 0; ai < 2; ++ai)
#pragma unroll
            for (int m = 0; m < 4; ++m) { const f32x4 g0 = acc[ai][0][m][0], g1 = acc[ai][0][m][1], u0 = acc[ai][1][m][0] * wv[ai][m], u1 = acc[ai][1][m][1] * wv[ai][m]; u32x4 w;
                w.x = pg8::cvt_pk_bf16(silu_mul(g0[0], u0[0]), silu_mul(g0[1], u0[1])); w.y = pg8::cvt_pk_bf16(silu_mul(g0[2], u0[2]), silu_mul(g0[3], u0[3]));
                w.z = pg8::cvt_pk_bf16(silu_mul(g1[0], u1[0]), silu_mul(g1[1], u1[1])); w.w = pg8::cvt_pk_bf16(silu_mul(g1[2], u1[2]), silu_mul(g1[3], u1[3]));
                *(u32x4*)(H + (size_t)(u.orow + rl0 + ai * 128 + m * 16) * DE + col0) = w; }
    }
};
struct EpiDownR {
    static constexpr bool PERM2 = true; static constexpr bool MIDK = false; static constexpr bool PERM = true; unsigned char* Y; int nostore;
    __device__ __forceinline__ void operator()(const f32x4 (&acc)[2][2][4][2], const pg8::Unit& u, int wr, int wc, int fr, int fq) const {
        const int rl0 = wr * 64 + fr, col0 = u.pn * 256 + wc * 64 + 16 * fq;
        if (nostore) {
#pragma unroll
            for (int ai = 0; ai < 2; ++ai)
#pragma unroll
                for (int bj = 0; bj < 2; ++bj)
#pragma unroll
                    for (int m = 0; m < 4; ++m)
#pragma unroll
                        for (int n = 0; n < 2; ++n) asm volatile("" :: "v"(acc[ai][bj][m][n]));
            return; }
#pragma unroll
        for (int ai = 0; ai < 2; ++ai)
#pragma unroll
            for (int m = 0; m < 4; ++m) { const int rl = rl0 + ai * 128 + m * 16; if (u.r0 + rl >= u.n) continue;
                f32x4 a0 = acc[ai][0][m][0], a1 = acc[ai][0][m][1], b0 = acc[ai][1][m][0], b1 = acc[ai][1][m][1];
                asm volatile("" : "+v"(a0), "+v"(a1), "+v"(b0), "+v"(b1));
                const u32x4 q = (u32x4){enc8x4(a0[0], a0[1], a0[2], a0[3]), enc8x4(a1[0], a1[1], a1[2], a1[3]), enc8x4(b0[0], b0[1], b0[2], b0[3]), enc8x4(b1[0], b1[1], b1[2], b1[3])};
                *(u32x4*)(Y + (size_t)(u.orow + rl) * D + col0) = q;
                asm volatile("" ::: "memory"); }
    }
};
struct EpiDownS {
    static constexpr bool PERM2 = false; static constexpr bool MIDK = false; static constexpr bool PERM = true; bf16_t* O; const bf16_t* H1;
    __device__ __forceinline__ void operator()(const f32x4 (&acc)[2][2][4][2], const pg8::Unit& u, int wr, int wc, int fr, int fq) const {
        const int rl0 = wr * 64 + fr, col0 = u.pn * 256 + wc * 32 + 8 * fq;
#pragma unroll
        for (int am = 0; am < 4; ++am) {
            u32x4 hv[2][2];
#pragma unroll
            for (int q = 0; q < 2; ++q) { const int ai = am >> 1, m = (am & 1) * 2 + q; const size_t off = (size_t)(u.r0 + rl0 + ai * 128 + m * 16) * D + col0;
#pragma unroll
                for (int bj = 0; bj < 2; ++bj) hv[q][bj] = *(const u32x4*)(H1 + off + bj * 128); }
#pragma unroll
            for (int q = 0; q < 2; ++q) { const int ai = am >> 1, m = (am & 1) * 2 + q; const size_t off = (size_t)(u.r0 + rl0 + ai * 128 + m * 16) * D + col0;
#pragma unroll
                for (int bj = 0; bj < 2; ++bj) { const u32x4 h4 = hv[q][bj];
                    const f32x4 h0v = (f32x4){__uint_as_float(h4.x << 16), __uint_as_float(h4.x & 0xffff0000u), __uint_as_float(h4.y << 16), __uint_as_float(h4.y & 0xffff0000u)};
                    const f32x4 h1v = (f32x4){__uint_as_float(h4.z << 16), __uint_as_float(h4.z & 0xffff0000u), __uint_as_float(h4.w << 16), __uint_as_float(h4.w & 0xffff0000u)};
                    const f32x4 v0 = acc[ai][bj][m][0] + h0v * ALPHA, v1 = acc[ai][bj][m][1] + h1v * ALPHA; u32x4 w;
                    w.x = pg8::cvt_pk_bf16(v0[0], v0[1]); w.y = pg8::cvt_pk_bf16(v0[2], v0[3]); w.z = pg8::cvt_pk_bf16(v1[0], v1[1]); w.w = pg8::cvt_pk_bf16(v1[2], v1[3]);
                    *(u32x4*)(O + off + bj * 128) = w; } }
            asm volatile("" ::: "memory"); }
    }
};

#ifndef FAST_P2
#define FAST_P2 1
#endif
namespace att {
typedef short bf16x8 __attribute__((ext_vector_type(8)));
typedef short s16x4 __attribute__((ext_vector_type(4)));
typedef float f32x16 __attribute__((ext_vector_type(16)));
typedef LAS const char* lds_cptr;
constexpr int SLOT = 16384, NSLOT = 6, RING = NSLOT * SLOT;
constexpr int TA_W = 452, TA_OFF = 224;
constexpr int TB_W = 468;
constexpr int OFF_TABA = RING, OFF_TABB = OFF_TABA, OFF_WS = OFF_TABA + 4 * TA_W * 4, OFF_OST = OFF_WS + 8 * 256, ATT_LDS = OFF_OST + 8 * 4096;
static_assert(ATT_LDS <= LDS_BYTES - 16 - 1024, "attention LDS map");
constexpr float NEGB = -1e30f, THR = 8.0f;
#define ATT_MFMA(a, b, c) __builtin_amdgcn_mfma_f32_32x32x16_bf16(a, b, c, 0, 0, 0)
__device__ __forceinline__ int crow(int r, int hi) { return (r & 3) + 8 * (r >> 2) + 4 * hi; }
__device__ __forceinline__ s16x4 vtr(lds_cptr p) { typedef short v4i16_t __attribute__((ext_vector_type(4))); return __builtin_bit_cast(s16x4, __builtin_amdgcn_ds_read_tr16_b64_v4i16((LAS v4i16_t*)p)); }
__device__ __forceinline__ float swapmax(float m) { auto rr = __builtin_amdgcn_permlane32_swap(__float_as_uint(m), __float_as_uint(m), false, false); return fmaxf(__uint_as_float(rr[0]), __uint_as_float(rr[1])); }
__device__ __forceinline__ float swapsum(float m) { auto rr = __builtin_amdgcn_permlane32_swap(__float_as_uint(m), __float_as_uint(m), false, false); return __uint_as_float(rr[0]) + __uint_as_float(rr[1]); }

__device__ __forceinline__ float bf16r(float x) { return __uint_as_float(pg8::cvt_pk_bf16(x, 0.f) << 16); }
__device__ __forceinline__ bf16x8 frag_k0(unsigned bits16, int hi) { const u32x4 w = (u32x4){hi == 0 ? bits16 : 0u, 0u, 0u, 0u}; return __builtin_bit_cast(bf16x8, w); }
template <int NH, int NS, class BiasFn>
__device__ __forceinline__ void tile_qb(const bf16x8 (&kf)[8], const bf16x8 (&qr)[4], bf16x8& mq, const bf16x8& ones, lds_cptr vp, f32x16 (&o)[2], float& m, float& l, LAS float* wsf, int r32, int hi, const BiasFn& bias) {
    f32x16 c[NH];
#pragma unroll
    for (int hf = 0; hf < NH; ++hf)
#pragma unroll
        for (int r = 0; r < 16; ++r) c[hf][r] = bias(hf, r);
    s16x4 vlo[NS][2], vhi[NS][2];
#pragma unroll
    for (int dh = 0; dh < 2; ++dh) { vlo[0][dh] = vtr(vp + dh * 4096); vhi[0][dh] = vtr(vp + dh * 4096 + 512); }
    __builtin_amdgcn_sched_barrier(0);
#pragma unroll
    for (int hf = 0; hf < NH; ++hf) { c[hf] = ATT_MFMA(ones, mq, c[hf]);
#pragma unroll
        for (int d0 = 0; d0 < 4; ++d0) c[hf] = ATT_MFMA(kf[2 * d0 + hf], qr[d0], c[hf]); }
    float mx = NEGB;
#pragma unroll
    for (int hf = 0; hf < NH; ++hf)
#pragma unroll
        for (int r = 0; r < 16; ++r) mx = fmaxf(mx, c[hf][r]);
    mx = swapmax(mx);
    if (__any(mx > THR)) {
        const float mn = bf16r(m + fmaxf(mx, 0.f)), dl = mn - m, f = __builtin_amdgcn_exp2f(-dl); m = mn; l *= f;
        mq = frag_k0(__float_as_uint(-mn) >> 16, hi);
        if (hi == 0) wsf[r32] = f;
        asm volatile("s_waitcnt lgkmcnt(0)" ::: "memory");
#pragma unroll
        for (int r = 0; r < 16; ++r) { const float fr = wsf[crow(r, hi)]; o[0][r] *= fr; o[1][r] *= fr; }
#pragma unroll
        for (int hf = 0; hf < NH; ++hf)
#pragma unroll
            for (int r = 0; r < 16; ++r) c[hf][r] -= dl;
    }
#pragma unroll
    for (int s = 1; s < NS; ++s)
#pragma unroll
        for (int dh = 0; dh < 2; ++dh) { vlo[s][dh] = vtr(vp + dh * 4096 + s * 1024); vhi[s][dh] = vtr(vp + dh * 4096 + s * 1024 + 512); }
    __builtin_amdgcn_sched_barrier(0);
    float ls = 0.f;
#pragma unroll
    for (int hf = 0; hf < NH; ++hf)
#pragma unroll
        for (int r = 0; r < 16; ++r) { c[hf][r] = __builtin_amdgcn_exp2f(c[hf][r]); ls += c[hf][r]; }
    l += ls;
#pragma unroll
    for (int s = 0; s < NS; ++s) {
        const f32x16& cc = c[s >> 1]; const int rb = (s & 1) * 8;
        u32x4 pw; pw.x = pg8::cvt_pk_bf16(cc[rb + 0], cc[rb + 1]); pw.y = pg8::cvt_pk_bf16(cc[rb + 2], cc[rb + 3]); pw.z = pg8::cvt_pk_bf16(cc[rb + 4], cc[rb + 5]); pw.w = pg8::cvt_pk_bf16(cc[rb + 6], cc[rb + 7]);
        const bf16x8 pa = __builtin_bit_cast(bf16x8, pw);
#pragma unroll
        for (int dh = 0; dh < 2; ++dh) { const s16x4 lo = vlo[s][dh], hi4 = vhi[s][dh];
            const bf16x8 vf = (bf16x8){lo[0], lo[1], lo[2], lo[3], hi4[0], hi4[1], hi4[2], hi4[3]};
            o[dh] = ATT_MFMA(pa, vf, o[dh]); }
    }
}
template <class TokFn>
__device__ __forceinline__ void finish_qb(const Frame& F, f32x16 (&o)[2], float l, LAS float* wsf, LAS bf16_t* stg, int lane, int r32, int hi, int ocol, int hidx, const TokFn& tokq) {
    l = swapsum(l);
    asm volatile("s_waitcnt lgkmcnt(0)" ::: "memory");
    if (hi == 0) wsf[32 + r32] = l;
    asm volatile("s_waitcnt lgkmcnt(0)" ::: "memory");
#pragma unroll
    for (int r = 0; r < 16; ++r) { const int orow = crow(r, hi); const float rl = __builtin_amdgcn_rcpf(wsf[32 + orow]);
        stg[orow * 64 + r32] = f2bf(o[0][r] * rl); stg[orow * 64 + 32 + r32] = f2bf(o[1][r] * rl); }
    asm volatile("s_waitcnt lgkmcnt(0)" ::: "memory");
#pragma unroll
    for (int i = 0; i < 4; ++i) { const int row = i * 8 + (lane >> 3), ch = lane & 7; const u32x4 w = *(const LAS u32x4*)(stg + row * 64 + ch * 8); const int tok = tokq(row);
        *(u32x4*)(F.ya() + (size_t)tok * D + ocol + ch * 8) = w;
        float q = 0.f;
#pragma unroll
        for (int j = 0; j < 4; ++j) { const float a = __uint_as_float(w[j] << 16), b = __uint_as_float(w[j] & 0xffff0000u); q += a * a + b * b; }
        q += __shfl_xor(q, 1); q += __shfl_xor(q, 2); q += __shfl_xor(q, 4);
        if (ch == 0) F.ssq()[tok * 32 + hidx] = q; }
    asm volatile("s_waitcnt lgkmcnt(0)" ::: "memory");
}

template <int MODE>
__device__ __forceinline__ void attn_unit(const Frame& F, int L) {
    LAS unsigned char* lds = F.lds;
    const int lane = F.lane, wid = F.wave, r32 = lane & 31, hi = lane >> 5;
    LAS float* wsf = (LAS float*)(lds + OFF_WS + wid * 256); LAS bf16_t* stg = (LAS bf16_t*)(lds + OFF_OST + wid * 4096);
    int b, kcol, vcol, qcol, ocol, hidx, nband, trow0, qtok0;
    int hb = 0, qbw = 0, kt0 = 0;
    int R0 = 0, pr = 0, jc = 0, cb = 0, kr0 = 0;
    if (MODE == 0) { const int kvh = L & 3; hb = (L >> 2) & 127; b = L >> 9; const int hq = 4 * kvh + (wid >> 1); qbw = wid & 1;
        qcol = COL_QA + hq * 64; kcol = COL_KA + kvh * 64; vcol = COL_VA + kvh * 64; ocol = hq * 64; hidx = hq;
        kt0 = max(0, hb - 2); const int kt1 = min(127, hb + 2); nband = kt1 - kt0 + 1; trow0 = b * SEQ + 64 * kt0; qtok0 = b * SEQ + 64 * hb + 32 * qbw;
    } else { const int h = L & 15, rb = (L >> 4) & 31; b = L >> 9; R0 = rb * 4; pr = wid >> 2; jc = wid & 3; cb = min(max(16 * jc - 8, 0), 32);
        qcol = COL_QB + h * 64; kcol = COL_KB + h * 64; vcol = COL_VB + h * 64; ocol = 1024 + h * 64; hidx = 16 + h;
        kr0 = min(max(R0 - 4, 0), 120); const int kr1 = min(max(R0 + 3 - 4, 0), 120) + 7; nband = kr1 - kr0 + 1; trow0 = b * SEQ + kr0 * 64; qtok0 = b * SEQ + (R0 + 2 * pr) * 64 + 16 * jc; }
    const int NT = 1 + nband;
    const bf16_t* ksrc = F.u() + (size_t)lane * INW + kcol + wid * 8;
    const bf16_t* vsrc = F.u() + (size_t)(16 * (wid & 3) + (lane >> 2)) * INW + vcol + (wid >> 2) * 32 + (lane & 3) * 8;
#define ATT_TROW(t) ((t) == 0 ? NTOK : trow0 + ((t) - 1) * 64)
#define ATT_ISSUE(t) do { const size_t ro_ = (size_t)ATT_TROW(t) * INW; const int sl_ = ((t) % NSLOT) * SLOT; \
        __builtin_amdgcn_global_load_lds((const unsigned*)(ksrc + ro_), (LAS unsigned*)(lds + sl_ + wid * 1024), 16, 0, 0); \
        __builtin_amdgcn_global_load_lds((const unsigned*)(vsrc + ro_), (LAS unsigned*)(lds + sl_ + 8192 + wid * 1024), 16, 0, 0); } while (0)
    bf16x8 qr[4];
    { const int tok = MODE == 0 ? qtok0 + r32 : qtok0 + (r32 >> 4) * 64 + (r32 & 15);
#pragma unroll
      for (int d0 = 0; d0 < 4; ++d0) qr[d0] = *(const bf16x8*)(F.u() + (size_t)tok * INW + qcol + d0 * 16 + hi * 8); }
    if (MODE == 0) { LAS float* tA = (LAS float*)(lds + OFF_TABA); const int h0 = 4 * (L & 3);
        for (int i = F.tid; i < 4 * TA_W; i += 512) { const int g = i / TA_W, rel = i % TA_W - TA_OFF; tA[i] = (rel >= -128 && rel <= 128) ? F.tab()[(h0 + g) * 272 + rel + 128] : NEGB; } }
    else { LAS float* tB = (LAS float*)(lds + OFF_TABB); const int h = L & 15;
        for (int i = F.tid; i < 576; i += 512) { const int k = i - 16; tB[i] = (k >= 0 && k < 465) ? F.rpb[h * 465 + k] * LOG2E : ((k >= 465 && k < 496) ? NEGB : 0.f); } }
#pragma unroll
    for (int t = 0; t < 5; ++t) if (t < NT) ATT_ISSUE(t);
    f32x16 o[2]; o[0] = f32x16{}; o[1] = f32x16{}; float m = 0.f, l = 0.f;
    bf16x8 mq = frag_k0(0u, hi); const bf16x8 ones = frag_k0(0x3F80u, hi);
    const LAS float* tabA = (const LAS float*)(lds + OFF_TABA) + (MODE == 0 ? (wid >> 1) : 0) * TA_W;
    const LAS float* tabB = (const LAS float*)(lds + OFF_TABB);
    const int qpos = 64 * hb + 32 * qbw + r32;
    const int qrow = R0 + 2 * pr + (r32 >> 4), qc = 16 * jc + (r32 & 15), rs = min(max(qrow - 4, 0), 120), cs = min(max(qc - 8, 0), 48);
    const int rsw0 = min(max(R0 + 2 * pr - 4, 0), 120), rsw1 = min(max(R0 + 2 * pr + 1 - 4, 0), 120);
    float cm[16];
#pragma unroll
    for (int r = 0; r < 16; ++r) { const int kc = cb + 4 * hi + (r & 3) + 8 * (r >> 2); cm[r] = (MODE == 1 && !(kc >= cs && kc < cs + 16)) ? NEGB : 0.f; }
    const int dc0 = cb + 4 * hi - qc + 15 + 16;
    for (int t = 0; t < NT; ++t) {
        { const int ahead = NT - 1 - t;
          if (ahead >= 4) asm volatile("s_waitcnt vmcnt(8)" ::: "memory"); else if (ahead == 3) asm volatile("s_waitcnt vmcnt(6)" ::: "memory");
          else if (ahead == 2) asm volatile("s_waitcnt vmcnt(4)" ::: "memory"); else if (ahead == 1) asm volatile("s_waitcnt vmcnt(2)" ::: "memory"); else asm volatile("s_waitcnt vmcnt(0)" ::: "memory"); }
        asm volatile("s_waitcnt lgkmcnt(0)" ::: "memory");
        __builtin_amdgcn_s_barrier();
        if (t + 5 < NT) ATT_ISSUE(t + 5);
        const int slot = (t % NSLOT) * SLOT;
        if (MODE == 1 && t > 0) { const int kr = kr0 + t - 1; if (kr < rsw0 || kr > rsw1 + 7) continue; }
        const int cbt = (MODE == 1 && t > 0) ? cb : 0;
        const lds_cptr kp = (lds_cptr)lds + slot + hi * 1024 + (r32 + cbt) * 16;
        const lds_cptr vp = (lds_cptr)lds + slot + 8192 + ((lane >> 4) & 1) * 32 + (lane & 3) * 8 + (4 * hi + ((lane & 15) >> 2) + cbt) * 64;
        bf16x8 kf[8];
        if (MODE == 0 && t > 0) {
#pragma unroll
            for (int d0 = 0; d0 < 4; ++d0) { kf[2 * d0] = *(const LAS bf16x8*)(kp + d0 * 2048); kf[2 * d0 + 1] = *(const LAS bf16x8*)(kp + d0 * 2048 + 512); }
        } else {
#pragma unroll
            for (int d0 = 0; d0 < 4; ++d0) { kf[2 * d0] = *(const LAS bf16x8*)(kp + d0 * 2048); kf[2 * d0 + 1] = kf[2 * d0]; }
        }
        if (t == 0) {
            if (MODE == 0) tile_qb<1, 1>(kf, qr, mq, ones, vp, o, m, l, wsf, r32, hi, [&](int, int r) { return r < 8 ? tabA[max(crow(r, hi) - 16 - qpos, -128) + TA_OFF] : NEGB; });
            else tile_qb<1, 1>(kf, qr, mq, ones, vp, o, m, l, wsf, r32, hi, [&](int, int r) { return r < 8 ? 0.f : NEGB; });
        } else if (MODE == 0) { const volatile LAS float* bp = tabA + 64 * (kt0 + t - 1) + 4 * hi - qpos + TA_OFF;
            tile_qb<2, 4>(kf, qr, mq, ones, vp, o, m, l, wsf, r32, hi, [&](int hf, int r) { return bp[32 * hf + (r & 3) + 8 * (r >> 2)]; });
        } else { const int kr = kr0 + t - 1; const bool rowok = kr >= rs && kr <= rs + 7; const volatile LAS float* bp = tabB + (rowok ? kr - qrow + 7 : 15) * 31 + dc0;
            tile_qb<1, 2>(kf, qr, mq, ones, vp, o, m, l, wsf, r32, hi, [&](int, int r) { return bp[(r & 3) + 8 * (r >> 2)] + cm[r]; });
        }
    }
    if (MODE == 0) { if (hi == 0) l += __builtin_amdgcn_exp2f(F.sink[hidx] * LOG2E - m); }
    if (MODE == 0) finish_qb(F, o, l, wsf, stg, lane, r32, hi, ocol, hidx, [&](int q) { return qtok0 + q; });
    else finish_qb(F, o, l, wsf, stg, lane, r32, hi, ocol, hidx, [&](int q) { return qtok0 + (q >> 4) * 64 + (q & 15); });
    __builtin_amdgcn_s_barrier();
#undef ATT_TROW
#undef ATT_ISSUE
}
__device__ __forceinline__ void attn_phase(const Frame& F, int mask = 3) {
    __syncthreads();
    int L = F.bx, un = 0; const int slot = (mask & 8) ? (F.bx & 7) : 0;
    for (; L < 2048 && un < slot; L += F.G, ++un) { if (L < 1024) { if (mask & 1) attn_unit<0>(F, L); } else if (mask & 2) attn_unit<1>(F, L - 1024); }
    if (mask & 8) { __syncthreads(); const int n = (IT_P6 - IT_MID + F.G - 1) / F.G, a = IT_MID + F.bx * n, e = a + n < IT_P6 ? a + n : IT_P6; if (a < e) conv_range(F, a, e); __syncthreads(); }
    for (; L < 2048; L += F.G) { if (L < 1024) { if (mask & 1) attn_unit<0>(F, L); } else if (mask & 2) attn_unit<1>(F, L - 1024); }
    __syncthreads();
}
}

#ifndef FAST_P5
#define FAST_P5 1
#endif
__device__ __forceinline__ void route_token(const Frame& F, int tok, float lg, int lane) {
    const float score = 1.0f / (1.0f + expf(-lg)), v0 = score + F.rbias[lane];
    int rk = 0;
#pragma unroll
    for (int j = 0; j < 8; ++j) { const int o = (lane & ~7) + j; const float w = __shfl(v0, o); rk += (w > v0 || (w == v0 && o < lane)) ? 1 : 0; }
    float gs = rk < 2 ? v0 : 0.f; gs += __shfl_xor(gs, 1); gs += __shfl_xor(gs, 2); gs += __shfl_xor(gs, 4);
    int grk = 0; const int myg = lane >> 3;
#pragma unroll
    for (int g = 0; g < 8; ++g) { const float w = __shfl(gs, g * 8); grk += (w > gs || (w == gs && g < myg)) ? 1 : 0; }
    const float mv = grk < 4 ? v0 : -INFINITY;
    int erk = 0;
    for (int o = 0; o < 64; ++o) { const float w = __shfl(mv, o); erk += (w > mv || (w == mv && o < lane)) ? 1 : 0; }
    const bool sel = erk < 8;
    const float wsm = wsum(sel ? score : 0.f), wgt = score / (wsm + 1e-20f) * 2.5f;
    if (sel) { const int rr = atomicAdd(F.cnt() + lane, 1); F.tokl()[(size_t)lane * NTOK + rr] = tok; F.wl()[(size_t)lane * NTOK + rr] = wgt; F.tke()[tok * 8 + erk] = lane; F.tkr()[tok * 8 + erk] = rr; }
}
__device__ __forceinline__ void route_token_local(const Frame& F, int tl  , float lg, int lane, LAS int* lcnt, LAS int* sel_e, LAS int* sel_lr, LAS float* sel_w) {
    lg = (lg == lg) ? lg : 0.f;
    const float score = 1.0f / (1.0f + expf(-lg)), v0 = score + F.rbias[lane];
    int rk = 0;
#pragma unroll
    for (int j = 0; j < 8; ++j) { const int o = (lane & ~7) + j; const float w = __shfl(v0, o); rk += (w > v0 || (w == v0 && o < lane)) ? 1 : 0; }
    float gs = rk < 2 ? v0 : 0.f; gs += __shfl_xor(gs, 1); gs += __shfl_xor(gs, 2); gs += __shfl_xor(gs, 4);
    int grk = 0; const int myg = lane >> 3;
#pragma unroll
    for (int g = 0; g < 8; ++g) { const float w = __shfl(gs, g * 8); grk += (w > gs || (w == gs && g < myg)) ? 1 : 0; }
    const float mv = grk < 4 ? v0 : -INFINITY;
    int erk = 0;
#pragma unroll 16
    for (int o = 0; o < 64; ++o) { const float w = __shfl(mv, o); erk += (w > mv || (w == mv && o < lane)) ? 1 : 0; }
    const bool sel = erk < 8;
    const float wsm = wsum(sel ? score : 0.f), wgt = score / (wsm + 1e-20f) * 2.5f;
    if (sel) { const int lr = __hip_atomic_fetch_add(lcnt + lane, 1, __ATOMIC_RELAXED, __HIP_MEMORY_SCOPE_WORKGROUP); sel_e[tl * 8 + erk] = lane; sel_lr[tl * 8 + erk] = lr; sel_w[tl * 8 + erk] = wgt; }
}
__device__ __forceinline__ void phase_ln1_router_fast(Frame& F) {
    constexpr int HSTR = 4112;
    LAS unsigned char* hb = F.lds; LAS float* part = (LAS float*)F.lds;
    LAS int* lcnt = (LAS int*)(F.lds + 132096); LAS int* lbase = lcnt + 64; LAS int* sel_e = lcnt + 128; LAS int* sel_lr = sel_e + 512; LAS float* sel_w = (LAS float*)(sel_lr + 512);
    const int lane = F.lane, w = F.wave, r32 = lane & 31, hi = lane >> 5;
    for (int it2 = F.bx; it2 < NTOK / 64; it2 += F.G) {
        if (F.tid < 64) lcnt[F.tid] = 0;
        for (int sub = 0; sub < 2; ++sub) {
            const int t0 = it2 * 64 + sub * 32;
            u32x4 raw[4][4];
#pragma unroll
            for (int q = 0; q < 4; ++q) { const bf16_t* src = F.z() + (size_t)(t0 + 4 * w + q) * D;
#pragma unroll
                for (int j = 0; j < 4; ++j) raw[q][j] = *(const u32x4*)(src + (lane + 64 * j) * 8); }
#pragma unroll
            for (int q = 0; q < 4; ++q) { const int row = 4 * w + q, tok = t0 + row; float v[4][8]; float s = 0.f;
#pragma unroll
                for (int j = 0; j < 4; ++j)
#pragma unroll
                    for (int i = 0; i < 4; ++i) { v[j][2 * i] = __uint_as_float(raw[q][j][i] << 16); v[j][2 * i + 1] = __uint_as_float(raw[q][j][i] & 0xffff0000u); s += v[j][2 * i] + v[j][2 * i + 1]; }
                const float mu = wsum(s) * (1.0f / D); float qq = 0.f;
#pragma unroll
                for (int j = 0; j < 4; ++j)
#pragma unroll
                    for (int i = 0; i < 8; ++i) { const float d = v[j][i] - mu; qq += d * d; }
                const float rstd = 1.0f / sqrtf(wsum(qq) * (1.0f / D) + LN_EPS);
#pragma unroll
                for (int j = 0; j < 4; ++j) { const int c = (lane + 64 * j) * 8; const f32x4 g0 = *(const f32x4*)(F.l1g + c), g1 = *(const f32x4*)(F.l1g + c + 4), b0 = *(const f32x4*)(F.l1b + c), b1 = *(const f32x4*)(F.l1b + c + 4);
                    u32x4 pk;
                    pk.x = pack2((v[j][0] - mu) * rstd * g0[0] + b0[0], (v[j][1] - mu) * rstd * g0[1] + b0[1]); pk.y = pack2((v[j][2] - mu) * rstd * g0[2] + b0[2], (v[j][3] - mu) * rstd * g0[3] + b0[3]);
                    pk.z = pack2((v[j][4] - mu) * rstd * g1[0] + b1[0], (v[j][5] - mu) * rstd * g1[1] + b1[1]); pk.w = pack2((v[j][6] - mu) * rstd * g1[2] + b1[2], (v[j][7] - mu) * rstd * g1[3] + b1[3]);
                    *(u32x4*)(F.h1() + (size_t)tok * D + c) = pk; *(LAS u32x4*)(hb + row * HSTR + c * 2) = pk; }
                if (lane == 0) { F.stats1()[tok * 2] = mu; F.stats1()[tok * 2 + 1] = rstd; } }
            __syncthreads();
            att::f32x16 acc[2]; acc[0] = att::f32x16{}; acc[1] = att::f32x16{};
            const bf16_t* wb = F.wrt() + (size_t)r32 * D + 256 * w + hi * 8;
#pragma unroll 8
            for (int s = 0; s < 16; ++s) {
                const att::bf16x8 a = *(const LAS att::bf16x8*)(hb + r32 * HSTR + (256 * w + 16 * s + 8 * hi) * 2);
                const att::bf16x8 b0 = *(const att::bf16x8*)(wb + 16 * s), b1 = *(const att::bf16x8*)(wb + (size_t)32 * D + 16 * s);
                acc[0] = __builtin_amdgcn_mfma_f32_32x32x16_bf16(a, b0, acc[0], 0, 0, 0); acc[1] = __builtin_amdgcn_mfma_f32_32x32x16_bf16(a, b1, acc[1], 0, 0, 0); }
            __syncthreads();
#pragma unroll
            for (int nt = 0; nt < 2; ++nt)
#pragma unroll
                for (int r = 0; r < 16; ++r) part[(w * 32 + att::crow(r, hi)) * 64 + 32 * nt + r32] = acc[nt][r];
            __syncthreads();
            for (int q = 0; q < 4; ++q) { const int row = 4 * w + q; float lg = 0.f;
#pragma unroll
                for (int ww = 0; ww < 8; ++ww) lg += part[(ww * 32 + row) * 64 + lane];
                route_token_local(F, sub * 32 + row, lg, lane, lcnt, sel_e, sel_lr, sel_w); }
            __syncthreads();
        }
        if (F.tid < 64) { const int n = lcnt[F.tid]; lbase[F.tid] = n > 0 ? atomicAdd(F.cnt() + F.tid, n) : 0; }
        __syncthreads();
        { const int tl = F.tid >> 3, slot = F.tid & 7, e = sel_e[F.tid], rr = lbase[e] + sel_lr[F.tid], tok = it2 * 64 + tl;
          F.tokl()[(size_t)e * NTOK + rr] = tok; F.wl()[(size_t)e * NTOK + rr] = sel_w[F.tid]; F.tke()[tok * 8 + slot] = e; F.tkr()[tok * 8 + slot] = rr; }
        __syncthreads();
    }
}

__global__ void __launch_bounds__(512, 2) mk_fwd(Args args) {
    extern __shared__ __attribute__((aligned(16))) unsigned char lds_raw[];
    Frame F; F.lds = (LAS unsigned char*)lds_raw; F.tid = threadIdx.x; F.lane = F.tid & 63; F.wave = __builtin_amdgcn_readfirstlane(F.tid >> 6); F.G = gridDim.x; F.bx = blockIdx.x;
    F.x = args.in[0]; F.meta = args.in[1]; F.lng = args.in[2]; F.lnb = args.in[3]; F.t5 = args.in[4]; F.w_in = args.in[5]; F.sink = args.in[6]; F.rpb = args.in[7]; F.ga = args.in[8]; F.gb = args.in[9];
    F.w_out = args.in[10]; F.l1g = args.in[11]; F.l1b = args.in[12]; F.w_router = args.in[13]; F.rbias = args.in[14]; F.w_gate = args.in[15]; F.w_up = args.in[16]; F.w_down = args.in[17];
    F.ws_gate = args.in[18]; F.ws_up = args.in[19]; F.ws_down = args.in[20]; F.l2g = args.in[21]; F.l2b = args.in[22]; F.out = args.out; F.ws = args.ws;
    unsigned char* ws = args.ws;
    volatile LAS unsigned* xbw = (volatile LAS unsigned*)(F.lds + LDS_BYTES - 16);
    LAS int* ps = (LAS int*)(F.lds + 131072);
    if (F.tid < 4) xbw[F.tid] = 0u;
    __syncthreads();
    const int lo = args.ph_lo, hi = args.ph_hi;
    XcdBarrier bar; bar.bar = (unsigned*)(ws + WS_CTL); bar.x = 0; bar.st = xbw;
    if (hi - lo > 1) bar = xcd_barrier_post((unsigned*)(ws + WS_CTL), xbw);
    unsigned* xcen = (unsigned*)(ws + WS_CTL + 20480);
    if (XCD_TRUE && hi - lo > 1 && F.tid == 0) { const unsigned x = xb_xcc_id(); xbw[2] = x; xbw[3] = xb_add(&xcen[x * 16], 1u); }
#ifndef PROBE_REPEAT
#define PROBE_REPEAT -1
#endif
#ifndef PROBE_SUB
#define PROBE_SUB 3
#endif
#ifndef PROBE_NOSTORE
#define PROBE_NOSTORE 0
#endif
#ifndef PROBE_HOT
#define PROBE_HOT 0
#endif
#ifndef PROBE_NT
#define PROBE_NT 32
#ifndef PROBE_LD
#define PROBE_LD 2048
#endif
#endif
#define IN(k) (lo <= (k) && (k) < hi)
#define SEAM(k) do { if (IN(k) && IN((k) + 1)) xcd_barrier(bar); } while (0)
    if (IN(0)) { F.fresh(); phase_prologue(F);
#if PROBE_REPEAT == 0
        xcd_barrier(bar); phase_prologue(F);
#endif
    } SEAM(0);
#define P1_BODY(rep) do { const int s_ = (rep) ? 0 : F.bx % 5; EpiU E{F.u(), rep}; { SchedInProj S{(const char*)F.h0(), (const char*)F.wtin(), F.G, F.bx, 0, s_}; pg8::gemm_phase(F.lds, S, E, D, D, D / 64); } if (!(rep)) { conv_inproj_share(F); __syncthreads(); } { SchedInProj S{(const char*)F.h0(), (const char*)F.wtin(), F.G, F.bx, s_, 1 << 20}; pg8::gemm_phase(F.lds, S, E, D, D, D / 64); } } while (0)
#define P4_BODY(rep) do { SchedOutProj S{(const char*)F.ya(), (const char*)F.wtout(), F.G, F.bx}; EpiZ E{F.z(), F.h0(), F.ssq(), (LAS float*)(F.lds + 131072 + 6144)}; pg8::gemm_phase(F.lds, S, E, D, D, D / 64, STAGGER4); } while (0)
#define P6_BODY(rep) do { moe_tables(F, ps); SchedGU S{(const char*)F.h1(), (const char*)F.wtgu(), F.tokl(), F.cnt(), ps, F.G, F.bx}; EpiGU E{F.hb(), F.wl()}; pg8::gemm_phase(F.lds, S, E, D, D, D / 64); if (!(rep)) conv_tail(F, IT_P6, IT_ALL, (ps[128 + 65] * 4) % F.G); } while (0)
#define P7_BODY(rep) do { moe_tables(F, ps); SchedDown S{(const char*)F.hb(), (const char*)F.wtd(), F.cnt(), ps, F.G, F.bx, (rep) ? PROBE_HOT : 0}; EpiDownR E{(unsigned char*)F.ym(), rep}; pg8::gemm_phase(F.lds, S, E, DE, DE, DE / 64, STAGGER7); SchedDownShared S2{(const char*)F.hb(), (const char*)F.wtd(), F.G, F.bx}; EpiDownS E2{F.o2(), F.h1()}; pg8::gemm_phase(F.lds, S2, E2, DE, DE, DE / 64); } while (0)
    if (XCD_TRUE && hi - lo > 1 && IN(0)) {
        if (F.tid == 0) { unsigned idx = 0, ok = 1, npop = 0; const unsigned x = xbw[2];
            for (unsigned j = 0; j < 16; ++j) { const unsigned cj = xb_ld(&xcen[j * 16]); if (cj) { ++npop; if (cj * 8u != (unsigned)F.G) ok = 0; if (j < x) ++idx; } }
            xbw[2] = (ok && npop == 8) ? xbw[3] * 8u + idx : (unsigned)blockIdx.x; }
        __syncthreads();
        F.bx = __builtin_amdgcn_readfirstlane((int)xbw[2]);
    }
    if (IN(1)) { F.fresh();
#if FAST_P1
        P1_BODY(0);
#if PROBE_REPEAT == 1
        xcd_barrier(bar); P1_BODY(PROBE_NOSTORE);
#endif
#else
        FnInProj f{F}; sgemm(f, F.lds, F.tid, F.bx, F.G);
#endif
#if PROBE_REPEAT == 9
        xcd_barrier(bar); if (F.bx % 8 == 0) { conv_range(F, IT_P0 + T_OUT, IT_P0 + T_OUT + 512); __syncthreads(); }
#endif
    } SEAM(1);
    if (IN(2)) { F.fresh();
#if FAST_P2
        att::attn_phase(F, 3 | 8);
#if PROBE_REPEAT == 2
        xcd_barrier(bar); att::attn_phase(F, PROBE_SUB);
#endif
#else
        phase_attn_simple(F);
#endif
    } SEAM(2);
#if !FAST_P4
    if (IN(3)) { phase_rmsnorm(F); } SEAM(3);
#endif
    if (IN(4)) { F.fresh();
#if FAST_P4
        P4_BODY(0);
#if PROBE_REPEAT == 4
        xcd_barrier(bar); P4_BODY(1);
#endif
#else
        FnOutProj f{F}; sgemm(f, F.lds, F.tid, F.bx, F.G);
#endif
    } SEAM(4);
#if FAST_P5
#define PH5(F) phase_ln1_router_fast(F)
#else
#define PH5(F) phase_ln1_router(F)
#endif
    if (IN(5)) { F.fresh(); PH5(F);
#if PROBE_REPEAT == 5
        xcd_barrier(bar); if (F.bx == 0 && F.tid < 64) F.cnt()[F.tid] = 0; xcd_barrier(bar); PH5(F);
#endif
    } SEAM(5);
    if (IN(6)) { F.fresh();
#if FAST_P6
        P6_BODY(0);
#if PROBE_REPEAT == 6
        xcd_barrier(bar); P6_BODY(1);
#endif
#else
        expert_starts(F, ps); FnGateUp f{F, ps}; sgemm(f, F.lds, F.tid, F.bx, F.G);
#endif
    } SEAM(6);
    if (IN(7)) { F.fresh();
#if FAST_P7
        P7_BODY(0);
#if PROBE_REPEAT == 7
        xcd_barrier(bar); P7_BODY(PROBE_NOSTORE);
#endif
#else
        expert_starts(F, ps); { FnDown f{F, ps}; sgemm(f, F.lds, F.tid, F.bx, F.G); } { FnFinal f{F, ps}; sgemm(f, F.lds, F.tid, F.bx, F.G); }
#endif
    } SEAM(7);
    if (IN(8)) { F.fresh(); expert_starts(F, ps); phase_ln2(F, ps);
#if PROBE_REPEAT == 8
        xcd_barrier(bar); phase_ln2(F, ps);
#endif
    }
#undef IN
#undef SEAM
}

extern "C" void kernel_launch(void* const* d_in, const int* in_sizes, int n_in, void* d_out, int out_size, void* d_ws, size_t ws_size, hipStream_t stream) {
    static int grid = 0;
    if (grid == 0) {
        if (n_in != 23 || in_sizes[0] != NTOK * D || out_size != NTOK * D || ws_size < WS_END) {
            fprintf(stderr, "kernel_launch: built for 23 inputs, x/out of %d floats, >= %zu bytes of workspace; got n_in %d in0 %d out %d ws %zu; nothing launched\n", NTOK * D, (size_t)WS_END, n_in, n_in > 0 ? in_sizes[0] : -1, out_size, ws_size);
            grid = -1; return; }
        int dev = 0, cus = 0, per_cu = 0;
        if (hipGetDevice(&dev) != hipSuccess || hipDeviceGetAttribute(&cus, hipDeviceAttributeMultiprocessorCount, dev) != hipSuccess) { fprintf(stderr, "kernel_launch: device query failed\n"); grid = -1; return; }
        if (hipFuncSetAttribute((const void*)mk_fwd, hipFuncAttributeMaxDynamicSharedMemorySize, LDS_BYTES) != hipSuccess) { fprintf(stderr, "kernel_launch: hipFuncSetAttribute failed\n"); grid = -1; return; }
        if (hipOccupancyMaxActiveBlocksPerMultiprocessor(&per_cu, (const void*)mk_fwd, 512, LDS_BYTES) != hipSuccess || per_cu < 1) fprintf(stderr, "kernel_launch: note: occupancy query reports %d\n", per_cu);
        (void)hipGetLastError();
        grid = cus;
    }
    if (grid < 0) return;
    if (hipMemsetAsync((char*)d_ws + WS_CTL, 0, CTL_BYTES, stream) != hipSuccess) { fprintf(stderr, "kernel_launch: memset failed\n"); return; }
    Args a{};
    for (int i = 0; i < 23; ++i) a.in[i] = (const float*)d_in[i];
    a.out = (float*)d_out; a.ws = (unsigned char*)d_ws;
#if MK_ONE_LAUNCH
    a.ph_lo = 0; a.ph_hi = NPHASE;
    hipLaunchKernelGGL(mk_fwd, dim3(grid), dim3(512), LDS_BYTES, stream, a);
#else
    for (int p = 0; p < NPHASE; ++p) { a.ph_lo = p; a.ph_hi = p + 1; hipLaunchKernelGGL(mk_fwd, dim3(grid), dim3(512), LDS_BYTES, stream, a); }
#endif
    const hipError_t le = hipPeekAtLastError();
    if (le != hipSuccess) fprintf(stderr, "kernel_launch: launch failed: %s\n", hipGetErrorName(le));
}
```

```cpp
#include <hip/hip_runtime.h>
#include <cstdio>
#include <cstdint>

#define LAS __attribute__((address_space(3)))
typedef unsigned short bf16_t;
typedef float f32x4 __attribute__((ext_vector_type(4)));
typedef unsigned u32x4 __attribute__((ext_vector_type(4)));
typedef unsigned u32x2 __attribute__((ext_vector_type(2)));

#ifndef CONV_P2
#define CONV_P2 28160
#endif
#ifndef CONV_NT
#define CONV_NT 1
#endif
#ifndef MK_ONE_LAUNCH
#define MK_ONE_LAUNCH 1
#endif

constexpr int D = 2048, SEQ = 8192, NB = 2, NTOK = NB * SEQ;
constexpr int NMETA = 16, INW = 4608, MROWS = NTOK + 256;
constexpr int NE = 64, DE = 512, PMAX = 147456, HBROWS = PMAX + NTOK;
constexpr float ALPHA = 1.189207115002721f;
constexpr float LN_EPS = 1e-5f, RMS_EPS = 1e-6f, LOG2E = 1.4426950408889634f, QSCALE = 0.125f * LOG2E;
constexpr int COL_QA = 0, COL_KA = 1024, COL_VA = 1280, COL_QB = 1536, COL_KB = 2560, COL_VB = 3584;
constexpr int NPHASE = 9;
constexpr int LDS_BYTES = 147456;

constexpr size_t WS_CTL = 0, CTL_BYTES = 32768;
constexpr size_t WS_CNT = 16384;
constexpr size_t WS_STATS0 = WS_CTL + CTL_BYTES;
constexpr size_t WS_STATS1 = WS_STATS0 + (size_t)NTOK * 8;
constexpr size_t WS_SSQ = WS_STATS1 + (size_t)NTOK * 8;
constexpr size_t WS_TOKL = WS_SSQ + (size_t)NTOK * 32 * 4;
constexpr size_t WS_WL = WS_TOKL + (size_t)NE * NTOK * 4;
constexpr size_t WS_TKE = WS_WL + (size_t)NE * NTOK * 4;
constexpr size_t WS_TKR = WS_TKE + (size_t)NTOK * 8 * 4;
constexpr size_t WS_TAB = WS_TKR + (size_t)NTOK * 8 * 4;
constexpr size_t WS_WRT = WS_TAB + 32768;
constexpr size_t WS_Z = WS_WRT + (size_t)NE * D * 2;
constexpr size_t WS_O2 = WS_Z + (size_t)NTOK * D * 2;
constexpr size_t WS_WTD = WS_Z + (size_t)NTOK * D * 4;
constexpr size_t WS_HB = WS_WTD + (size_t)65 * 2048 * 512 * 2;
constexpr size_t WS_B = WS_HB + (size_t)HBROWS * 512 * 2;
constexpr size_t WS_WTGU = WS_B;
constexpr size_t WS_WTIN = WS_WTGU + (size_t)65 * 1024 * 2048 * 2;
constexpr size_t WS_WTOUT = WS_WTIN + (size_t)INW * D * 2;
constexpr size_t WS_H0 = WS_WTOUT + (size_t)D * D * 2;
constexpr size_t WS_U = WS_H0 + (size_t)MROWS * D * 2;
constexpr size_t WS_YA = WS_U + (size_t)MROWS * INW * 2;
constexpr size_t WS_H1Q = WS_WTD + (size_t)65 * 2048 * 512;
constexpr size_t WS_H1 = WS_Z;
constexpr size_t WS_YM = WS_B;
constexpr size_t WS_END_A = WS_YA + (size_t)NTOK * D * 2, WS_END_B = WS_YM + (size_t)PMAX * D * 2;
constexpr size_t WS_END = WS_END_A > WS_END_B ? WS_END_A : WS_END_B;
static_assert(WS_END <= ((size_t)1 << 30), "workspace map must fit 1 GiB");

__device__ __forceinline__ float bf2f(bf16_t b) { return __uint_as_float(((unsigned)b) << 16); }
__device__ __forceinline__ bf16_t f2bf(float f) { unsigned u = __float_as_uint(f); u += 0x7FFFu + ((u >> 16) & 1u); return (bf16_t)(u >> 16); }
__device__ __forceinline__ unsigned pack2(float lo, float hi) { return (unsigned)f2bf(lo) | ((unsigned)f2bf(hi) << 16); }
constexpr int ENC8_EXP = 12 << 23;
__device__ __forceinline__ unsigned enc8(float x) {
    const unsigned u = __float_as_uint(x); int t = (int)(u & 0x7fffffffu) - 0x00F80000 - ENC8_EXP;
    t = t < 0x38000000 ? 0x38000000 : (t > 0x3FF00000 ? 0x3FF00000 : t);
    return (((unsigned)t >> 20) & 0x7fu) | ((u >> 24) & 0x80u); }
__device__ __forceinline__ unsigned enc8x4(float a, float b, float c, float d) { return enc8(a) | (enc8(b) << 8) | (enc8(c) << 16) | (enc8(d) << 24); }
__device__ __forceinline__ float dec8(unsigned b) { return __uint_as_float(((b & 0x7fu) << 20) + 0x39000000u + ((b & 0x80u) << 24)); }
typedef unsigned short u16x2 __attribute__((ext_vector_type(2)));
__device__ __forceinline__ unsigned cvt_pk_bf16_g(float lo, float hi) { unsigned r; asm volatile("v_cvt_pk_bf16_f32 %0, %1, %2" : "=v"(r) : "v"(lo), "v"(hi)); return r; }
__device__ __forceinline__ unsigned e4m3x2(float a, float b) {
    const unsigned p = cvt_pk_bf16_g(a, b);
    u16x2 m = __builtin_bit_cast(u16x2, p & 0x7fff7fffu);
    m = (m + (u16x2){8, 8}) >> (u16x2){4, 4};
    m = __builtin_elementwise_sub_sat(m, (u16x2){0x3C0, 0x3C0});
    m = __builtin_elementwise_min(m, (u16x2){0x7E, 0x7E});
    return __builtin_bit_cast(unsigned, m) | ((p >> 8) & 0x00800080u); }
__device__ __forceinline__ unsigned e4m3x4(float a, float b, float c, float d) { return __builtin_amdgcn_perm(e4m3x2(c, d), e4m3x2(a, b), 0x06040200u); }
constexpr float S8_H1 = 8.0f, S8_W = 256.0f, S8_HB = 16.0f, S8_GU_INV = 1.0f / (S8_H1 * S8_W), S8_DN_INV = 1.0f / (S8_HB * S8_W);
__device__ __forceinline__ float wsum(float v) {
#pragma unroll
    for (int o = 32; o >= 1; o >>= 1) v += __shfl_xor(v, o);
    return v; }
__device__ __forceinline__ float wmax(float v) {
#pragma unroll
    for (int o = 32; o >= 1; o >>= 1) v = fmaxf(v, __shfl_xor(v, o));
    return v; }
__device__ __forceinline__ int t5_bucket(int rel) {
    const int ret = rel > 0 ? 16 : 0, n = rel < 0 ? -rel : rel;
    if (n < 8) return ret + n;
    const int n2 = n > 32768 ? 0x40000000 : n * n; int lg = 31 - __clz(n2) + 2; if (lg > 15) lg = 15;
    return ret + lg; }

#define XB_TMO      128
#define XB_XCNT(j)  (256  + 64 * (j))
#define XB_XSUB(j)  (1280 + 64 * (j))
#define XB_XGEN(j)  (2304 + 64 * (j))
#define XB_TOP      3328
#define XB_TOPGEN   3392
#define XCD_BAR_WORDS 3456
#define XB_SPIN_CAP (1u << 18)
__device__ __forceinline__ int lane_id() { int l; asm volatile("v_mbcnt_lo_u32_b32 %0, -1, 0\n\tv_mbcnt_hi_u32_b32 %0, -1, %0" : "=v"(l)); return l; }
__device__ __forceinline__ unsigned xb_ld(unsigned* p)              { return __hip_atomic_load(p, __ATOMIC_RELAXED, __HIP_MEMORY_SCOPE_AGENT); }
__device__ __forceinline__ unsigned xb_add(unsigned* p, unsigned v) { return __hip_atomic_fetch_add(p, v, __ATOMIC_RELAXED, __HIP_MEMORY_SCOPE_AGENT); }
__device__ __forceinline__ unsigned xb_xcc_id() { return (unsigned)__builtin_amdgcn_s_getreg((3 << 11) | 20) & 0xFu; }
#define XB_SPIN(cond, bar) do { unsigned _sp = 0; while (cond) { __builtin_amdgcn_s_sleep(1); \
    if ((++_sp & 255u) == 0u) { if (xb_ld(&(bar)[XB_TMO])) break; if (_sp > XB_SPIN_CAP) { atomicAdd(&(bar)[XB_TMO], 1u); break; } } } } while (0)
struct XcdBarrier { unsigned* bar; unsigned x; volatile LAS unsigned* st; int wave0; };
__device__ __forceinline__ XcdBarrier xcd_barrier_post(unsigned* bar, volatile LAS unsigned* st, int wave0) {
    XcdBarrier b; b.bar = bar; b.x = xb_xcc_id(); b.st = st; b.wave0 = wave0;
    if (wave0 == 0 && lane_id() == 0) (void)xb_add(&bar[XB_XCNT(b.x)], 1u);
    return b;
}
__device__ __forceinline__ void xcd_barrier_complete(unsigned* bar, unsigned x, unsigned& nloc, unsigned& nx) {
    const unsigned G = gridDim.x * gridDim.y * gridDim.z;
    unsigned sum, cnt, mine, sp = 0u;
    for (;;) {
        sum = 0u; cnt = 0u; mine = 0u;
#pragma unroll
        for (unsigned j = 0; j < 16; ++j) { const unsigned c = xb_ld(&bar[XB_XCNT(j)]); sum += c; cnt += (c > 0u) ? 1u : 0u; mine = (j == x) ? c : mine; }
        if (sum == G) break;
        __builtin_amdgcn_s_sleep(1);
        if ((++sp & 255u) == 0u) { if (xb_ld(&bar[XB_TMO])) break; if (sp > XB_SPIN_CAP) { atomicAdd(&bar[XB_TMO], 1u); break; } }
    }
    nloc = mine > 0u ? mine : 1u; nx = cnt > 0u ? cnt : 1u;
}
__device__ __forceinline__ void xcd_barrier(const XcdBarrier& b) {
    asm volatile("s_waitcnt vmcnt(0)" ::: "memory");
    __syncthreads();
    if (b.wave0 == 0 && lane_id() == 0) {
        unsigned* bar = b.bar;
        __builtin_amdgcn_s_waitcnt(0);
        unsigned nloc = b.st[0], nx = b.st[1];
        if (nloc == 0u) { xcd_barrier_complete(bar, b.x, nloc, nx); b.st[0] = nloc; b.st[1] = nx; }
        const unsigned old = xb_add(&bar[XB_XSUB(b.x)], 1u);
        const unsigned gen = old / nloc;
        if (old + 1u == (gen + 1u) * nloc) {
            __builtin_amdgcn_fence(__ATOMIC_RELEASE, "agent");
            asm volatile("s_waitcnt vmcnt(0)" ::: "memory");
            const unsigned og = xb_add(&bar[XB_TOP], 1u);
            const unsigned tg = og / nx;
            if (og + 1u == (tg + 1u) * nx) xb_add(&bar[XB_TOPGEN], 1u);
            else XB_SPIN(xb_ld(&bar[XB_TOPGEN]) == tg, bar);
            __builtin_amdgcn_fence(__ATOMIC_ACQUIRE, "agent");
            xb_add(&bar[XB_XGEN(b.x)], 1u);
            asm volatile("s_waitcnt vmcnt(0)" ::: "memory");
        } else {
            XB_SPIN(xb_ld(&bar[XB_XGEN(b.x)]) == gen, bar);
            __builtin_amdgcn_fence(__ATOMIC_ACQUIRE, "agent");
            asm volatile("s_waitcnt vmcnt(0)" ::: "memory");
        }
    }
    __syncthreads();
}

struct Args { const float* in[23]; float* out; unsigned char* ws; int ph_lo, ph_hi; };
struct Frame {
    LAS unsigned char* lds; int tid, lane, wave, G, bx;
    const float *x, *meta, *lng, *lnb, *t5, *w_in, *sink, *rpb, *ga, *gb, *w_out, *l1g, *l1b, *w_router, *rbias, *w_gate, *w_up, *w_down, *ws_gate, *ws_up, *ws_down, *l2g, *l2b;
    float* out; unsigned char* ws;
    int wave0;
    __device__ __forceinline__ void fresh() { int t = wave0 * 64 + lane_id(); asm volatile("" : "+v"(t)); tid = t; lane = t & 63; wave = wave0; }
    __device__ __forceinline__ float* stats0() const { return (float*)(ws + WS_STATS0); }
    __device__ __forceinline__ float* stats1() const { return (float*)(ws + WS_STATS1); }
    __device__ __forceinline__ float* ssq() const { return (float*)(ws + WS_SSQ); }
    __device__ __forceinline__ float* wl() const { return (float*)(ws + WS_WL); }
    __device__ __forceinline__ float* tab() const { return (float*)(ws + WS_TAB); }
    __device__ __forceinline__ int* cnt() const { return (int*)(ws + WS_CNT); }
    __device__ __forceinline__ int* tokl() const { return (int*)(ws + WS_TOKL); }
    __device__ __forceinline__ int* tke() const { return (int*)(ws + WS_TKE); }
    __device__ __forceinline__ int* tkr() const { return (int*)(ws + WS_TKR); }
    __device__ __forceinline__ bf16_t* wtd() const { return (bf16_t*)(ws + WS_WTD); }
    __device__ __forceinline__ bf16_t* hb() const { return (bf16_t*)(ws + WS_HB); }
    __device__ __forceinline__ bf16_t* wtgu() const { return (bf16_t*)(ws + WS_WTGU); }
    __device__ __forceinline__ bf16_t* wtin() const { return (bf16_t*)(ws + WS_WTIN); }
    __device__ __forceinline__ bf16_t* wtout() const { return (bf16_t*)(ws + WS_WTOUT); }
    __device__ __forceinline__ bf16_t* h0() const { return (bf16_t*)(ws + WS_H0); }
    __device__ __forceinline__ bf16_t* u() const { return (bf16_t*)(ws + WS_U); }
    __device__ __forceinline__ bf16_t* ya() const { return (bf16_t*)(ws + WS_YA); }
    __device__ __forceinline__ bf16_t* h1() const { return (bf16_t*)(ws + WS_H1); }
    __device__ __forceinline__ unsigned char* h1q() const { return (unsigned char*)(ws + WS_H1Q); }
    __device__ __forceinline__ bf16_t* ym() const { return (bf16_t*)(ws + WS_YM); }
    __device__ __forceinline__ bf16_t* wrt() const { return (bf16_t*)(ws + WS_WRT); }
    __device__ __forceinline__ bf16_t* z() const { return (bf16_t*)(ws + WS_Z); }
    __device__ __forceinline__ bf16_t* o2() const { return (bf16_t*)(ws + WS_O2); }
};

struct ConvDesc { const float* src; bf16_t* dst; int lds_, ldd_; const float* ksc; float csc; int f8; };
__device__ __forceinline__ void conv_load(const ConvDesc& d, f32x4 (&v)[16], int lane) {
    const int kk = lane & 3, n4 = (lane >> 2) * 4;
#pragma unroll
    for (int p = 0; p < 16; ++p) v[p] = __builtin_nontemporal_load((const f32x4*)(d.src + (size_t)(4 * p + kk) * d.lds_ + n4));
}
__device__ __forceinline__ void conv_finish(const ConvDesc& d, const f32x4 (&v)[16], LAS float* scr, int lane) {
    const int kk = lane & 3, n4 = (lane >> 2) * 4;
#pragma unroll
    for (int p = 0; p < 16; ++p) { const int k = 4 * p + kk; const float s = d.ksc ? d.ksc[k] * d.csc : d.csc;
        scr[k * 65 + n4] = v[p][0] * s; scr[k * 65 + n4 + 1] = v[p][1] * s; scr[k * 65 + n4 + 2] = v[p][2] * s; scr[k * 65 + n4 + 3] = v[p][3] * s; }
    asm volatile("s_waitcnt lgkmcnt(0)" ::: "memory");
    if (d.f8) {
        const int c = lane >> 4;
#pragma unroll
        for (int j = 0; j < 4; ++j) { const int n = (lane & 15) + 16 * j; const LAS float* s = scr + (16 * c) * 65 + n; u32x4 o;
            o.x = e4m3x4(s[0], s[65], s[2 * 65], s[3 * 65]); o.y = e4m3x4(s[4 * 65], s[5 * 65], s[6 * 65], s[7 * 65]);
            o.z = e4m3x4(s[8 * 65], s[9 * 65], s[10 * 65], s[11 * 65]); o.w = e4m3x4(s[12 * 65], s[13 * 65], s[14 * 65], s[15 * 65]);
            __builtin_nontemporal_store(o, (u32x4*)((unsigned char*)d.dst + (size_t)n * d.ldd_ + 16 * c)); }
        asm volatile("s_waitcnt lgkmcnt(0)" ::: "memory");
        return; }
    const int c = lane >> 3;
#pragma unroll
    for (int j = 0; j < 8; ++j) { const int n = (lane & 7) + 8 * j; const LAS float* s = scr + (8 * c) * 65 + n; u32x4 o;
        o.x = pack2(s[0], s[65]); o.y = pack2(s[2 * 65], s[3 * 65]); o.z = pack2(s[4 * 65], s[5 * 65]); o.w = pack2(s[6 * 65], s[7 * 65]);
        __builtin_nontemporal_store(o, (u32x4*)(d.dst + (size_t)n * d.ldd_ + 8 * c)); }
    asm volatile("s_waitcnt lgkmcnt(0)" ::: "memory");
}
constexpr int T_R = 32, T_IN = 72 * 32, T_OUT = 32 * 32, T_GU = 65 * 2 * 8 * 32, T_D = 65 * 32 * 8;
constexpr int IT_P0 = T_R + T_IN, IT_ALL = IT_P0 + T_OUT + T_GU + T_D, IT_P6 = IT_ALL - 6400, IT_MID = IT_P6 - CONV_P2;
__device__ __forceinline__ ConvDesc conv_desc(const Frame& F, int it) {
    int r = it; const float* src; bf16_t* dst; int lds_, ldd_, f8 = 0; const float* ksc = nullptr; float csc = 1.0f;
    if (r < T_R) { src = F.w_router + (size_t)(r * 64) * NE; lds_ = NE; dst = F.wrt() + r * 64; ldd_ = D; }
    else if ((r -= T_R) < T_IN) { const int tn = r % 72, tk = r / 72; const int n0 = tn * 64; const bool isq = (n0 < COL_KA) || (n0 >= COL_QB && n0 < COL_KB);
        src = F.w_in + (size_t)(tk * 64) * INW + n0; lds_ = INW; dst = F.wtin() + (size_t)n0 * D + tk * 64; ldd_ = D; csc = isq ? QSCALE : 1.0f; }
    else if ((r -= T_IN) < T_OUT) { const int tn = r % 32, tk = r / 32; const int k0 = tk * 64;
        src = F.w_out + (size_t)k0 * D + tn * 64; lds_ = D; dst = F.wtout() + (size_t)(tn * 64) * D + k0; ldd_ = D; ksc = k0 < 1024 ? F.ga + k0 : F.gb + (k0 - 1024); }
    else if ((r -= T_OUT) < T_GU) { const int tn = r % 8, tk = (r / 8) % 32, which = (r / 256) % 2, e = r / 512;
        const float* s0 = e < NE ? (which ? F.w_up : F.w_gate) + (size_t)e * D * DE : (which ? F.ws_up : F.ws_gate);
        const int c0 = tn * 64, nprime = 256 * (c0 / 128) + 128 * which + (c0 % 128);
        src = s0 + (size_t)(tk * 64) * DE + c0; lds_ = DE; dst = (bf16_t*)((unsigned char*)F.wtgu() + ((size_t)e * 1024 + nprime) * D + tk * 64); ldd_ = D; f8 = 1; csc = S8_W; }
    else { r -= T_GU; const int tn = r % 32, tk = (r / 32) % 8, e = r / 256;
        const float* s0 = e < NE ? F.w_down + (size_t)e * DE * D : F.ws_down;
        src = s0 + (size_t)(tk * 64) * D + tn * 64; lds_ = D; dst = (bf16_t*)((unsigned char*)F.wtd() + ((size_t)e * D + tn * 64) * DE + tk * 64); ldd_ = DE; f8 = 1; csc = S8_W; }
    return ConvDesc{src, dst, lds_, ldd_, ksc, csc, f8};
}
__device__ __forceinline__ void conv_items(const Frame& F, int first, int last, int step) {
    LAS float* t = (LAS float*)F.lds + F.wave * (64 * 65);
    if (first >= last) return;
    f32x4 va[16], vb[16]; ConvDesc da = conv_desc(F, first), db = da;
    conv_load(da, va, F.lane);
    for (int it = first; it < last; it += 2 * step) {
        const bool hb = it + step < last; if (hb) { db = conv_desc(F, it + step); conv_load(db, vb, F.lane); }
        conv_finish(da, va, t, F.lane);
        if (!hb) break;
        const bool ha = it + 2 * step < last; if (ha) { da = conv_desc(F, it + 2 * step); conv_load(da, va, F.lane); }
        conv_finish(db, vb, t, F.lane);
        if (!ha) break;
    }
}
__device__ __forceinline__ void conv_range(const Frame& F, int first, int last) { conv_items(F, first + F.wave, last, 8); }
__device__ __forceinline__ void conv_inproj_share(const Frame& F) {
    constexpr int N1 = IT_MID - IT_P0, CY = (N1 - 118 * 100 + 255) / 256, CX = CY + 100; int a, n;
    if (F.G == 256) { if (F.bx < 138) { a = F.bx * CY; n = CY; } else { a = 138 * CY + (F.bx - 138) * CX; n = CX; } }
    else { n = (N1 + F.G - 1) / F.G; a = F.bx * n; }
    const int e = a + n < N1 ? a + n : N1;
    if (a < e) conv_range(F, IT_P0 + a, IT_P0 + e);
}
__device__ __forceinline__ void conv_tail(const Frame& F, int first, int last, int c0) {
    int nw = F.G - c0, me = F.bx - c0; if (nw <= 0) { nw = F.G; me = F.bx; }
    if (me < 0) return;
    conv_items(F, first + me * 8 + F.wave, last, nw * 8);
}
__device__ __forceinline__ void phase_prologue(Frame& F) {
    const int gw = F.bx * 8 + F.wave, NGW = F.G * 8;
    conv_items(F, gw, IT_P0, NGW);
    for (int row = gw; row < MROWS; row += NGW) {
        bf16_t* dst = F.h0() + (size_t)row * D;
        if (row >= NTOK + NMETA) {
#pragma unroll
            for (int j = 0; j < 8; ++j) *(u32x2*)(dst + (j * 64 + F.lane) * 4) = (u32x2){0u, 0u};
            continue; }
        const float* src = row < NTOK ? F.x + (size_t)row * D : F.meta + (size_t)(row - NTOK) * D;
        f32x4 v[8]; float s = 0.f;
#pragma unroll
        for (int j = 0; j < 8; ++j) { v[j] = *(const f32x4*)(src + (j * 64 + F.lane) * 4); s += (v[j][0] + v[j][1]) + (v[j][2] + v[j][3]); }
        const float mu = wsum(s) * (1.0f / D); float q = 0.f;
#pragma unroll
        for (int j = 0; j < 8; ++j) { const f32x4 d = v[j] - mu; q += (d[0] * d[0] + d[1] * d[1]) + (d[2] * d[2] + d[3] * d[3]); }
        const float rstd = 1.0f / sqrtf(wsum(q) * (1.0f / D) + LN_EPS);
#pragma unroll
        for (int j = 0; j < 8; ++j) { const int c = (j * 64 + F.lane) * 4; const f32x4 g = *(const f32x4*)(F.lng + c), b = *(const f32x4*)(F.lnb + c); const f32x4 y = (v[j] - mu) * rstd * g + b;
            *(u32x2*)(dst + c) = (u32x2){pack2(y[0], y[1]), pack2(y[2], y[3])}; }
        if (row < NTOK && F.lane == 0) { F.stats0()[row * 2] = mu; F.stats0()[row * 2 + 1] = rstd; }
    }
    if (F.bx == 0) for (int i = F.tid; i < 16 * 272; i += 512) { const int h = i / 272, r = i % 272; F.tab()[i] = r <= 256 ? F.t5[t5_bucket(r - 128) * 16 + h] * LOG2E : 0.f; }
}

template <class Fn> __device__ __forceinline__ void sgemm(const Fn& f, LAS unsigned char* ldsb, int tid, int bx, int G) {
    LAS float* As = (LAS float*)ldsb; LAS float* Bs = As + 32 * 132; LAS float* Bs2 = Bs + 32 * 68;
    const int ntm = f.ntm(), ntn = f.ntn(), K = f.K();
    const int tx = tid & 15, ty = tid >> 4, ar = tid >> 2, akc = (tid & 3) * 8, br = (tid & 255) >> 2;
    for (int tile = bx; tile < ntm * ntn; tile += G) {
        const int tm = tile / ntn, tn = tile % ntn;
        typename Fn::Tile T; if (!f.tile(tm, T)) continue;
        float acc[4][4], acc2[4][4];
#pragma unroll
        for (int i = 0; i < 4; ++i)
#pragma unroll
            for (int j = 0; j < 4; ++j) { acc[i][j] = 0.f; acc2[i][j] = 0.f; }
        const bf16_t* ap = f.arow(T, tm * 128 + ar);
        const bf16_t* bp = tid < 256 ? f.brow(T, tn * 64 + br) : (Fn::DUAL ? f.brow2(T, tn * 64 + br) : nullptr);
        LAS float* Bw = tid < 256 ? Bs : Bs2;
        for (int k0 = 0; k0 < K; k0 += 32) {
            u32x4 av = (u32x4){0u, 0u, 0u, 0u}, bv = (u32x4){0u, 0u, 0u, 0u};
            if (ap) av = *(const u32x4*)(ap + k0 + akc);
            if (bp) bv = *(const u32x4*)(bp + k0 + akc);
            __syncthreads();
#pragma unroll
            for (int i = 0; i < 4; ++i) { As[(akc + 2 * i) * 132 + ar] = __uint_as_float(av[i] << 16); As[(akc + 2 * i + 1) * 132 + ar] = __uint_as_float(av[i] & 0xffff0000u); }
            if (tid < 256 || Fn::DUAL) {
#pragma unroll
                for (int i = 0; i < 4; ++i) { Bw[(akc + 2 * i) * 68 + br] = __uint_as_float(bv[i] << 16); Bw[(akc + 2 * i + 1) * 68 + br] = __uint_as_float(bv[i] & 0xffff0000u); } }
            __syncthreads();
#pragma unroll 8
            for (int kk = 0; kk < 32; ++kk) {
                const f32x4 a = *(const LAS f32x4*)(As + kk * 132 + ty * 4), b = *(const LAS f32x4*)(Bs + kk * 68 + tx * 4);
#pragma unroll
                for (int i = 0; i < 4; ++i)
#pragma unroll
                    for (int j = 0; j < 4; ++j) acc[i][j] += a[i] * b[j];
                if (Fn::DUAL) { const f32x4 b2 = *(const LAS f32x4*)(Bs2 + kk * 68 + tx * 4);
#pragma unroll
                    for (int i = 0; i < 4; ++i)
#pragma unroll
                        for (int j = 0; j < 4; ++j) acc2[i][j] += a[i] * b2[j]; }
            }
        }
#pragma unroll
        for (int i = 0; i < 4; ++i)
#pragma unroll
            for (int j = 0; j < 4; ++j) f.store(T, tm * 128 + ty * 4 + i, tn * 64 + tx * 4 + j, acc[i][j], acc2[i][j]);
    }
}

__device__ __forceinline__ void expert_starts(const Frame& F, LAS int* ps  ) {
    if (F.tid == 0) { int acc = 0; for (int e = 0; e < NE; ++e) { ps[e] = acc; acc += ((F.cnt()[e] + 255) >> 8) << 8; } ps[64] = acc; }
    __syncthreads();
}

struct FnInProj {
    static constexpr bool DUAL = false; struct Tile {}; const Frame& F;
    __device__ int ntm() const { return MROWS / 128; } __device__ int ntn() const { return INW / 64; } __device__ int K() const { return D; }
    __device__ bool tile(int, Tile&) const { return true; }
    __device__ const bf16_t* arow(const Tile&, int row) const { return F.h0() + (size_t)row * D; }
    __device__ const bf16_t* brow(const Tile&, int n) const { return F.wtin() + (size_t)n * D; }
    __device__ const bf16_t* brow2(const Tile&, int) const { return nullptr; }
    __device__ void store(const Tile&, int row, int n, float a, float) const { F.u()[(size_t)row * INW + n] = f2bf(a); }
};
struct FnOutProj {
    static constexpr bool DUAL = false; struct Tile {}; const Frame& F;
    __device__ int ntm() const { return NTOK / 128; } __device__ int ntn() const { return D / 64; } __device__ int K() const { return D; }
    __device__ bool tile(int, Tile&) const { return true; }
    __device__ const bf16_t* arow(const Tile&, int row) const { return F.ya() + (size_t)row * D; }
    __device__ const bf16_t* brow(const Tile&, int n) const { return F.wtout() + (size_t)n * D; }
    __device__ const bf16_t* brow2(const Tile&, int) const { return nullptr; }
    __device__ void store(const Tile&, int row, int n, float a, float) const {
        const float h0 = (F.x[(size_t)row * D + n] - F.stats0()[row * 2]) * F.stats0()[row * 2 + 1] * F.lng[n] + F.lnb[n];
        F.z()[(size_t)row * D + n] = f2bf(a + ALPHA * h0); }
};
struct FnGateUp {
    static constexpr bool DUAL = true; struct Tile { int e, r0, n; }; const Frame& F; const LAS int* ps;
    __device__ int ntm() const { return HBROWS / 128; } __device__ int ntn() const { return DE / 64; } __device__ int K() const { return D; }
    __device__ bool tile(int tm, Tile& T) const { const int row0 = tm * 128;
        if (row0 >= PMAX) { T.e = NE; T.r0 = row0 - PMAX; T.n = NTOK; return true; }
        if (row0 >= ps[64]) return false;
        int e = 0; while (e < NE - 1 && row0 >= ps[e + 1]) ++e;
        T.e = e; T.r0 = row0 - ps[e]; T.n = F.cnt()[e]; return T.r0 < T.n; }
    __device__ const bf16_t* arow(const Tile& T, int row) const { const int r = T.r0 + (row & 127); if (r >= T.n) return nullptr;
        const int tok = T.e < NE ? F.tokl()[(size_t)T.e * NTOK + r] : r; return F.h1() + (size_t)tok * D; }
    __device__ const bf16_t* brow(const Tile& T, int n) const { return F.wtgu() + ((size_t)T.e * 1024 + 256 * (n >> 7) + (n & 127)) * D; }
    __device__ const bf16_t* brow2(const Tile& T, int n) const { return F.wtgu() + ((size_t)T.e * 1024 + 256 * (n >> 7) + 128 + (n & 127)) * D; }
    __device__ void store(const Tile& T, int row, int n, float g, float u) const { const int r = T.r0 + (row & 127); const float w = T.e < NE ? (r < T.n ? F.wl()[(size_t)T.e * NTOK + r] : 0.f) : 1.0f;
        F.hb()[(size_t)row * DE + n] = f2bf(g / (1.0f + __expf(-g)) * (u * w)); }
};
struct FnDown {
    static constexpr bool DUAL = false; struct Tile { int e, r0, n; }; const Frame& F; const LAS int* ps;
    __device__ int ntm() const { return PMAX / 128; } __device__ int ntn() const { return D / 64; } __device__ int K() const { return DE; }
    __device__ bool tile(int tm, Tile& T) const { const int row0 = tm * 128; if (row0 >= ps[64]) return false;
        int e = 0; while (e < NE - 1 && row0 >= ps[e + 1]) ++e;
        T.e = e; T.r0 = row0 - ps[e]; T.n = F.cnt()[e]; return T.r0 < T.n; }
    __device__ const bf16_t* arow(const Tile&, int row) const { return F.hb() + (size_t)row * DE; }
    __device__ const bf16_t* brow(const Tile& T, int n) const { return F.wtd() + ((size_t)T.e * D + n) * DE; }
    __device__ const bf16_t* brow2(const Tile&, int) const { return nullptr; }
    __device__ void store(const Tile& T, int row, int n, float a, float) const { const int r = T.r0 + (row & 127);
        (void)r; ((unsigned char*)F.ym())[(size_t)row * D + n] = (unsigned char)enc8(a); }
};
struct FnFinal {
    static constexpr bool DUAL = false; struct Tile {}; const Frame& F; const LAS int* ps;
    __device__ int ntm() const { return NTOK / 128; } __device__ int ntn() const { return D / 64; } __device__ int K() const { return DE; }
    __device__ bool tile(int, Tile&) const { return true; }
    __device__ const bf16_t* arow(const Tile&, int row) const { return F.hb() + (size_t)(PMAX + row) * DE; }
    __device__ const bf16_t* brow(const Tile&, int n) const { return F.wtd() + ((size_t)NE * D + n) * DE; }
    __device__ const bf16_t* brow2(const Tile&, int) const { return nullptr; }
    __device__ void store(const Tile&, int row, int n, float a, float) const {
        const float h1 = bf2f(F.h1()[(size_t)row * D + n]);
        F.o2()[(size_t)row * D + n] = f2bf(a + ALPHA * h1); }
};

__device__ __forceinline__ void phase_attn_simple(Frame& F) {
    LAS float* qs = (LAS float*)F.lds + F.wave * 512; LAS float* psm = qs + 64;
    const int gw = F.bx * 8 + F.wave, NGW = F.G * 8, lane = F.lane;
    for (int item = gw; item < NTOK * 32; item += NGW) {
        const int tok = item >> 5, hh = item & 31, b = tok >> 13, s = tok & 8191;
        const bool isA = hh < 16; const int h = hh & 15;
        const int qcol = isA ? COL_QA + h * 64 : COL_QB + h * 64, kcol = isA ? COL_KA + (h >> 2) * 64 : COL_KB + h * 64, vcol = isA ? COL_VA + (h >> 2) * 64 : COL_VB + h * 64;
        const int r = s >> 6, c = s & 63, rs = min(max(r - 4, 0), 120), cs = min(max(c - 8, 0), 48);
        const int nkeys = isA ? 16 + 257 : 16 + 128;
        asm volatile("s_waitcnt lgkmcnt(0)" ::: "memory");
        qs[lane] = bf2f(F.u()[(size_t)tok * INW + qcol + lane]);
        asm volatile("s_waitcnt lgkmcnt(0)" ::: "memory");
        float sc[5]; float mx = -INFINITY;
#pragma unroll
        for (int i = 0; i < 5; ++i) {
            const int j = lane + 64 * i; sc[i] = -INFINITY;
            if (j < nkeys) {
                int krow; float bias; bool valid = true;
                if (j < 16) { krow = NTOK + j; bias = isA ? F.t5[t5_bucket(j - 16 - s) * 16 + h] * LOG2E : 0.f; }
                else if (isA) { const int kpos = s - 128 + (j - 16); valid = kpos >= 0 && kpos < SEQ; krow = b * SEQ + kpos; bias = F.tab()[h * 272 + (j - 16)]; }
                else { const int w = j - 16, kr = rs + (w >> 4), kc = cs + (w & 15); krow = b * SEQ + kr * 64 + kc; bias = F.rpb[(h * 15 + (kr - r + 7)) * 31 + (kc - c + 15)] * LOG2E; }
                if (valid) { const bf16_t* kp = F.u() + (size_t)krow * INW + kcol; float dot = 0.f;
#pragma unroll
                    for (int d8 = 0; d8 < 8; ++d8) { const u32x4 kv = *(const u32x4*)(kp + d8 * 8);
#pragma unroll
                        for (int i2 = 0; i2 < 4; ++i2) { dot += qs[d8 * 8 + 2 * i2] * __uint_as_float(kv[i2] << 16); dot += qs[d8 * 8 + 2 * i2 + 1] * __uint_as_float(kv[i2] & 0xffff0000u); } }
                    sc[i] = dot + bias; }
            }
            mx = fmaxf(mx, sc[i]);
        }
        const float sinkl = isA ? F.sink[h] * LOG2E : -INFINITY;
        mx = fmaxf(wmax(mx), sinkl);
        float l = 0.f;
#pragma unroll
        for (int i = 0; i < 5; ++i) { const int j = lane + 64 * i; const float p = sc[i] == -INFINITY ? 0.f : exp2f(sc[i] - mx); l += p; if (j < 320) psm[j] = p; }
        l = wsum(l) + (isA ? exp2f(sinkl - mx) : 0.f);
        asm volatile("s_waitcnt lgkmcnt(0)" ::: "memory");
        float o = 0.f;
        for (int j = 0; j < nkeys; ++j) { const float p = psm[j]; if (p == 0.f) continue;
            int krow; if (j < 16) krow = NTOK + j; else if (isA) krow = b * SEQ + s - 128 + (j - 16); else { const int w = j - 16; krow = b * SEQ + (rs + (w >> 4)) * 64 + cs + (w & 15); }
            o += p * bf2f(F.u()[(size_t)krow * INW + vcol + lane]); }
        o /= l;
        const bf16_t ob = f2bf(o); F.ya()[(size_t)tok * D + hh * 64 + lane] = ob;
        const float of = bf2f(ob), q = wsum(of * of);
        if (lane == 0) F.ssq()[tok * 32 + hh] = q;
    }
}
__device__ __forceinline__ void phase_rmsnorm(Frame& F) {
    const int gw = F.bx * 8 + F.wave, NGW = F.G * 8, lane = F.lane;
    for (int tok = gw; tok < NTOK; tok += NGW) {
        const float q = lane < 32 ? F.ssq()[tok * 32 + lane] : 0.f;
        float qa = lane < 16 ? q : 0.f, qb = (lane >= 16 && lane < 32) ? q : 0.f; qa = wsum(qa); qb = wsum(qb);
        const float ra = 1.0f / sqrtf(qa * (1.0f / 1024.f) + RMS_EPS), rb = 1.0f / sqrtf(qb * (1.0f / 1024.f) + RMS_EPS);
        bf16_t* p = F.ya() + (size_t)tok * D;
#pragma unroll
        for (int j = 0; j < 8; ++j) { const int c = (j * 64 + lane) * 4; const float rr = c < 1024 ? ra : rb; u32x2 w = *(u32x2*)(p + c);
            w.x = pack2(__uint_as_float(w.x << 16) * rr, __uint_as_float(w.x & 0xffff0000u) * rr); w.y = pack2(__uint_as_float(w.y << 16) * rr, __uint_as_float(w.y & 0xffff0000u) * rr); *(u32x2*)(p + c) = w; }
    }
}

__device__ __forceinline__ void phase_ln1_router(Frame& F) {
    LAS float* hs = (LAS float*)F.lds + F.wave * 2048;
    const int gw = F.bx * 8 + F.wave, NGW = F.G * 8, lane = F.lane;
    for (int tok = gw; tok < NTOK; tok += NGW) {
        const bf16_t* src = F.z() + (size_t)tok * D; f32x4 v[8]; float s = 0.f;
#pragma unroll
        for (int j = 0; j < 8; ++j) { const u32x2 w = *(const u32x2*)(src + (j * 64 + lane) * 4); v[j] = (f32x4){__uint_as_float(w.x << 16), __uint_as_float(w.x & 0xffff0000u), __uint_as_float(w.y << 16), __uint_as_float(w.y & 0xffff0000u)}; s += (v[j][0] + v[j][1]) + (v[j][2] + v[j][3]); }
        const float mu = wsum(s) * (1.0f / D); float q = 0.f;
#pragma unroll
        for (int j = 0; j < 8; ++j) { const f32x4 d = v[j] - mu; q += (d[0] * d[0] + d[1] * d[1]) + (d[2] * d[2] + d[3] * d[3]); }
        const float rstd = 1.0f / sqrtf(wsum(q) * (1.0f / D) + LN_EPS);
        asm volatile("s_waitcnt lgkmcnt(0)" ::: "memory");
#pragma unroll
        for (int j = 0; j < 8; ++j) { const int c = (j * 64 + lane) * 4; const f32x4 g = *(const f32x4*)(F.l1g + c), bb = *(const f32x4*)(F.l1b + c); const f32x4 y = (v[j] - mu) * rstd * g + bb;
            *(u32x2*)(F.h1() + (size_t)tok * D + c) = (u32x2){pack2(y[0], y[1]), pack2(y[2], y[3])}; *(LAS f32x4*)(hs + c) = y; }
        if (lane == 0) { F.stats1()[tok * 2] = mu; F.stats1()[tok * 2 + 1] = rstd; }
        asm volatile("s_waitcnt lgkmcnt(0)" ::: "memory");
        float lg = 0.f;
#pragma unroll 8
        for (int n = 0; n < D; ++n) lg += hs[n] * F.w_router[(size_t)n * NE + lane];
        const float score = 1.0f / (1.0f + expf(-lg)), v0 = score + F.rbias[lane];
        int rk = 0;
#pragma unroll
        for (int j = 0; j < 8; ++j) { const int o = (lane & ~7) + j; const float w = __shfl(v0, o); rk += (w > v0 || (w == v0 && o < lane)) ? 1 : 0; }
        float gs = rk < 2 ? v0 : 0.f; gs += __shfl_xor(gs, 1); gs += __shfl_xor(gs, 2); gs += __shfl_xor(gs, 4);
        int grk = 0; const int myg = lane >> 3;
#pragma unroll
        for (int g = 0; g < 8; ++g) { const float w = __shfl(gs, g * 8); grk += (w > gs || (w == gs && g < myg)) ? 1 : 0; }
        const float mv = grk < 4 ? v0 : -INFINITY;
        int erk = 0;
        for (int o = 0; o < 64; ++o) { const float w = __shfl(mv, o); erk += (w > mv || (w == mv && o < lane)) ? 1 : 0; }
        const bool sel = erk < 8;
        const float wsm = wsum(sel ? score : 0.f), wgt = score / (wsm + 1e-20f) * 2.5f;
        if (sel) { const int rr = atomicAdd(F.cnt() + lane, 1); F.tokl()[(size_t)lane * NTOK + rr] = tok; F.wl()[(size_t)lane * NTOK + rr] = wgt; F.tke()[tok * 8 + erk] = lane; F.tkr()[tok * 8 + erk] = rr; }
    }
}
__device__ __forceinline__ void phase_ln2(Frame& F, const LAS int* ps) {
    const int gw = F.bx * 8 + F.wave, NGW = F.G * 8, lane = F.lane;
#pragma unroll 1
    for (int tok = gw; tok < NTOK; tok += NGW) {
        float* dst = F.out + (size_t)tok * D; const bf16_t* o2p = F.o2() + (size_t)tok * D; float v[2][16]; float s = 0.f;
        const int mye = F.tke()[tok * 8 + (lane & 7)], myr = F.tkr()[tok * 8 + (lane & 7)], mypos = ps[mye] + myr;
        u32x4 o[2][2];
#pragma unroll
        for (int k = 0; k < 2; ++k) { o[k][0] = *(const u32x4*)(o2p + (lane + 64 * k) * 16); o[k][1] = *(const u32x4*)(o2p + (lane + 64 * k) * 16 + 8); }
#pragma unroll
        for (int k = 0; k < 2; ++k)
#pragma unroll
            for (int h = 0; h < 2; ++h)
#pragma unroll
                for (int i = 0; i < 4; ++i) { v[k][8 * h + 2 * i] = __uint_as_float(o[k][h][i] << 16); v[k][8 * h + 2 * i + 1] = __uint_as_float(o[k][h][i] & 0xffff0000u); }
        u32x4 y[8][2];
#pragma unroll
        for (int j = 0; j < 8; ++j) { const int p = __shfl(mypos, j); const unsigned char* yp = (const unsigned char*)F.ym() + (size_t)p * D;
#pragma unroll
            for (int k = 0; k < 2; ++k) y[j][k] = *(const u32x4*)(yp + (lane + 64 * k) * 16); }
#pragma unroll
        for (int j = 0; j < 8; ++j)
#pragma unroll
            for (int k = 0; k < 2; ++k)
#pragma unroll
                for (int i = 0; i < 4; ++i) { unsigned w = y[j][k][i]; asm volatile("" : "+v"(w));
                    const unsigned w1 = w >> 8;
                    const unsigned p02 = ((w & 0x007f007fu) << 4) + 0x39003900u + ((w & 0x00800080u) << 8), p13 = ((w1 & 0x007f007fu) << 4) + 0x39003900u + ((w1 & 0x00800080u) << 8);
                    v[k][4 * i] += __uint_as_float(p02 << 16); v[k][4 * i + 2] += __uint_as_float(p02 & 0xffff0000u);
                    v[k][4 * i + 1] += __uint_as_float(p13 << 16); v[k][4 * i + 3] += __uint_as_float(p13 & 0xffff0000u);
                    asm volatile("" : "+v"(v[k][4 * i]), "+v"(v[k][4 * i + 1]), "+v"(v[k][4 * i + 2]), "+v"(v[k][4 * i + 3])); }
#pragma unroll
        for (int k = 0; k < 2; ++k)
#pragma unroll
            for (int i = 0; i < 16; ++i) s += v[k][i];
        const float mu = wsum(s) * (1.0f / D); float q = 0.f;
#pragma unroll
        for (int k = 0; k < 2; ++k)
#pragma unroll
            for (int i = 0; i < 16; ++i) { const float d = v[k][i] - mu; q += d * d; }
        const float rstd = 1.0f / sqrtf(wsum(q) * (1.0f / D) + LN_EPS);
        asm volatile("" ::: "memory");
#pragma unroll
        for (int k = 0; k < 2; ++k)
#pragma unroll
            for (int h = 0; h < 4; ++h) { const int c = (lane + 64 * k) * 16 + 4 * h; const f32x4 g = *(const f32x4*)(F.l2g + c), bb = *(const f32x4*)(F.l2b + c);
                *(f32x4*)(dst + c) = (f32x4){(v[k][4 * h] - mu) * rstd * g[0] + bb[0], (v[k][4 * h + 1] - mu) * rstd * g[1] + bb[1], (v[k][4 * h + 2] - mu) * rstd * g[2] + bb[2], (v[k][4 * h + 3] - mu) * rstd * g[3] + bb[3]}; }
    }
}

#ifndef FAST_P1
#define FAST_P1 1
#endif
#ifndef STAGGER7
#define STAGGER7 0
#endif
#ifndef CONV_NT
#define CONV_NT 1
#endif
#ifndef STAGGER4
#define STAGGER4 0
#endif
#ifndef XCD_TRUE
#define XCD_TRUE 1
#endif
#ifndef DOWN_REV
#define DOWN_REV false
#endif
#ifndef YM_NT
#define YM_NT 0
#endif
#ifndef FAST_P4
#define FAST_P4 1
#endif
#ifndef FAST_P6
#define FAST_P6 1
#endif
#ifndef FAST_P7
#define FAST_P7 1
#endif
namespace pg8 {
typedef short bf16x8 __attribute__((ext_vector_type(8)));
constexpr int BM = 256, BK = 64, HALF = 128, HTB = HALF * BK * 2, STAGE_BYTES = 8 * HTB, NXCD = 8, WGM = 8;
__host__ __device__ __forceinline__ int lds_byte(int r, int c) { const int st = (r >> 4) * 2 + (c >> 5), rr = r & 15, cc = c & 31, ob = rr * 64 + cc * 2; return st * 1024 + (ob ^ (((ob >> 9) & 1) << 5)); }
__host__ __device__ __forceinline__ void stage_rc(int b, int& R, int& C) { const int st = b / 1024, sb = b % 1024, swz = sb ^ (((sb >> 9) & 1) << 5); R = (st >> 1) * 16 + swz / 64; C = (st & 1) * 32 + (swz % 64) / 2; }
__host__ __device__ __forceinline__ int perm32(int rho) { const int n = rho >> 4, i = rho & 15; return 8 * (i >> 2) + 4 * n + (i & 3); }
__device__ __forceinline__ unsigned cvt_pk_bf16(float lo, float hi) { unsigned r; asm volatile("v_cvt_pk_bf16_f32 %0, %1, %2" : "=v"(r) : "v"(lo), "v"(hi)); return r; }
typedef int i32x4 __attribute__((ext_vector_type(4)));
typedef int i32x8 __attribute__((ext_vector_type(8)));
__device__ __forceinline__ i32x8 cat8(bf16x8 a, bf16x8 b) { return __builtin_shufflevector(__builtin_bit_cast(i32x4, a), __builtin_bit_cast(i32x4, b), 0, 1, 2, 3, 4, 5, 6, 7); }
struct Unit { int pm, pn, e, r0, n, orow, tb; };
__device__ __forceinline__ int xcd_remap(int L, int nwg) { const int q = nwg / NXCD, r = nwg % NXCD, xcd = L % NXCD, off = L / NXCD; return (xcd < r ? xcd * (q + 1) : r * (q + 1) + (xcd - r) * q) + off; }
__device__ __forceinline__ void tile_of(int wgid, int nM, int nN, int& pm, int& pn) { const int nig = WGM * nN, gid = wgid / nig, fm = gid * WGM, gsz = (nM - fm) < WGM ? (nM - fm) : WGM; pm = fm + ((wgid % nig) % gsz); pn = (wgid % nig) / gsz; }

template <class Epi, class Sched>
__device__ __forceinline__ void gemm_phase(const int wave0, LAS unsigned char* lds, const Sched& S, const Epi& E, const int lda, const int ldb, const int nt, const int stagger_ticks = 0) {
    int tid = wave0 * 64 + lane_id(); asm volatile("" : "+v"(tid));
    const int wid = wave0, lane = tid & 63, wr = wid >> 2, wc = wid & 3, fr = lane & 15, fq = lane >> 4;
    unsigned voffA[2], voffB[2], voffB2[2], c2[2]; int RA[2];
#pragma unroll
    for (int i = 0; i < 2; ++i) { int R, C; stage_rc(tid * 16 + i * 8192, R, C); const int Rb = Epi::PERM ? ((R & ~31) + perm32(R & 31)) : R;
        voffA[i] = (unsigned)(R * lda + C) * 2u; voffB[i] = (unsigned)(Rb * ldb + C) * 2u; RA[i] = R; c2[i] = (unsigned)C * 2u;
        voffB2[i] = (unsigned)((64 * (R >> 5) + 16 * ((R >> 2) & 3) + 4 * ((R >> 4) & 1) + (R & 3)) * ldb + C) * 2u; }
    const size_t kstep = (size_t)(BK * 2), hstepA = (size_t)HALF * lda * 2, hstepB = (size_t)HALF * ldb * 2, hstepB2 = (size_t)8 * ldb * 2;
    const unsigned lda2 = (unsigned)lda * 2u;
    const unsigned ldsw = (unsigned)wid * 1024u;
    int aoff = lds_byte(wr * 64 + fr, fq * 8), boff = lds_byte(wc * 32 + fr, fq * 8) + 4 * HTB; asm volatile("" : "+v"(aoff), "+v"(boff));
#define PG8_SA(b, h) (((b) * 2 + (h)) * HTB)
#define PG8_SB(b, h) ((4 + (b) * 2 + (h)) * HTB)
#define PG8_STAGE(bufoff, gbase, voff) do { const char* _g = (const char*)(gbase); asm volatile("" : "+s"(_g)); _Pragma("unroll") for (int _i = 0; _i < 2; ++_i) { unsigned _v = (voff)[_i]; asm volatile("" : "+v"(_v)); \
        __builtin_amdgcn_global_load_lds((const unsigned*)(_g + _v), (LAS unsigned*)(lds + (bufoff) + ldsw + _i * 8192), 16, 0, 0); } } while (0)
#define PG8_STG_A(bufoff, p, h, V) do { if constexpr (Sched::GATHER) { PG8_STAGE(bufoff, p, V[h]); } else { PG8_STAGE(bufoff, (p) + (h) * hstepA, voffA); } } while (0)
#define PG8_STG_B(bufoff, p, h) do { if constexpr (Epi::PERM2) { PG8_STAGE(bufoff, (p) + (h) * hstepB2, voffB2); } else { PG8_STAGE(bufoff, (p) + (h) * hstepB, voffB); } } while (0)
#define PG8_LDA(dst, b, h) do { _Pragma("unroll") for (int m = 0; m < 4; ++m) _Pragma("unroll") for (int k = 0; k < 2; ++k) dst[m][k] = *(const LAS bf16x8*)(lds + PG8_SA(b, h) + aoff + m * 2048 + k * 1024); } while (0)
#define PG8_LDB(dst, b, h) do { _Pragma("unroll") for (int n = 0; n < 2; ++n) _Pragma("unroll") for (int k = 0; k < 2; ++k) dst[n][k] = *(const LAS bf16x8*)(lds + boff + (PG8_SB(b, h) - 4 * HTB) + n * 2048 + k * 1024); } while (0)
#define PG8_MMA(ai, bj, At, Bt) do { __builtin_amdgcn_s_setprio(1); _Pragma("unroll") for (int m = 0; m < 4; ++m) _Pragma("unroll") for (int n = 0; n < 2; ++n) { \
        if constexpr (Epi::F8) acc[ai][bj][m][n] = __builtin_amdgcn_mfma_scale_f32_16x16x128_f8f6f4(cat8(Bt[n][0], Bt[n][1]), cat8(At[m][0], At[m][1]), acc[ai][bj][m][n], 0, 0, 0, 0, 0, 0); \
        else { _Pragma("unroll") for (int k = 0; k < 2; ++k) acc[ai][bj][m][n] = __builtin_amdgcn_mfma_f32_16x16x32_bf16(Bt[n][k], At[m][k], acc[ai][bj][m][n], 0, 0, 0); } } __builtin_amdgcn_s_setprio(0); } while (0)
#define PG8_WAIT_V(n) asm volatile("s_waitcnt vmcnt(" #n ")" ::: "memory")
#define PG8_WAIT_L(n) asm volatile("s_waitcnt lgkmcnt(" #n ")" ::: "memory")
#define PG8_BAR __builtin_amdgcn_s_barrier()
#define PG8_SCHED __builtin_amdgcn_sched_barrier(0)
    Unit cur, nxt; int ui = 0;
    if (stagger_ticks) {
        const unsigned long long t0 = __builtin_amdgcn_s_memrealtime(), dl = (unsigned long long)((blockIdx.x >> 3) & 15) * (unsigned)stagger_ticks;
        while (__builtin_amdgcn_s_memrealtime() - t0 < dl) __builtin_amdgcn_s_sleep(4);
        __syncthreads(); }
    if (!S.next(0, cur)) return;
    cur.tb = 0;
    f32x4 acc[2][2][4][2];
#pragma unroll
    for (int a = 0; a < 2; ++a)
#pragma unroll
        for (int b = 0; b < 2; ++b)
#pragma unroll
            for (int m = 0; m < 4; ++m)
#pragma unroll
                for (int n = 0; n < 2; ++n) acc[a][b][m][n] = (f32x4){0.f, 0.f, 0.f, 0.f};
    bf16x8 At[4][2], B0[2][2], B1[2][2];
    unsigned vac[2][2], van[2][2];
    const char* cA = S.abase(cur); const char* cB = S.bbase(cur);
#pragma unroll
    for (int h = 0; h < 2; ++h)
#pragma unroll
        for (int i = 0; i < 2; ++i) { vac[h][i] = Sched::GATHER ? (unsigned)S.arow(cur, h * HALF + RA[i]) * lda2 + c2[i] : 0u; van[h][i] = vac[h][i]; }
    PG8_STG_B(PG8_SB(0, 0), cB, 0); PG8_STG_B(PG8_SB(0, 1), cB, 1); PG8_STG_A(PG8_SA(0, 0), cA, 0, vac); PG8_STG_A(PG8_SA(0, 1), cA, 1, vac);
    if (wr == 1) PG8_BAR;
    PG8_WAIT_V(2); PG8_BAR;
    PG8_STG_B(PG8_SB(1, 0), cB + kstep, 0); PG8_STG_A(PG8_SA(1, 0), cA + kstep, 0, vac); PG8_STG_B(PG8_SB(1, 1), cB + kstep, 1);
    PG8_WAIT_V(6); PG8_BAR;
    for (;;) {
        const bool has_next = S.next(ui + 1, nxt); nxt.tb = (ui + 1) & 1;
        if constexpr (Epi::MIDK) E.unit_begin(cur, wave0 * 64 + lane_id());
        const char* nA = has_next ? S.abase(nxt) : cA; const char* nB = has_next ? S.bbase(nxt) : cB;
        if constexpr (Sched::GATHER) { if (has_next) { const int tq = wave0 * 64 + lane_id();
#pragma unroll
            for (int h = 0; h < 2; ++h)
#pragma unroll
                for (int i = 0; i < 2; ++i) { int R, C; stage_rc(tq * 16 + i * 8192, R, C); van[h][i] = (unsigned)S.arow(nxt, h * HALF + R); } } }
#pragma unroll 1
        for (int t = 0; t < nt; t += 2) {
            const bool last = (t == nt - 2);
            const char* a1 = cA + (size_t)(t + 1) * kstep;
            const char* a2 = last ? nA : cA + (size_t)(t + 2) * kstep; const char* b2 = last ? nB : cB + (size_t)(t + 2) * kstep;
            const char* a3 = a2 + kstep; const char* b3 = b2 + kstep;
            unsigned va2[2][2];
#pragma unroll
            for (int h = 0; h < 2; ++h)
#pragma unroll
                for (int i = 0; i < 2; ++i) va2[h][i] = last ? van[h][i] : vac[h][i];
            PG8_LDB(B0, 0, 0); PG8_LDB(B1, 0, 1); PG8_SCHED; PG8_LDA(At, 0, 0); PG8_STG_A(PG8_SA(1, 1), a1, 1, vac);
            PG8_WAIT_V(8); PG8_WAIT_L(0); PG8_BAR; PG8_MMA(0, 0, At, B0); PG8_MMA(0, 1, At, B1); PG8_BAR; PG8_SCHED;
            PG8_LDA(At, 0, 1); PG8_STG_B(PG8_SB(0, 0), b2, 0); PG8_STG_B(PG8_SB(0, 1), b2, 1); PG8_STG_A(PG8_SA(0, 0), a2, 0, va2);
            PG8_WAIT_V(8); PG8_WAIT_L(0); PG8_BAR; PG8_MMA(1, 0, At, B0); PG8_MMA(1, 1, At, B1); PG8_BAR; PG8_SCHED;
            PG8_LDB(B0, 1, 0); PG8_LDB(B1, 1, 1); PG8_SCHED; PG8_LDA(At, 1, 0); PG8_STG_A(PG8_SA(0, 1), a2, 1, va2);
            PG8_WAIT_V(8); PG8_WAIT_L(0); PG8_BAR; PG8_MMA(0, 0, At, B0); PG8_MMA(0, 1, At, B1); PG8_BAR; PG8_SCHED;
            PG8_LDA(At, 1, 1); PG8_STG_B(PG8_SB(1, 0), b3, 0); PG8_STG_B(PG8_SB(1, 1), b3, 1); PG8_STG_A(PG8_SA(1, 0), a3, 0, va2);
            PG8_WAIT_V(8); PG8_WAIT_L(0); PG8_BAR; PG8_MMA(1, 0, At, B0); PG8_MMA(1, 1, At, B1); PG8_BAR; PG8_SCHED;
            if constexpr (Epi::MIDK) { if (2 * (t + 2) == nt) E.mid(acc, cur, wr, fr); }
            if constexpr (Sched::GATHER) { if (t + 4 == nt && has_next) {
                const int tq = wave0 * 64 + lane_id();
#pragma unroll
                for (int h = 0; h < 2; ++h)
#pragma unroll
                    for (int i = 0; i < 2; ++i) { int R, C; stage_rc(tq * 16 + i * 8192, R, C); asm volatile("" : "+v"(van[h][i])); van[h][i] = van[h][i] * lda2 + (unsigned)C * 2u; } } }
        }
        if (wr == 0) PG8_BAR;
        { const int le = lane_id(); E(acc, cur, wr, wc, le & 15, le >> 4); }
        if (!has_next) break;
#pragma unroll
        for (int a = 0; a < 2; ++a)
#pragma unroll
            for (int b = 0; b < 2; ++b)
#pragma unroll
                for (int m = 0; m < 4; ++m)
#pragma unroll
                    for (int n = 0; n < 2; ++n) acc[a][b][m][n] = (f32x4){0.f, 0.f, 0.f, 0.f};
        cur = nxt; cA = nA; cB = nB; ++ui;
#pragma unroll
        for (int h = 0; h < 2; ++h)
#pragma unroll
            for (int i = 0; i < 2; ++i) vac[h][i] = van[h][i];
        if (wr == 1) PG8_BAR;
    }
    PG8_WAIT_V(0);
    PG8_BAR;
#undef PG8_SA
#undef PG8_SB
#undef PG8_STAGE
#undef PG8_STG_A
#undef PG8_STG_B
#undef PG8_LDA
#undef PG8_LDB
#undef PG8_MMA
#undef PG8_WAIT_V
#undef PG8_WAIT_L
#undef PG8_BAR
#undef PG8_SCHED
}
}

struct SchedInProj {
    static constexpr bool GATHER = false; const char* A; const char* B; int G, c, i0, i1;
    __device__ __forceinline__ bool next(int i, pg8::Unit& u) const { const int ii = i0 + i; if (ii >= i1) return false; const int L = ii * G + c; if (L >= 1162) return false;
        if (L < 1152) pg8::tile_of(pg8::xcd_remap(L, 1152), 64, 18, u.pm, u.pn); else { const int k = L - 1152; u.pm = 64; u.pn = k < 2 ? 4 + k : 8 + k; }
        return true; }
    __device__ __forceinline__ const char* abase(const pg8::Unit& u) const { return A + (size_t)u.pm * 256 * D * 2; }
    __device__ __forceinline__ const char* bbase(const pg8::Unit& u) const { return B + (size_t)u.pn * 256 * D * 2; }
    __device__ __forceinline__ int arow(const pg8::Unit&, int) const { return 0; }
};
struct SchedOutProj {
    static constexpr bool GATHER = false; const char* A; const char* B; int G, c;
    __device__ __forceinline__ bool next(int i, pg8::Unit& u) const { const int L = i * G + c; if (L >= 512) return false; pg8::tile_of(pg8::xcd_remap(L, 512), 64, 8, u.pm, u.pn); return true; }
    __device__ __forceinline__ const char* abase(const pg8::Unit& u) const { return A + (size_t)u.pm * 256 * D * 2; }
    __device__ __forceinline__ const char* bbase(const pg8::Unit& u) const { return B + (size_t)u.pn * 256 * D * 2; }
    __device__ __forceinline__ int arow(const pg8::Unit&, int) const { return 0; }
};
__device__ __forceinline__ void moe_tables(const Frame& F, LAS int* ps) {
    if (F.tid < NE) ps[256 + F.tid] = F.cnt()[F.tid];
    __syncthreads();
    if (F.tid == 0) { int acc = 0, ta = 0; for (int e = 0; e < NE; ++e) { const int mt = (ps[256 + e] + 255) >> 8; ps[e] = acc; ps[128 + e] = ta; acc += mt * 256; ta += mt; }
        ps[64] = acc; ps[128 + 64] = ta; ps[128 + 65] = ta + NTOK / 256; ps[256 + 64] = NTOK; }
    __syncthreads();
    for (int t = F.tid; t < 640; t += 512) { int e = 0; while (e < NE && t >= ps[128 + e + 1]) ++e; ps[384 + t] = e; }
    __syncthreads();
}
template <int NN, bool REV> __device__ __forceinline__ bool moe_unit(const LAS int* ps, int L, pg8::Unit& u, int ntile) {
    const int nU = ntile * NN; if (L >= nU) return false;
    const int wg0 = pg8::xcd_remap(L, nU), wg = REV ? nU - 1 - wg0 : wg0, tile = wg / NN; u.pn = wg % NN;
    const int e = __builtin_amdgcn_readfirstlane(ps[384 + tile]); u.e = e; u.pm = tile - __builtin_amdgcn_readfirstlane(ps[128 + e]); u.r0 = u.pm * 256; u.n = __builtin_amdgcn_readfirstlane(ps[256 + e]);
    u.orow = (e < NE ? __builtin_amdgcn_readfirstlane(ps[e]) : PMAX) + u.r0;
    return true; }
struct SchedGU {
    static constexpr bool GATHER = true; const char* A; const char* B; const int* tokl; const int* cnt; const LAS int* ps; int G, c, ntile;
    __device__ __forceinline__ bool next(int i, pg8::Unit& u) const { return moe_unit<4, false>(ps, i * G + c, u, ntile); }
    __device__ __forceinline__ const char* abase(const pg8::Unit&) const { return A; }
    __device__ __forceinline__ const char* bbase(const pg8::Unit& u) const { return B + ((size_t)u.e * 1024 + u.pn * 256) * D; }
    __device__ __forceinline__ int arow(const pg8::Unit& u, int r) const { const int rr = min(u.r0 + r, u.n - 1); return u.e < NE ? tokl[(size_t)u.e * NTOK + rr] : rr; }
};
struct SchedDown {
    static constexpr bool GATHER = false; const char* A; const char* B; const int* cnt; const LAS int* ps; int G, c, ntile;
    __device__ __forceinline__ bool next(int i, pg8::Unit& u) const { return moe_unit<8, DOWN_REV>(ps, i * G + c, u, ntile); }
    __device__ __forceinline__ const char* abase(const pg8::Unit& u) const { return A + (size_t)u.orow * DE; }
    __device__ __forceinline__ const char* bbase(const pg8::Unit& u) const { return B + ((size_t)u.e * D + u.pn * 256) * DE; }
    __device__ __forceinline__ int arow(const pg8::Unit&, int) const { return 0; }
};
struct SchedDownShared {
    static constexpr bool GATHER = false; const char* A; const char* B; int G, c;
    __device__ __forceinline__ bool next(int i, pg8::Unit& u) const { const int L = i * G + c; if (L >= 512) return false; pg8::tile_of(pg8::xcd_remap(L, 512), 64, 8, u.pm, u.pn);
        u.e = NE; u.r0 = u.pm * 256; u.n = NTOK; u.orow = PMAX + u.r0; return true; }
    __device__ __forceinline__ const char* abase(const pg8::Unit& u) const { return A + (size_t)u.orow * DE; }
    __device__ __forceinline__ const char* bbase(const pg8::Unit& u) const { return B + ((size_t)NE * D + u.pn * 256) * DE; }
    __device__ __forceinline__ int arow(const pg8::Unit&, int) const { return 0; }
};
struct EpiU {
    static constexpr bool F8 = false; static constexpr bool PERM2 = false; static constexpr bool MIDK = false; static constexpr bool PERM = true; bf16_t* U; int nostore;
    __device__ __forceinline__ void operator()(const f32x4 (&acc)[2][2][4][2], const pg8::Unit& u, int wr, int wc, int fr, int fq) const {
        const int row0 = u.pm * 256 + wr * 64 + fr, col0 = u.pn * 256 + wc * 32 + 8 * fq;
        if (nostore) {
#pragma unroll
            for (int ai = 0; ai < 2; ++ai)
#pragma unroll
                for (int bj = 0; bj < 2; ++bj)
#pragma unroll
                    for (int m = 0; m < 4; ++m)
#pragma unroll
                        for (int n = 0; n < 2; ++n) asm volatile("" :: "v"(acc[ai][bj][m][n]));
            return; }
#pragma unroll
        for (int ai = 0; ai < 2; ++ai)
#pragma unroll
            for (int m = 0; m < 4; ++m) { bf16_t* rowp = U + (size_t)(row0 + ai * 128 + m * 16) * INW + col0;
#pragma unroll
                for (int bj = 0; bj < 2; ++bj) { const f32x4 v0 = acc[ai][bj][m][0], v1 = acc[ai][bj][m][1]; u32x4 w;
                    w.x = pg8::cvt_pk_bf16(v0[0], v0[1]); w.y = pg8::cvt_pk_bf16(v0[2], v0[3]); w.z = pg8::cvt_pk_bf16(v1[0], v1[1]); w.w = pg8::cvt_pk_bf16(v1[2], v1[3]);
                    *(u32x4*)(rowp + bj * 128) = w; } }
    }
};
struct EpiZ {
    static constexpr bool F8 = false; static constexpr bool PERM2 = false; static constexpr bool MIDK = true; static constexpr bool PERM = true; bf16_t* Z; const bf16_t* H0; const float* ssq; LAS float* tab;
    __device__ __forceinline__ void unit_begin(const pg8::Unit& u, int tid) const {
        const int row = tid >> 1, grp = tid & 1; const float* p = ssq + (size_t)(u.pm * 256 + row) * 32 + 16 * grp;
        const f32x4 a = *(const f32x4*)p, b4 = *(const f32x4*)(p + 4), c = *(const f32x4*)(p + 8), d = *(const f32x4*)(p + 12);
        const float s = (((a[0] + a[1]) + (a[2] + a[3])) + ((b4[0] + b4[1]) + (b4[2] + b4[3]))) + (((c[0] + c[1]) + (c[2] + c[3])) + ((d[0] + d[1]) + (d[2] + d[3])));
        tab[(u.tb * 256 + row) * 2 + grp] = 1.0f / sqrtf(s * (1.0f / 1024.f) + RMS_EPS);
    }
    __device__ __forceinline__ void mid(f32x4 (&acc)[2][2][4][2], const pg8::Unit& u, int wr, int fr) const {
#pragma unroll
        for (int ai = 0; ai < 2; ++ai)
#pragma unroll
            for (int m = 0; m < 4; ++m) { const int r = ai * 128 + wr * 64 + m * 16 + fr; const float f = tab[(u.tb * 256 + r) * 2] / tab[(u.tb * 256 + r) * 2 + 1];
#pragma unroll
                for (int bj = 0; bj < 2; ++bj)
#pragma unroll
                    for (int n = 0; n < 2; ++n) acc[ai][bj][m][n] *= f; }
    }
    __device__ __forceinline__ void operator()(const f32x4 (&acc)[2][2][4][2], const pg8::Unit& u, int wr, int wc, int fr, int fq) const {
        const int row0 = u.pm * 256 + wr * 64 + fr, col0 = u.pn * 256 + wc * 32 + 8 * fq;
#pragma unroll
        for (int am = 0; am < 4; ++am) {
            u32x4 hv[2][2]; float rb[2];
#pragma unroll
            for (int q = 0; q < 2; ++q) { const int ai = am >> 1, m = (am & 1) * 2 + q; const size_t off = (size_t)(row0 + ai * 128 + m * 16) * D + col0;
                rb[q] = tab[(u.tb * 256 + ai * 128 + wr * 64 + m * 16 + fr) * 2 + 1];
#pragma unroll
                for (int bj = 0; bj < 2; ++bj) hv[q][bj] = *(const u32x4*)(H0 + off + bj * 128); }
#pragma unroll
            for (int q = 0; q < 2; ++q) { const int ai = am >> 1, m = (am & 1) * 2 + q; const size_t off = (size_t)(row0 + ai * 128 + m * 16) * D + col0;
#pragma unroll
                for (int bj = 0; bj < 2; ++bj) { const u32x4 h4 = hv[q][bj];
                    const f32x4 h0v = (f32x4){__uint_as_float(h4.x << 16), __uint_as_float(h4.x & 0xffff0000u), __uint_as_float(h4.y << 16), __uint_as_float(h4.y & 0xffff0000u)};
                    const f32x4 h1v = (f32x4){__uint_as_float(h4.z << 16), __uint_as_float(h4.z & 0xffff0000u), __uint_as_float(h4.w << 16), __uint_as_float(h4.w & 0xffff0000u)};
                    const f32x4 v0 = acc[ai][bj][m][0] * rb[q] + h0v * ALPHA, v1 = acc[ai][bj][m][1] * rb[q] + h1v * ALPHA; u32x4 w;
                    w.x = pg8::cvt_pk_bf16(v0[0], v0[1]); w.y = pg8::cvt_pk_bf16(v0[2], v0[3]); w.z = pg8::cvt_pk_bf16(v1[0], v1[1]); w.w = pg8::cvt_pk_bf16(v1[2], v1[3]);
                    *(u32x4*)(Z + off + bj * 128) = w; } }
            asm volatile("" ::: "memory"); }
    }
};
__device__ __forceinline__ float silu_mul(float g, float u) { return g * __builtin_amdgcn_rcpf(1.0f + __builtin_amdgcn_exp2f(-g * LOG2E)) * u; }
struct EpiGU {
    static constexpr bool F8 = true; static constexpr bool PERM2 = false; static constexpr bool MIDK = false; static constexpr bool PERM = true; unsigned char* H; const float* wl;
    __device__ __forceinline__ void operator()(const f32x4 (&acc)[2][2][4][2], const pg8::Unit& u, int wr, int wc, int fr, int fq) const {
        int rl0 = wr * 64 + fr, col0 = u.pn * 128 + wc * 32 + 8 * fq; asm volatile("" : "+v"(rl0), "+v"(col0));
        float wv[2][4];
#pragma unroll
        for (int ai = 0; ai < 2; ++ai)
#pragma unroll
            for (int m = 0; m < 4; ++m) { const int r = u.r0 + rl0 + ai * 128 + m * 16; wv[ai][m] = (u.e < NE ? (r < u.n ? wl[(size_t)u.e * NTOK + r] : 0.f) : 1.0f) * (S8_GU_INV * S8_HB); }
#pragma unroll
        for (int ai = 0; ai < 2; ++ai)
#pragma unroll
            for (int m = 0; m < 4; ++m) { const f32x4 g0 = acc[ai][0][m][0] * S8_GU_INV, g1 = acc[ai][0][m][1] * S8_GU_INV, u0 = acc[ai][1][m][0] * wv[ai][m], u1 = acc[ai][1][m][1] * wv[ai][m];
                const u32x2 w = (u32x2){e4m3x4(silu_mul(g0[0], u0[0]), silu_mul(g0[1], u0[1]), silu_mul(g0[2], u0[2]), silu_mul(g0[3], u0[3])),
                                        e4m3x4(silu_mul(g1[0], u1[0]), silu_mul(g1[1], u1[1]), silu_mul(g1[2], u1[2]), silu_mul(g1[3], u1[3]))};
                *(u32x2*)(H + (size_t)(u.orow + rl0 + ai * 128 + m * 16) * DE + col0) = w; }
    }
};
struct EpiDownR {
    static constexpr bool F8 = true; static constexpr bool PERM2 = true; static constexpr bool MIDK = false; static constexpr bool PERM = true; unsigned char* Y; int nostore;
    __device__ __forceinline__ void operator()(const f32x4 (&acc)[2][2][4][2], const pg8::Unit& u, int wr, int wc, int fr, int fq) const {
        int rl0 = wr * 64 + fr, col0 = u.pn * 256 + wc * 64 + 16 * fq; asm volatile("" : "+v"(rl0), "+v"(col0));
        if (nostore) {
#pragma unroll
            for (int ai = 0; ai < 2; ++ai)
#pragma unroll
                for (int bj = 0; bj < 2; ++bj)
#pragma unroll
                    for (int m = 0; m < 4; ++m)
#pragma unroll
                        for (int n = 0; n < 2; ++n) asm volatile("" :: "v"(acc[ai][bj][m][n]));
            return; }
#pragma unroll
        for (int ai = 0; ai < 2; ++ai)
#pragma unroll
            for (int m = 0; m < 4; ++m) { const int rl = rl0 + ai * 128 + m * 16; if (u.r0 + rl >= u.n) continue;
                f32x4 a0 = acc[ai][0][m][0], a1 = acc[ai][0][m][1], b0 = acc[ai][1][m][0], b1 = acc[ai][1][m][1];
                asm volatile("" : "+v"(a0), "+v"(a1), "+v"(b0), "+v"(b1));
                const u32x4 q = (u32x4){enc8x4(a0[0], a0[1], a0[2], a0[3]), enc8x4(a1[0], a1[1], a1[2], a1[3]), enc8x4(b0[0], b0[1], b0[2], b0[3]), enc8x4(b1[0], b1[1], b1[2], b1[3])};
                *(u32x4*)(Y + (size_t)(u.orow + rl) * D + col0) = q;
                asm volatile("" ::: "memory"); }
    }
};
struct EpiDownS {
    static constexpr bool F8 = true; static constexpr bool PERM2 = false; static constexpr bool MIDK = false; static constexpr bool PERM = true; bf16_t* O; const bf16_t* H1;
    __device__ __forceinline__ void operator()(const f32x4 (&acc)[2][2][4][2], const pg8::Unit& u, int wr, int wc, int fr, int fq) const {
        int rl0 = wr * 64 + fr, col0 = u.pn * 256 + wc * 32 + 8 * fq; asm volatile("" : "+v"(rl0), "+v"(col0));
#pragma unroll
        for (int am = 0; am < 4; ++am) {
            u32x4 hv[2][2];
#pragma unroll
            for (int q = 0; q < 2; ++q) { const int ai = am >> 1, m = (am & 1) * 2 + q; const size_t off = (size_t)(u.r0 + rl0 + ai * 128 + m * 16) * D + col0;
#pragma unroll
                for (int bj = 0; bj < 2; ++bj) hv[q][bj] = *(const u32x4*)(H1 + off + bj * 128); }
#pragma unroll
            for (int q = 0; q < 2; ++q) { const int ai = am >> 1, m = (am & 1) * 2 + q; const size_t off = (size_t)(u.r0 + rl0 + ai * 128 + m * 16) * D + col0;
#pragma unroll
                for (int bj = 0; bj < 2; ++bj) { const u32x4 h4 = hv[q][bj];
                    const f32x4 h0v = (f32x4){__uint_as_float(h4.x << 16), __uint_as_float(h4.x & 0xffff0000u), __uint_as_float(h4.y << 16), __uint_as_float(h4.y & 0xffff0000u)};
                    const f32x4 h1v = (f32x4){__uint_as_float(h4.z << 16), __uint_as_float(h4.z & 0xffff0000u), __uint_as_float(h4.w << 16), __uint_as_float(h4.w & 0xffff0000u)};
                    const f32x4 v0 = acc[ai][bj][m][0] * S8_DN_INV + h0v * ALPHA, v1 = acc[ai][bj][m][1] * S8_DN_INV + h1v * ALPHA; u32x4 w;
                    w.x = pg8::cvt_pk_bf16(v0[0], v0[1]); w.y = pg8::cvt_pk_bf16(v0[2], v0[3]); w.z = pg8::cvt_pk_bf16(v1[0], v1[1]); w.w = pg8::cvt_pk_bf16(v1[2], v1[3]);
                    *(u32x4*)(O + off + bj * 128) = w; } }
            asm volatile("" ::: "memory"); }
    }
};

#ifndef FAST_P2
#define FAST_P2 1
#endif
namespace att {
typedef short bf16x8 __attribute__((ext_vector_type(8)));
typedef short s16x4 __attribute__((ext_vector_type(4)));
typedef float f32x16 __attribute__((ext_vector_type(16)));
typedef LAS const char* lds_cptr;
constexpr int SLOT = 16384, NSLOT = 6, RING = NSLOT * SLOT;
constexpr int TA_W = 452, TA_OFF = 224;
constexpr int TB_W = 468;
constexpr int OFF_TABA = RING, OFF_TABB = OFF_TABA, OFF_WS = OFF_TABA + 4 * TA_W * 4, OFF_OST = OFF_WS + 8 * 256, ATT_LDS = OFF_OST + 8 * 4096;
static_assert(ATT_LDS <= LDS_BYTES - 16 - 1024, "attention LDS map");
constexpr float NEGB = -1e30f, THR = 8.0f;
#define ATT_MFMA(a, b, c) __builtin_amdgcn_mfma_f32_32x32x16_bf16(a, b, c, 0, 0, 0)
__device__ __forceinline__ int crow(int r, int hi) { return (r & 3) + 8 * (r >> 2) + 4 * hi; }
__device__ __forceinline__ s16x4 vtr(lds_cptr p) { typedef short v4i16_t __attribute__((ext_vector_type(4))); return __builtin_bit_cast(s16x4, __builtin_amdgcn_ds_read_tr16_b64_v4i16((LAS v4i16_t*)p)); }
__device__ __forceinline__ float swapmax(float m) { auto rr = __builtin_amdgcn_permlane32_swap(__float_as_uint(m), __float_as_uint(m), false, false); return fmaxf(__uint_as_float(rr[0]), __uint_as_float(rr[1])); }
__device__ __forceinline__ float swapsum(float m) { auto rr = __builtin_amdgcn_permlane32_swap(__float_as_uint(m), __float_as_uint(m), false, false); return __uint_as_float(rr[0]) + __uint_as_float(rr[1]); }

__device__ __forceinline__ float bf16r(float x) { return __uint_as_float(pg8::cvt_pk_bf16(x, 0.f) << 16); }
__device__ __forceinline__ bf16x8 frag_k0(unsigned bits16, int hi) { const u32x4 w = (u32x4){hi == 0 ? bits16 : 0u, 0u, 0u, 0u}; return __builtin_bit_cast(bf16x8, w); }
template <int NH, int NS, class BiasFn>
__device__ __forceinline__ void tile_qb(const bf16x8 (&kf)[8], const bf16x8 (&qr)[4], bf16x8& mq, const bf16x8& ones, lds_cptr vp, f32x16 (&o)[2], float& m, float& l, LAS float* wsf, int r32, int hi, const BiasFn& bias) {
    f32x16 c[NH];
#pragma unroll
    for (int hf = 0; hf < NH; ++hf)
#pragma unroll
        for (int r = 0; r < 16; ++r) c[hf][r] = bias(hf, r);
    s16x4 vlo[NS][2], vhi[NS][2];
#pragma unroll
    for (int dh = 0; dh < 2; ++dh) { vlo[0][dh] = vtr(vp + dh * 4096); vhi[0][dh] = vtr(vp + dh * 4096 + 512); }
    __builtin_amdgcn_sched_barrier(0);
#pragma unroll
    for (int hf = 0; hf < NH; ++hf) { c[hf] = ATT_MFMA(ones, mq, c[hf]);
#pragma unroll
        for (int d0 = 0; d0 < 4; ++d0) c[hf] = ATT_MFMA(kf[2 * d0 + hf], qr[d0], c[hf]); }
    float mx = NEGB;
#pragma unroll
    for (int hf = 0; hf < NH; ++hf)
#pragma unroll
        for (int r = 0; r < 16; ++r) mx = fmaxf(mx, c[hf][r]);
    mx = swapmax(mx);
    if (__any(mx > THR)) {
        const float mn = bf16r(m + fmaxf(mx, 0.f)), dl = mn - m, f = __builtin_amdgcn_exp2f(-dl); m = mn; l *= f;
        mq = frag_k0(__float_as_uint(-mn) >> 16, hi);
        if (hi == 0) wsf[r32] = f;
        asm volatile("s_waitcnt lgkmcnt(0)" ::: "memory");
#pragma unroll
        for (int r = 0; r < 16; ++r) { const float fr = wsf[crow(r, hi)]; o[0][r] *= fr; o[1][r] *= fr; }
#pragma unroll
        for (int hf = 0; hf < NH; ++hf)
#pragma unroll
            for (int r = 0; r < 16; ++r) c[hf][r] -= dl;
    }
#pragma unroll
    for (int s = 1; s < NS; ++s)
#pragma unroll
        for (int dh = 0; dh < 2; ++dh) { vlo[s][dh] = vtr(vp + dh * 4096 + s * 1024); vhi[s][dh] = vtr(vp + dh * 4096 + s * 1024 + 512); }
    __builtin_amdgcn_sched_barrier(0);
    float ls = 0.f;
#pragma unroll
    for (int hf = 0; hf < NH; ++hf)
#pragma unroll
        for (int r = 0; r < 16; ++r) { c[hf][r] = __builtin_amdgcn_exp2f(c[hf][r]); ls += c[hf][r]; }
    l += ls;
#pragma unroll
    for (int s = 0; s < NS; ++s) {
        const f32x16& cc = c[s >> 1]; const int rb = (s & 1) * 8;
        u32x4 pw; pw.x = pg8::cvt_pk_bf16(cc[rb + 0], cc[rb + 1]); pw.y = pg8::cvt_pk_bf16(cc[rb + 2], cc[rb + 3]); pw.z = pg8::cvt_pk_bf16(cc[rb + 4], cc[rb + 5]); pw.w = pg8::cvt_pk_bf16(cc[rb + 6], cc[rb + 7]);
        const bf16x8 pa = __builtin_bit_cast(bf16x8, pw);
#pragma unroll
        for (int dh = 0; dh < 2; ++dh) { const s16x4 lo = vlo[s][dh], hi4 = vhi[s][dh];
            const bf16x8 vf = (bf16x8){lo[0], lo[1], lo[2], lo[3], hi4[0], hi4[1], hi4[2], hi4[3]};
            o[dh] = ATT_MFMA(pa, vf, o[dh]); }
    }
}
template <class TokFn>
__device__ __forceinline__ void finish_qb(const Frame& F, f32x16 (&o)[2], float l, LAS float* wsf, LAS bf16_t* stg, int lane, int r32, int hi, int ocol, int hidx, const TokFn& tokq) {
    l = swapsum(l);
    asm volatile("s_waitcnt lgkmcnt(0)" ::: "memory");
    if (hi == 0) wsf[32 + r32] = l;
    asm volatile("s_waitcnt lgkmcnt(0)" ::: "memory");
#pragma unroll
    for (int r = 0; r < 16; ++r) { const int orow = crow(r, hi); const float rl = __builtin_amdgcn_rcpf(wsf[32 + orow]);
        stg[orow * 64 + r32] = f2bf(o[0][r] * rl); stg[orow * 64 + 32 + r32] = f2bf(o[1][r] * rl); }
    asm volatile("s_waitcnt lgkmcnt(0)" ::: "memory");
#pragma unroll
    for (int i = 0; i < 4; ++i) { const int row = i * 8 + (lane >> 3), ch = lane & 7; const u32x4 w = *(const LAS u32x4*)(stg + row * 64 + ch * 8); const int tok = tokq(row);
        *(u32x4*)(F.ya() + (size_t)tok * D + ocol + ch * 8) = w;
        float q = 0.f;
#pragma unroll
        for (int j = 0; j < 4; ++j) { const float a = __uint_as_float(w[j] << 16), b = __uint_as_float(w[j] & 0xffff0000u); q += a * a + b * b; }
        q += __shfl_xor(q, 1); q += __shfl_xor(q, 2); q += __shfl_xor(q, 4);
        if (ch == 0) F.ssq()[tok * 32 + hidx] = q; }
    asm volatile("s_waitcnt lgkmcnt(0)" ::: "memory");
}

template <int MODE>
__device__ __forceinline__ void attn_unit(const Frame& F, int L) {
    LAS unsigned char* lds = F.lds;
    const int lane = F.lane, wid = F.wave, r32 = lane & 31, hi = lane >> 5;
    LAS float* wsf = (LAS float*)(lds + OFF_WS + wid * 256); LAS bf16_t* stg = (LAS bf16_t*)(lds + OFF_OST + wid * 4096);
    int b, kcol, vcol, qcol, ocol, hidx, nband, trow0, qtok0;
    int hb = 0, qbw = 0, kt0 = 0;
    int R0 = 0, pr = 0, jc = 0, cb = 0, kr0 = 0;
    if (MODE == 0) { const int kvh = L & 3; hb = (L >> 2) & 127; b = L >> 9; const int hq = 4 * kvh + (wid >> 1); qbw = wid & 1;
        qcol = COL_QA + hq * 64; kcol = COL_KA + kvh * 64; vcol = COL_VA + kvh * 64; ocol = hq * 64; hidx = hq;
        kt0 = max(0, hb - 2); const int kt1 = min(127, hb + 2); nband = kt1 - kt0 + 1; trow0 = b * SEQ + 64 * kt0; qtok0 = b * SEQ + 64 * hb + 32 * qbw;
    } else { const int h = L & 15, rb = (L >> 4) & 31; b = L >> 9; R0 = rb * 4; pr = wid >> 2; jc = wid & 3; cb = min(max(16 * jc - 8, 0), 32);
        qcol = COL_QB + h * 64; kcol = COL_KB + h * 64; vcol = COL_VB + h * 64; ocol = 1024 + h * 64; hidx = 16 + h;
        kr0 = min(max(R0 - 4, 0), 120); const int kr1 = min(max(R0 + 3 - 4, 0), 120) + 7; nband = kr1 - kr0 + 1; trow0 = b * SEQ + kr0 * 64; qtok0 = b * SEQ + (R0 + 2 * pr) * 64 + 16 * jc; }
    const int NT = 1 + nband;
    const bf16_t* ksrc = F.u() + (size_t)lane * INW + kcol + wid * 8;
    const bf16_t* vsrc = F.u() + (size_t)(16 * (wid & 3) + (lane >> 2)) * INW + vcol + (wid >> 2) * 32 + (lane & 3) * 8;
#define ATT_TROW(t) ((t) == 0 ? NTOK : trow0 + ((t) - 1) * 64)
#define ATT_ISSUE(t) do { const size_t ro_ = (size_t)ATT_TROW(t) * INW; const int sl_ = ((t) % NSLOT) * SLOT; \
        __builtin_amdgcn_global_load_lds((const unsigned*)(ksrc + ro_), (LAS unsigned*)(lds + sl_ + wid * 1024), 16, 0, 0); \
        __builtin_amdgcn_global_load_lds((const unsigned*)(vsrc + ro_), (LAS unsigned*)(lds + sl_ + 8192 + wid * 1024), 16, 0, 0); } while (0)
    bf16x8 qr[4];
    { const int tok = MODE == 0 ? qtok0 + r32 : qtok0 + (r32 >> 4) * 64 + (r32 & 15);
#pragma unroll
      for (int d0 = 0; d0 < 4; ++d0) qr[d0] = *(const bf16x8*)(F.u() + (size_t)tok * INW + qcol + d0 * 16 + hi * 8); }
    if (MODE == 0) { LAS float* tA = (LAS float*)(lds + OFF_TABA); const int h0 = 4 * (L & 3);
        for (int i = F.tid; i < 4 * TA_W; i += 512) { const int g = i / TA_W, rel = i % TA_W - TA_OFF; tA[i] = (rel >= -128 && rel <= 128) ? F.tab()[(h0 + g) * 272 + rel + 128] : NEGB; } }
    else { LAS float* tB = (LAS float*)(lds + OFF_TABB); const int h = L & 15;
        for (int i = F.tid; i < 576; i += 512) { const int k = i - 16; tB[i] = (k >= 0 && k < 465) ? F.rpb[h * 465 + k] * LOG2E : ((k >= 465 && k < 496) ? NEGB : 0.f); } }
#pragma unroll
    for (int t = 0; t < 5; ++t) if (t < NT) ATT_ISSUE(t);
    f32x16 o[2]; o[0] = f32x16{}; o[1] = f32x16{}; float m = 0.f, l = 0.f;
    bf16x8 mq = frag_k0(0u, hi); const bf16x8 ones = frag_k0(0x3F80u, hi);
    const LAS float* tabA = (const LAS float*)(lds + OFF_TABA) + (MODE == 0 ? (wid >> 1) : 0) * TA_W;
    const LAS float* tabB = (const LAS float*)(lds + OFF_TABB);
    const int qpos = 64 * hb + 32 * qbw + r32;
    const int qrow = R0 + 2 * pr + (r32 >> 4), qc = 16 * jc + (r32 & 15), rs = min(max(qrow - 4, 0), 120), cs = min(max(qc - 8, 0), 48);
    const int rsw0 = min(max(R0 + 2 * pr - 4, 0), 120), rsw1 = min(max(R0 + 2 * pr + 1 - 4, 0), 120);
    float cm[16];
#pragma unroll
    for (int r = 0; r < 16; ++r) { const int kc = cb + 4 * hi + (r & 3) + 8 * (r >> 2); cm[r] = (MODE == 1 && !(kc >= cs && kc < cs + 16)) ? NEGB : 0.f; }
    const int dc0 = cb + 4 * hi - qc + 15 + 16;
    for (int t = 0; t < NT; ++t) {
        { const int ahead = NT - 1 - t;
          if (ahead >= 4) asm volatile("s_waitcnt vmcnt(8)" ::: "memory"); else if (ahead == 3) asm volatile("s_waitcnt vmcnt(6)" ::: "memory");
          else if (ahead == 2) asm volatile("s_waitcnt vmcnt(4)" ::: "memory"); else if (ahead == 1) asm volatile("s_waitcnt vmcnt(2)" ::: "memory"); else asm volatile("s_waitcnt vmcnt(0)" ::: "memory"); }
        asm volatile("s_waitcnt lgkmcnt(0)" ::: "memory");
        __builtin_amdgcn_s_barrier();
        if (t + 5 < NT) ATT_ISSUE(t + 5);
        const int slot = (t % NSLOT) * SLOT;
        if (MODE == 1 && t > 0) { const int kr = kr0 + t - 1; if (kr < rsw0 || kr > rsw1 + 7) continue; }
        const int cbt = (MODE == 1 && t > 0) ? cb : 0;
        const lds_cptr kp = (lds_cptr)lds + slot + hi * 1024 + (r32 + cbt) * 16;
        const lds_cptr vp = (lds_cptr)lds + slot + 8192 + ((lane >> 4) & 1) * 32 + (lane & 3) * 8 + (4 * hi + ((lane & 15) >> 2) + cbt) * 64;
        bf16x8 kf[8];
        if (MODE == 0 && t > 0) {
#pragma unroll
            for (int d0 = 0; d0 < 4; ++d0) { kf[2 * d0] = *(const LAS bf16x8*)(kp + d0 * 2048); kf[2 * d0 + 1] = *(const LAS bf16x8*)(kp + d0 * 2048 + 512); }
        } else {
#pragma unroll
            for (int d0 = 0; d0 < 4; ++d0) { kf[2 * d0] = *(const LAS bf16x8*)(kp + d0 * 2048); kf[2 * d0 + 1] = kf[2 * d0]; }
        }
        if (t == 0) {
            if (MODE == 0) tile_qb<1, 1>(kf, qr, mq, ones, vp, o, m, l, wsf, r32, hi, [&](int, int r) { return r < 8 ? tabA[max(crow(r, hi) - 16 - qpos, -128) + TA_OFF] : NEGB; });
            else tile_qb<1, 1>(kf, qr, mq, ones, vp, o, m, l, wsf, r32, hi, [&](int, int r) { return r < 8 ? 0.f : NEGB; });
        } else if (MODE == 0) { const volatile LAS float* bp = tabA + 64 * (kt0 + t - 1) + 4 * hi - qpos + TA_OFF;
            tile_qb<2, 4>(kf, qr, mq, ones, vp, o, m, l, wsf, r32, hi, [&](int hf, int r) { return bp[32 * hf + (r & 3) + 8 * (r >> 2)]; });
        } else { const int kr = kr0 + t - 1; const bool rowok = kr >= rs && kr <= rs + 7; const volatile LAS float* bp = tabB + (rowok ? kr - qrow + 7 : 15) * 31 + dc0;
            tile_qb<1, 2>(kf, qr, mq, ones, vp, o, m, l, wsf, r32, hi, [&](int, int r) { return bp[(r & 3) + 8 * (r >> 2)] + cm[r]; });
        }
    }
    if (MODE == 0) { if (hi == 0) l += __builtin_amdgcn_exp2f(F.sink[hidx] * LOG2E - m); }
    if (MODE == 0) finish_qb(F, o, l, wsf, stg, lane, r32, hi, ocol, hidx, [&](int q) { return qtok0 + q; });
    else finish_qb(F, o, l, wsf, stg, lane, r32, hi, ocol, hidx, [&](int q) { return qtok0 + (q >> 4) * 64 + (q & 15); });
    __builtin_amdgcn_s_barrier();
#undef ATT_TROW
#undef ATT_ISSUE
}
__device__ __forceinline__ void attn_phase(const Frame& F, int mask = 3) {
    __syncthreads();
    int L = F.bx, un = 0; const int slot = (mask & 8) ? (F.bx & 7) : 0;
    for (; L < 2048 && un < slot; L += F.G, ++un) { if (L < 1024) { if (mask & 1) attn_unit<0>(F, L); } else if (mask & 2) attn_unit<1>(F, L - 1024); }
    if (mask & 8) { __syncthreads(); const int n = (IT_P6 - IT_MID + F.G - 1) / F.G, a = IT_MID + F.bx * n, e = a + n < IT_P6 ? a + n : IT_P6; if (a < e) conv_range(F, a, e); __syncthreads(); }
    for (; L < 2048; L += F.G) { if (L < 1024) { if (mask & 1) attn_unit<0>(F, L); } else if (mask & 2) attn_unit<1>(F, L - 1024); }
    __syncthreads();
}
}

#ifndef FAST_P5
#define FAST_P5 1
#endif
__device__ __forceinline__ void route_token(const Frame& F, int tok, float lg, int lane) {
    const float score = 1.0f / (1.0f + expf(-lg)), v0 = score + F.rbias[lane];
    int rk = 0;
#pragma unroll
    for (int j = 0; j < 8; ++j) { const int o = (lane & ~7) + j; const float w = __shfl(v0, o); rk += (w > v0 || (w == v0 && o < lane)) ? 1 : 0; }
    float gs = rk < 2 ? v0 : 0.f; gs += __shfl_xor(gs, 1); gs += __shfl_xor(gs, 2); gs += __shfl_xor(gs, 4);
    int grk = 0; const int myg = lane >> 3;
#pragma unroll
    for (int g = 0; g < 8; ++g) { const float w = __shfl(gs, g * 8); grk += (w > gs || (w == gs && g < myg)) ? 1 : 0; }
    const float mv = grk < 4 ? v0 : -INFINITY;
    int erk = 0;
    for (int o = 0; o < 64; ++o) { const float w = __shfl(mv, o); erk += (w > mv || (w == mv && o < lane)) ? 1 : 0; }
    const bool sel = erk < 8;
    const float wsm = wsum(sel ? score : 0.f), wgt = score / (wsm + 1e-20f) * 2.5f;
    if (sel) { const int rr = atomicAdd(F.cnt() + lane, 1); F.tokl()[(size_t)lane * NTOK + rr] = tok; F.wl()[(size_t)lane * NTOK + rr] = wgt; F.tke()[tok * 8 + erk] = lane; F.tkr()[tok * 8 + erk] = rr; }
}
__device__ __forceinline__ void route_token_local(const Frame& F, int tl  , float lg, int lane, LAS int* lcnt, LAS int* sel_e, LAS int* sel_lr, LAS float* sel_w) {
    lg = (lg == lg) ? lg : 0.f;
    const float score = 1.0f / (1.0f + expf(-lg)), v0 = score + F.rbias[lane];
    int rk = 0;
#pragma unroll
    for (int j = 0; j < 8; ++j) { const int o = (lane & ~7) + j; const float w = __shfl(v0, o); rk += (w > v0 || (w == v0 && o < lane)) ? 1 : 0; }
    float gs = rk < 2 ? v0 : 0.f; gs += __shfl_xor(gs, 1); gs += __shfl_xor(gs, 2); gs += __shfl_xor(gs, 4);
    int grk = 0; const int myg = lane >> 3;
#pragma unroll
    for (int g = 0; g < 8; ++g) { const float w = __shfl(gs, g * 8); grk += (w > gs || (w == gs && g < myg)) ? 1 : 0; }
    const float mv = grk < 4 ? v0 : -INFINITY;
    int erk = 0;
#pragma unroll 16
    for (int o = 0; o < 64; ++o) { const float w = __shfl(mv, o); erk += (w > mv || (w == mv && o < lane)) ? 1 : 0; }
    const bool sel = erk < 8;
    const float wsm = wsum(sel ? score : 0.f), wgt = score / (wsm + 1e-20f) * 2.5f;
    if (sel) { const int lr = __hip_atomic_fetch_add(lcnt + lane, 1, __ATOMIC_RELAXED, __HIP_MEMORY_SCOPE_WORKGROUP); sel_e[tl * 8 + erk] = lane; sel_lr[tl * 8 + erk] = lr; sel_w[tl * 8 + erk] = wgt; }
}
__device__ __forceinline__ void phase_ln1_router_fast(Frame& F) {
    constexpr int HSTR = 4112;
    LAS unsigned char* hb = F.lds; LAS float* part = (LAS float*)F.lds;
    LAS int* lcnt = (LAS int*)(F.lds + 132096); LAS int* lbase = lcnt + 64; LAS int* sel_e = lcnt + 128; LAS int* sel_lr = sel_e + 512; LAS float* sel_w = (LAS float*)(sel_lr + 512);
    const int lane = F.lane, w = F.wave, r32 = lane & 31, hi = lane >> 5;
    for (int it2 = F.bx; it2 < NTOK / 64; it2 += F.G) {
        if (F.tid < 64) lcnt[F.tid] = 0;
        for (int sub = 0; sub < 2; ++sub) {
            const int t0 = it2 * 64 + sub * 32;
            u32x4 raw[4][4];
#pragma unroll
            for (int q = 0; q < 4; ++q) { const bf16_t* src = F.z() + (size_t)(t0 + 4 * w + q) * D;
#pragma unroll
                for (int j = 0; j < 4; ++j) raw[q][j] = *(const u32x4*)(src + (lane + 64 * j) * 8); }
#pragma unroll
            for (int q = 0; q < 4; ++q) { const int row = 4 * w + q, tok = t0 + row; float v[4][8]; float s = 0.f;
#pragma unroll
                for (int j = 0; j < 4; ++j)
#pragma unroll
                    for (int i = 0; i < 4; ++i) { v[j][2 * i] = __uint_as_float(raw[q][j][i] << 16); v[j][2 * i + 1] = __uint_as_float(raw[q][j][i] & 0xffff0000u); s += v[j][2 * i] + v[j][2 * i + 1]; }
                const float mu = wsum(s) * (1.0f / D); float qq = 0.f;
#pragma unroll
                for (int j = 0; j < 4; ++j)
#pragma unroll
                    for (int i = 0; i < 8; ++i) { const float d = v[j][i] - mu; qq += d * d; }
                const float rstd = 1.0f / sqrtf(wsum(qq) * (1.0f / D) + LN_EPS);
#pragma unroll
                for (int j = 0; j < 4; ++j) { const int c = (lane + 64 * j) * 8; const f32x4 g0 = *(const f32x4*)(F.l1g + c), g1 = *(const f32x4*)(F.l1g + c + 4), b0 = *(const f32x4*)(F.l1b + c), b1 = *(const f32x4*)(F.l1b + c + 4);
                    u32x4 pk; float y[8];
#pragma unroll
                    for (int i = 0; i < 4; ++i) { y[i] = (v[j][i] - mu) * rstd * g0[i] + b0[i]; y[4 + i] = (v[j][4 + i] - mu) * rstd * g1[i] + b1[i]; }
                    pk.x = pack2(y[0], y[1]); pk.y = pack2(y[2], y[3]); pk.z = pack2(y[4], y[5]); pk.w = pack2(y[6], y[7]);
                    *(u32x4*)(F.h1() + (size_t)tok * D + c) = pk; *(LAS u32x4*)(hb + row * HSTR + c * 2) = pk;
                    *(u32x2*)(F.h1q() + (size_t)tok * D + c) = (u32x2){e4m3x4(y[0] * S8_H1, y[1] * S8_H1, y[2] * S8_H1, y[3] * S8_H1), e4m3x4(y[4] * S8_H1, y[5] * S8_H1, y[6] * S8_H1, y[7] * S8_H1)}; }
                if (lane == 0) { F.stats1()[tok * 2] = mu; F.stats1()[tok * 2 + 1] = rstd; } }
            __syncthreads();
            att::f32x16 acc[2]; acc[0] = att::f32x16{}; acc[1] = att::f32x16{};
            const bf16_t* wb = F.wrt() + (size_t)r32 * D + 256 * w + hi * 8;
#pragma unroll 8
            for (int s = 0; s < 16; ++s) {
                const att::bf16x8 a = *(const LAS att::bf16x8*)(hb + r32 * HSTR + (256 * w + 16 * s + 8 * hi) * 2);
                const att::bf16x8 b0 = *(const att::bf16x8*)(wb + 16 * s), b1 = *(const att::bf16x8*)(wb + (size_t)32 * D + 16 * s);
                acc[0] = __builtin_amdgcn_mfma_f32_32x32x16_bf16(a, b0, acc[0], 0, 0, 0); acc[1] = __builtin_amdgcn_mfma_f32_32x32x16_bf16(a, b1, acc[1], 0, 0, 0); }
            __syncthreads();
#pragma unroll
            for (int nt = 0; nt < 2; ++nt)
#pragma unroll
                for (int r = 0; r < 16; ++r) part[(w * 32 + att::crow(r, hi)) * 64 + 32 * nt + r32] = acc[nt][r];
            __syncthreads();
            for (int q = 0; q < 4; ++q) { const int row = 4 * w + q; float lg = 0.f;
#pragma unroll
                for (int ww = 0; ww < 8; ++ww) lg += part[(ww * 32 + row) * 64 + lane];
                route_token_local(F, sub * 32 + row, lg, lane, lcnt, sel_e, sel_lr, sel_w); }
            __syncthreads();
        }
        if (F.tid < 64) { const int n = lcnt[F.tid]; lbase[F.tid] = n > 0 ? atomicAdd(F.cnt() + F.tid, n) : 0; }
        __syncthreads();
        { const int tl = F.tid >> 3, slot = F.tid & 7, e = sel_e[F.tid], rr = lbase[e] + sel_lr[F.tid], tok = it2 * 64 + tl;
          F.tokl()[(size_t)e * NTOK + rr] = tok; F.wl()[(size_t)e * NTOK + rr] = sel_w[F.tid]; F.tke()[tok * 8 + slot] = e; F.tkr()[tok * 8 + slot] = rr; }
        __syncthreads();
    }
}

__global__ void __launch_bounds__(512, 2) mk_fwd(Args args) {
    extern __shared__ __attribute__((aligned(16))) unsigned char lds_raw[];
    Frame F; F.lds = (LAS unsigned char*)lds_raw; F.wave0 = __builtin_amdgcn_readfirstlane((int)threadIdx.x >> 6); F.fresh(); F.G = gridDim.x; F.bx = blockIdx.x;
    F.x = args.in[0]; F.meta = args.in[1]; F.lng = args.in[2]; F.lnb = args.in[3]; F.t5 = args.in[4]; F.w_in = args.in[5]; F.sink = args.in[6]; F.rpb = args.in[7]; F.ga = args.in[8]; F.gb = args.in[9];
    F.w_out = args.in[10]; F.l1g = args.in[11]; F.l1b = args.in[12]; F.w_router = args.in[13]; F.rbias = args.in[14]; F.w_gate = args.in[15]; F.w_up = args.in[16]; F.w_down = args.in[17];
    F.ws_gate = args.in[18]; F.ws_up = args.in[19]; F.ws_down = args.in[20]; F.l2g = args.in[21]; F.l2b = args.in[22]; F.out = args.out; F.ws = args.ws;
    unsigned char* ws = args.ws;
    volatile LAS unsigned* xbw = (volatile LAS unsigned*)(F.lds + LDS_BYTES - 16);
    LAS int* ps = (LAS int*)(F.lds + 131072);
    if (F.tid < 4) xbw[F.tid] = 0u;
    __syncthreads();
    const int lo = args.ph_lo, hi = args.ph_hi;
    XcdBarrier bar; bar.bar = (unsigned*)(ws + WS_CTL); bar.x = 0; bar.st = xbw; bar.wave0 = F.wave0;
    if (hi - lo > 1) bar = xcd_barrier_post((unsigned*)(ws + WS_CTL), xbw, F.wave0);
    unsigned* xcen = (unsigned*)(ws + WS_CTL + 20480);
    if (XCD_TRUE && hi - lo > 1 && F.tid == 0) { const unsigned x = xb_xcc_id(); xbw[2] = x; xbw[3] = xb_add(&xcen[x * 16], 1u); }
#ifndef PROBE_REPEAT
#define PROBE_REPEAT -1
#endif
#ifndef PROBE_SUB
#define PROBE_SUB 3
#endif
#ifndef PROBE_NOSTORE
#define PROBE_NOSTORE 0
#endif
#ifndef PROBE_HOT
#define PROBE_HOT 0
#endif
#ifndef PROBE_NT
#define PROBE_NT 32
#ifndef PROBE_LD
#define PROBE_LD 2048
#endif
#endif
#define IN(k) (lo <= (k) && (k) < hi)
#define SEAM(k) do { if (IN(k) && IN((k) + 1)) xcd_barrier(bar); } while (0)
    if (IN(0)) { F.fresh(); phase_prologue(F);
#if PROBE_REPEAT == 0
        xcd_barrier(bar); phase_prologue(F);
#endif
    } SEAM(0);
#define P1_BODY(rep) do { const int s_ = (rep) ? 0 : F.bx % 5; EpiU E{F.u(), rep}; { SchedInProj S{(const char*)F.h0(), (const char*)F.wtin(), F.G, F.bx, 0, s_}; pg8::gemm_phase(F.wave0, F.lds, S, E, D, D, D / 64); } if (!(rep)) { conv_inproj_share(F); __syncthreads(); } { SchedInProj S{(const char*)F.h0(), (const char*)F.wtin(), F.G, F.bx, s_, 1 << 20}; pg8::gemm_phase(F.wave0, F.lds, S, E, D, D, D / 64); } } while (0)
#define P4_BODY(rep) do { SchedOutProj S{(const char*)F.ya(), (const char*)F.wtout(), F.G, F.bx}; EpiZ E{F.z(), F.h0(), F.ssq(), (LAS float*)(F.lds + 131072 + 6144)}; pg8::gemm_phase(F.wave0, F.lds, S, E, D, D, D / 64, STAGGER4); } while (0)
#define P6_BODY(rep) do { moe_tables(F, ps); SchedGU S{(const char*)F.h1q(), (const char*)F.wtgu(), F.tokl(), F.cnt(), ps, F.G, F.bx, __builtin_amdgcn_readfirstlane(ps[128 + 65])}; EpiGU E{(unsigned char*)F.hb(), F.wl()}; pg8::gemm_phase(F.wave0, F.lds, S, E, D / 2, D / 2, D / 128); if (!(rep)) { F.fresh(); conv_tail(F, IT_P6, IT_ALL, (ps[128 + 65] * 4) % F.G); } } while (0)
#define P7_BODY(rep) do { moe_tables(F, ps); SchedDown S{(const char*)F.hb(), (const char*)F.wtd(), F.cnt(), ps, F.G, F.bx, __builtin_amdgcn_readfirstlane(ps[128 + 64])}; EpiDownR E{(unsigned char*)F.ym(), rep}; pg8::gemm_phase(F.wave0, F.lds, S, E, DE / 2, DE / 2, DE / 128, STAGGER7); SchedDownShared S2{(const char*)F.hb(), (const char*)F.wtd(), F.G, F.bx}; EpiDownS E2{F.o2(), F.h1()}; pg8::gemm_phase(F.wave0, F.lds, S2, E2, DE / 2, DE / 2, DE / 128); } while (0)
    if (XCD_TRUE && hi - lo > 1 && IN(0)) {
        if (F.tid == 0) { unsigned idx = 0, ok = 1, npop = 0; const unsigned x = xbw[2];
            for (unsigned j = 0; j < 16; ++j) { const unsigned cj = xb_ld(&xcen[j * 16]); if (cj) { ++npop; if (cj * 8u != (unsigned)F.G) ok = 0; if (j < x) ++idx; } }
            xbw[2] = (ok && npop == 8) ? xbw[3] * 8u + idx : (unsigned)blockIdx.x; }
        __syncthreads();
        F.bx = __builtin_amdgcn_readfirstlane((int)xbw[2]);
    }
    if (IN(1)) { F.fresh();
#if FAST_P1
        P1_BODY(0);
#if PROBE_REPEAT == 1
        xcd_barrier(bar); P1_BODY(PROBE_NOSTORE);
#endif
#else
        FnInProj f{F}; sgemm(f, F.lds, F.tid, F.bx, F.G);
#endif
#if PROBE_REPEAT == 9
        xcd_barrier(bar); if (F.bx % 8 == 0) { conv_range(F, IT_P0 + T_OUT, IT_P0 + T_OUT + 512); __syncthreads(); }
#endif
    } SEAM(1);
    if (IN(2)) { F.fresh();
#if FAST_P2
        att::attn_phase(F, 3 | 8);
#if PROBE_REPEAT == 2
        xcd_barrier(bar); att::attn_phase(F, PROBE_SUB);
#endif
#else
        phase_attn_simple(F);
#endif
    } SEAM(2);
#if !FAST_P4
    if (IN(3)) { phase_rmsnorm(F); } SEAM(3);
#endif
    if (IN(4)) { F.fresh();
#if FAST_P4
        P4_BODY(0);
#if PROBE_REPEAT == 4
        xcd_barrier(bar); P4_BODY(1);
#endif
#else
        FnOutProj f{F}; sgemm(f, F.lds, F.tid, F.bx, F.G);
#endif
    } SEAM(4);
#if FAST_P5
#define PH5(F) phase_ln1_router_fast(F)
#else
#define PH5(F) phase_ln1_router(F)
#endif
    if (IN(5)) { F.fresh(); PH5(F);
#if PROBE_REPEAT == 5
        xcd_barrier(bar); if (F.bx == 0 && F.tid < 64) F.cnt()[F.tid] = 0; xcd_barrier(bar); PH5(F);
#endif
    } SEAM(5);
    if (IN(6)) { F.fresh();
#if FAST_P6
        P6_BODY(0);
#if PROBE_REPEAT == 6
        xcd_barrier(bar); P6_BODY(1);
#endif
#else
        expert_starts(F, ps); FnGateUp f{F, ps}; sgemm(f, F.lds, F.tid, F.bx, F.G);
#endif
    } SEAM(6);
    if (IN(7)) { F.fresh();
#if FAST_P7
        P7_BODY(0);
#if PROBE_REPEAT == 7
        xcd_barrier(bar); P7_BODY(PROBE_NOSTORE);
#endif
#else
        expert_starts(F, ps); { FnDown f{F, ps}; sgemm(f, F.lds, F.tid, F.bx, F.G); } { FnFinal f{F, ps}; sgemm(f, F.lds, F.tid, F.bx, F.G); }
#endif
    } SEAM(7);
    if (IN(8)) { F.fresh(); expert_starts(F, ps); phase_ln2(F, ps);
#if PROBE_REPEAT == 8
        xcd_barrier(bar); phase_ln2(F, ps);
#endif
    }
#undef IN
#undef SEAM
}

extern "C" void kernel_launch(void* const* d_in, const int* in_sizes, int n_in, void* d_out, int out_size, void* d_ws, size_t ws_size, hipStream_t stream) {
    static int grid = 0;
    if (grid == 0) {
        if (n_in != 23 || in_sizes[0] != NTOK * D || out_size != NTOK * D || ws_size < WS_END) {
            fprintf(stderr, "kernel_launch: built for 23 inputs, x/out of %d floats, >= %zu bytes of workspace; got n_in %d in0 %d out %d ws %zu; nothing launched\n", NTOK * D, (size_t)WS_END, n_in, n_in > 0 ? in_sizes[0] : -1, out_size, ws_size);
            grid = -1; return; }
        int dev = 0, cus = 0, per_cu = 0;
        if (hipGetDevice(&dev) != hipSuccess || hipDeviceGetAttribute(&cus, hipDeviceAttributeMultiprocessorCount, dev) != hipSuccess) { fprintf(stderr, "kernel_launch: device query failed\n"); grid = -1; return; }
        if (hipFuncSetAttribute((const void*)mk_fwd, hipFuncAttributeMaxDynamicSharedMemorySize, LDS_BYTES) != hipSuccess) { fprintf(stderr, "kernel_launch: hipFuncSetAttribute failed\n"); grid = -1; return; }
        if (hipOccupancyMaxActiveBlocksPerMultiprocessor(&per_cu, (const void*)mk_fwd, 512, LDS_BYTES) != hipSuccess || per_cu < 1) fprintf(stderr, "kernel_launch: note: occupancy query reports %d\n", per_cu);
        (void)hipGetLastError();
        grid = cus;
    }
    if (grid < 0) return;
    if (hipMemsetAsync((char*)d_ws + WS_CTL, 0, CTL_BYTES, stream) != hipSuccess) { fprintf(stderr, "kernel_launch: memset failed\n"); return; }
    Args a{};
    for (int i = 0; i < 23; ++i) a.in[i] = (const float*)d_in[i];
    a.out = (float*)d_out; a.ws = (unsigned char*)d_ws;
#if MK_ONE_LAUNCH
    a.ph_lo = 0; a.ph_hi = NPHASE;
    hipLaunchKernelGGL(mk_fwd, dim3(grid), dim3(512), LDS_BYTES, stream, a);
#else
    for (int p = 0; p < NPHASE; ++p) { a.ph_lo = p; a.ph_hi = p + 1; hipLaunchKernelGGL(mk_fwd, dim3(grid), dim3(512), LDS_BYTES, stream, a); }
#endif
    const hipError_t le = hipPeekAtLastError();
    if (le != hipSuccess) fprintf(stderr, "kernel_launch: launch failed: %s\n", hipGetErrorName(le));
}
```

```cpp
#include <hip/hip_runtime.h>
#include <cstdio>
#include <cstdint>

#define LAS __attribute__((address_space(3)))
typedef unsigned short bf16_t;
typedef float f32x4 __attribute__((ext_vector_type(4)));
typedef unsigned u32x4 __attribute__((ext_vector_type(4)));
typedef unsigned u32x2 __attribute__((ext_vector_type(2)));

#ifndef CONV_P2
#define CONV_P2 28160
#endif
#ifndef CONV_NT
#define CONV_NT 1
#endif
#ifndef MK_ONE_LAUNCH
#define MK_ONE_LAUNCH 1
#endif

constexpr int D = 2048, SEQ = 8192, NB = 2, NTOK = NB * SEQ;
constexpr int NMETA = 16, INW = 4608, MROWS = NTOK + 256;
constexpr int NE = 64, DE = 512, PMAX = 147456, HBROWS = PMAX + NTOK;
constexpr float ALPHA = 1.189207115002721f;
constexpr float LN_EPS = 1e-5f, RMS_EPS = 1e-6f, LOG2E = 1.4426950408889634f, QSCALE = 0.125f * LOG2E;
constexpr int COL_QA = 0, COL_KA = 1024, COL_VA = 1280, COL_QB = 1536, COL_KB = 2560, COL_VB = 3584;
constexpr int NPHASE = 9;
constexpr int LDS_BYTES = 147456;

constexpr size_t WS_CTL = 0, CTL_BYTES = 32768;
constexpr size_t WS_CNT = 16384;
constexpr size_t WS_STATS0 = WS_CTL + CTL_BYTES;
constexpr size_t WS_STATS1 = WS_STATS0 + (size_t)NTOK * 8;
constexpr size_t WS_SSQ = WS_STATS1 + (size_t)NTOK * 8;
constexpr size_t WS_TOKL = WS_SSQ + (size_t)NTOK * 32 * 4;
constexpr size_t WS_WL = WS_TOKL + (size_t)NE * NTOK * 4;
constexpr size_t WS_TKE = WS_WL + (size_t)NE * NTOK * 4;
constexpr size_t WS_TKR = WS_TKE + (size_t)NTOK * 8 * 4;
constexpr size_t WS_TAB = WS_TKR + (size_t)NTOK * 8 * 4;
constexpr size_t WS_WRT = WS_TAB + 32768;
constexpr size_t WS_Z = WS_WRT + (size_t)NE * D * 2;
constexpr size_t WS_O2 = WS_Z + (size_t)NTOK * D * 2;
constexpr size_t WS_WTD = WS_Z + (size_t)NTOK * D * 4;
constexpr size_t WS_HB = WS_WTD + (size_t)65 * 2048 * 512 * 2;
constexpr size_t WS_B = WS_HB + (size_t)HBROWS * 512 * 2;
constexpr size_t WS_WTGU = WS_B;
constexpr size_t WS_WTIN = WS_WTGU + (size_t)65 * 1024 * 2048 * 2;
constexpr size_t WS_WTOUT = WS_WTIN + (size_t)INW * D * 2;
constexpr size_t WS_H0 = WS_WTOUT + (size_t)D * D * 2;
constexpr size_t WS_U = WS_H0 + (size_t)MROWS * D * 2;
constexpr size_t WS_YA = WS_U + (size_t)MROWS * INW * 2;
constexpr size_t WS_H1Q = WS_WTD + (size_t)65 * 2048 * 512;
constexpr size_t WS_H1 = WS_Z;
constexpr size_t WS_YM = WS_B;
constexpr size_t WS_END_A = WS_YA + (size_t)NTOK * D * 2, WS_END_B = WS_YM + (size_t)PMAX * D * 2;
constexpr size_t WS_END = WS_END_A > WS_END_B ? WS_END_A : WS_END_B;
static_assert(WS_END <= ((size_t)1 << 30), "workspace map must fit 1 GiB");

__device__ __forceinline__ float bf2f(bf16_t b) { return __uint_as_float(((unsigned)b) << 16); }
__device__ __forceinline__ bf16_t f2bf(float f) { unsigned u = __float_as_uint(f); u += 0x7FFFu + ((u >> 16) & 1u); return (bf16_t)(u >> 16); }
__device__ __forceinline__ unsigned pack2(float lo, float hi) { return (unsigned)f2bf(lo) | ((unsigned)f2bf(hi) << 16); }
constexpr int ENC8_EXP = 12 << 23;
__device__ __forceinline__ unsigned enc8(float x) {
    const unsigned u = __float_as_uint(x); int t = (int)(u & 0x7fffffffu) - 0x00F80000 - ENC8_EXP;
    t = t < 0x38000000 ? 0x38000000 : (t > 0x3FF00000 ? 0x3FF00000 : t);
    return (((unsigned)t >> 20) & 0x7fu) | ((u >> 24) & 0x80u); }
__device__ __forceinline__ unsigned enc8x4(float a, float b, float c, float d) { return enc8(a) | (enc8(b) << 8) | (enc8(c) << 16) | (enc8(d) << 24); }
__device__ __forceinline__ float dec8(unsigned b) { return __uint_as_float(((b & 0x7fu) << 20) + 0x39000000u + ((b & 0x80u) << 24)); }
typedef unsigned short u16x2 __attribute__((ext_vector_type(2)));
__device__ __forceinline__ unsigned cvt_pk_bf16_g(float lo, float hi) { unsigned r; asm volatile("v_cvt_pk_bf16_f32 %0, %1, %2" : "=v"(r) : "v"(lo), "v"(hi)); return r; }
__device__ __forceinline__ unsigned e4m3x2(float a, float b) {
    const unsigned p = cvt_pk_bf16_g(a, b);
    u16x2 m = __builtin_bit_cast(u16x2, p & 0x7fff7fffu);
    m = (m + (u16x2){8, 8}) >> (u16x2){4, 4};
    m = __builtin_elementwise_sub_sat(m, (u16x2){0x3C0, 0x3C0});
    m = __builtin_elementwise_min(m, (u16x2){0x7E, 0x7E});
    return __builtin_bit_cast(unsigned, m) | ((p >> 8) & 0x00800080u); }
__device__ __forceinline__ unsigned e4m3x4(float a, float b, float c, float d) { return __builtin_amdgcn_perm(e4m3x2(c, d), e4m3x2(a, b), 0x06040200u); }
__device__ __forceinline__ unsigned ym8x2(float a, float b) {
    const unsigned p = cvt_pk_bf16_g(a, b);
    u16x2 m = __builtin_bit_cast(u16x2, p & 0x7fff7fffu);
    m = (m + (u16x2){8, 8}) >> (u16x2){4, 4};
    m = __builtin_elementwise_sub_sat(m, (u16x2){0x3F0, 0x3F0});
    m = __builtin_elementwise_min(m, (u16x2){0x7F, 0x7F});
    return __builtin_bit_cast(unsigned, m) | ((p >> 8) & 0x00800080u); }
__device__ __forceinline__ unsigned ym8x4(float a, float b, float c, float d) { return __builtin_amdgcn_perm(ym8x2(c, d), ym8x2(a, b), 0x06040200u); }
constexpr float S8_H1 = 8.0f, S8_W = 256.0f, S8_HB = 16.0f, S8_GU_INV = 1.0f / (S8_H1 * S8_W), S8_DN_INV = 1.0f / (S8_HB * S8_W);
__device__ __forceinline__ float wsum(float v) {
#pragma unroll
    for (int o = 32; o >= 1; o >>= 1) v += __shfl_xor(v, o);
    return v; }
__device__ __forceinline__ float wmax(float v) {
#pragma unroll
    for (int o = 32; o >= 1; o >>= 1) v = fmaxf(v, __shfl_xor(v, o));
    return v; }
__device__ __forceinline__ int t5_bucket(int rel) {
    const int ret = rel > 0 ? 16 : 0, n = rel < 0 ? -rel : rel;
    if (n < 8) return ret + n;
    const int n2 = n > 32768 ? 0x40000000 : n * n; int lg = 31 - __clz(n2) + 2; if (lg > 15) lg = 15;
    return ret + lg; }

#define XB_TMO      128
#define XB_XCNT(j)  (256  + 64 * (j))
#define XB_XSUB(j)  (1280 + 64 * (j))
#define XB_XGEN(j)  (2304 + 64 * (j))
#define XB_TOP      3328
#define XB_TOPGEN   3392
#define XCD_BAR_WORDS 3456
#define XB_SPIN_CAP (1u << 18)
__device__ __forceinline__ int lane_id() { int l; asm volatile("v_mbcnt_lo_u32_b32 %0, -1, 0\n\tv_mbcnt_hi_u32_b32 %0, -1, %0" : "=v"(l)); return l; }
__device__ __forceinline__ unsigned xb_ld(unsigned* p)              { return __hip_atomic_load(p, __ATOMIC_RELAXED, __HIP_MEMORY_SCOPE_AGENT); }
__device__ __forceinline__ unsigned xb_add(unsigned* p, unsigned v) { return __hip_atomic_fetch_add(p, v, __ATOMIC_RELAXED, __HIP_MEMORY_SCOPE_AGENT); }
__device__ __forceinline__ unsigned xb_xcc_id() { return (unsigned)__builtin_amdgcn_s_getreg((3 << 11) | 20) & 0xFu; }
#define XB_SPIN(cond, bar) do { unsigned _sp = 0; while (cond) { __builtin_amdgcn_s_sleep(1); \
    if ((++_sp & 255u) == 0u) { if (xb_ld(&(bar)[XB_TMO])) break; if (_sp > XB_SPIN_CAP) { atomicAdd(&(bar)[XB_TMO], 1u); break; } } } } while (0)
struct XcdBarrier { unsigned* bar; unsigned x; volatile LAS unsigned* st; int wave0; };
__device__ __forceinline__ XcdBarrier xcd_barrier_post(unsigned* bar, volatile LAS unsigned* st, int wave0) {
    XcdBarrier b; b.bar = bar; b.x = xb_xcc_id(); b.st = st; b.wave0 = wave0;
    if (wave0 == 0 && lane_id() == 0) (void)xb_add(&bar[XB_XCNT(b.x)], 1u);
    return b;
}
__device__ __forceinline__ void xcd_barrier_complete(unsigned* bar, unsigned x, unsigned& nloc, unsigned& nx) {
    const unsigned G = gridDim.x * gridDim.y * gridDim.z;
    unsigned sum, cnt, mine, sp = 0u;
    for (;;) {
        sum = 0u; cnt = 0u; mine = 0u;
#pragma unroll
        for (unsigned j = 0; j < 16; ++j) { const unsigned c = xb_ld(&bar[XB_XCNT(j)]); sum += c; cnt += (c > 0u) ? 1u : 0u; mine = (j == x) ? c : mine; }
        if (sum == G) break;
        __builtin_amdgcn_s_sleep(1);
        if ((++sp & 255u) == 0u) { if (xb_ld(&bar[XB_TMO])) break; if (sp > XB_SPIN_CAP) { atomicAdd(&bar[XB_TMO], 1u); break; } }
    }
    nloc = mine > 0u ? mine : 1u; nx = cnt > 0u ? cnt : 1u;
}
__device__ __forceinline__ void xcd_barrier(const XcdBarrier& b) {
    asm volatile("s_waitcnt vmcnt(0)" ::: "memory");
    __syncthreads();
    if (b.wave0 == 0 && lane_id() == 0) {
        unsigned* bar = b.bar;
        __builtin_amdgcn_s_waitcnt(0);
        unsigned nloc = b.st[0], nx = b.st[1];
        if (nloc == 0u) { xcd_barrier_complete(bar, b.x, nloc, nx); b.st[0] = nloc; b.st[1] = nx; }
        const unsigned old = xb_add(&bar[XB_XSUB(b.x)], 1u);
        const unsigned gen = old / nloc;
        if (old + 1u == (gen + 1u) * nloc) {
            __builtin_amdgcn_fence(__ATOMIC_RELEASE, "agent");
            asm volatile("s_waitcnt vmcnt(0)" ::: "memory");
            const unsigned og = xb_add(&bar[XB_TOP], 1u);
            const unsigned tg = og / nx;
            if (og + 1u == (tg + 1u) * nx) xb_add(&bar[XB_TOPGEN], 1u);
            else XB_SPIN(xb_ld(&bar[XB_TOPGEN]) == tg, bar);
            __builtin_amdgcn_fence(__ATOMIC_ACQUIRE, "agent");
            xb_add(&bar[XB_XGEN(b.x)], 1u);
            asm volatile("s_waitcnt vmcnt(0)" ::: "memory");
        } else {
            XB_SPIN(xb_ld(&bar[XB_XGEN(b.x)]) == gen, bar);
            __builtin_amdgcn_fence(__ATOMIC_ACQUIRE, "agent");
            asm volatile("s_waitcnt vmcnt(0)" ::: "memory");
        }
    }
    __syncthreads();
}

struct Args { const float* in[23]; float* out; unsigned char* ws; int ph_lo, ph_hi; };
struct Frame {
    LAS unsigned char* lds; int tid, lane, wave, G, bx;
    const float *x, *meta, *lng, *lnb, *t5, *w_in, *sink, *rpb, *ga, *gb, *w_out, *l1g, *l1b, *w_router, *rbias, *w_gate, *w_up, *w_down, *ws_gate, *ws_up, *ws_down, *l2g, *l2b;
    float* out; unsigned char* ws;
    int wave0;
    __device__ __forceinline__ void fresh() { int t = wave0 * 64 + lane_id(); asm volatile("" : "+v"(t)); tid = t; lane = t & 63; wave = wave0; }
    __device__ __forceinline__ float* stats0() const { return (float*)(ws + WS_STATS0); }
    __device__ __forceinline__ float* stats1() const { return (float*)(ws + WS_STATS1); }
    __device__ __forceinline__ float* ssq() const { return (float*)(ws + WS_SSQ); }
    __device__ __forceinline__ float* wl() const { return (float*)(ws + WS_WL); }
    __device__ __forceinline__ float* tab() const { return (float*)(ws + WS_TAB); }
    __device__ __forceinline__ int* cnt() const { return (int*)(ws + WS_CNT); }
    __device__ __forceinline__ int* tokl() const { return (int*)(ws + WS_TOKL); }
    __device__ __forceinline__ int* tke() const { return (int*)(ws + WS_TKE); }
    __device__ __forceinline__ int* tkr() const { return (int*)(ws + WS_TKR); }
    __device__ __forceinline__ bf16_t* wtd() const { return (bf16_t*)(ws + WS_WTD); }
    __device__ __forceinline__ bf16_t* hb() const { return (bf16_t*)(ws + WS_HB); }
    __device__ __forceinline__ bf16_t* wtgu() const { return (bf16_t*)(ws + WS_WTGU); }
    __device__ __forceinline__ bf16_t* wtin() const { return (bf16_t*)(ws + WS_WTIN); }
    __device__ __forceinline__ bf16_t* wtout() const { return (bf16_t*)(ws + WS_WTOUT); }
    __device__ __forceinline__ bf16_t* h0() const { return (bf16_t*)(ws + WS_H0); }
    __device__ __forceinline__ bf16_t* u() const { return (bf16_t*)(ws + WS_U); }
    __device__ __forceinline__ bf16_t* ya() const { return (bf16_t*)(ws + WS_YA); }
    __device__ __forceinline__ bf16_t* h1() const { return (bf16_t*)(ws + WS_H1); }
    __device__ __forceinline__ unsigned char* h1q() const { return (unsigned char*)(ws + WS_H1Q); }
    __device__ __forceinline__ bf16_t* ym() const { return (bf16_t*)(ws + WS_YM); }
    __device__ __forceinline__ bf16_t* wrt() const { return (bf16_t*)(ws + WS_WRT); }
    __device__ __forceinline__ bf16_t* z() const { return (bf16_t*)(ws + WS_Z); }
    __device__ __forceinline__ bf16_t* o2() const { return (bf16_t*)(ws + WS_O2); }
};

struct ConvDesc { const float* src; bf16_t* dst; int lds_, ldd_; const float* ksc; float csc; int f8; };
__device__ __forceinline__ void conv_load(const ConvDesc& d, f32x4 (&v)[16], int lane) {
    const int kk = lane & 3, n4 = (lane >> 2) * 4;
#pragma unroll
    for (int p = 0; p < 16; ++p) v[p] = __builtin_nontemporal_load((const f32x4*)(d.src + (size_t)(4 * p + kk) * d.lds_ + n4));
}
__device__ __forceinline__ void conv_finish(const ConvDesc& d, const f32x4 (&v)[16], LAS float* scr, int lane) {
    const int kk = lane & 3, n4 = (lane >> 2) * 4;
#pragma unroll
    for (int p = 0; p < 16; ++p) { const int k = 4 * p + kk; const float s = d.ksc ? d.ksc[k] * d.csc : d.csc;
        scr[k * 65 + n4] = v[p][0] * s; scr[k * 65 + n4 + 1] = v[p][1] * s; scr[k * 65 + n4 + 2] = v[p][2] * s; scr[k * 65 + n4 + 3] = v[p][3] * s; }
    asm volatile("s_waitcnt lgkmcnt(0)" ::: "memory");
    if (d.f8) {
        const int c = lane >> 4;
#pragma unroll
        for (int j = 0; j < 4; ++j) { const int n = (lane & 15) + 16 * j; const LAS float* s = scr + (16 * c) * 65 + n; u32x4 o;
            o.x = e4m3x4(s[0], s[65], s[2 * 65], s[3 * 65]); o.y = e4m3x4(s[4 * 65], s[5 * 65], s[6 * 65], s[7 * 65]);
            o.z = e4m3x4(s[8 * 65], s[9 * 65], s[10 * 65], s[11 * 65]); o.w = e4m3x4(s[12 * 65], s[13 * 65], s[14 * 65], s[15 * 65]);
            __builtin_nontemporal_store(o, (u32x4*)((unsigned char*)d.dst + (size_t)n * d.ldd_ + 16 * c)); }
        asm volatile("s_waitcnt lgkmcnt(0)" ::: "memory");
        return; }
    const int c = lane >> 3;
#pragma unroll
    for (int j = 0; j < 8; ++j) { const int n = (lane & 7) + 8 * j; const LAS float* s = scr + (8 * c) * 65 + n; u32x4 o;
        o.x = pack2(s[0], s[65]); o.y = pack2(s[2 * 65], s[3 * 65]); o.z = pack2(s[4 * 65], s[5 * 65]); o.w = pack2(s[6 * 65], s[7 * 65]);
        __builtin_nontemporal_store(o, (u32x4*)(d.dst + (size_t)n * d.ldd_ + 8 * c)); }
    asm volatile("s_waitcnt lgkmcnt(0)" ::: "memory");
}
constexpr int T_R = 32, T_IN = 72 * 32, T_OUT = 32 * 32, T_GU = 65 * 2 * 8 * 32, T_D = 65 * 32 * 8;
constexpr int IT_P0 = T_R + T_IN, IT_ALL = IT_P0 + T_OUT + T_GU + T_D, IT_P6 = IT_ALL - 6400, IT_MID = IT_P6 - CONV_P2;
__device__ __forceinline__ ConvDesc conv_desc(const Frame& F, int it) {
    int r = it; const float* src; bf16_t* dst; int lds_, ldd_, f8 = 0; const float* ksc = nullptr; float csc = 1.0f;
    if (r < T_R) { src = F.w_router + (size_t)(r * 64) * NE; lds_ = NE; dst = F.wrt() + r * 64; ldd_ = D; }
    else if ((r -= T_R) < T_IN) { const int tn = r % 72, tk = r / 72; const int n0 = tn * 64; const bool isq = (n0 < COL_KA) || (n0 >= COL_QB && n0 < COL_KB);
        src = F.w_in + (size_t)(tk * 64) * INW + n0; lds_ = INW; dst = F.wtin() + (size_t)n0 * D + tk * 64; ldd_ = D; csc = isq ? QSCALE : 1.0f; }
    else if ((r -= T_IN) < T_OUT) { const int tn = r % 32, tk = r / 32; const int k0 = tk * 64;
        src = F.w_out + (size_t)k0 * D + tn * 64; lds_ = D; dst = F.wtout() + (size_t)(tn * 64) * D + k0; ldd_ = D; ksc = k0 < 1024 ? F.ga + k0 : F.gb + (k0 - 1024); }
    else if ((r -= T_OUT) < T_GU) { const int tn = r % 8, tk = (r / 8) % 32, which = (r / 256) % 2, e = r / 512;
        const float* s0 = e < NE ? (which ? F.w_up : F.w_gate) + (size_t)e * D * DE : (which ? F.ws_up : F.ws_gate);
        const int c0 = tn * 64, nprime = 256 * (c0 / 128) + 128 * which + (c0 % 128);
        src = s0 + (size_t)(tk * 64) * DE + c0; lds_ = DE; dst = (bf16_t*)((unsigned char*)F.wtgu() + ((size_t)e * 1024 + nprime) * D + tk * 64); ldd_ = D; f8 = 1; csc = S8_W; }
    else { r -= T_GU; const int tn = r % 32, tk = (r / 32) % 8, e = r / 256;
        const float* s0 = e < NE ? F.w_down + (size_t)e * DE * D : F.ws_down;
        src = s0 + (size_t)(tk * 64) * D + tn * 64; lds_ = D; dst = (bf16_t*)((unsigned char*)F.wtd() + ((size_t)e * D + tn * 64) * DE + tk * 64); ldd_ = DE; f8 = 1; csc = S8_W; }
    return ConvDesc{src, dst, lds_, ldd_, ksc, csc, f8};
}
__device__ __forceinline__ void conv_items(const Frame& F, int first, int last, int step) {
    LAS float* t = (LAS float*)F.lds + F.wave * (64 * 65);
    if (first >= last) return;
    f32x4 va[16], vb[16]; ConvDesc da = conv_desc(F, first), db = da;
    conv_load(da, va, F.lane);
    for (int it = first; it < last; it += 2 * step) {
        const bool hb = it + step < last; if (hb) { db = conv_desc(F, it + step); conv_load(db, vb, F.lane); }
        conv_finish(da, va, t, F.lane);
        if (!hb) break;
        const bool ha = it + 2 * step < last; if (ha) { da = conv_desc(F, it + 2 * step); conv_load(da, va, F.lane); }
        conv_finish(db, vb, t, F.lane);
        if (!ha) break;
    }
}
__device__ __forceinline__ void conv_range(const Frame& F, int first, int last) { conv_items(F, first + F.wave, last, 8); }
__device__ __forceinline__ void conv_inproj_share(const Frame& F) {
    constexpr int N1 = IT_MID - IT_P0, CY = (N1 - 118 * 100 + 255) / 256, CX = CY + 100; int a, n;
    if (F.G == 256) { if (F.bx < 138) { a = F.bx * CY; n = CY; } else { a = 138 * CY + (F.bx - 138) * CX; n = CX; } }
    else { n = (N1 + F.G - 1) / F.G; a = F.bx * n; }
    const int e = a + n < N1 ? a + n : N1;
    if (a < e) conv_range(F, IT_P0 + a, IT_P0 + e);
}
__device__ __forceinline__ void conv_tail(const Frame& F, int first, int last, int c0) {
    int nw = F.G - c0, me = F.bx - c0; if (nw <= 0) { nw = F.G; me = F.bx; }
    if (me < 0) return;
    conv_items(F, first + me * 8 + F.wave, last, nw * 8);
}
__device__ __forceinline__ void phase_prologue(Frame& F) {
    const int gw = F.bx * 8 + F.wave, NGW = F.G * 8;
    conv_items(F, gw, IT_P0, NGW);
    for (int row = gw; row < MROWS; row += NGW) {
        bf16_t* dst = F.h0() + (size_t)row * D;
        if (row >= NTOK + NMETA) {
#pragma unroll
            for (int j = 0; j < 8; ++j) *(u32x2*)(dst + (j * 64 + F.lane) * 4) = (u32x2){0u, 0u};
            continue; }
        const float* src = row < NTOK ? F.x + (size_t)row * D : F.meta + (size_t)(row - NTOK) * D;
        f32x4 v[8]; float s = 0.f;
#pragma unroll
        for (int j = 0; j < 8; ++j) { v[j] = *(const f32x4*)(src + (j * 64 + F.lane) * 4); s += (v[j][0] + v[j][1]) + (v[j][2] + v[j][3]); }
        const float mu = wsum(s) * (1.0f / D); float q = 0.f;
#pragma unroll
        for (int j = 0; j < 8; ++j) { const f32x4 d = v[j] - mu; q += (d[0] * d[0] + d[1] * d[1]) + (d[2] * d[2] + d[3] * d[3]); }
        const float rstd = 1.0f / sqrtf(wsum(q) * (1.0f / D) + LN_EPS);
#pragma unroll
        for (int j = 0; j < 8; ++j) { const int c = (j * 64 + F.lane) * 4; const f32x4 g = *(const f32x4*)(F.lng + c), b = *(const f32x4*)(F.lnb + c); const f32x4 y = (v[j] - mu) * rstd * g + b;
            *(u32x2*)(dst + c) = (u32x2){pack2(y[0], y[1]), pack2(y[2], y[3])}; }
        if (row < NTOK && F.lane == 0) { F.stats0()[row * 2] = mu; F.stats0()[row * 2 + 1] = rstd; }
    }
    if (F.bx == 0) for (int i = F.tid; i < 16 * 272; i += 512) { const int h = i / 272, r = i % 272; F.tab()[i] = r <= 256 ? F.t5[t5_bucket(r - 128) * 16 + h] * LOG2E : 0.f; }
}

template <class Fn> __device__ __forceinline__ void sgemm(const Fn& f, LAS unsigned char* ldsb, int tid, int bx, int G) {
    LAS float* As = (LAS float*)ldsb; LAS float* Bs = As + 32 * 132; LAS float* Bs2 = Bs + 32 * 68;
    const int ntm = f.ntm(), ntn = f.ntn(), K = f.K();
    const int tx = tid & 15, ty = tid >> 4, ar = tid >> 2, akc = (tid & 3) * 8, br = (tid & 255) >> 2;
    for (int tile = bx; tile < ntm * ntn; tile += G) {
        const int tm = tile / ntn, tn = tile % ntn;
        typename Fn::Tile T; if (!f.tile(tm, T)) continue;
        float acc[4][4], acc2[4][4];
#pragma unroll
        for (int i = 0; i < 4; ++i)
#pragma unroll
            for (int j = 0; j < 4; ++j) { acc[i][j] = 0.f; acc2[i][j] = 0.f; }
        const bf16_t* ap = f.arow(T, tm * 128 + ar);
        const bf16_t* bp = tid < 256 ? f.brow(T, tn * 64 + br) : (Fn::DUAL ? f.brow2(T, tn * 64 + br) : nullptr);
        LAS float* Bw = tid < 256 ? Bs : Bs2;
        for (int k0 = 0; k0 < K; k0 += 32) {
            u32x4 av = (u32x4){0u, 0u, 0u, 0u}, bv = (u32x4){0u, 0u, 0u, 0u};
            if (ap) av = *(const u32x4*)(ap + k0 + akc);
            if (bp) bv = *(const u32x4*)(bp + k0 + akc);
            __syncthreads();
#pragma unroll
            for (int i = 0; i < 4; ++i) { As[(akc + 2 * i) * 132 + ar] = __uint_as_float(av[i] << 16); As[(akc + 2 * i + 1) * 132 + ar] = __uint_as_float(av[i] & 0xffff0000u); }
            if (tid < 256 || Fn::DUAL) {
#pragma unroll
                for (int i = 0; i < 4; ++i) { Bw[(akc + 2 * i) * 68 + br] = __uint_as_float(bv[i] << 16); Bw[(akc + 2 * i + 1) * 68 + br] = __uint_as_float(bv[i] & 0xffff0000u); } }
            __syncthreads();
#pragma unroll 8
            for (int kk = 0; kk < 32; ++kk) {
                const f32x4 a = *(const LAS f32x4*)(As + kk * 132 + ty * 4), b = *(const LAS f32x4*)(Bs + kk * 68 + tx * 4);
#pragma unroll
                for (int i = 0; i < 4; ++i)
#pragma unroll
                    for (int j = 0; j < 4; ++j) acc[i][j] += a[i] * b[j];
                if (Fn::DUAL) { const f32x4 b2 = *(const LAS f32x4*)(Bs2 + kk * 68 + tx * 4);
#pragma unroll
                    for (int i = 0; i < 4; ++i)
#pragma unroll
                        for (int j = 0; j < 4; ++j) acc2[i][j] += a[i] * b2[j]; }
            }
        }
#pragma unroll
        for (int i = 0; i < 4; ++i)
#pragma unroll
            for (int j = 0; j < 4; ++j) f.store(T, tm * 128 + ty * 4 + i, tn * 64 + tx * 4 + j, acc[i][j], acc2[i][j]);
    }
}

__device__ __forceinline__ void expert_starts(const Frame& F, LAS int* ps  ) {
    if (F.tid == 0) { int acc = 0; for (int e = 0; e < NE; ++e) { ps[e] = acc; acc += ((F.cnt()[e] + 255) >> 8) << 8; } ps[64] = acc; }
    __syncthreads();
}

struct FnInProj {
    static constexpr bool DUAL = false; struct Tile {}; const Frame& F;
    __device__ int ntm() const { return MROWS / 128; } __device__ int ntn() const { return INW / 64; } __device__ int K() const { return D; }
    __device__ bool tile(int, Tile&) const { return true; }
    __device__ const bf16_t* arow(const Tile&, int row) const { return F.h0() + (size_t)row * D; }
    __device__ const bf16_t* brow(const Tile&, int n) const { return F.wtin() + (size_t)n * D; }
    __device__ const bf16_t* brow2(const Tile&, int) const { return nullptr; }
    __device__ void store(const Tile&, int row, int n, float a, float) const { F.u()[(size_t)row * INW + n] = f2bf(a); }
};
struct FnOutProj {
    static constexpr bool DUAL = false; struct Tile {}; const Frame& F;
    __device__ int ntm() const { return NTOK / 128; } __device__ int ntn() const { return D / 64; } __device__ int K() const { return D; }
    __device__ bool tile(int, Tile&) const { return true; }
    __device__ const bf16_t* arow(const Tile&, int row) const { return F.ya() + (size_t)row * D; }
    __device__ const bf16_t* brow(const Tile&, int n) const { return F.wtout() + (size_t)n * D; }
    __device__ const bf16_t* brow2(const Tile&, int) const { return nullptr; }
    __device__ void store(const Tile&, int row, int n, float a, float) const {
        const float h0 = (F.x[(size_t)row * D + n] - F.stats0()[row * 2]) * F.stats0()[row * 2 + 1] * F.lng[n] + F.lnb[n];
        F.z()[(size_t)row * D + n] = f2bf(a + ALPHA * h0); }
};
struct FnGateUp {
    static constexpr bool DUAL = true; struct Tile { int e, r0, n; }; const Frame& F; const LAS int* ps;
    __device__ int ntm() const { return HBROWS / 128; } __device__ int ntn() const { return DE / 64; } __device__ int K() const { return D; }
    __device__ bool tile(int tm, Tile& T) const { const int row0 = tm * 128;
        if (row0 >= PMAX) { T.e = NE; T.r0 = row0 - PMAX; T.n = NTOK; return true; }
        if (row0 >= ps[64]) return false;
        int e = 0; while (e < NE - 1 && row0 >= ps[e + 1]) ++e;
        T.e = e; T.r0 = row0 - ps[e]; T.n = F.cnt()[e]; return T.r0 < T.n; }
    __device__ const bf16_t* arow(const Tile& T, int row) const { const int r = T.r0 + (row & 127); if (r >= T.n) return nullptr;
        const int tok = T.e < NE ? F.tokl()[(size_t)T.e * NTOK + r] : r; return F.h1() + (size_t)tok * D; }
    __device__ const bf16_t* brow(const Tile& T, int n) const { return F.wtgu() + ((size_t)T.e * 1024 + 256 * (n >> 7) + (n & 127)) * D; }
    __device__ const bf16_t* brow2(const Tile& T, int n) const { return F.wtgu() + ((size_t)T.e * 1024 + 256 * (n >> 7) + 128 + (n & 127)) * D; }
    __device__ void store(const Tile& T, int row, int n, float g, float u) const { const int r = T.r0 + (row & 127); const float w = T.e < NE ? (r < T.n ? F.wl()[(size_t)T.e * NTOK + r] : 0.f) : 1.0f;
        F.hb()[(size_t)row * DE + n] = f2bf(g / (1.0f + __expf(-g)) * (u * w)); }
};
struct FnDown {
    static constexpr bool DUAL = false; struct Tile { int e, r0, n; }; const Frame& F; const LAS int* ps;
    __device__ int ntm() const { return PMAX / 128; } __device__ int ntn() const { return D / 64; } __device__ int K() const { return DE; }
    __device__ bool tile(int tm, Tile& T) const { const int row0 = tm * 128; if (row0 >= ps[64]) return false;
        int e = 0; while (e < NE - 1 && row0 >= ps[e + 1]) ++e;
        T.e = e; T.r0 = row0 - ps[e]; T.n = F.cnt()[e]; return T.r0 < T.n; }
    __device__ const bf16_t* arow(const Tile&, int row) const { return F.hb() + (size_t)row * DE; }
    __device__ const bf16_t* brow(const Tile& T, int n) const { return F.wtd() + ((size_t)T.e * D + n) * DE; }
    __device__ const bf16_t* brow2(const Tile&, int) const { return nullptr; }
    __device__ void store(const Tile& T, int row, int n, float a, float) const { const int r = T.r0 + (row & 127);
        (void)r; ((unsigned char*)F.ym())[(size_t)row * D + n] = (unsigned char)enc8(a); }
};
struct FnFinal {
    static constexpr bool DUAL = false; struct Tile {}; const Frame& F; const LAS int* ps;
    __device__ int ntm() const { return NTOK / 128; } __device__ int ntn() const { return D / 64; } __device__ int K() const { return DE; }
    __device__ bool tile(int, Tile&) const { return true; }
    __device__ const bf16_t* arow(const Tile&, int row) const { return F.hb() + (size_t)(PMAX + row) * DE; }
    __device__ const bf16_t* brow(const Tile&, int n) const { return F.wtd() + ((size_t)NE * D + n) * DE; }
    __device__ const bf16_t* brow2(const Tile&, int) const { return nullptr; }
    __device__ void store(const Tile&, int row, int n, float a, float) const {
        const float h1 = bf2f(F.h1()[(size_t)row * D + n]);
        F.o2()[(size_t)row * D + n] = f2bf(a + ALPHA * h1); }
};

__device__ __forceinline__ void phase_attn_simple(Frame& F) {
    LAS float* qs = (LAS float*)F.lds + F.wave * 512; LAS float* psm = qs + 64;
    const int gw = F.bx * 8 + F.wave, NGW = F.G * 8, lane = F.lane;
    for (int item = gw; item < NTOK * 32; item += NGW) {
        const int tok = item >> 5, hh = item & 31, b = tok >> 13, s = tok & 8191;
        const bool isA = hh < 16; const int h = hh & 15;
        const int qcol = isA ? COL_QA + h * 64 : COL_QB + h * 64, kcol = isA ? COL_KA + (h >> 2) * 64 : COL_KB + h * 64, vcol = isA ? COL_VA + (h >> 2) * 64 : COL_VB + h * 64;
        const int r = s >> 6, c = s & 63, rs = min(max(r - 4, 0), 120), cs = min(max(c - 8, 0), 48);
        const int nkeys = isA ? 16 + 257 : 16 + 128;
        asm volatile("s_waitcnt lgkmcnt(0)" ::: "memory");
        qs[lane] = bf2f(F.u()[(size_t)tok * INW + qcol + lane]);
        asm volatile("s_waitcnt lgkmcnt(0)" ::: "memory");
        float sc[5]; float mx = -INFINITY;
#pragma unroll
        for (int i = 0; i < 5; ++i) {
            const int j = lane + 64 * i; sc[i] = -INFINITY;
            if (j < nkeys) {
                int krow; float bias; bool valid = true;
                if (j < 16) { krow = NTOK + j; bias = isA ? F.t5[t5_bucket(j - 16 - s) * 16 + h] * LOG2E : 0.f; }
                else if (isA) { const int kpos = s - 128 + (j - 16); valid = kpos >= 0 && kpos < SEQ; krow = b * SEQ + kpos; bias = F.tab()[h * 272 + (j - 16)]; }
                else { const int w = j - 16, kr = rs + (w >> 4), kc = cs + (w & 15); krow = b * SEQ + kr * 64 + kc; bias = F.rpb[(h * 15 + (kr - r + 7)) * 31 + (kc - c + 15)] * LOG2E; }
                if (valid) { const bf16_t* kp = F.u() + (size_t)krow * INW + kcol; float dot = 0.f;
#pragma unroll
                    for (int d8 = 0; d8 < 8; ++d8) { const u32x4 kv = *(const u32x4*)(kp + d8 * 8);
#pragma unroll
                        for (int i2 = 0; i2 < 4; ++i2) { dot += qs[d8 * 8 + 2 * i2] * __uint_as_float(kv[i2] << 16); dot += qs[d8 * 8 + 2 * i2 + 1] * __uint_as_float(kv[i2] & 0xffff0000u); } }
                    sc[i] = dot + bias; }
            }
            mx = fmaxf(mx, sc[i]);
        }
        const float sinkl = isA ? F.sink[h] * LOG2E : -INFINITY;
        mx = fmaxf(wmax(mx), sinkl);
        float l = 0.f;
#pragma unroll
        for (int i = 0; i < 5; ++i) { const int j = lane + 64 * i; const float p = sc[i] == -INFINITY ? 0.f : exp2f(sc[i] - mx); l += p; if (j < 320) psm[j] = p; }
        l = wsum(l) + (isA ? exp2f(sinkl - mx) : 0.f);
        asm volatile("s_waitcnt lgkmcnt(0)" ::: "memory");
        float o = 0.f;
        for (int j = 0; j < nkeys; ++j) { const float p = psm[j]; if (p == 0.f) continue;
            int krow; if (j < 16) krow = NTOK + j; else if (isA) krow = b * SEQ + s - 128 + (j - 16); else { const int w = j - 16; krow = b * SEQ + (rs + (w >> 4)) * 64 + cs + (w & 15); }
            o += p * bf2f(F.u()[(size_t)krow * INW + vcol + lane]); }
        o /= l;
        const bf16_t ob = f2bf(o); F.ya()[(size_t)tok * D + hh * 64 + lane] = ob;
        const float of = bf2f(ob), q = wsum(of * of);
        if (lane == 0) F.ssq()[tok * 32 + hh] = q;
    }
}
__device__ __forceinline__ void phase_rmsnorm(Frame& F) {
    const int gw = F.bx * 8 + F.wave, NGW = F.G * 8, lane = F.lane;
    for (int tok = gw; tok < NTOK; tok += NGW) {
        const float q = lane < 32 ? F.ssq()[tok * 32 + lane] : 0.f;
        float qa = lane < 16 ? q : 0.f, qb = (lane >= 16 && lane < 32) ? q : 0.f; qa = wsum(qa); qb = wsum(qb);
        const float ra = 1.0f / sqrtf(qa * (1.0f / 1024.f) + RMS_EPS), rb = 1.0f / sqrtf(qb * (1.0f / 1024.f) + RMS_EPS);
        bf16_t* p = F.ya() + (size_t)tok * D;
#pragma unroll
        for (int j = 0; j < 8; ++j) { const int c = (j * 64 + lane) * 4; const float rr = c < 1024 ? ra : rb; u32x2 w = *(u32x2*)(p + c);
            w.x = pack2(__uint_as_float(w.x << 16) * rr, __uint_as_float(w.x & 0xffff0000u) * rr); w.y = pack2(__uint_as_float(w.y << 16) * rr, __uint_as_float(w.y & 0xffff0000u) * rr); *(u32x2*)(p + c) = w; }
    }
}

__device__ __forceinline__ void phase_ln1_router(Frame& F) {
    LAS float* hs = (LAS float*)F.lds + F.wave * 2048;
    const int gw = F.bx * 8 + F.wave, NGW = F.G * 8, lane = F.lane;
    for (int tok = gw; tok < NTOK; tok += NGW) {
        const bf16_t* src = F.z() + (size_t)tok * D; f32x4 v[8]; float s = 0.f;
#pragma unroll
        for (int j = 0; j < 8; ++j) { const u32x2 w = *(const u32x2*)(src + (j * 64 + lane) * 4); v[j] = (f32x4){__uint_as_float(w.x << 16), __uint_as_float(w.x & 0xffff0000u), __uint_as_float(w.y << 16), __uint_as_float(w.y & 0xffff0000u)}; s += (v[j][0] + v[j][1]) + (v[j][2] + v[j][3]); }
        const float mu = wsum(s) * (1.0f / D); float q = 0.f;
#pragma unroll
        for (int j = 0; j < 8; ++j) { const f32x4 d = v[j] - mu; q += (d[0] * d[0] + d[1] * d[1]) + (d[2] * d[2] + d[3] * d[3]); }
        const float rstd = 1.0f / sqrtf(wsum(q) * (1.0f / D) + LN_EPS);
        asm volatile("s_waitcnt lgkmcnt(0)" ::: "memory");
#pragma unroll
        for (int j = 0; j < 8; ++j) { const int c = (j * 64 + lane) * 4; const f32x4 g = *(const f32x4*)(F.l1g + c), bb = *(const f32x4*)(F.l1b + c); const f32x4 y = (v[j] - mu) * rstd * g + bb;
            *(u32x2*)(F.h1() + (size_t)tok * D + c) = (u32x2){pack2(y[0], y[1]), pack2(y[2], y[3])}; *(LAS f32x4*)(hs + c) = y; }
        if (lane == 0) { F.stats1()[tok * 2] = mu; F.stats1()[tok * 2 + 1] = rstd; }
        asm volatile("s_waitcnt lgkmcnt(0)" ::: "memory");
        float lg = 0.f;
#pragma unroll 8
        for (int n = 0; n < D; ++n) lg += hs[n] * F.w_router[(size_t)n * NE + lane];
        const float score = 1.0f / (1.0f + expf(-lg)), v0 = score + F.rbias[lane];
        int rk = 0;
#pragma unroll
        for (int j = 0; j < 8; ++j) { const int o = (lane & ~7) + j; const float w = __shfl(v0, o); rk += (w > v0 || (w == v0 && o < lane)) ? 1 : 0; }
        float gs = rk < 2 ? v0 : 0.f; gs += __shfl_xor(gs, 1); gs += __shfl_xor(gs, 2); gs += __shfl_xor(gs, 4);
        int grk = 0; const int myg = lane >> 3;
#pragma unroll
        for (int g = 0; g < 8; ++g) { const float w = __shfl(gs, g * 8); grk += (w > gs || (w == gs && g < myg)) ? 1 : 0; }
        const float mv = grk < 4 ? v0 : -INFINITY;
        int erk = 0;
        for (int o = 0; o < 64; ++o) { const float w = __shfl(mv, o); erk += (w > mv || (w == mv && o < lane)) ? 1 : 0; }
        const bool sel = erk < 8;
        const float wsm = wsum(sel ? score : 0.f), wgt = score / (wsm + 1e-20f) * 2.5f;
        if (sel) { const int rr = atomicAdd(F.cnt() + lane, 1); F.tokl()[(size_t)lane * NTOK + rr] = tok; F.wl()[(size_t)lane * NTOK + rr] = wgt; F.tke()[tok * 8 + erk] = lane; F.tkr()[tok * 8 + erk] = rr; }
    }
}
__device__ __forceinline__ void phase_ln2(Frame& F, const LAS int* ps) {
    const int gw = F.bx * 8 + F.wave, NGW = F.G * 8, lane = F.lane;
#pragma unroll 1
    for (int tok = gw; tok < NTOK; tok += NGW) {
        float* dst = F.out + (size_t)tok * D; const bf16_t* o2p = F.o2() + (size_t)tok * D; float v[2][16]; float s = 0.f;
        const int mye = F.tke()[tok * 8 + (lane & 7)], myr = F.tkr()[tok * 8 + (lane & 7)], mypos = ps[mye] + myr;
        u32x4 o[2][2];
#pragma unroll
        for (int k = 0; k < 2; ++k) { o[k][0] = *(const u32x4*)(o2p + (lane + 64 * k) * 16); o[k][1] = *(const u32x4*)(o2p + (lane + 64 * k) * 16 + 8); }
#pragma unroll
        for (int k = 0; k < 2; ++k)
#pragma unroll
            for (int h = 0; h < 2; ++h)
#pragma unroll
                for (int i = 0; i < 4; ++i) { v[k][8 * h + 2 * i] = __uint_as_float(o[k][h][i] << 16); v[k][8 * h + 2 * i + 1] = __uint_as_float(o[k][h][i] & 0xffff0000u); }
        u32x4 y[8][2];
#pragma unroll
        for (int j = 0; j < 8; ++j) { const int p = __shfl(mypos, j); const unsigned char* yp = (const unsigned char*)F.ym() + (size_t)p * D;
#pragma unroll
            for (int k = 0; k < 2; ++k) y[j][k] = *(const u32x4*)(yp + (lane + 64 * k) * 16); }
#pragma unroll
        for (int j = 0; j < 8; ++j)
#pragma unroll
            for (int k = 0; k < 2; ++k)
#pragma unroll
                for (int i = 0; i < 4; ++i) { unsigned w = y[j][k][i]; asm volatile("" : "+v"(w));
                    const unsigned w1 = w >> 8;
                    const unsigned p02 = ((w & 0x007f007fu) << 4) + 0x39003900u + ((w & 0x00800080u) << 8), p13 = ((w1 & 0x007f007fu) << 4) + 0x39003900u + ((w1 & 0x00800080u) << 8);
                    v[k][4 * i] += __uint_as_float(p02 << 16); v[k][4 * i + 2] += __uint_as_float(p02 & 0xffff0000u);
                    v[k][4 * i + 1] += __uint_as_float(p13 << 16); v[k][4 * i + 3] += __uint_as_float(p13 & 0xffff0000u);
                    asm volatile("" : "+v"(v[k][4 * i]), "+v"(v[k][4 * i + 1]), "+v"(v[k][4 * i + 2]), "+v"(v[k][4 * i + 3])); }
#pragma unroll
        for (int k = 0; k < 2; ++k)
#pragma unroll
            for (int i = 0; i < 16; ++i) s += v[k][i];
        const float mu = wsum(s) * (1.0f / D); float q = 0.f;
#pragma unroll
        for (int k = 0; k < 2; ++k)
#pragma unroll
            for (int i = 0; i < 16; ++i) { const float d = v[k][i] - mu; q += d * d; }
        const float rstd = 1.0f / sqrtf(wsum(q) * (1.0f / D) + LN_EPS);
        asm volatile("" ::: "memory");
#pragma unroll
        for (int k = 0; k < 2; ++k)
#pragma unroll
            for (int h = 0; h < 4; ++h) { const int c = (lane + 64 * k) * 16 + 4 * h; const f32x4 g = *(const f32x4*)(F.l2g + c), bb = *(const f32x4*)(F.l2b + c);
                *(f32x4*)(dst + c) = (f32x4){(v[k][4 * h] - mu) * rstd * g[0] + bb[0], (v[k][4 * h + 1] - mu) * rstd * g[1] + bb[1], (v[k][4 * h + 2] - mu) * rstd * g[2] + bb[2], (v[k][4 * h + 3] - mu) * rstd * g[3] + bb[3]}; }
    }
}

#ifndef FAST_P1
#define FAST_P1 1
#endif
#ifndef STAGGER7
#define STAGGER7 0
#endif
#ifndef CONV_NT
#define CONV_NT 1
#endif
#ifndef STAGGER4
#define STAGGER4 0
#endif
#ifndef XCD_TRUE
#define XCD_TRUE 1
#endif
#ifndef DOWN_REV
#define DOWN_REV false
#endif
#ifndef YM_NT
#define YM_NT 0
#endif
#ifndef FAST_P4
#define FAST_P4 1
#endif
#ifndef FAST_P6
#define FAST_P6 1
#endif
#ifndef FAST_P7
#define FAST_P7 1
#endif
namespace pg8 {
typedef short bf16x8 __attribute__((ext_vector_type(8)));
constexpr int BM = 256, BK = 64, HALF = 128, HTB = HALF * BK * 2, STAGE_BYTES = 8 * HTB, NXCD = 8, WGM = 8;
__host__ __device__ __forceinline__ int lds_byte(int r, int c) { const int st = (r >> 4) * 2 + (c >> 5), rr = r & 15, cc = c & 31, ob = rr * 64 + cc * 2; return st * 1024 + (ob ^ (((ob >> 9) & 1) << 5)); }
__host__ __device__ __forceinline__ void stage_rc(int b, int& R, int& C) { const int st = b / 1024, sb = b % 1024, swz = sb ^ (((sb >> 9) & 1) << 5); R = (st >> 1) * 16 + swz / 64; C = (st & 1) * 32 + (swz % 64) / 2; }
__host__ __device__ __forceinline__ int perm32(int rho) { const int n = rho >> 4, i = rho & 15; return 8 * (i >> 2) + 4 * n + (i & 3); }
__device__ __forceinline__ unsigned cvt_pk_bf16(float lo, float hi) { unsigned r; asm volatile("v_cvt_pk_bf16_f32 %0, %1, %2" : "=v"(r) : "v"(lo), "v"(hi)); return r; }
typedef int i32x4 __attribute__((ext_vector_type(4)));
typedef int i32x8 __attribute__((ext_vector_type(8)));
__device__ __forceinline__ i32x8 cat8(bf16x8 a, bf16x8 b) { return __builtin_shufflevector(__builtin_bit_cast(i32x4, a), __builtin_bit_cast(i32x4, b), 0, 1, 2, 3, 4, 5, 6, 7); }
struct Unit { int pm, pn, e, r0, n, orow, tb; };
__device__ __forceinline__ int xcd_remap(int L, int nwg) { const int q = nwg / NXCD, r = nwg % NXCD, xcd = L % NXCD, off = L / NXCD; return (xcd < r ? xcd * (q + 1) : r * (q + 1) + (xcd - r) * q) + off; }
__device__ __forceinline__ void tile_of(int wgid, int nM, int nN, int& pm, int& pn) { const int nig = WGM * nN, gid = wgid / nig, fm = gid * WGM, gsz = (nM - fm) < WGM ? (nM - fm) : WGM; pm = fm + ((wgid % nig) % gsz); pn = (wgid % nig) / gsz; }

template <class Epi, class Sched>
__device__ __forceinline__ void gemm_phase(const int wave0, LAS unsigned char* lds, const Sched& S, const Epi& E, const int lda, const int ldb, const int nt, const int stagger_ticks = 0) {
    int tid = wave0 * 64 + lane_id(); asm volatile("" : "+v"(tid));
    const int wid = wave0, lane = tid & 63, wr = wid >> 2, wc = wid & 3, fr = lane & 15, fq = lane >> 4;
    unsigned voffA[2], voffB[2], voffB2[2], c2[2]; int RA[2];
#pragma unroll
    for (int i = 0; i < 2; ++i) { int R, C; stage_rc(tid * 16 + i * 8192, R, C); const int Rb = Epi::PERM ? ((R & ~31) + perm32(R & 31)) : R;
        voffA[i] = (unsigned)(R * lda + C) * 2u; voffB[i] = (unsigned)(Rb * ldb + C) * 2u; RA[i] = R; c2[i] = (unsigned)C * 2u;
        voffB2[i] = (unsigned)((64 * (R >> 5) + 16 * ((R >> 2) & 3) + 4 * ((R >> 4) & 1) + (R & 3)) * ldb + C) * 2u; }
    const size_t kstep = (size_t)(BK * 2), hstepA = (size_t)HALF * lda * 2, hstepB = (size_t)HALF * ldb * 2, hstepB2 = (size_t)8 * ldb * 2;
    const unsigned lda2 = (unsigned)lda * 2u;
    const unsigned ldsw = (unsigned)wid * 1024u;
    int aoff = lds_byte(wr * 64 + fr, fq * 8), boff = lds_byte(wc * 32 + fr, fq * 8) + 4 * HTB; asm volatile("" : "+v"(aoff), "+v"(boff));
#define PG8_SA(b, h) (((b) * 2 + (h)) * HTB)
#define PG8_SB(b, h) ((4 + (b) * 2 + (h)) * HTB)
#define PG8_STAGE(bufoff, gbase, voff) do { const char* _g = (const char*)(gbase); asm volatile("" : "+s"(_g)); _Pragma("unroll") for (int _i = 0; _i < 2; ++_i) { unsigned _v = (voff)[_i]; asm volatile("" : "+v"(_v)); \
        __builtin_amdgcn_global_load_lds((const unsigned*)(_g + _v), (LAS unsigned*)(lds + (bufoff) + ldsw + _i * 8192), 16, 0, 0); } } while (0)
#define PG8_STG_A(bufoff, p, h, V) do { if constexpr (Sched::GATHER) { PG8_STAGE(bufoff, p, V[h]); } else { PG8_STAGE(bufoff, (p) + (h) * hstepA, voffA); } } while (0)
#define PG8_STG_B(bufoff, p, h) do { if constexpr (Epi::PERM2) { PG8_STAGE(bufoff, (p) + (h) * hstepB2, voffB2); } else { PG8_STAGE(bufoff, (p) + (h) * hstepB, voffB); } } while (0)
#define PG8_LDA(dst, b, h) do { _Pragma("unroll") for (int m = 0; m < 4; ++m) _Pragma("unroll") for (int k = 0; k < 2; ++k) dst[m][k] = *(const LAS bf16x8*)(lds + PG8_SA(b, h) + aoff + m * 2048 + k * 1024); } while (0)
#define PG8_LDB(dst, b, h) do { _Pragma("unroll") for (int n = 0; n < 2; ++n) _Pragma("unroll") for (int k = 0; k < 2; ++k) dst[n][k] = *(const LAS bf16x8*)(lds + boff + (PG8_SB(b, h) - 4 * HTB) + n * 2048 + k * 1024); } while (0)
#define PG8_MMA(ai, bj, At, Bt) do { __builtin_amdgcn_s_setprio(1); _Pragma("unroll") for (int m = 0; m < 4; ++m) _Pragma("unroll") for (int n = 0; n < 2; ++n) { \
        if constexpr (Epi::F8) acc[ai][bj][m][n] = __builtin_amdgcn_mfma_scale_f32_16x16x128_f8f6f4(cat8(Bt[n][0], Bt[n][1]), cat8(At[m][0], At[m][1]), acc[ai][bj][m][n], 0, 0, 0, 0, 0, 0); \
        else { _Pragma("unroll") for (int k = 0; k < 2; ++k) acc[ai][bj][m][n] = __builtin_amdgcn_mfma_f32_16x16x32_bf16(Bt[n][k], At[m][k], acc[ai][bj][m][n], 0, 0, 0); } } __builtin_amdgcn_s_setprio(0); } while (0)
#define PG8_WAIT_V(n) asm volatile("s_waitcnt vmcnt(" #n ")" ::: "memory")
#define PG8_WAIT_L(n) asm volatile("s_waitcnt lgkmcnt(" #n ")" ::: "memory")
#define PG8_BAR __builtin_amdgcn_s_barrier()
#define PG8_SCHED __builtin_amdgcn_sched_barrier(0)
    Unit cur, nxt; int ui = 0;
    if (stagger_ticks) {
        const unsigned long long t0 = __builtin_amdgcn_s_memrealtime(), dl = (unsigned long long)((blockIdx.x >> 3) & 15) * (unsigned)stagger_ticks;
        while (__builtin_amdgcn_s_memrealtime() - t0 < dl) __builtin_amdgcn_s_sleep(4);
        __syncthreads(); }
    if (!S.next(0, cur)) return;
    cur.tb = 0;
    f32x4 acc[2][2][4][2];
#pragma unroll
    for (int a = 0; a < 2; ++a)
#pragma unroll
        for (int b = 0; b < 2; ++b)
#pragma unroll
            for (int m = 0; m < 4; ++m)
#pragma unroll
                for (int n = 0; n < 2; ++n) acc[a][b][m][n] = (f32x4){0.f, 0.f, 0.f, 0.f};
    bf16x8 At[4][2], B0[2][2], B1[2][2];
    unsigned vac[2][2], van[2][2];
    const char* cA = S.abase(cur); const char* cB = S.bbase(cur);
#pragma unroll
    for (int h = 0; h < 2; ++h)
#pragma unroll
        for (int i = 0; i < 2; ++i) { vac[h][i] = Sched::GATHER ? (unsigned)S.arow(cur, h * HALF + RA[i]) * lda2 + c2[i] : 0u; van[h][i] = vac[h][i]; }
    PG8_STG_B(PG8_SB(0, 0), cB, 0); PG8_STG_B(PG8_SB(0, 1), cB, 1); PG8_STG_A(PG8_SA(0, 0), cA, 0, vac); PG8_STG_A(PG8_SA(0, 1), cA, 1, vac);
    if (wr == 1) PG8_BAR;
    PG8_WAIT_V(2); PG8_BAR;
    PG8_STG_B(PG8_SB(1, 0), cB + kstep, 0); PG8_STG_A(PG8_SA(1, 0), cA + kstep, 0, vac); PG8_STG_B(PG8_SB(1, 1), cB + kstep, 1);
    PG8_WAIT_V(6); PG8_BAR;
    for (;;) {
        const bool has_next = S.next(ui + 1, nxt); nxt.tb = (ui + 1) & 1;
        if constexpr (Epi::MIDK) E.unit_begin(cur, wave0 * 64 + lane_id());
        const char* nA = has_next ? S.abase(nxt) : cA; const char* nB = has_next ? S.bbase(nxt) : cB;
        if constexpr (Sched::GATHER) { if (has_next) { const int tq = wave0 * 64 + lane_id();
#pragma unroll
            for (int h = 0; h < 2; ++h)
#pragma unroll
                for (int i = 0; i < 2; ++i) { int R, C; stage_rc(tq * 16 + i * 8192, R, C); van[h][i] = (unsigned)S.arow(nxt, h * HALF + R); } } }
#pragma unroll 1
        for (int t = 0; t < nt; t += 2) {
            const bool last = (t == nt - 2);
            const char* a1 = cA + (size_t)(t + 1) * kstep;
            const char* a2 = last ? nA : cA + (size_t)(t + 2) * kstep; const char* b2 = last ? nB : cB + (size_t)(t + 2) * kstep;
            const char* a3 = a2 + kstep; const char* b3 = b2 + kstep;
            unsigned va2[2][2];
#pragma unroll
            for (int h = 0; h < 2; ++h)
#pragma unroll
                for (int i = 0; i < 2; ++i) va2[h][i] = last ? van[h][i] : vac[h][i];
            PG8_LDB(B0, 0, 0); PG8_LDB(B1, 0, 1); PG8_SCHED; PG8_LDA(At, 0, 0); PG8_STG_A(PG8_SA(1, 1), a1, 1, vac);
            PG8_WAIT_V(8); PG8_WAIT_L(0); PG8_BAR; PG8_MMA(0, 0, At, B0); PG8_MMA(0, 1, At, B1); PG8_BAR; PG8_SCHED;
            PG8_LDA(At, 0, 1); PG8_STG_B(PG8_SB(0, 0), b2, 0); PG8_STG_B(PG8_SB(0, 1), b2, 1); PG8_STG_A(PG8_SA(0, 0), a2, 0, va2);
            PG8_WAIT_V(8); PG8_WAIT_L(0); PG8_BAR; PG8_MMA(1, 0, At, B0); PG8_MMA(1, 1, At, B1); PG8_BAR; PG8_SCHED;
            PG8_LDB(B0, 1, 0); PG8_LDB(B1, 1, 1); PG8_SCHED; PG8_LDA(At, 1, 0); PG8_STG_A(PG8_SA(0, 1), a2, 1, va2);
            PG8_WAIT_V(8); PG8_WAIT_L(0); PG8_BAR; PG8_MMA(0, 0, At, B0); PG8_MMA(0, 1, At, B1); PG8_BAR; PG8_SCHED;
            PG8_LDA(At, 1, 1); PG8_STG_B(PG8_SB(1, 0), b3, 0); PG8_STG_B(PG8_SB(1, 1), b3, 1); PG8_STG_A(PG8_SA(1, 0), a3, 0, va2);
            PG8_WAIT_V(8); PG8_WAIT_L(0); PG8_BAR; PG8_MMA(1, 0, At, B0); PG8_MMA(1, 1, At, B1); PG8_BAR; PG8_SCHED;
            if constexpr (Epi::MIDK) { if (2 * (t + 2) == nt) E.mid(acc, cur, wr, fr); }
            if constexpr (Sched::GATHER) { if (t + 4 == nt && has_next) {
                const int tq = wave0 * 64 + lane_id();
#pragma unroll
                for (int h = 0; h < 2; ++h)
#pragma unroll
                    for (int i = 0; i < 2; ++i) { int R, C; stage_rc(tq * 16 + i * 8192, R, C); asm volatile("" : "+v"(van[h][i])); van[h][i] = van[h][i] * lda2 + (unsigned)C * 2u; } } }
        }
        if (wr == 0) PG8_BAR;
        { const int le = lane_id(); E(acc, cur, wr, wc, le & 15, le >> 4); }
        if (!has_next) break;
#pragma unroll
        for (int a = 0; a < 2; ++a)
#pragma unroll
            for (int b = 0; b < 2; ++b)
#pragma unroll
                for (int m = 0; m < 4; ++m)
#pragma unroll
                    for (int n = 0; n < 2; ++n) acc[a][b][m][n] = (f32x4){0.f, 0.f, 0.f, 0.f};
        cur = nxt; cA = nA; cB = nB; ++ui;
#pragma unroll
        for (int h = 0; h < 2; ++h)
#pragma unroll
            for (int i = 0; i < 2; ++i) vac[h][i] = van[h][i];
        if (wr == 1) PG8_BAR;
    }
    PG8_WAIT_V(0);
    PG8_BAR;
#undef PG8_SA
#undef PG8_SB
#undef PG8_STAGE
#undef PG8_STG_A
#undef PG8_STG_B
#undef PG8_LDA
#undef PG8_LDB
#undef PG8_MMA
#undef PG8_WAIT_V
#undef PG8_WAIT_L
#undef PG8_BAR
#undef PG8_SCHED
}
}

struct SchedInProj {
    static constexpr bool GATHER = false; const char* A; const char* B; int G, c, i0, i1;
    __device__ __forceinline__ bool next(int i, pg8::Unit& u) const { const int ii = i0 + i; if (ii >= i1) return false; const int L = ii * G + c; if (L >= 1162) return false;
        if (L < 1152) pg8::tile_of(pg8::xcd_remap(L, 1152), 64, 18, u.pm, u.pn); else { const int k = L - 1152; u.pm = 64; u.pn = k < 2 ? 4 + k : 8 + k; }
        return true; }
    __device__ __forceinline__ const char* abase(const pg8::Unit& u) const { return A + (size_t)u.pm * 256 * D * 2; }
    __device__ __forceinline__ const char* bbase(const pg8::Unit& u) const { return B + (size_t)u.pn * 256 * D * 2; }
    __device__ __forceinline__ int arow(const pg8::Unit&, int) const { return 0; }
};
struct SchedOutProj {
    static constexpr bool GATHER = false; const char* A; const char* B; int G, c;
    __device__ __forceinline__ bool next(int i, pg8::Unit& u) const { const int L = i * G + c; if (L >= 512) return false; pg8::tile_of(pg8::xcd_remap(L, 512), 64, 8, u.pm, u.pn); return true; }
    __device__ __forceinline__ const char* abase(const pg8::Unit& u) const { return A + (size_t)u.pm * 256 * D * 2; }
    __device__ __forceinline__ const char* bbase(const pg8::Unit& u) const { return B + (size_t)u.pn * 256 * D * 2; }
    __device__ __forceinline__ int arow(const pg8::Unit&, int) const { return 0; }
};
__device__ __forceinline__ void moe_tables(const Frame& F, LAS int* ps) {
    if (F.tid < NE) ps[256 + F.tid] = F.cnt()[F.tid];
    __syncthreads();
    if (F.tid == 0) { int acc = 0, ta = 0; for (int e = 0; e < NE; ++e) { const int mt = (ps[256 + e] + 255) >> 8; ps[e] = acc; ps[128 + e] = ta; acc += mt * 256; ta += mt; }
        ps[64] = acc; ps[128 + 64] = ta; ps[128 + 65] = ta + NTOK / 256; ps[256 + 64] = NTOK; }
    __syncthreads();
    for (int t = F.tid; t < 640; t += 512) { int e = 0; while (e < NE && t >= ps[128 + e + 1]) ++e; ps[384 + t] = e; }
    __syncthreads();
}
template <int NN, bool REV> __device__ __forceinline__ bool moe_unit(const LAS int* ps, int L, pg8::Unit& u, int ntile) {
    const int nU = ntile * NN; if (L >= nU) return false;
    const int wg0 = pg8::xcd_remap(L, nU), wg = REV ? nU - 1 - wg0 : wg0, tile = wg / NN; u.pn = wg % NN;
    const int e = __builtin_amdgcn_readfirstlane(ps[384 + tile]); u.e = e; u.pm = tile - __builtin_amdgcn_readfirstlane(ps[128 + e]); u.r0 = u.pm * 256; u.n = __builtin_amdgcn_readfirstlane(ps[256 + e]);
    u.orow = (e < NE ? __builtin_amdgcn_readfirstlane(ps[e]) : PMAX) + u.r0;
    return true; }
struct SchedGU {
    static constexpr bool GATHER = true; const char* A; const char* B; const int* tokl; const int* cnt; const LAS int* ps; int G, c, ntile;
    __device__ __forceinline__ bool next(int i, pg8::Unit& u) const { return moe_unit<4, false>(ps, i * G + c, u, ntile); }
    __device__ __forceinline__ const char* abase(const pg8::Unit&) const { return A; }
    __device__ __forceinline__ const char* bbase(const pg8::Unit& u) const { return B + ((size_t)u.e * 1024 + u.pn * 256) * D; }
    __device__ __forceinline__ int arow(const pg8::Unit& u, int r) const { const int rr = min(u.r0 + r, u.n - 1); return u.e < NE ? tokl[(size_t)u.e * NTOK + rr] : rr; }
};
struct SchedDown {
    static constexpr bool GATHER = false; const char* A; const char* B; const int* cnt; const LAS int* ps; int G, c, ntile;
    __device__ __forceinline__ bool next(int i, pg8::Unit& u) const { return moe_unit<8, DOWN_REV>(ps, i * G + c, u, ntile); }
    __device__ __forceinline__ const char* abase(const pg8::Unit& u) const { return A + (size_t)u.orow * DE; }
    __device__ __forceinline__ const char* bbase(const pg8::Unit& u) const { return B + ((size_t)u.e * D + u.pn * 256) * DE; }
    __device__ __forceinline__ int arow(const pg8::Unit&, int) const { return 0; }
};
struct SchedDownShared {
    static constexpr bool GATHER = false; const char* A; const char* B; int G, c;
    __device__ __forceinline__ bool next(int i, pg8::Unit& u) const { const int L = i * G + c; if (L >= 512) return false; pg8::tile_of(pg8::xcd_remap(L, 512), 64, 8, u.pm, u.pn);
        u.e = NE; u.r0 = u.pm * 256; u.n = NTOK; u.orow = PMAX + u.r0; return true; }
    __device__ __forceinline__ const char* abase(const pg8::Unit& u) const { return A + (size_t)u.orow * DE; }
    __device__ __forceinline__ const char* bbase(const pg8::Unit& u) const { return B + ((size_t)NE * D + u.pn * 256) * DE; }
    __device__ __forceinline__ int arow(const pg8::Unit&, int) const { return 0; }
};
struct EpiU {
    static constexpr bool F8 = false; static constexpr bool PERM2 = false; static constexpr bool MIDK = false; static constexpr bool PERM = true; bf16_t* U; int nostore;
    __device__ __forceinline__ void operator()(const f32x4 (&acc)[2][2][4][2], const pg8::Unit& u, int wr, int wc, int fr, int fq) const {
        const int row0 = u.pm * 256 + wr * 64 + fr, col0 = u.pn * 256 + wc * 32 + 8 * fq;
        if (nostore) {
#pragma unroll
            for (int ai = 0; ai < 2; ++ai)
#pragma unroll
                for (int bj = 0; bj < 2; ++bj)
#pragma unroll
                    for (int m = 0; m < 4; ++m)
#pragma unroll
                        for (int n = 0; n < 2; ++n) asm volatile("" :: "v"(acc[ai][bj][m][n]));
            return; }
#pragma unroll
        for (int ai = 0; ai < 2; ++ai)
#pragma unroll
            for (int m = 0; m < 4; ++m) { bf16_t* rowp = U + (size_t)(row0 + ai * 128 + m * 16) * INW + col0;
#pragma unroll
                for (int bj = 0; bj < 2; ++bj) { const f32x4 v0 = acc[ai][bj][m][0], v1 = acc[ai][bj][m][1]; u32x4 w;
                    w.x = pg8::cvt_pk_bf16(v0[0], v0[1]); w.y = pg8::cvt_pk_bf16(v0[2], v0[3]); w.z = pg8::cvt_pk_bf16(v1[0], v1[1]); w.w = pg8::cvt_pk_bf16(v1[2], v1[3]);
                    *(u32x4*)(rowp + bj * 128) = w; } }
    }
};
struct EpiZ {
    static constexpr bool F8 = false; static constexpr bool PERM2 = false; static constexpr bool MIDK = true; static constexpr bool PERM = true; bf16_t* Z; const bf16_t* H0; const float* ssq; LAS float* tab;
    __device__ __forceinline__ void unit_begin(const pg8::Unit& u, int tid) const {
        const int row = tid >> 1, grp = tid & 1; const float* p = ssq + (size_t)(u.pm * 256 + row) * 32 + 16 * grp;
        const f32x4 a = *(const f32x4*)p, b4 = *(const f32x4*)(p + 4), c = *(const f32x4*)(p + 8), d = *(const f32x4*)(p + 12);
        const float s = (((a[0] + a[1]) + (a[2] + a[3])) + ((b4[0] + b4[1]) + (b4[2] + b4[3]))) + (((c[0] + c[1]) + (c[2] + c[3])) + ((d[0] + d[1]) + (d[2] + d[3])));
        tab[(u.tb * 256 + row) * 2 + grp] = 1.0f / sqrtf(s * (1.0f / 1024.f) + RMS_EPS);
    }
    __device__ __forceinline__ void mid(f32x4 (&acc)[2][2][4][2], const pg8::Unit& u, int wr, int fr) const {
#pragma unroll
        for (int ai = 0; ai < 2; ++ai)
#pragma unroll
            for (int m = 0; m < 4; ++m) { const int r = ai * 128 + wr * 64 + m * 16 + fr; const float f = tab[(u.tb * 256 + r) * 2] / tab[(u.tb * 256 + r) * 2 + 1];
#pragma unroll
                for (int bj = 0; bj < 2; ++bj)
#pragma unroll
                    for (int n = 0; n < 2; ++n) acc[ai][bj][m][n] *= f; }
    }
    __device__ __forceinline__ void operator()(const f32x4 (&acc)[2][2][4][2], const pg8::Unit& u, int wr, int wc, int fr, int fq) const {
        const int row0 = u.pm * 256 + wr * 64 + fr, col0 = u.pn * 256 + wc * 32 + 8 * fq;
#pragma unroll
        for (int am = 0; am < 4; ++am) {
            u32x4 hv[2][2]; float rb[2];
#pragma unroll
            for (int q = 0; q < 2; ++q) { const int ai = am >> 1, m = (am & 1) * 2 + q; const size_t off = (size_t)(row0 + ai * 128 + m * 16) * D + col0;
                rb[q] = tab[(u.tb * 256 + ai * 128 + wr * 64 + m * 16 + fr) * 2 + 1];
#pragma unroll
                for (int bj = 0; bj < 2; ++bj) hv[q][bj] = *(const u32x4*)(H0 + off + bj * 128); }
#pragma unroll
            for (int q = 0; q < 2; ++q) { const int ai = am >> 1, m = (am & 1) * 2 + q; const size_t off = (size_t)(row0 + ai * 128 + m * 16) * D + col0;
#pragma unroll
                for (int bj = 0; bj < 2; ++bj) { const u32x4 h4 = hv[q][bj];
                    const f32x4 h0v = (f32x4){__uint_as_float(h4.x << 16), __uint_as_float(h4.x & 0xffff0000u), __uint_as_float(h4.y << 16), __uint_as_float(h4.y & 0xffff0000u)};
                    const f32x4 h1v = (f32x4){__uint_as_float(h4.z << 16), __uint_as_float(h4.z & 0xffff0000u), __uint_as_float(h4.w << 16), __uint_as_float(h4.w & 0xffff0000u)};
                    const f32x4 v0 = acc[ai][bj][m][0] * rb[q] + h0v * ALPHA, v1 = acc[ai][bj][m][1] * rb[q] + h1v * ALPHA; u32x4 w;
                    w.x = pg8::cvt_pk_bf16(v0[0], v0[1]); w.y = pg8::cvt_pk_bf16(v0[2], v0[3]); w.z = pg8::cvt_pk_bf16(v1[0], v1[1]); w.w = pg8::cvt_pk_bf16(v1[2], v1[3]);
                    *(u32x4*)(Z + off + bj * 128) = w; } }
            asm volatile("" ::: "memory"); }
    }
};
__device__ __forceinline__ float silu_mul(float g, float u) { return g * __builtin_amdgcn_rcpf(1.0f + __builtin_amdgcn_exp2f(-g * LOG2E)) * u; }
struct EpiGU {
    static constexpr bool F8 = true; static constexpr bool PERM2 = false; static constexpr bool MIDK = false; static constexpr bool PERM = true; unsigned char* H; const float* wl;
    __device__ __forceinline__ void operator()(const f32x4 (&acc)[2][2][4][2], const pg8::Unit& u, int wr, int wc, int fr, int fq) const {
        int rl0 = wr * 64 + fr, col0 = u.pn * 128 + wc * 32 + 8 * fq; asm volatile("" : "+v"(rl0), "+v"(col0));
        float wv[2][4];
#pragma unroll
        for (int ai = 0; ai < 2; ++ai)
#pragma unroll
            for (int m = 0; m < 4; ++m) { const int r = u.r0 + rl0 + ai * 128 + m * 16; wv[ai][m] = (u.e < NE ? (r < u.n ? wl[(size_t)u.e * NTOK + r] : 0.f) : 1.0f) * (S8_GU_INV * S8_HB); }
#pragma unroll
        for (int ai = 0; ai < 2; ++ai)
#pragma unroll
            for (int m = 0; m < 4; ++m) { const f32x4 g0 = acc[ai][0][m][0] * S8_GU_INV, g1 = acc[ai][0][m][1] * S8_GU_INV, u0 = acc[ai][1][m][0] * wv[ai][m], u1 = acc[ai][1][m][1] * wv[ai][m];
                const u32x2 w = (u32x2){e4m3x4(silu_mul(g0[0], u0[0]), silu_mul(g0[1], u0[1]), silu_mul(g0[2], u0[2]), silu_mul(g0[3], u0[3])),
                                        e4m3x4(silu_mul(g1[0], u1[0]), silu_mul(g1[1], u1[1]), silu_mul(g1[2], u1[2]), silu_mul(g1[3], u1[3]))};
                *(u32x2*)(H + (size_t)(u.orow + rl0 + ai * 128 + m * 16) * DE + col0) = w; }
    }
};
struct EpiDownR {
    static constexpr bool F8 = true; static constexpr bool PERM2 = true; static constexpr bool MIDK = false; static constexpr bool PERM = true; unsigned char* Y; int nostore;
    __device__ __forceinline__ void operator()(const f32x4 (&acc)[2][2][4][2], const pg8::Unit& u, int wr, int wc, int fr, int fq) const {
        int rl0 = wr * 64 + fr, col0 = u.pn * 256 + wc * 64 + 16 * fq; asm volatile("" : "+v"(rl0), "+v"(col0));
        if (nostore) {
#pragma unroll
            for (int ai = 0; ai < 2; ++ai)
#pragma unroll
                for (int bj = 0; bj < 2; ++bj)
#pragma unroll
                    for (int m = 0; m < 4; ++m)
#pragma unroll
                        for (int n = 0; n < 2; ++n) asm volatile("" :: "v"(acc[ai][bj][m][n]));
            return; }
#pragma unroll
        for (int ai = 0; ai < 2; ++ai)
#pragma unroll
            for (int m = 0; m < 4; ++m) { const int rl = rl0 + ai * 128 + m * 16; if (u.r0 + rl >= u.n) continue;
                f32x4 a0 = acc[ai][0][m][0], a1 = acc[ai][0][m][1], b0 = acc[ai][1][m][0], b1 = acc[ai][1][m][1];
                asm volatile("" : "+v"(a0), "+v"(a1), "+v"(b0), "+v"(b1));
                const u32x4 q = (u32x4){ym8x4(a0[0], a0[1], a0[2], a0[3]), ym8x4(a1[0], a1[1], a1[2], a1[3]), ym8x4(b0[0], b0[1], b0[2], b0[3]), ym8x4(b1[0], b1[1], b1[2], b1[3])};
                *(u32x4*)(Y + (size_t)(u.orow + rl) * D + col0) = q;
                asm volatile("" ::: "memory"); }
    }
};
struct EpiDownS {
    static constexpr bool F8 = true; static constexpr bool PERM2 = false; static constexpr bool MIDK = false; static constexpr bool PERM = true; bf16_t* O; const bf16_t* H1;
    __device__ __forceinline__ void operator()(const f32x4 (&acc)[2][2][4][2], const pg8::Unit& u, int wr, int wc, int fr, int fq) const {
        int rl0 = wr * 64 + fr, col0 = u.pn * 256 + wc * 32 + 8 * fq; asm volatile("" : "+v"(rl0), "+v"(col0));
#pragma unroll
        for (int am = 0; am < 4; ++am) {
            u32x4 hv[2][2];
#pragma unroll
            for (int q = 0; q < 2; ++q) { const int ai = am >> 1, m = (am & 1) * 2 + q; const size_t off = (size_t)(u.r0 + rl0 + ai * 128 + m * 16) * D + col0;
#pragma unroll
                for (int bj = 0; bj < 2; ++bj) hv[q][bj] = *(const u32x4*)(H1 + off + bj * 128); }
#pragma unroll
            for (int q = 0; q < 2; ++q) { const int ai = am >> 1, m = (am & 1) * 2 + q; const size_t off = (size_t)(u.r0 + rl0 + ai * 128 + m * 16) * D + col0;
#pragma unroll
                for (int bj = 0; bj < 2; ++bj) { const u32x4 h4 = hv[q][bj];
                    const f32x4 h0v = (f32x4){__uint_as_float(h4.x << 16), __uint_as_float(h4.x & 0xffff0000u), __uint_as_float(h4.y << 16), __uint_as_float(h4.y & 0xffff0000u)};
                    const f32x4 h1v = (f32x4){__uint_as_float(h4.z << 16), __uint_as_float(h4.z & 0xffff0000u), __uint_as_float(h4.w << 16), __uint_as_float(h4.w & 0xffff0000u)};
                    const f32x4 v0 = acc[ai][bj][m][0] * S8_DN_INV + h0v * ALPHA, v1 = acc[ai][bj][m][1] * S8_DN_INV + h1v * ALPHA; u32x4 w;
                    w.x = pg8::cvt_pk_bf16(v0[0], v0[1]); w.y = pg8::cvt_pk_bf16(v0[2], v0[3]); w.z = pg8::cvt_pk_bf16(v1[0], v1[1]); w.w = pg8::cvt_pk_bf16(v1[2], v1[3]);
                    *(u32x4*)(O + off + bj * 128) = w; } }
            asm volatile("" ::: "memory"); }
    }
};

#ifndef FAST_P2
#define FAST_P2 1
#endif
namespace att {
typedef short bf16x8 __attribute__((ext_vector_type(8)));
typedef short s16x4 __attribute__((ext_vector_type(4)));
typedef float f32x16 __attribute__((ext_vector_type(16)));
typedef LAS const char* lds_cptr;
constexpr int SLOT = 16384, NSLOT = 6, RING = NSLOT * SLOT;
constexpr int TA_W = 452, TA_OFF = 224;
constexpr int TB_W = 468;
constexpr int OFF_TABA = RING, OFF_TABB = OFF_TABA, OFF_WS = OFF_TABA + 4 * TA_W * 4, OFF_OST = OFF_WS + 8 * 256, ATT_LDS = OFF_OST + 8 * 4096;
static_assert(ATT_LDS <= LDS_BYTES - 16 - 1024, "attention LDS map");
constexpr float NEGB = -1e30f, THR = 8.0f;
#define ATT_MFMA(a, b, c) __builtin_amdgcn_mfma_f32_32x32x16_bf16(a, b, c, 0, 0, 0)
__device__ __forceinline__ int crow(int r, int hi) { return (r & 3) + 8 * (r >> 2) + 4 * hi; }
__device__ __forceinline__ s16x4 vtr(lds_cptr p) { typedef short v4i16_t __attribute__((ext_vector_type(4))); return __builtin_bit_cast(s16x4, __builtin_amdgcn_ds_read_tr16_b64_v4i16((LAS v4i16_t*)p)); }
__device__ __forceinline__ float swapmax(float m) { auto rr = __builtin_amdgcn_permlane32_swap(__float_as_uint(m), __float_as_uint(m), false, false); return fmaxf(__uint_as_float(rr[0]), __uint_as_float(rr[1])); }
__device__ __forceinline__ float swapsum(float m) { auto rr = __builtin_amdgcn_permlane32_swap(__float_as_uint(m), __float_as_uint(m), false, false); return __uint_as_float(rr[0]) + __uint_as_float(rr[1]); }

__device__ __forceinline__ float bf16r(float x) { return __uint_as_float(pg8::cvt_pk_bf16(x, 0.f) << 16); }
__device__ __forceinline__ bf16x8 frag_k0(unsigned bits16, int hi) { const u32x4 w = (u32x4){hi == 0 ? bits16 : 0u, 0u, 0u, 0u}; return __builtin_bit_cast(bf16x8, w); }
template <int NH, int NS, class BiasFn>
__device__ __forceinline__ void tile_qb(const bf16x8 (&kf)[8], const bf16x8 (&qr)[4], bf16x8& mq, const bf16x8& ones, lds_cptr vp, f32x16 (&o)[2], float& m, float& l, LAS float* wsf, int r32, int hi, const BiasFn& bias) {
    f32x16 c[NH];
#pragma unroll
    for (int hf = 0; hf < NH; ++hf)
#pragma unroll
        for (int r = 0; r < 16; ++r) c[hf][r] = bias(hf, r);
    s16x4 vlo[NS][2], vhi[NS][2];
#pragma unroll
    for (int dh = 0; dh < 2; ++dh) { vlo[0][dh] = vtr(vp + dh * 4096); vhi[0][dh] = vtr(vp + dh * 4096 + 512); }
    __builtin_amdgcn_sched_barrier(0);
#pragma unroll
    for (int hf = 0; hf < NH; ++hf) { c[hf] = ATT_MFMA(ones, mq, c[hf]);
#pragma unroll
        for (int d0 = 0; d0 < 4; ++d0) c[hf] = ATT_MFMA(kf[2 * d0 + hf], qr[d0], c[hf]); }
    float mx = NEGB;
#pragma unroll
    for (int hf = 0; hf < NH; ++hf)
#pragma unroll
        for (int r = 0; r < 16; ++r) mx = fmaxf(mx, c[hf][r]);
    mx = swapmax(mx);
    if (__any(mx > THR)) {
        const float mn = bf16r(m + fmaxf(mx, 0.f)), dl = mn - m, f = __builtin_amdgcn_exp2f(-dl); m = mn; l *= f;
        mq = frag_k0(__float_as_uint(-mn) >> 16, hi);
        if (hi == 0) wsf[r32] = f;
        asm volatile("s_waitcnt lgkmcnt(0)" ::: "memory");
#pragma unroll
        for (int r = 0; r < 16; ++r) { const float fr = wsf[crow(r, hi)]; o[0][r] *= fr; o[1][r] *= fr; }
#pragma unroll
        for (int hf = 0; hf < NH; ++hf)
#pragma unroll
            for (int r = 0; r < 16; ++r) c[hf][r] -= dl;
    }
#pragma unroll
    for (int s = 1; s < NS; ++s)
#pragma unroll
        for (int dh = 0; dh < 2; ++dh) { vlo[s][dh] = vtr(vp + dh * 4096 + s * 1024); vhi[s][dh] = vtr(vp + dh * 4096 + s * 1024 + 512); }
    __builtin_amdgcn_sched_barrier(0);
    float ls = 0.f;
#pragma unroll
    for (int hf = 0; hf < NH; ++hf)
#pragma unroll
        for (int r = 0; r < 16; ++r) { c[hf][r] = __builtin_amdgcn_exp2f(c[hf][r]); ls += c[hf][r]; }
    l += ls;
#pragma unroll
    for (int s = 0; s < NS; ++s) {
        const f32x16& cc = c[s >> 1]; const int rb = (s & 1) * 8;
        u32x4 pw; pw.x = pg8::cvt_pk_bf16(cc[rb + 0], cc[rb + 1]); pw.y = pg8::cvt_pk_bf16(cc[rb + 2], cc[rb + 3]); pw.z = pg8::cvt_pk_bf16(cc[rb + 4], cc[rb + 5]); pw.w = pg8::cvt_pk_bf16(cc[rb + 6], cc[rb + 7]);
        const bf16x8 pa = __builtin_bit_cast(bf16x8, pw);
#pragma unroll
        for (int dh = 0; dh < 2; ++dh) { const s16x4 lo = vlo[s][dh], hi4 = vhi[s][dh];
            const bf16x8 vf = (bf16x8){lo[0], lo[1], lo[2], lo[3], hi4[0], hi4[1], hi4[2], hi4[3]};
            o[dh] = ATT_MFMA(pa, vf, o[dh]); }
    }
}
template <class TokFn>
__device__ __forceinline__ void finish_qb(const Frame& F, f32x16 (&o)[2], float l, LAS float* wsf, LAS bf16_t* stg, int lane, int r32, int hi, int ocol, int hidx, const TokFn& tokq) {
    l = swapsum(l);
    asm volatile("s_waitcnt lgkmcnt(0)" ::: "memory");
    if (hi == 0) wsf[32 + r32] = l;
    asm volatile("s_waitcnt lgkmcnt(0)" ::: "memory");
#pragma unroll
    for (int r = 0; r < 16; ++r) { const int orow = crow(r, hi); const float rl = __builtin_amdgcn_rcpf(wsf[32 + orow]);
        stg[orow * 64 + r32] = f2bf(o[0][r] * rl); stg[orow * 64 + 32 + r32] = f2bf(o[1][r] * rl); }
    asm volatile("s_waitcnt lgkmcnt(0)" ::: "memory");
#pragma unroll
    for (int i = 0; i < 4; ++i) { const int row = i * 8 + (lane >> 3), ch = lane & 7; const u32x4 w = *(const LAS u32x4*)(stg + row * 64 + ch * 8); const int tok = tokq(row);
        *(u32x4*)(F.ya() + (size_t)tok * D + ocol + ch * 8) = w;
        float q = 0.f;
#pragma unroll
        for (int j = 0; j < 4; ++j) { const float a = __uint_as_float(w[j] << 16), b = __uint_as_float(w[j] & 0xffff0000u); q += a * a + b * b; }
        q += __shfl_xor(q, 1); q += __shfl_xor(q, 2); q += __shfl_xor(q, 4);
        if (ch == 0) F.ssq()[tok * 32 + hidx] = q; }
    asm volatile("s_waitcnt lgkmcnt(0)" ::: "memory");
}

template <int MODE>
__device__ __forceinline__ void attn_unit(const Frame& F, int L) {
    LAS unsigned char* lds = F.lds;
    const int lane = F.lane, wid = F.wave, r32 = lane & 31, hi = lane >> 5;
    LAS float* wsf = (LAS float*)(lds + OFF_WS + wid * 256); LAS bf16_t* stg = (LAS bf16_t*)(lds + OFF_OST + wid * 4096);
    int b, kcol, vcol, qcol, ocol, hidx, nband, trow0, qtok0;
    int hb = 0, qbw = 0, kt0 = 0;
    int R0 = 0, pr = 0, jc = 0, cb = 0, kr0 = 0;
    if (MODE == 0) { const int kvh = L & 3; hb = (L >> 2) & 127; b = L >> 9; const int hq = 4 * kvh + (wid >> 1); qbw = wid & 1;
        qcol = COL_QA + hq * 64; kcol = COL_KA + kvh * 64; vcol = COL_VA + kvh * 64; ocol = hq * 64; hidx = hq;
        kt0 = max(0, hb - 2); const int kt1 = min(127, hb + 2); nband = kt1 - kt0 + 1; trow0 = b * SEQ + 64 * kt0; qtok0 = b * SEQ + 64 * hb + 32 * qbw;
    } else { const int h = L & 15, rb = (L >> 4) & 31; b = L >> 9; R0 = rb * 4; pr = wid >> 2; jc = wid & 3; cb = min(max(16 * jc - 8, 0), 32);
        qcol = COL_QB + h * 64; kcol = COL_KB + h * 64; vcol = COL_VB + h * 64; ocol = 1024 + h * 64; hidx = 16 + h;
        kr0 = min(max(R0 - 4, 0), 120); const int kr1 = min(max(R0 + 3 - 4, 0), 120) + 7; nband = kr1 - kr0 + 1; trow0 = b * SEQ + kr0 * 64; qtok0 = b * SEQ + (R0 + 2 * pr) * 64 + 16 * jc; }
    const int NT = 1 + nband;
    const bf16_t* ksrc = F.u() + (size_t)lane * INW + kcol + wid * 8;
    const bf16_t* vsrc = F.u() + (size_t)(16 * (wid & 3) + (lane >> 2)) * INW + vcol + (wid >> 2) * 32 + (lane & 3) * 8;
#define ATT_TROW(t) ((t) == 0 ? NTOK : trow0 + ((t) - 1) * 64)
#define ATT_ISSUE(t) do { const size_t ro_ = (size_t)ATT_TROW(t) * INW; const int sl_ = ((t) % NSLOT) * SLOT; \
        __builtin_amdgcn_global_load_lds((const unsigned*)(ksrc + ro_), (LAS unsigned*)(lds + sl_ + wid * 1024), 16, 0, 0); \
        __builtin_amdgcn_global_load_lds((const unsigned*)(vsrc + ro_), (LAS unsigned*)(lds + sl_ + 8192 + wid * 1024), 16, 0, 0); } while (0)
    bf16x8 qr[4];
    { const int tok = MODE == 0 ? qtok0 + r32 : qtok0 + (r32 >> 4) * 64 + (r32 & 15);
#pragma unroll
      for (int d0 = 0; d0 < 4; ++d0) qr[d0] = *(const bf16x8*)(F.u() + (size_t)tok * INW + qcol + d0 * 16 + hi * 8); }
    if (MODE == 0) { LAS float* tA = (LAS float*)(lds + OFF_TABA); const int h0 = 4 * (L & 3);
        for (int i = F.tid; i < 4 * TA_W; i += 512) { const int g = i / TA_W, rel = i % TA_W - TA_OFF; tA[i] = (rel >= -128 && rel <= 128) ? F.tab()[(h0 + g) * 272 + rel + 128] : NEGB; } }
    else { LAS float* tB = (LAS float*)(lds + OFF_TABB); const int h = L & 15;
        for (int i = F.tid; i < 576; i += 512) { const int k = i - 16; tB[i] = (k >= 0 && k < 465) ? F.rpb[h * 465 + k] * LOG2E : ((k >= 465 && k < 496) ? NEGB : 0.f); } }
#pragma unroll
    for (int t = 0; t < 5; ++t) if (t < NT) ATT_ISSUE(t);
    f32x16 o[2]; o[0] = f32x16{}; o[1] = f32x16{}; float m = 0.f, l = 0.f;
    bf16x8 mq = frag_k0(0u, hi); const bf16x8 ones = frag_k0(0x3F80u, hi);
    const LAS float* tabA = (const LAS float*)(lds + OFF_TABA) + (MODE == 0 ? (wid >> 1) : 0) * TA_W;
    const LAS float* tabB = (const LAS float*)(lds + OFF_TABB);
    const int qpos = 64 * hb + 32 * qbw + r32;
    const int qrow = R0 + 2 * pr + (r32 >> 4), qc = 16 * jc + (r32 & 15), rs = min(max(qrow - 4, 0), 120), cs = min(max(qc - 8, 0), 48);
    const int rsw0 = min(max(R0 + 2 * pr - 4, 0), 120), rsw1 = min(max(R0 + 2 * pr + 1 - 4, 0), 120);
    float cm[16];
#pragma unroll
    for (int r = 0; r < 16; ++r) { const int kc = cb + 4 * hi + (r & 3) + 8 * (r >> 2); cm[r] = (MODE == 1 && !(kc >= cs && kc < cs + 16)) ? NEGB : 0.f; }
    const int dc0 = cb + 4 * hi - qc + 15 + 16;
    for (int t = 0; t < NT; ++t) {
        { const int ahead = NT - 1 - t;
          if (ahead >= 4) asm volatile("s_waitcnt vmcnt(8)" ::: "memory"); else if (ahead == 3) asm volatile("s_waitcnt vmcnt(6)" ::: "memory");
          else if (ahead == 2) asm volatile("s_waitcnt vmcnt(4)" ::: "memory"); else if (ahead == 1) asm volatile("s_waitcnt vmcnt(2)" ::: "memory"); else asm volatile("s_waitcnt vmcnt(0)" ::: "memory"); }
        asm volatile("s_waitcnt lgkmcnt(0)" ::: "memory");
        __builtin_amdgcn_s_barrier();
        if (t + 5 < NT) ATT_ISSUE(t + 5);
        const int slot = (t % NSLOT) * SLOT;
        if (MODE == 1 && t > 0) { const int kr = kr0 + t - 1; if (kr < rsw0 || kr > rsw1 + 7) continue; }
        const int cbt = (MODE == 1 && t > 0) ? cb : 0;
        const lds_cptr kp = (lds_cptr)lds + slot + hi * 1024 + (r32 + cbt) * 16;
        const lds_cptr vp = (lds_cptr)lds + slot + 8192 + ((lane >> 4) & 1) * 32 + (lane & 3) * 8 + (4 * hi + ((lane & 15) >> 2) + cbt) * 64;
        bf16x8 kf[8];
        if (MODE == 0 && t > 0) {
#pragma unroll
            for (int d0 = 0; d0 < 4; ++d0) { kf[2 * d0] = *(const LAS bf16x8*)(kp + d0 * 2048); kf[2 * d0 + 1] = *(const LAS bf16x8*)(kp + d0 * 2048 + 512); }
        } else {
#pragma unroll
            for (int d0 = 0; d0 < 4; ++d0) { kf[2 * d0] = *(const LAS bf16x8*)(kp + d0 * 2048); kf[2 * d0 + 1] = kf[2 * d0]; }
        }
        if (t == 0) {
            if (MODE == 0) tile_qb<1, 1>(kf, qr, mq, ones, vp, o, m, l, wsf, r32, hi, [&](int, int r) { return r < 8 ? tabA[max(crow(r, hi) - 16 - qpos, -128) + TA_OFF] : NEGB; });
            else tile_qb<1, 1>(kf, qr, mq, ones, vp, o, m, l, wsf, r32, hi, [&](int, int r) { return r < 8 ? 0.f : NEGB; });
        } else if (MODE == 0) { const volatile LAS float* bp = tabA + 64 * (kt0 + t - 1) + 4 * hi - qpos + TA_OFF;
            tile_qb<2, 4>(kf, qr, mq, ones, vp, o, m, l, wsf, r32, hi, [&](int hf, int r) { return bp[32 * hf + (r & 3) + 8 * (r >> 2)]; });
        } else { const int kr = kr0 + t - 1; const bool rowok = kr >= rs && kr <= rs + 7; const volatile LAS float* bp = tabB + (rowok ? kr - qrow + 7 : 15) * 31 + dc0;
            tile_qb<1, 2>(kf, qr, mq, ones, vp, o, m, l, wsf, r32, hi, [&](int, int r) { return bp[(r & 3) + 8 * (r >> 2)] + cm[r]; });
        }
    }
    if (MODE == 0) { if (hi == 0) l += __builtin_amdgcn_exp2f(F.sink[hidx] * LOG2E - m); }
    if (MODE == 0) finish_qb(F, o, l, wsf, stg, lane, r32, hi, ocol, hidx, [&](int q) { return qtok0 + q; });
    else finish_qb(F, o, l, wsf, stg, lane, r32, hi, ocol, hidx, [&](int q) { return qtok0 + (q >> 4) * 64 + (q & 15); });
    __builtin_amdgcn_s_barrier();
#undef ATT_TROW
#undef ATT_ISSUE
}
__device__ __forceinline__ void attn_phase(const Frame& F, int mask = 3) {
    __syncthreads();
    int L = F.bx, un = 0; const int slot = (mask & 8) ? (F.bx & 7) : 0;
    for (; L < 2048 && un < slot; L += F.G, ++un) { if (L < 1024) { if (mask & 1) attn_unit<0>(F, L); } else if (mask & 2) attn_unit<1>(F, L - 1024); }
    if (mask & 8) { __syncthreads(); const int n = (IT_P6 - IT_MID + F.G - 1) / F.G, a = IT_MID + F.bx * n, e = a + n < IT_P6 ? a + n : IT_P6; if (a < e) conv_range(F, a, e); __syncthreads(); }
    for (; L < 2048; L += F.G) { if (L < 1024) { if (mask & 1) attn_unit<0>(F, L); } else if (mask & 2) attn_unit<1>(F, L - 1024); }
    __syncthreads();
}
}

#ifndef FAST_P5
#define FAST_P5 1
#endif
__device__ __forceinline__ void route_token(const Frame& F, int tok, float lg, int lane) {
    const float score = 1.0f / (1.0f + expf(-lg)), v0 = score + F.rbias[lane];
    int rk = 0;
#pragma unroll
    for (int j = 0; j < 8; ++j) { const int o = (lane & ~7) + j; const float w = __shfl(v0, o); rk += (w > v0 || (w == v0 && o < lane)) ? 1 : 0; }
    float gs = rk < 2 ? v0 : 0.f; gs += __shfl_xor(gs, 1); gs += __shfl_xor(gs, 2); gs += __shfl_xor(gs, 4);
    int grk = 0; const int myg = lane >> 3;
#pragma unroll
    for (int g = 0; g < 8; ++g) { const float w = __shfl(gs, g * 8); grk += (w > gs || (w == gs && g < myg)) ? 1 : 0; }
    const float mv = grk < 4 ? v0 : -INFINITY;
    int erk = 0;
    for (int o = 0; o < 64; ++o) { const float w = __shfl(mv, o); erk += (w > mv || (w == mv && o < lane)) ? 1 : 0; }
    const bool sel = erk < 8;
    const float wsm = wsum(sel ? score : 0.f), wgt = score / (wsm + 1e-20f) * 2.5f;
    if (sel) { const int rr = atomicAdd(F.cnt() + lane, 1); F.tokl()[(size_t)lane * NTOK + rr] = tok; F.wl()[(size_t)lane * NTOK + rr] = wgt; F.tke()[tok * 8 + erk] = lane; F.tkr()[tok * 8 + erk] = rr; }
}
__device__ __forceinline__ void route_token_local(const Frame& F, int tl  , float lg, int lane, LAS int* lcnt, LAS int* sel_e, LAS int* sel_lr, LAS float* sel_w) {
    lg = (lg == lg) ? lg : 0.f;
    const float score = 1.0f / (1.0f + expf(-lg)), v0 = score + F.rbias[lane];
    int rk = 0;
#pragma unroll
    for (int j = 0; j < 8; ++j) { const int o = (lane & ~7) + j; const float w = __shfl(v0, o); rk += (w > v0 || (w == v0 && o < lane)) ? 1 : 0; }
    float gs = rk < 2 ? v0 : 0.f; gs += __shfl_xor(gs, 1); gs += __shfl_xor(gs, 2); gs += __shfl_xor(gs, 4);
    int grk = 0; const int myg = lane >> 3;
#pragma unroll
    for (int g = 0; g < 8; ++g) { const float w = __shfl(gs, g * 8); grk += (w > gs || (w == gs && g < myg)) ? 1 : 0; }
    const float mv = grk < 4 ? v0 : -INFINITY;
    int erk = 0;
#pragma unroll 16
    for (int o = 0; o < 64; ++o) { const float w = __shfl(mv, o); erk += (w > mv || (w == mv && o < lane)) ? 1 : 0; }
    const bool sel = erk < 8;
    const float wsm = wsum(sel ? score : 0.f), wgt = score / (wsm + 1e-20f) * 2.5f;
    if (sel) { const int lr = __hip_atomic_fetch_add(lcnt + lane, 1, __ATOMIC_RELAXED, __HIP_MEMORY_SCOPE_WORKGROUP); sel_e[tl * 8 + erk] = lane; sel_lr[tl * 8 + erk] = lr; sel_w[tl * 8 + erk] = wgt; }
}
__device__ __forceinline__ void phase_ln1_router_fast(Frame& F) {
    constexpr int HSTR = 4112;
    LAS unsigned char* hb = F.lds; LAS float* part = (LAS float*)F.lds;
    LAS int* lcnt = (LAS int*)(F.lds + 132096); LAS int* lbase = lcnt + 64; LAS int* sel_e = lcnt + 128; LAS int* sel_lr = sel_e + 512; LAS float* sel_w = (LAS float*)(sel_lr + 512);
    const int lane = F.lane, w = F.wave, r32 = lane & 31, hi = lane >> 5;
    for (int it2 = F.bx; it2 < NTOK / 64; it2 += F.G) {
        if (F.tid < 64) lcnt[F.tid] = 0;
        for (int sub = 0; sub < 2; ++sub) {
            const int t0 = it2 * 64 + sub * 32;
            u32x4 raw[4][4];
#pragma unroll
            for (int q = 0; q < 4; ++q) { const bf16_t* src = F.z() + (size_t)(t0 + 4 * w + q) * D;
#pragma unroll
                for (int j = 0; j < 4; ++j) raw[q][j] = *(const u32x4*)(src + (lane + 64 * j) * 8); }
#pragma unroll
            for (int q = 0; q < 4; ++q) { const int row = 4 * w + q, tok = t0 + row; float v[4][8]; float s = 0.f;
#pragma unroll
                for (int j = 0; j < 4; ++j)
#pragma unroll
                    for (int i = 0; i < 4; ++i) { v[j][2 * i] = __uint_as_float(raw[q][j][i] << 16); v[j][2 * i + 1] = __uint_as_float(raw[q][j][i] & 0xffff0000u); s += v[j][2 * i] + v[j][2 * i + 1]; }
                const float mu = wsum(s) * (1.0f / D); float qq = 0.f;
#pragma unroll
                for (int j = 0; j < 4; ++j)
#pragma unroll
                    for (int i = 0; i < 8; ++i) { const float d = v[j][i] - mu; qq += d * d; }
                const float rstd = 1.0f / sqrtf(wsum(qq) * (1.0f / D) + LN_EPS);
#pragma unroll
                for (int j = 0; j < 4; ++j) { const int c = (lane + 64 * j) * 8; const f32x4 g0 = *(const f32x4*)(F.l1g + c), g1 = *(const f32x4*)(F.l1g + c + 4), b0 = *(const f32x4*)(F.l1b + c), b1 = *(const f32x4*)(F.l1b + c + 4);
                    u32x4 pk; float y[8];
#pragma unroll
                    for (int i = 0; i < 4; ++i) { y[i] = (v[j][i] - mu) * rstd * g0[i] + b0[i]; y[4 + i] = (v[j][4 + i] - mu) * rstd * g1[i] + b1[i]; }
                    pk.x = pack2(y[0], y[1]); pk.y = pack2(y[2], y[3]); pk.z = pack2(y[4], y[5]); pk.w = pack2(y[6], y[7]);
                    *(u32x4*)(F.h1() + (size_t)tok * D + c) = pk; *(LAS u32x4*)(hb + row * HSTR + c * 2) = pk;
                    *(u32x2*)(F.h1q() + (size_t)tok * D + c) = (u32x2){e4m3x4(y[0] * S8_H1, y[1] * S8_H1, y[2] * S8_H1, y[3] * S8_H1), e4m3x4(y[4] * S8_H1, y[5] * S8_H1, y[6] * S8_H1, y[7] * S8_H1)}; }
                if (lane == 0) { F.stats1()[tok * 2] = mu; F.stats1()[tok * 2 + 1] = rstd; } }
            __syncthreads();
            att::f32x16 acc[2]; acc[0] = att::f32x16{}; acc[1] = att::f32x16{};
            const bf16_t* wb = F.wrt() + (size_t)r32 * D + 256 * w + hi * 8;
#pragma unroll 8
            for (int s = 0; s < 16; ++s) {
                const att::bf16x8 a = *(const LAS att::bf16x8*)(hb + r32 * HSTR + (256 * w + 16 * s + 8 * hi) * 2);
                const att::bf16x8 b0 = *(const att::bf16x8*)(wb + 16 * s), b1 = *(const att::bf16x8*)(wb + (size_t)32 * D + 16 * s);
                acc[0] = __builtin_amdgcn_mfma_f32_32x32x16_bf16(a, b0, acc[0], 0, 0, 0); acc[1] = __builtin_amdgcn_mfma_f32_32x32x16_bf16(a, b1, acc[1], 0, 0, 0); }
            __syncthreads();
#pragma unroll
            for (int nt = 0; nt < 2; ++nt)
#pragma unroll
                for (int r = 0; r < 16; ++r) part[(w * 32 + att::crow(r, hi)) * 64 + 32 * nt + r32] = acc[nt][r];
            __syncthreads();
            for (int q = 0; q < 4; ++q) { const int row = 4 * w + q; float lg = 0.f;
#pragma unroll
                for (int ww = 0; ww < 8; ++ww) lg += part[(ww * 32 + row) * 64 + lane];
                route_token_local(F, sub * 32 + row, lg, lane, lcnt, sel_e, sel_lr, sel_w); }
            __syncthreads();
        }
        if (F.tid < 64) { const int n = lcnt[F.tid]; lbase[F.tid] = n > 0 ? atomicAdd(F.cnt() + F.tid, n) : 0; }
        __syncthreads();
        { const int tl = F.tid >> 3, slot = F.tid & 7, e = sel_e[F.tid], rr = lbase[e] + sel_lr[F.tid], tok = it2 * 64 + tl;
          F.tokl()[(size_t)e * NTOK + rr] = tok; F.wl()[(size_t)e * NTOK + rr] = sel_w[F.tid]; F.tke()[tok * 8 + slot] = e; F.tkr()[tok * 8 + slot] = rr; }
        __syncthreads();
    }
}

__global__ void __launch_bounds__(512, 2) mk_fwd(Args args) {
    extern __shared__ __attribute__((aligned(16))) unsigned char lds_raw[];
    Frame F; F.lds = (LAS unsigned char*)lds_raw; F.wave0 = __builtin_amdgcn_readfirstlane((int)threadIdx.x >> 6); F.fresh(); F.G = gridDim.x; F.bx = blockIdx.x;
    F.x = args.in[0]; F.meta = args.in[1]; F.lng = args.in[2]; F.lnb = args.in[3]; F.t5 = args.in[4]; F.w_in = args.in[5]; F.sink = args.in[6]; F.rpb = args.in[7]; F.ga = args.in[8]; F.gb = args.in[9];
    F.w_out = args.in[10]; F.l1g = args.in[11]; F.l1b = args.in[12]; F.w_router = args.in[13]; F.rbias = args.in[14]; F.w_gate = args.in[15]; F.w_up = args.in[16]; F.w_down = args.in[17];
    F.ws_gate = args.in[18]; F.ws_up = args.in[19]; F.ws_down = args.in[20]; F.l2g = args.in[21]; F.l2b = args.in[22]; F.out = args.out; F.ws = args.ws;
    unsigned char* ws = args.ws;
    volatile LAS unsigned* xbw = (volatile LAS unsigned*)(F.lds + LDS_BYTES - 16);
    LAS int* ps = (LAS int*)(F.lds + 131072);
    if (F.tid < 4) xbw[F.tid] = 0u;
    __syncthreads();
    const int lo = args.ph_lo, hi = args.ph_hi;
    XcdBarrier bar; bar.bar = (unsigned*)(ws + WS_CTL); bar.x = 0; bar.st = xbw; bar.wave0 = F.wave0;
    if (hi - lo > 1) bar = xcd_barrier_post((unsigned*)(ws + WS_CTL), xbw, F.wave0);
    unsigned* xcen = (unsigned*)(ws + WS_CTL + 20480);
    if (XCD_TRUE && hi - lo > 1 && F.tid == 0) { const unsigned x = xb_xcc_id(); xbw[2] = x; xbw[3] = xb_add(&xcen[x * 16], 1u); }
#ifndef PROBE_REPEAT
#define PROBE_REPEAT -1
#endif
#ifndef PROBE_SUB
#define PROBE_SUB 3
#endif
#ifndef PROBE_NOSTORE
#define PROBE_NOSTORE 0
#endif
#ifndef PROBE_HOT
#define PROBE_HOT 0
#endif
#ifndef PROBE_NT
#define PROBE_NT 32
#ifndef PROBE_LD
#define PROBE_LD 2048
#endif
#endif
#define IN(k) (lo <= (k) && (k) < hi)
#define SEAM(k) do { if (IN(k) && IN((k) + 1)) xcd_barrier(bar); } while (0)
    if (IN(0)) { F.fresh(); phase_prologue(F);
#if PROBE_REPEAT == 0
        xcd_barrier(bar); phase_prologue(F);
#endif
    } SEAM(0);
#define P1_BODY(rep) do { const int s_ = (rep) ? 0 : F.bx % 5; EpiU E{F.u(), rep}; { SchedInProj S{(const char*)F.h0(), (const char*)F.wtin(), F.G, F.bx, 0, s_}; pg8::gemm_phase(F.wave0, F.lds, S, E, D, D, D / 64); } if (!(rep)) { conv_inproj_share(F); __syncthreads(); } { SchedInProj S{(const char*)F.h0(), (const char*)F.wtin(), F.G, F.bx, s_, 1 << 20}; pg8::gemm_phase(F.wave0, F.lds, S, E, D, D, D / 64); } } while (0)
#define P4_BODY(rep) do { SchedOutProj S{(const char*)F.ya(), (const char*)F.wtout(), F.G, F.bx}; EpiZ E{F.z(), F.h0(), F.ssq(), (LAS float*)(F.lds + 131072 + 6144)}; pg8::gemm_phase(F.wave0, F.lds, S, E, D, D, D / 64, STAGGER4); } while (0)
#define P6_BODY(rep) do { moe_tables(F, ps); SchedGU S{(const char*)F.h1q(), (const char*)F.wtgu(), F.tokl(), F.cnt(), ps, F.G, F.bx, __builtin_amdgcn_readfirstlane(ps[128 + 65])}; EpiGU E{(unsigned char*)F.hb(), F.wl()}; pg8::gemm_phase(F.wave0, F.lds, S, E, D / 2, D / 2, D / 128); if (!(rep)) { F.fresh(); conv_tail(F, IT_P6, IT_ALL, (ps[128 + 65] * 4) % F.G); } } while (0)
#define P7_BODY(rep) do { moe_tables(F, ps); SchedDown S{(const char*)F.hb(), (const char*)F.wtd(), F.cnt(), ps, F.G, F.bx, __builtin_amdgcn_readfirstlane(ps[128 + 64])}; EpiDownR E{(unsigned char*)F.ym(), rep}; pg8::gemm_phase(F.wave0, F.lds, S, E, DE / 2, DE / 2, DE / 128, STAGGER7); SchedDownShared S2{(const char*)F.hb(), (const char*)F.wtd(), F.G, F.bx}; EpiDownS E2{F.o2(), F.h1()}; pg8::gemm_phase(F.wave0, F.lds, S2, E2, DE / 2, DE / 2, DE / 128); } while (0)
    if (XCD_TRUE && hi - lo > 1 && IN(0)) {
        if (F.tid == 0) { unsigned idx = 0, ok = 1, npop = 0; const unsigned x = xbw[2];
            for (unsigned j = 0; j < 16; ++j) { const unsigned cj = xb_ld(&xcen[j * 16]); if (cj) { ++npop; if (cj * 8u != (unsigned)F.G) ok = 0; if (j < x) ++idx; } }
            xbw[2] = (ok && npop == 8) ? xbw[3] * 8u + idx : (unsigned)blockIdx.x; }
        __syncthreads();
        F.bx = __builtin_amdgcn_readfirstlane((int)xbw[2]);
    }
    if (IN(1)) { F.fresh();
#if FAST_P1
        P1_BODY(0);
#if PROBE_REPEAT == 1
        xcd_barrier(bar); P1_BODY(PROBE_NOSTORE);
#endif
#else
        FnInProj f{F}; sgemm(f, F.lds, F.tid, F.bx, F.G);
#endif
#if PROBE_REPEAT == 9
        xcd_barrier(bar); if (F.bx % 8 == 0) { conv_range(F, IT_P0 + T_OUT, IT_P0 + T_OUT + 512); __syncthreads(); }
#endif
    } SEAM(1);
    if (IN(2)) { F.fresh();
#if FAST_P2
        att::attn_phase(F, 3 | 8);
#if PROBE_REPEAT == 2
        xcd_barrier(bar); att::attn_phase(F, PROBE_SUB);
#endif
#else
        phase_attn_simple(F);
#endif
    } SEAM(2);
#if !FAST_P4
    if (IN(3)) { phase_rmsnorm(F); } SEAM(3);
#endif
    if (IN(4)) { F.fresh();
#if FAST_P4
        P4_BODY(0);
#if PROBE_REPEAT == 4
        xcd_barrier(bar); P4_BODY(1);
#endif
#else
        FnOutProj f{F}; sgemm(f, F.lds, F.tid, F.bx, F.G);
#endif
    } SEAM(4);
#if FAST_P5
#define PH5(F) phase_ln1_router_fast(F)
#else
#define PH5(F) phase_ln1_router(F)
#endif
    if (IN(5)) { F.fresh(); PH5(F);
#if PROBE_REPEAT == 5
        xcd_barrier(bar); if (F.bx == 0 && F.tid < 64) F.cnt()[F.tid] = 0; xcd_barrier(bar); PH5(F);
#endif
    } SEAM(5);
    if (IN(6)) { F.fresh();
#if FAST_P6
        P6_BODY(0);
#if PROBE_REPEAT == 6
        xcd_barrier(bar); P6_BODY(1);
#endif
#else
        expert_starts(F, ps); FnGateUp f{F, ps}; sgemm(f, F.lds, F.tid, F.bx, F.G);
#endif
    } SEAM(6);
    if (IN(7)) { F.fresh();
#if FAST_P7
        P7_BODY(0);
#if PROBE_REPEAT == 7
        xcd_barrier(bar); P7_BODY(PROBE_NOSTORE);
#endif
#else
        expert_starts(F, ps); { FnDown f{F, ps}; sgemm(f, F.lds, F.tid, F.bx, F.G); } { FnFinal f{F, ps}; sgemm(f, F.lds, F.tid, F.bx, F.G); }
#endif
    } SEAM(7);
    if (IN(8)) { F.fresh(); expert_starts(F, ps); phase_ln2(F, ps);
#if PROBE_REPEAT == 8
        xcd_barrier(bar); phase_ln2(F, ps);
#endif
    }
#undef IN
#undef SEAM
}

extern "C" void kernel_launch(void* const* d_in, const int* in_sizes, int n_in, void* d_out, int out_size, void* d_ws, size_t ws_size, hipStream_t stream) {
    static int grid = 0;
    if (grid == 0) {
        if (n_in != 23 || in_sizes[0] != NTOK * D || out_size != NTOK * D || ws_size < WS_END) {
            fprintf(stderr, "kernel_launch: built for 23 inputs, x/out of %d floats, >= %zu bytes of workspace; got n_in %d in0 %d out %d ws %zu; nothing launched\n", NTOK * D, (size_t)WS_END, n_in, n_in > 0 ? in_sizes[0] : -1, out_size, ws_size);
            grid = -1; return; }
        int dev = 0, cus = 0, per_cu = 0;
        if (hipGetDevice(&dev) != hipSuccess || hipDeviceGetAttribute(&cus, hipDeviceAttributeMultiprocessorCount, dev) != hipSuccess) { fprintf(stderr, "kernel_launch: device query failed\n"); grid = -1; return; }
        if (hipFuncSetAttribute((const void*)mk_fwd, hipFuncAttributeMaxDynamicSharedMemorySize, LDS_BYTES) != hipSuccess) { fprintf(stderr, "kernel_launch: hipFuncSetAttribute failed\n"); grid = -1; return; }
        if (hipOccupancyMaxActiveBlocksPerMultiprocessor(&per_cu, (const void*)mk_fwd, 512, LDS_BYTES) != hipSuccess || per_cu < 1) fprintf(stderr, "kernel_launch: note: occupancy query reports %d\n", per_cu);
        (void)hipGetLastError();
        grid = cus;
    }
    if (grid < 0) return;
    if (hipMemsetAsync((char*)d_ws + WS_CTL, 0, CTL_BYTES, stream) != hipSuccess) { fprintf(stderr, "kernel_launch: memset failed\n"); return; }
    Args a{};
    for (int i = 0; i < 23; ++i) a.in[i] = (const float*)d_in[i];
    a.out = (float*)d_out; a.ws = (unsigned char*)d_ws;
#if MK_ONE_LAUNCH
    a.ph_lo = 0; a.ph_hi = NPHASE;
    hipLaunchKernelGGL(mk_fwd, dim3(grid), dim3(512), LDS_BYTES, stream, a);
#else
    for (int p = 0; p < NPHASE; ++p) { a.ph_lo = p; a.ph_hi = p + 1; hipLaunchKernelGGL(mk_fwd, dim3(grid), dim3(512), LDS_BYTES, stream, a); }
#endif
    const hipError_t le = hipPeekAtLastError();
    if (le != hipSuccess) fprintf(stderr, "kernel_launch: launch failed: %s\n", hipGetErrorName(le));
}
```

```cpp
#include <hip/hip_runtime.h>
#include <cstdio>
#include <cstdint>

#define LAS __attribute__((address_space(3)))
typedef unsigned short bf16_t;
typedef float f32x4 __attribute__((ext_vector_type(4)));
typedef unsigned u32x4 __attribute__((ext_vector_type(4)));
typedef unsigned u32x2 __attribute__((ext_vector_type(2)));

#ifndef CONV_P2
#define CONV_P2 28160
#endif
#ifndef CONV_NT
#define CONV_NT 1
#endif
#ifndef MK_ONE_LAUNCH
#define MK_ONE_LAUNCH 1
#endif

constexpr int D = 2048, SEQ = 8192, NB = 2, NTOK = NB * SEQ;
constexpr int NMETA = 16, INW = 4608, MROWS = NTOK + 256;
constexpr int NE = 64, DE = 512, PMAX = 147456, HBROWS = PMAX + NTOK;
constexpr float ALPHA = 1.189207115002721f;
constexpr float LN_EPS = 1e-5f, RMS_EPS = 1e-6f, LOG2E = 1.4426950408889634f, QSCALE = 0.125f * LOG2E;
constexpr int COL_QA = 0, COL_KA = 1024, COL_VA = 1280, COL_QB = 1536, COL_KB = 2560, COL_VB = 3584;
constexpr int NPHASE = 9;
constexpr int LDS_BYTES = 147456;

constexpr size_t WS_CTL = 0, CTL_BYTES = 32768;
constexpr size_t WS_CNT = 16384;
constexpr size_t WS_STATS0 = WS_CTL + CTL_BYTES;
constexpr size_t WS_STATS1 = WS_STATS0 + (size_t)NTOK * 8;
constexpr size_t WS_SSQ = WS_STATS1 + (size_t)NTOK * 8;
constexpr size_t WS_TOKL = WS_SSQ + (size_t)NTOK * 32 * 4;
constexpr size_t WS_WL = WS_TOKL + (size_t)NE * NTOK * 4;
constexpr size_t WS_TKE = WS_WL + (size_t)NE * NTOK * 4;
constexpr size_t WS_TKR = WS_TKE + (size_t)NTOK * 8 * 4;
constexpr size_t WS_TAB = WS_TKR + (size_t)NTOK * 8 * 4;
constexpr size_t WS_WRT = WS_TAB + 32768;
constexpr size_t WS_Z = WS_WRT + (size_t)NE * D * 2;
constexpr size_t WS_O2 = WS_Z + (size_t)NTOK * D * 2;
constexpr size_t WS_WTD = WS_Z + (size_t)NTOK * D * 4;
constexpr size_t WS_HB = WS_WTD + (size_t)65 * 2048 * 512 * 2;
constexpr size_t WS_B = WS_HB + (size_t)HBROWS * 512 * 2;
constexpr size_t WS_WTGU = WS_B;
constexpr size_t WS_WTIN = WS_WTGU + (size_t)65 * 1024 * 2048 * 2;
constexpr size_t WS_WTOUT = WS_WTIN + (size_t)INW * D * 2;
constexpr size_t WS_H0 = WS_WTOUT + (size_t)D * D * 2;
constexpr size_t WS_U = WS_H0 + (size_t)MROWS * D * 2;
constexpr size_t WS_YA = WS_U + (size_t)MROWS * INW * 2;
constexpr size_t WS_H1Q = WS_WTD + (size_t)65 * 2048 * 512;
constexpr size_t WS_H1 = WS_Z;
constexpr size_t WS_YM = WS_B;
constexpr size_t WS_END_A = WS_YA + (size_t)NTOK * D * 2, WS_END_B = WS_YM + (size_t)PMAX * D * 2;
constexpr size_t WS_END = WS_END_A > WS_END_B ? WS_END_A : WS_END_B;
static_assert(WS_END <= ((size_t)1 << 30), "workspace map must fit 1 GiB");

__device__ __forceinline__ float bf2f(bf16_t b) { return __uint_as_float(((unsigned)b) << 16); }
__device__ __forceinline__ bf16_t f2bf(float f) { unsigned u = __float_as_uint(f); u += 0x7FFFu + ((u >> 16) & 1u); return (bf16_t)(u >> 16); }
__device__ __forceinline__ unsigned pack2(float lo, float hi) { return (unsigned)f2bf(lo) | ((unsigned)f2bf(hi) << 16); }
constexpr int ENC8_EXP = 12 << 23;
__device__ __forceinline__ unsigned enc8(float x) {
    const unsigned u = __float_as_uint(x); int t = (int)(u & 0x7fffffffu) - 0x00F80000 - ENC8_EXP;
    t = t < 0x38000000 ? 0x38000000 : (t > 0x3FF00000 ? 0x3FF00000 : t);
    return (((unsigned)t >> 20) & 0x7fu) | ((u >> 24) & 0x80u); }
__device__ __forceinline__ unsigned enc8x4(float a, float b, float c, float d) { return enc8(a) | (enc8(b) << 8) | (enc8(c) << 16) | (enc8(d) << 24); }
__device__ __forceinline__ float dec8(unsigned b) { return __uint_as_float(((b & 0x7fu) << 20) + 0x39000000u + ((b & 0x80u) << 24)); }
typedef unsigned short u16x2 __attribute__((ext_vector_type(2)));
__device__ __forceinline__ unsigned cvt_pk_bf16_g(float lo, float hi) { unsigned r; asm volatile("v_cvt_pk_bf16_f32 %0, %1, %2" : "=v"(r) : "v"(lo), "v"(hi)); return r; }
__device__ __forceinline__ unsigned e4m3x2(float a, float b) {
    const unsigned p = cvt_pk_bf16_g(a, b);
    u16x2 m = __builtin_bit_cast(u16x2, p & 0x7fff7fffu);
    m = (m + (u16x2){8, 8}) >> (u16x2){4, 4};
    m = __builtin_elementwise_sub_sat(m, (u16x2){0x3C0, 0x3C0});
    m = __builtin_elementwise_min(m, (u16x2){0x7E, 0x7E});
    return __builtin_bit_cast(unsigned, m) | ((p >> 8) & 0x00800080u); }
__device__ __forceinline__ unsigned e4m3x4(float a, float b, float c, float d) { return __builtin_amdgcn_perm(e4m3x2(c, d), e4m3x2(a, b), 0x06040200u); }
__device__ __forceinline__ unsigned ym8x2(float a, float b) {
    const unsigned p = cvt_pk_bf16_g(a, b);
    u16x2 m = __builtin_bit_cast(u16x2, p & 0x7fff7fffu);
    m = (m + (u16x2){8, 8}) >> (u16x2){4, 4};
    m = __builtin_elementwise_sub_sat(m, (u16x2){0x3F0, 0x3F0});
    m = __builtin_elementwise_min(m, (u16x2){0x7F, 0x7F});
    return __builtin_bit_cast(unsigned, m) | ((p >> 8) & 0x00800080u); }
__device__ __forceinline__ unsigned ym8x4(float a, float b, float c, float d) { return __builtin_amdgcn_perm(ym8x2(c, d), ym8x2(a, b), 0x06040200u); }
constexpr float S8_H1 = 8.0f, S8_W = 256.0f, S8_HB = 16.0f, S8_GU_INV = 1.0f / (S8_H1 * S8_W), S8_DN_INV = 1.0f / (S8_HB * S8_W);
__device__ __forceinline__ float wsum(float v) {
#pragma unroll
    for (int o = 32; o >= 1; o >>= 1) v += __shfl_xor(v, o);
    return v; }
__device__ __forceinline__ float wmax(float v) {
#pragma unroll
    for (int o = 32; o >= 1; o >>= 1) v = fmaxf(v, __shfl_xor(v, o));
    return v; }
__device__ __forceinline__ int t5_bucket(int rel) {
    const int ret = rel > 0 ? 16 : 0, n = rel < 0 ? -rel : rel;
    if (n < 8) return ret + n;
    const int n2 = n > 32768 ? 0x40000000 : n * n; int lg = 31 - __clz(n2) + 2; if (lg > 15) lg = 15;
    return ret + lg; }

#define XB_TMO      128
#define XB_XCNT(j)  (256  + 64 * (j))
#define XB_XSUB(j)  (1280 + 64 * (j))
#define XB_XGEN(j)  (2304 + 64 * (j))
#define XB_TOP      3328
#define XB_TOPGEN   3392
#define XCD_BAR_WORDS 3456
#define XB_SPIN_CAP (1u << 18)
__device__ __forceinline__ int lane_id() { int l; asm volatile("v_mbcnt_lo_u32_b32 %0, -1, 0\n\tv_mbcnt_hi_u32_b32 %0, -1, %0" : "=v"(l)); return l; }
__device__ __forceinline__ unsigned xb_ld(unsigned* p)              { return __hip_atomic_load(p, __ATOMIC_RELAXED, __HIP_MEMORY_SCOPE_AGENT); }
__device__ __forceinline__ unsigned xb_add(unsigned* p, unsigned v) { return __hip_atomic_fetch_add(p, v, __ATOMIC_RELAXED, __HIP_MEMORY_SCOPE_AGENT); }
__device__ __forceinline__ unsigned xb_xcc_id() { return (unsigned)__builtin_amdgcn_s_getreg((3 << 11) | 20) & 0xFu; }
#define XB_SPIN(cond, bar) do { unsigned _sp = 0; while (cond) { __builtin_amdgcn_s_sleep(1); \
    if ((++_sp & 255u) == 0u) { if (xb_ld(&(bar)[XB_TMO])) break; if (_sp > XB_SPIN_CAP) { atomicAdd(&(bar)[XB_TMO], 1u); break; } } } } while (0)
struct XcdBarrier { unsigned* bar; unsigned x; volatile LAS unsigned* st; int wave0; };
__device__ __forceinline__ XcdBarrier xcd_barrier_post(unsigned* bar, volatile LAS unsigned* st, int wave0) {
    XcdBarrier b; b.bar = bar; b.x = xb_xcc_id(); b.st = st; b.wave0 = wave0;
    if (wave0 == 0 && lane_id() == 0) (void)xb_add(&bar[XB_XCNT(b.x)], 1u);
    return b;
}
__device__ __forceinline__ void xcd_barrier_complete(unsigned* bar, unsigned x, unsigned& nloc, unsigned& nx) {
    const unsigned G = gridDim.x * gridDim.y * gridDim.z;
    unsigned sum, cnt, mine, sp = 0u;
    for (;;) {
        sum = 0u; cnt = 0u; mine = 0u;
#pragma unroll
        for (unsigned j = 0; j < 16; ++j) { const unsigned c = xb_ld(&bar[XB_XCNT(j)]); sum += c; cnt += (c > 0u) ? 1u : 0u; mine = (j == x) ? c : mine; }
        if (sum == G) break;
        __builtin_amdgcn_s_sleep(1);
        if ((++sp & 255u) == 0u) { if (xb_ld(&bar[XB_TMO])) break; if (sp > XB_SPIN_CAP) { atomicAdd(&bar[XB_TMO], 1u); break; } }
    }
    nloc = mine > 0u ? mine : 1u; nx = cnt > 0u ? cnt : 1u;
}
__device__ __forceinline__ void xcd_barrier(const XcdBarrier& b) {
    asm volatile("s_waitcnt vmcnt(0)" ::: "memory");
    __syncthreads();
    if (b.wave0 == 0 && lane_id() == 0) {
        unsigned* bar = b.bar;
        __builtin_amdgcn_s_waitcnt(0);
        unsigned nloc = b.st[0], nx = b.st[1];
        if (nloc == 0u) { xcd_barrier_complete(bar, b.x, nloc, nx); b.st[0] = nloc; b.st[1] = nx; }
        const unsigned old = xb_add(&bar[XB_XSUB(b.x)], 1u);
        const unsigned gen = old / nloc;
        if (old + 1u == (gen + 1u) * nloc) {
            __builtin_amdgcn_fence(__ATOMIC_RELEASE, "agent");
            asm volatile("s_waitcnt vmcnt(0)" ::: "memory");
            const unsigned og = xb_add(&bar[XB_TOP], 1u);
            const unsigned tg = og / nx;
            if (og + 1u == (tg + 1u) * nx) xb_add(&bar[XB_TOPGEN], 1u);
            else XB_SPIN(xb_ld(&bar[XB_TOPGEN]) == tg, bar);
            __builtin_amdgcn_fence(__ATOMIC_ACQUIRE, "agent");
            xb_add(&bar[XB_XGEN(b.x)], 1u);
            asm volatile("s_waitcnt vmcnt(0)" ::: "memory");
        } else {
            XB_SPIN(xb_ld(&bar[XB_XGEN(b.x)]) == gen, bar);
            __builtin_amdgcn_fence(__ATOMIC_ACQUIRE, "agent");
            asm volatile("s_waitcnt vmcnt(0)" ::: "memory");
        }
    }
    __syncthreads();
}

struct Args { const float* in[23]; float* out; unsigned char* ws; int ph_lo, ph_hi; };
struct Frame {
    LAS unsigned char* lds; int tid, lane, wave, G, bx;
    const float *x, *meta, *lng, *lnb, *t5, *w_in, *sink, *rpb, *ga, *gb, *w_out, *l1g, *l1b, *w_router, *rbias, *w_gate, *w_up, *w_down, *ws_gate, *ws_up, *ws_down, *l2g, *l2b;
    float* out; unsigned char* ws;
    int wave0;
    __device__ __forceinline__ void fresh() { int t = wave0 * 64 + lane_id(); asm volatile("" : "+v"(t)); tid = t; lane = t & 63; wave = wave0; }
    __device__ __forceinline__ float* stats0() const { return (float*)(ws + WS_STATS0); }
    __device__ __forceinline__ float* stats1() const { return (float*)(ws + WS_STATS1); }
    __device__ __forceinline__ float* ssq() const { return (float*)(ws + WS_SSQ); }
    __device__ __forceinline__ float* wl() const { return (float*)(ws + WS_WL); }
    __device__ __forceinline__ float* tab() const { return (float*)(ws + WS_TAB); }
    __device__ __forceinline__ int* cnt() const { return (int*)(ws + WS_CNT); }
    __device__ __forceinline__ int* tokl() const { return (int*)(ws + WS_TOKL); }
    __device__ __forceinline__ int* tke() const { return (int*)(ws + WS_TKE); }
    __device__ __forceinline__ int* tkr() const { return (int*)(ws + WS_TKR); }
    __device__ __forceinline__ bf16_t* wtd() const { return (bf16_t*)(ws + WS_WTD); }
    __device__ __forceinline__ bf16_t* hb() const { return (bf16_t*)(ws + WS_HB); }
    __device__ __forceinline__ bf16_t* wtgu() const { return (bf16_t*)(ws + WS_WTGU); }
    __device__ __forceinline__ bf16_t* wtin() const { return (bf16_t*)(ws + WS_WTIN); }
    __device__ __forceinline__ bf16_t* wtout() const { return (bf16_t*)(ws + WS_WTOUT); }
    __device__ __forceinline__ bf16_t* h0() const { return (bf16_t*)(ws + WS_H0); }
    __device__ __forceinline__ bf16_t* u() const { return (bf16_t*)(ws + WS_U); }
    __device__ __forceinline__ bf16_t* ya() const { return (bf16_t*)(ws + WS_YA); }
    __device__ __forceinline__ bf16_t* h1() const { return (bf16_t*)(ws + WS_H1); }
    __device__ __forceinline__ unsigned char* h1q() const { return (unsigned char*)(ws + WS_H1Q); }
    __device__ __forceinline__ bf16_t* ym() const { return (bf16_t*)(ws + WS_YM); }
    __device__ __forceinline__ bf16_t* wrt() const { return (bf16_t*)(ws + WS_WRT); }
    __device__ __forceinline__ bf16_t* z() const { return (bf16_t*)(ws + WS_Z); }
    __device__ __forceinline__ bf16_t* o2() const { return (bf16_t*)(ws + WS_O2); }
};

struct ConvDesc { const float* src; bf16_t* dst; int lds_, ldd_; const float* ksc; float csc; int f8; };
__device__ __forceinline__ void conv_load(const ConvDesc& d, f32x4 (&v)[16], int lane) {
    const int kk = lane & 3, n4 = (lane >> 2) * 4;
#pragma unroll
    for (int p = 0; p < 16; ++p) v[p] = __builtin_nontemporal_load((const f32x4*)(d.src + (size_t)(4 * p + kk) * d.lds_ + n4));
}
__device__ __forceinline__ void conv_finish(const ConvDesc& d, const f32x4 (&v)[16], LAS float* scr, int lane) {
    const int kk = lane & 3, n4 = (lane >> 2) * 4;
#pragma unroll
    for (int p = 0; p < 16; ++p) { const int k = 4 * p + kk; const float s = d.ksc ? d.ksc[k] * d.csc : d.csc;
        scr[k * 65 + n4] = v[p][0] * s; scr[k * 65 + n4 + 1] = v[p][1] * s; scr[k * 65 + n4 + 2] = v[p][2] * s; scr[k * 65 + n4 + 3] = v[p][3] * s; }
    asm volatile("s_waitcnt lgkmcnt(0)" ::: "memory");
    if (d.f8) {
        const int c = lane >> 4;
#pragma unroll
        for (int j = 0; j < 4; ++j) { const int n = (lane & 15) + 16 * j; const LAS float* s = scr + (16 * c) * 65 + n; u32x4 o;
            o.x = e4m3x4(s[0], s[65], s[2 * 65], s[3 * 65]); o.y = e4m3x4(s[4 * 65], s[5 * 65], s[6 * 65], s[7 * 65]);
            o.z = e4m3x4(s[8 * 65], s[9 * 65], s[10 * 65], s[11 * 65]); o.w = e4m3x4(s[12 * 65], s[13 * 65], s[14 * 65], s[15 * 65]);
            __builtin_nontemporal_store(o, (u32x4*)((unsigned char*)d.dst + (size_t)n * d.ldd_ + 16 * c)); }
        asm volatile("s_waitcnt lgkmcnt(0)" ::: "memory");
        return; }
    const int c = lane >> 3;
#pragma unroll
    for (int j = 0; j < 8; ++j) { const int n = (lane & 7) + 8 * j; const LAS float* s = scr + (8 * c) * 65 + n; u32x4 o;
        o.x = pack2(s[0], s[65]); o.y = pack2(s[2 * 65], s[3 * 65]); o.z = pack2(s[4 * 65], s[5 * 65]); o.w = pack2(s[6 * 65], s[7 * 65]);
        __builtin_nontemporal_store(o, (u32x4*)(d.dst + (size_t)n * d.ldd_ + 8 * c)); }
    asm volatile("s_waitcnt lgkmcnt(0)" ::: "memory");
}
constexpr int T_R = 32, T_IN = 72 * 32, T_OUT = 32 * 32, T_GU = 65 * 2 * 8 * 32, T_D = 65 * 32 * 8;
constexpr int IT_P0 = T_R + T_IN, IT_ALL = IT_P0 + T_OUT + T_GU + T_D, IT_P6 = IT_ALL - 6400, IT_MID = IT_P6 - CONV_P2;
__device__ __forceinline__ ConvDesc conv_desc(const Frame& F, int it) {
    int r = it; const float* src; bf16_t* dst; int lds_, ldd_, f8 = 0; const float* ksc = nullptr; float csc = 1.0f;
    if (r < T_R) { src = F.w_router + (size_t)(r * 64) * NE; lds_ = NE; dst = F.wrt() + r * 64; ldd_ = D; }
    else if ((r -= T_R) < T_IN) { const int tn = r % 72, tk = r / 72; const int n0 = tn * 64; const bool isq = (n0 < COL_KA) || (n0 >= COL_QB && n0 < COL_KB);
        src = F.w_in + (size_t)(tk * 64) * INW + n0; lds_ = INW; dst = F.wtin() + (size_t)n0 * D + tk * 64; ldd_ = D; csc = isq ? QSCALE : 1.0f; }
    else if ((r -= T_IN) < T_OUT) { const int tn = r % 32, tk = r / 32; const int k0 = tk * 64;
        src = F.w_out + (size_t)k0 * D + tn * 64; lds_ = D; dst = F.wtout() + (size_t)(tn * 64) * D + k0; ldd_ = D; ksc = k0 < 1024 ? F.ga + k0 : F.gb + (k0 - 1024); }
    else if ((r -= T_OUT) < T_GU) { const int tn = r % 8, tk = (r / 8) % 32, which = (r / 256) % 2, e = r / 512;
        const float* s0 = e < NE ? (which ? F.w_up : F.w_gate) + (size_t)e * D * DE : (which ? F.ws_up : F.ws_gate);
        const int c0 = tn * 64, nprime = 256 * (c0 / 128) + 128 * which + (c0 % 128);
        src = s0 + (size_t)(tk * 64) * DE + c0; lds_ = DE; dst = (bf16_t*)((unsigned char*)F.wtgu() + ((size_t)e * 1024 + nprime) * D + tk * 64); ldd_ = D; f8 = 1; csc = S8_W; }
    else { r -= T_GU; const int tn = r % 32, tk = (r / 32) % 8, e = r / 256;
        const float* s0 = e < NE ? F.w_down + (size_t)e * DE * D : F.ws_down;
        src = s0 + (size_t)(tk * 64) * D + tn * 64; lds_ = D; dst = (bf16_t*)((unsigned char*)F.wtd() + ((size_t)e * D + tn * 64) * DE + tk * 64); ldd_ = DE; f8 = 1; csc = S8_W; }
    return ConvDesc{src, dst, lds_, ldd_, ksc, csc, f8};
}
__device__ __forceinline__ void conv_items(const Frame& F, int first, int last, int step) {
    LAS float* t = (LAS float*)F.lds + F.wave * (64 * 65);
    if (first >= last) return;
    f32x4 va[16], vb[16]; ConvDesc da = conv_desc(F, first), db = da;
    conv_load(da, va, F.lane);
    for (int it = first; it < last; it += 2 * step) {
        const bool hb = it + step < last; if (hb) { db = conv_desc(F, it + step); conv_load(db, vb, F.lane); }
        conv_finish(da, va, t, F.lane);
        if (!hb) break;
        const bool ha = it + 2 * step < last; if (ha) { da = conv_desc(F, it + 2 * step); conv_load(da, va, F.lane); }
        conv_finish(db, vb, t, F.lane);
        if (!ha) break;
    }
}
__device__ __forceinline__ void conv_range(const Frame& F, int first, int last) { conv_items(F, first + F.wave, last, 8); }
__device__ __forceinline__ void conv_inproj_share(const Frame& F) {
    constexpr int N1 = IT_MID - IT_P0, CY = (N1 - 118 * 100 + 255) / 256, CX = CY + 100; int a, n;
    if (F.G == 256) { if (F.bx < 138) { a = F.bx * CY; n = CY; } else { a = 138 * CY + (F.bx - 138) * CX; n = CX; } }
    else { n = (N1 + F.G - 1) / F.G; a = F.bx * n; }
    const int e = a + n < N1 ? a + n : N1;
    if (a < e) conv_range(F, IT_P0 + a, IT_P0 + e);
}
__device__ __forceinline__ void conv_tail(const Frame& F, int first, int last, int c0) {
    int nw = F.G - c0, me = F.bx - c0; if (nw <= 0) { nw = F.G; me = F.bx; }
    if (me < 0) return;
    conv_items(F, first + me * 8 + F.wave, last, nw * 8);
}
__device__ __forceinline__ void phase_prologue(Frame& F) {
    const int gw = F.bx * 8 + F.wave, NGW = F.G * 8;
    conv_items(F, gw, IT_P0, NGW);
    for (int row = gw; row < MROWS; row += NGW) {
        bf16_t* dst = F.h0() + (size_t)row * D;
        if (row >= NTOK + NMETA) {
#pragma unroll
            for (int j = 0; j < 8; ++j) *(u32x2*)(dst + (j * 64 + F.lane) * 4) = (u32x2){0u, 0u};
            continue; }
        const float* src = row < NTOK ? F.x + (size_t)row * D : F.meta + (size_t)(row - NTOK) * D;
        f32x4 v[8]; float s = 0.f;
#pragma unroll
        for (int j = 0; j < 8; ++j) { v[j] = *(const f32x4*)(src + (j * 64 + F.lane) * 4); s += (v[j][0] + v[j][1]) + (v[j][2] + v[j][3]); }
        const float mu = wsum(s) * (1.0f / D); float q = 0.f;
#pragma unroll
        for (int j = 0; j < 8; ++j) { const f32x4 d = v[j] - mu; q += (d[0] * d[0] + d[1] * d[1]) + (d[2] * d[2] + d[3] * d[3]); }
        const float rstd = 1.0f / sqrtf(wsum(q) * (1.0f / D) + LN_EPS);
#pragma unroll
        for (int j = 0; j < 8; ++j) { const int c = (j * 64 + F.lane) * 4; const f32x4 g = *(const f32x4*)(F.lng + c), b = *(const f32x4*)(F.lnb + c); const f32x4 y = (v[j] - mu) * rstd * g + b;
            *(u32x2*)(dst + c) = (u32x2){pack2(y[0], y[1]), pack2(y[2], y[3])}; }
        if (row < NTOK && F.lane == 0) { F.stats0()[row * 2] = mu; F.stats0()[row * 2 + 1] = rstd; }
    }
    if (F.bx == 0) for (int i = F.tid; i < 16 * 272; i += 512) { const int h = i / 272, r = i % 272; F.tab()[i] = r <= 256 ? F.t5[t5_bucket(r - 128) * 16 + h] * LOG2E : 0.f; }
}

template <class Fn> __device__ __forceinline__ void sgemm(const Fn& f, LAS unsigned char* ldsb, int tid, int bx, int G) {
    LAS float* As = (LAS float*)ldsb; LAS float* Bs = As + 32 * 132; LAS float* Bs2 = Bs + 32 * 68;
    const int ntm = f.ntm(), ntn = f.ntn(), K = f.K();
    const int tx = tid & 15, ty = tid >> 4, ar = tid >> 2, akc = (tid & 3) * 8, br = (tid & 255) >> 2;
    for (int tile = bx; tile < ntm * ntn; tile += G) {
        const int tm = tile / ntn, tn = tile % ntn;
        typename Fn::Tile T; if (!f.tile(tm, T)) continue;
        float acc[4][4], acc2[4][4];
#pragma unroll
        for (int i = 0; i < 4; ++i)
#pragma unroll
            for (int j = 0; j < 4; ++j) { acc[i][j] = 0.f; acc2[i][j] = 0.f; }
        const bf16_t* ap = f.arow(T, tm * 128 + ar);
        const bf16_t* bp = tid < 256 ? f.brow(T, tn * 64 + br) : (Fn::DUAL ? f.brow2(T, tn * 64 + br) : nullptr);
        LAS float* Bw = tid < 256 ? Bs : Bs2;
        for (int k0 = 0; k0 < K; k0 += 32) {
            u32x4 av = (u32x4){0u, 0u, 0u, 0u}, bv = (u32x4){0u, 0u, 0u, 0u};
            if (ap) av = *(const u32x4*)(ap + k0 + akc);
            if (bp) bv = *(const u32x4*)(bp + k0 + akc);
            __syncthreads();
#pragma unroll
            for (int i = 0; i < 4; ++i) { As[(akc + 2 * i) * 132 + ar] = __uint_as_float(av[i] << 16); As[(akc + 2 * i + 1) * 132 + ar] = __uint_as_float(av[i] & 0xffff0000u); }
            if (tid < 256 || Fn::DUAL) {
#pragma unroll
                for (int i = 0; i < 4; ++i) { Bw[(akc + 2 * i) * 68 + br] = __uint_as_float(bv[i] << 16); Bw[(akc + 2 * i + 1) * 68 + br] = __uint_as_float(bv[i] & 0xffff0000u); } }
            __syncthreads();
#pragma unroll 8
            for (int kk = 0; kk < 32; ++kk) {
                const f32x4 a = *(const LAS f32x4*)(As + kk * 132 + ty * 4), b = *(const LAS f32x4*)(Bs + kk * 68 + tx * 4);
#pragma unroll
                for (int i = 0; i < 4; ++i)
#pragma unroll
                    for (int j = 0; j < 4; ++j) acc[i][j] += a[i] * b[j];
                if (Fn::DUAL) { const f32x4 b2 = *(const LAS f32x4*)(Bs2 + kk * 68 + tx * 4);
#pragma unroll
                    for (int i = 0; i < 4; ++i)
#pragma unroll
                        for (int j = 0; j < 4; ++j) acc2[i][j] += a[i] * b2[j]; }
            }
        }
#pragma unroll
        for (int i = 0; i < 4; ++i)
#pragma unroll
            for (int j = 0; j < 4; ++j) f.store(T, tm * 128 + ty * 4 + i, tn * 64 + tx * 4 + j, acc[i][j], acc2[i][j]);
    }
}

__device__ __forceinline__ void expert_starts(const Frame& F, LAS int* ps  ) {
    if (F.tid == 0) { int acc = 0; for (int e = 0; e < NE; ++e) { ps[e] = acc; acc += ((F.cnt()[e] + 255) >> 8) << 8; } ps[64] = acc; }
    __syncthreads();
}

struct FnInProj {
    static constexpr bool DUAL = false; struct Tile {}; const Frame& F;
    __device__ int ntm() const { return MROWS / 128; } __device__ int ntn() const { return INW / 64; } __device__ int K() const { return D; }
    __device__ bool tile(int, Tile&) const { return true; }
    __device__ const bf16_t* arow(const Tile&, int row) const { return F.h0() + (size_t)row * D; }
    __device__ const bf16_t* brow(const Tile&, int n) const { return F.wtin() + (size_t)n * D; }
    __device__ const bf16_t* brow2(const Tile&, int) const { return nullptr; }
    __device__ void store(const Tile&, int row, int n, float a, float) const { F.u()[(size_t)row * INW + n] = f2bf(a); }
};
struct FnOutProj {
    static constexpr bool DUAL = false; struct Tile {}; const Frame& F;
    __device__ int ntm() const { return NTOK / 128; } __device__ int ntn() const { return D / 64; } __device__ int K() const { return D; }
    __device__ bool tile(int, Tile&) const { return true; }
    __device__ const bf16_t* arow(const Tile&, int row) const { return F.ya() + (size_t)row * D; }
    __device__ const bf16_t* brow(const Tile&, int n) const { return F.wtout() + (size_t)n * D; }
    __device__ const bf16_t* brow2(const Tile&, int) const { return nullptr; }
    __device__ void store(const Tile&, int row, int n, float a, float) const {
        const float h0 = (F.x[(size_t)row * D + n] - F.stats0()[row * 2]) * F.stats0()[row * 2 + 1] * F.lng[n] + F.lnb[n];
        F.z()[(size_t)row * D + n] = f2bf(a + ALPHA * h0); }
};
struct FnGateUp {
    static constexpr bool DUAL = true; struct Tile { int e, r0, n; }; const Frame& F; const LAS int* ps;
    __device__ int ntm() const { return HBROWS / 128; } __device__ int ntn() const { return DE / 64; } __device__ int K() const { return D; }
    __device__ bool tile(int tm, Tile& T) const { const int row0 = tm * 128;
        if (row0 >= PMAX) { T.e = NE; T.r0 = row0 - PMAX; T.n = NTOK; return true; }
        if (row0 >= ps[64]) return false;
        int e = 0; while (e < NE - 1 && row0 >= ps[e + 1]) ++e;
        T.e = e; T.r0 = row0 - ps[e]; T.n = F.cnt()[e]; return T.r0 < T.n; }
    __device__ const bf16_t* arow(const Tile& T, int row) const { const int r = T.r0 + (row & 127); if (r >= T.n) return nullptr;
        const int tok = T.e < NE ? F.tokl()[(size_t)T.e * NTOK + r] : r; return F.h1() + (size_t)tok * D; }
    __device__ const bf16_t* brow(const Tile& T, int n) const { return F.wtgu() + ((size_t)T.e * 1024 + 256 * (n >> 7) + (n & 127)) * D; }
    __device__ const bf16_t* brow2(const Tile& T, int n) const { return F.wtgu() + ((size_t)T.e * 1024 + 256 * (n >> 7) + 128 + (n & 127)) * D; }
    __device__ void store(const Tile& T, int row, int n, float g, float u) const { const int r = T.r0 + (row & 127); const float w = T.e < NE ? (r < T.n ? F.wl()[(size_t)T.e * NTOK + r] : 0.f) : 1.0f;
        F.hb()[(size_t)row * DE + n] = f2bf(g / (1.0f + __expf(-g)) * (u * w)); }
};
struct FnDown {
    static constexpr bool DUAL = false; struct Tile { int e, r0, n; }; const Frame& F; const LAS int* ps;
    __device__ int ntm() const { return PMAX / 128; } __device__ int ntn() const { return D / 64; } __device__ int K() const { return DE; }
    __device__ bool tile(int tm, Tile& T) const { const int row0 = tm * 128; if (row0 >= ps[64]) return false;
        int e = 0; while (e < NE - 1 && row0 >= ps[e + 1]) ++e;
        T.e = e; T.r0 = row0 - ps[e]; T.n = F.cnt()[e]; return T.r0 < T.n; }
    __device__ const bf16_t* arow(const Tile&, int row) const { return F.hb() + (size_t)row * DE; }
    __device__ const bf16_t* brow(const Tile& T, int n) const { return F.wtd() + ((size_t)T.e * D + n) * DE; }
    __device__ const bf16_t* brow2(const Tile&, int) const { return nullptr; }
    __device__ void store(const Tile& T, int row, int n, float a, float) const { const int r = T.r0 + (row & 127);
        (void)r; ((unsigned char*)F.ym())[(size_t)row * D + n] = (unsigned char)enc8(a); }
};
struct FnFinal {
    static constexpr bool DUAL = false; struct Tile {}; const Frame& F; const LAS int* ps;
    __device__ int ntm() const { return NTOK / 128; } __device__ int ntn() const { return D / 64; } __device__ int K() const { return DE; }
    __device__ bool tile(int, Tile&) const { return true; }
    __device__ const bf16_t* arow(const Tile&, int row) const { return F.hb() + (size_t)(PMAX + row) * DE; }
    __device__ const bf16_t* brow(const Tile&, int n) const { return F.wtd() + ((size_t)NE * D + n) * DE; }
    __device__ const bf16_t* brow2(const Tile&, int) const { return nullptr; }
    __device__ void store(const Tile&, int row, int n, float a, float) const {
        const float h1 = bf2f(F.h1()[(size_t)row * D + n]);
        F.o2()[(size_t)row * D + n] = f2bf(a + ALPHA * h1); }
};

__device__ __forceinline__ void phase_attn_simple(Frame& F) {
    LAS float* qs = (LAS float*)F.lds + F.wave * 512; LAS float* psm = qs + 64;
    const int gw = F.bx * 8 + F.wave, NGW = F.G * 8, lane = F.lane;
    for (int item = gw; item < NTOK * 32; item += NGW) {
        const int tok = item >> 5, hh = item & 31, b = tok >> 13, s = tok & 8191;
        const bool isA = hh < 16; const int h = hh & 15;
        const int qcol = isA ? COL_QA + h * 64 : COL_QB + h * 64, kcol = isA ? COL_KA + (h >> 2) * 64 : COL_KB + h * 64, vcol = isA ? COL_VA + (h >> 2) * 64 : COL_VB + h * 64;
        const int r = s >> 6, c = s & 63, rs = min(max(r - 4, 0), 120), cs = min(max(c - 8, 0), 48);
        const int nkeys = isA ? 16 + 257 : 16 + 128;
        asm volatile("s_waitcnt lgkmcnt(0)" ::: "memory");
        qs[lane] = bf2f(F.u()[(size_t)tok * INW + qcol + lane]);
        asm volatile("s_waitcnt lgkmcnt(0)" ::: "memory");
        float sc[5]; float mx = -INFINITY;
#pragma unroll
        for (int i = 0; i < 5; ++i) {
            const int j = lane + 64 * i; sc[i] = -INFINITY;
            if (j < nkeys) {
                int krow; float bias; bool valid = true;
                if (j < 16) { krow = NTOK + j; bias = isA ? F.t5[t5_bucket(j - 16 - s) * 16 + h] * LOG2E : 0.f; }
                else if (isA) { const int kpos = s - 128 + (j - 16); valid = kpos >= 0 && kpos < SEQ; krow = b * SEQ + kpos; bias = F.tab()[h * 272 + (j - 16)]; }
                else { const int w = j - 16, kr = rs + (w >> 4), kc = cs + (w & 15); krow = b * SEQ + kr * 64 + kc; bias = F.rpb[(h * 15 + (kr - r + 7)) * 31 + (kc - c + 15)] * LOG2E; }
                if (valid) { const bf16_t* kp = F.u() + (size_t)krow * INW + kcol; float dot = 0.f;
#pragma unroll
                    for (int d8 = 0; d8 < 8; ++d8) { const u32x4 kv = *(const u32x4*)(kp + d8 * 8);
#pragma unroll
                        for (int i2 = 0; i2 < 4; ++i2) { dot += qs[d8 * 8 + 2 * i2] * __uint_as_float(kv[i2] << 16); dot += qs[d8 * 8 + 2 * i2 + 1] * __uint_as_float(kv[i2] & 0xffff0000u); } }
                    sc[i] = dot + bias; }
            }
            mx = fmaxf(mx, sc[i]);
        }
        const float sinkl = isA ? F.sink[h] * LOG2E : -INFINITY;
        mx = fmaxf(wmax(mx), sinkl);
        float l = 0.f;
#pragma unroll
        for (int i = 0; i < 5; ++i) { const int j = lane + 64 * i; const float p = sc[i] == -INFINITY ? 0.f : exp2f(sc[i] - mx); l += p; if (j < 320) psm[j] = p; }
        l = wsum(l) + (isA ? exp2f(sinkl - mx) : 0.f);
        asm volatile("s_waitcnt lgkmcnt(0)" ::: "memory");
        float o = 0.f;
        for (int j = 0; j < nkeys; ++j) { const float p = psm[j]; if (p == 0.f) continue;
            int krow; if (j < 16) krow = NTOK + j; else if (isA) krow = b * SEQ + s - 128 + (j - 16); else { const int w = j - 16; krow = b * SEQ + (rs + (w >> 4)) * 64 + cs + (w & 15); }
            o += p * bf2f(F.u()[(size_t)krow * INW + vcol + lane]); }
        o /= l;
        const bf16_t ob = f2bf(o); F.ya()[(size_t)tok * D + hh * 64 + lane] = ob;
        const float of = bf2f(ob), q = wsum(of * of);
        if (lane == 0) F.ssq()[tok * 32 + hh] = q;
    }
}
__device__ __forceinline__ void phase_rmsnorm(Frame& F) {
    const int gw = F.bx * 8 + F.wave, NGW = F.G * 8, lane = F.lane;
    for (int tok = gw; tok < NTOK; tok += NGW) {
        const float q = lane < 32 ? F.ssq()[tok * 32 + lane] : 0.f;
        float qa = lane < 16 ? q : 0.f, qb = (lane >= 16 && lane < 32) ? q : 0.f; qa = wsum(qa); qb = wsum(qb);
        const float ra = 1.0f / sqrtf(qa * (1.0f / 1024.f) + RMS_EPS), rb = 1.0f / sqrtf(qb * (1.0f / 1024.f) + RMS_EPS);
        bf16_t* p = F.ya() + (size_t)tok * D;
#pragma unroll
        for (int j = 0; j < 8; ++j) { const int c = (j * 64 + lane) * 4; const float rr = c < 1024 ? ra : rb; u32x2 w = *(u32x2*)(p + c);
            w.x = pack2(__uint_as_float(w.x << 16) * rr, __uint_as_float(w.x & 0xffff0000u) * rr); w.y = pack2(__uint_as_float(w.y << 16) * rr, __uint_as_float(w.y & 0xffff0000u) * rr); *(u32x2*)(p + c) = w; }
    }
}

__device__ __forceinline__ void phase_ln1_router(Frame& F) {
    LAS float* hs = (LAS float*)F.lds + F.wave * 2048;
    const int gw = F.bx * 8 + F.wave, NGW = F.G * 8, lane = F.lane;
    for (int tok = gw; tok < NTOK; tok += NGW) {
        const bf16_t* src = F.z() + (size_t)tok * D; f32x4 v[8]; float s = 0.f;
#pragma unroll
        for (int j = 0; j < 8; ++j) { const u32x2 w = *(const u32x2*)(src + (j * 64 + lane) * 4); v[j] = (f32x4){__uint_as_float(w.x << 16), __uint_as_float(w.x & 0xffff0000u), __uint_as_float(w.y << 16), __uint_as_float(w.y & 0xffff0000u)}; s += (v[j][0] + v[j][1]) + (v[j][2] + v[j][3]); }
        const float mu = wsum(s) * (1.0f / D); float q = 0.f;
#pragma unroll
        for (int j = 0; j < 8; ++j) { const f32x4 d = v[j] - mu; q += (d[0] * d[0] + d[1] * d[1]) + (d[2] * d[2] + d[3] * d[3]); }
        const float rstd = 1.0f / sqrtf(wsum(q) * (1.0f / D) + LN_EPS);
        asm volatile("s_waitcnt lgkmcnt(0)" ::: "memory");
#pragma unroll
        for (int j = 0; j < 8; ++j) { const int c = (j * 64 + lane) * 4; const f32x4 g = *(const f32x4*)(F.l1g + c), bb = *(const f32x4*)(F.l1b + c); const f32x4 y = (v[j] - mu) * rstd * g + bb;
            *(u32x2*)(F.h1() + (size_t)tok * D + c) = (u32x2){pack2(y[0], y[1]), pack2(y[2], y[3])}; *(LAS f32x4*)(hs + c) = y; }
        if (lane == 0) { F.stats1()[tok * 2] = mu; F.stats1()[tok * 2 + 1] = rstd; }
        asm volatile("s_waitcnt lgkmcnt(0)" ::: "memory");
        float lg = 0.f;
#pragma unroll 8
        for (int n = 0; n < D; ++n) lg += hs[n] * F.w_router[(size_t)n * NE + lane];
        const float score = 1.0f / (1.0f + expf(-lg)), v0 = score + F.rbias[lane];
        int rk = 0;
#pragma unroll
        for (int j = 0; j < 8; ++j) { const int o = (lane & ~7) + j; const float w = __shfl(v0, o); rk += (w > v0 || (w == v0 && o < lane)) ? 1 : 0; }
        float gs = rk < 2 ? v0 : 0.f; gs += __shfl_xor(gs, 1); gs += __shfl_xor(gs, 2); gs += __shfl_xor(gs, 4);
        int grk = 0; const int myg = lane >> 3;
#pragma unroll
        for (int g = 0; g < 8; ++g) { const float w = __shfl(gs, g * 8); grk += (w > gs || (w == gs && g < myg)) ? 1 : 0; }
        const float mv = grk < 4 ? v0 : -INFINITY;
        int erk = 0;
        for (int o = 0; o < 64; ++o) { const float w = __shfl(mv, o); erk += (w > mv || (w == mv && o < lane)) ? 1 : 0; }
        const bool sel = erk < 8;
        const float wsm = wsum(sel ? score : 0.f), wgt = score / (wsm + 1e-20f) * 2.5f;
        if (sel) { const int rr = atomicAdd(F.cnt() + lane, 1); F.tokl()[(size_t)lane * NTOK + rr] = tok; F.wl()[(size_t)lane * NTOK + rr] = wgt; F.tke()[tok * 8 + erk] = lane; F.tkr()[tok * 8 + erk] = rr; }
    }
}
__device__ __forceinline__ void phase_ln2(Frame& F, const LAS int* ps) {
    const int gw = F.bx * 8 + F.wave, NGW = F.G * 8, lane = F.lane;
#pragma unroll 1
    for (int tok = gw; tok < NTOK; tok += NGW) {
        float* dst = F.out + (size_t)tok * D; const bf16_t* o2p = F.o2() + (size_t)tok * D; float v[2][16]; float s = 0.f;
        const int mye = F.tke()[tok * 8 + (lane & 7)], myr = F.tkr()[tok * 8 + (lane & 7)], mypos = ps[mye] + myr;
        u32x4 o[2][2];
#pragma unroll
        for (int k = 0; k < 2; ++k) { o[k][0] = *(const u32x4*)(o2p + (lane + 64 * k) * 16); o[k][1] = *(const u32x4*)(o2p + (lane + 64 * k) * 16 + 8); }
#pragma unroll
        for (int k = 0; k < 2; ++k)
#pragma unroll
            for (int h = 0; h < 2; ++h)
#pragma unroll
                for (int i = 0; i < 4; ++i) { v[k][8 * h + 2 * i] = __uint_as_float(o[k][h][i] << 16); v[k][8 * h + 2 * i + 1] = __uint_as_float(o[k][h][i] & 0xffff0000u); }
        u32x4 y[8][2];
#pragma unroll
        for (int j = 0; j < 8; ++j) { const int p = __shfl(mypos, j); const unsigned char* yp = (const unsigned char*)F.ym() + (size_t)p * D;
#pragma unroll
            for (int k = 0; k < 2; ++k) y[j][k] = *(const u32x4*)(yp + (lane + 64 * k) * 16); }
#pragma unroll
        for (int j = 0; j < 8; ++j)
#pragma unroll
            for (int k = 0; k < 2; ++k)
#pragma unroll
                for (int i = 0; i < 4; ++i) { unsigned w = y[j][k][i]; asm volatile("" : "+v"(w));
                    const unsigned w1 = w >> 8;
                    const unsigned p02 = ((w & 0x007f007fu) << 4) + 0x39003900u + ((w & 0x00800080u) << 8), p13 = ((w1 & 0x007f007fu) << 4) + 0x39003900u + ((w1 & 0x00800080u) << 8);
                    v[k][4 * i] += __uint_as_float(p02 << 16); v[k][4 * i + 2] += __uint_as_float(p02 & 0xffff0000u);
                    v[k][4 * i + 1] += __uint_as_float(p13 << 16); v[k][4 * i + 3] += __uint_as_float(p13 & 0xffff0000u);
                    asm volatile("" : "+v"(v[k][4 * i]), "+v"(v[k][4 * i + 1]), "+v"(v[k][4 * i + 2]), "+v"(v[k][4 * i + 3])); }
#pragma unroll
        for (int k = 0; k < 2; ++k)
#pragma unroll
            for (int i = 0; i < 16; ++i) s += v[k][i];
        const float mu = wsum(s) * (1.0f / D); float q = 0.f;
#pragma unroll
        for (int k = 0; k < 2; ++k)
#pragma unroll
            for (int i = 0; i < 16; ++i) { const float d = v[k][i] - mu; q += d * d; }
        const float rstd = 1.0f / sqrtf(wsum(q) * (1.0f / D) + LN_EPS);
        asm volatile("" ::: "memory");
#pragma unroll
        for (int k = 0; k < 2; ++k)
#pragma unroll
            for (int h = 0; h < 4; ++h) { const int c = (lane + 64 * k) * 16 + 4 * h; const f32x4 g = *(const f32x4*)(F.l2g + c), bb = *(const f32x4*)(F.l2b + c);
                *(f32x4*)(dst + c) = (f32x4){(v[k][4 * h] - mu) * rstd * g[0] + bb[0], (v[k][4 * h + 1] - mu) * rstd * g[1] + bb[1], (v[k][4 * h + 2] - mu) * rstd * g[2] + bb[2], (v[k][4 * h + 3] - mu) * rstd * g[3] + bb[3]}; }
    }
}

#ifndef FAST_P1
#define FAST_P1 1
#endif
#ifndef STAGGER7
#define STAGGER7 0
#endif
#ifndef CONV_NT
#define CONV_NT 1
#endif
#ifndef STAGGER4
#define STAGGER4 0
#endif
#ifndef XCD_TRUE
#define XCD_TRUE 1
#endif
#ifndef DOWN_REV
#define DOWN_REV false
#endif
#ifndef YM_NT
#define YM_NT 0
#endif
#ifndef FAST_P4
#define FAST_P4 1
#endif
#ifndef FAST_P6
#define FAST_P6 1
#endif
#ifndef FAST_P7
#define FAST_P7 1
#endif
namespace pg8 {
typedef short bf16x8 __attribute__((ext_vector_type(8)));
constexpr int BM = 256, BK = 64, HALF = 128, HTB = HALF * BK * 2, STAGE_BYTES = 8 * HTB, NXCD = 8, WGM = 8;
__host__ __device__ __forceinline__ int lds_byte(int r, int c) { const int st = (r >> 4) * 2 + (c >> 5), rr = r & 15, cc = c & 31, ob = rr * 64 + cc * 2; return st * 1024 + (ob ^ (((ob >> 9) & 1) << 5)); }
__host__ __device__ __forceinline__ void stage_rc(int b, int& R, int& C) { const int st = b / 1024, sb = b % 1024, swz = sb ^ (((sb >> 9) & 1) << 5); R = (st >> 1) * 16 + swz / 64; C = (st & 1) * 32 + (swz % 64) / 2; }
__host__ __device__ __forceinline__ int perm32(int rho) { const int n = rho >> 4, i = rho & 15; return 8 * (i >> 2) + 4 * n + (i & 3); }
__device__ __forceinline__ unsigned cvt_pk_bf16(float lo, float hi) { unsigned r; asm volatile("v_cvt_pk_bf16_f32 %0, %1, %2" : "=v"(r) : "v"(lo), "v"(hi)); return r; }
typedef int i32x4 __attribute__((ext_vector_type(4)));
typedef int i32x8 __attribute__((ext_vector_type(8)));
__device__ __forceinline__ i32x8 cat8(bf16x8 a, bf16x8 b) { return __builtin_shufflevector(__builtin_bit_cast(i32x4, a), __builtin_bit_cast(i32x4, b), 0, 1, 2, 3, 4, 5, 6, 7); }
struct Unit { int pm, pn, e, r0, n, orow, tb; };
__device__ __forceinline__ int xcd_remap(int L, int nwg) { const int q = nwg / NXCD, r = nwg % NXCD, xcd = L % NXCD, off = L / NXCD; return (xcd < r ? xcd * (q + 1) : r * (q + 1) + (xcd - r) * q) + off; }
__device__ __forceinline__ void tile_of(int wgid, int nM, int nN, int& pm, int& pn) { const int nig = WGM * nN, gid = wgid / nig, fm = gid * WGM, gsz = (nM - fm) < WGM ? (nM - fm) : WGM; pm = fm + ((wgid % nig) % gsz); pn = (wgid % nig) / gsz; }

template <class Epi, class Sched>
__device__ __forceinline__ void gemm_phase(const int wave0, LAS unsigned char* lds, const Sched& S, const Epi& E, const int lda, const int ldb, const int nt, const int stagger_ticks = 0) {
    int tid = wave0 * 64 + lane_id(); asm volatile("" : "+v"(tid));
    const int wid = wave0, lane = tid & 63, wr = wid >> 2, wc = wid & 3, fr = lane & 15, fq = lane >> 4;
    unsigned voffA[2], voffB[2], voffB2[2], c2[2]; int RA[2];
#pragma unroll
    for (int i = 0; i < 2; ++i) { int R, C; stage_rc(tid * 16 + i * 8192, R, C); const int Rb = Epi::PERM ? ((R & ~31) + perm32(R & 31)) : R;
        voffA[i] = (unsigned)(R * lda + C) * 2u; voffB[i] = (unsigned)(Rb * ldb + C) * 2u; RA[i] = R; c2[i] = (unsigned)C * 2u;
        voffB2[i] = (unsigned)((64 * (R >> 5) + 16 * ((R >> 2) & 3) + 4 * ((R >> 4) & 1) + (R & 3)) * ldb + C) * 2u; }
    const size_t kstep = (size_t)(BK * 2), hstepA = (size_t)HALF * lda * 2, hstepB = (size_t)HALF * ldb * 2, hstepB2 = (size_t)8 * ldb * 2;
    const unsigned lda2 = (unsigned)lda * 2u;
    const unsigned ldsw = (unsigned)wid * 1024u;
    int aoff = lds_byte(wr * 64 + fr, fq * 8), boff = lds_byte(wc * 32 + fr, fq * 8) + 4 * HTB; asm volatile("" : "+v"(aoff), "+v"(boff));
#define PG8_SA(b, h) (((b) * 2 + (h)) * HTB)
#define PG8_SB(b, h) ((4 + (b) * 2 + (h)) * HTB)
#define PG8_STAGE(bufoff, gbase, voff) do { const char* _g = (const char*)(gbase); asm volatile("" : "+s"(_g)); _Pragma("unroll") for (int _i = 0; _i < 2; ++_i) { unsigned _v = (voff)[_i]; asm volatile("" : "+v"(_v)); \
        __builtin_amdgcn_global_load_lds((const unsigned*)(_g + _v), (LAS unsigned*)(lds + (bufoff) + ldsw + _i * 8192), 16, 0, 0); } } while (0)
#define PG8_STG_A(bufoff, p, h, V) do { if constexpr (Sched::GATHER) { PG8_STAGE(bufoff, p, V[h]); } else { PG8_STAGE(bufoff, (p) + (h) * hstepA, voffA); } } while (0)
#define PG8_STG_B(bufoff, p, h) do { if constexpr (Epi::PERM2) { PG8_STAGE(bufoff, (p) + (h) * hstepB2, voffB2); } else { PG8_STAGE(bufoff, (p) + (h) * hstepB, voffB); } } while (0)
#define PG8_LDA(dst, b, h) do { _Pragma("unroll") for (int m = 0; m < 4; ++m) _Pragma("unroll") for (int k = 0; k < 2; ++k) dst[m][k] = *(const LAS bf16x8*)(lds + PG8_SA(b, h) + aoff + m * 2048 + k * 1024); } while (0)
#define PG8_LDB(dst, b, h) do { _Pragma("unroll") for (int n = 0; n < 2; ++n) _Pragma("unroll") for (int k = 0; k < 2; ++k) dst[n][k] = *(const LAS bf16x8*)(lds + boff + (PG8_SB(b, h) - 4 * HTB) + n * 2048 + k * 1024); } while (0)
#define PG8_MMA(ai, bj, At, Bt) do { __builtin_amdgcn_s_setprio(1); _Pragma("unroll") for (int m = 0; m < 4; ++m) _Pragma("unroll") for (int n = 0; n < 2; ++n) { \
        if constexpr (Epi::F8) acc[ai][bj][m][n] = __builtin_amdgcn_mfma_scale_f32_16x16x128_f8f6f4(cat8(Bt[n][0], Bt[n][1]), cat8(At[m][0], At[m][1]), acc[ai][bj][m][n], 0, 0, 0, 0, 0, 0); \
        else { _Pragma("unroll") for (int k = 0; k < 2; ++k) acc[ai][bj][m][n] = __builtin_amdgcn_mfma_f32_16x16x32_bf16(Bt[n][k], At[m][k], acc[ai][bj][m][n], 0, 0, 0); } } __builtin_amdgcn_s_setprio(0); } while (0)
#define PG8_WAIT_V(n) asm volatile("s_waitcnt vmcnt(" #n ")" ::: "memory")
#define PG8_WAIT_L(n) asm volatile("s_waitcnt lgkmcnt(" #n ")" ::: "memory")
#define PG8_BAR __builtin_amdgcn_s_barrier()
#define PG8_SCHED __builtin_amdgcn_sched_barrier(0)
    Unit cur, nxt; int ui = 0;
    if (stagger_ticks) {
        const unsigned long long t0 = __builtin_amdgcn_s_memrealtime(), dl = (unsigned long long)((blockIdx.x >> 3) & 15) * (unsigned)stagger_ticks;
        while (__builtin_amdgcn_s_memrealtime() - t0 < dl) __builtin_amdgcn_s_sleep(4);
        __syncthreads(); }
    if (!S.next(0, cur)) return;
    cur.tb = 0;
    f32x4 acc[2][2][4][2];
#pragma unroll
    for (int a = 0; a < 2; ++a)
#pragma unroll
        for (int b = 0; b < 2; ++b)
#pragma unroll
            for (int m = 0; m < 4; ++m)
#pragma unroll
                for (int n = 0; n < 2; ++n) acc[a][b][m][n] = (f32x4){0.f, 0.f, 0.f, 0.f};
    bf16x8 At[4][2], B0[2][2], B1[2][2];
    unsigned vac[2][2], van[2][2];
    const char* cA = S.abase(cur); const char* cB = S.bbase(cur);
#pragma unroll
    for (int h = 0; h < 2; ++h)
#pragma unroll
        for (int i = 0; i < 2; ++i) { vac[h][i] = Sched::GATHER ? (unsigned)S.arow(cur, h * HALF + RA[i]) * lda2 + c2[i] : 0u; van[h][i] = vac[h][i]; }
    PG8_STG_B(PG8_SB(0, 0), cB, 0); PG8_STG_B(PG8_SB(0, 1), cB, 1); PG8_STG_A(PG8_SA(0, 0), cA, 0, vac); PG8_STG_A(PG8_SA(0, 1), cA, 1, vac);
    if (wr == 1) PG8_BAR;
    PG8_WAIT_V(2); PG8_BAR;
    PG8_STG_B(PG8_SB(1, 0), cB + kstep, 0); PG8_STG_A(PG8_SA(1, 0), cA + kstep, 0, vac); PG8_STG_B(PG8_SB(1, 1), cB + kstep, 1);
    PG8_WAIT_V(6); PG8_BAR;
    for (;;) {
        const bool has_next = S.next(ui + 1, nxt); nxt.tb = (ui + 1) & 1;
        if constexpr (Epi::MIDK) E.unit_begin(cur, wave0 * 64 + lane_id());
        const char* nA = has_next ? S.abase(nxt) : cA; const char* nB = has_next ? S.bbase(nxt) : cB;
        if constexpr (Sched::GATHER) { if (has_next) { const int tq = wave0 * 64 + lane_id();
#pragma unroll
            for (int h = 0; h < 2; ++h)
#pragma unroll
                for (int i = 0; i < 2; ++i) { int R, C; stage_rc(tq * 16 + i * 8192, R, C); van[h][i] = (unsigned)S.arow(nxt, h * HALF + R); } } }
#pragma unroll 1
        for (int t = 0; t < nt; t += 2) {
            const bool last = (t == nt - 2);
            const char* a1 = cA + (size_t)(t + 1) * kstep;
            const char* a2 = last ? nA : cA + (size_t)(t + 2) * kstep; const char* b2 = last ? nB : cB + (size_t)(t + 2) * kstep;
            const char* a3 = a2 + kstep; const char* b3 = b2 + kstep;
            unsigned va2[2][2];
#pragma unroll
            for (int h = 0; h < 2; ++h)
#pragma unroll
                for (int i = 0; i < 2; ++i) va2[h][i] = last ? van[h][i] : vac[h][i];
            PG8_LDB(B0, 0, 0); PG8_LDB(B1, 0, 1); PG8_SCHED; PG8_LDA(At, 0, 0); PG8_STG_A(PG8_SA(1, 1), a1, 1, vac);
            PG8_WAIT_V(8); PG8_WAIT_L(0); PG8_BAR; PG8_MMA(0, 0, At, B0); PG8_MMA(0, 1, At, B1); PG8_BAR; PG8_SCHED;
            PG8_LDA(At, 0, 1); PG8_STG_B(PG8_SB(0, 0), b2, 0); PG8_STG_B(PG8_SB(0, 1), b2, 1); PG8_STG_A(PG8_SA(0, 0), a2, 0, va2);
            PG8_WAIT_V(8); PG8_WAIT_L(0); PG8_BAR; PG8_MMA(1, 0, At, B0); PG8_MMA(1, 1, At, B1); PG8_BAR; PG8_SCHED;
            PG8_LDB(B0, 1, 0); PG8_LDB(B1, 1, 1); PG8_SCHED; PG8_LDA(At, 1, 0); PG8_STG_A(PG8_SA(0, 1), a2, 1, va2);
            PG8_WAIT_V(8); PG8_WAIT_L(0); PG8_BAR; PG8_MMA(0, 0, At, B0); PG8_MMA(0, 1, At, B1); PG8_BAR; PG8_SCHED;
            PG8_LDA(At, 1, 1); PG8_STG_B(PG8_SB(1, 0), b3, 0); PG8_STG_B(PG8_SB(1, 1), b3, 1); PG8_STG_A(PG8_SA(1, 0), a3, 0, va2);
            PG8_WAIT_V(8); PG8_WAIT_L(0); PG8_BAR; PG8_MMA(1, 0, At, B0); PG8_MMA(1, 1, At, B1); PG8_BAR; PG8_SCHED;
            if constexpr (Epi::MIDK) { if (2 * (t + 2) == nt) E.mid(acc, cur, wr, fr); }
            if constexpr (Sched::GATHER) { if (t + 4 == nt && has_next) {
                const int tq = wave0 * 64 + lane_id();
#pragma unroll
                for (int h = 0; h < 2; ++h)
#pragma unroll
                    for (int i = 0; i < 2; ++i) { int R, C; stage_rc(tq * 16 + i * 8192, R, C); asm volatile("" : "+v"(van[h][i])); van[h][i] = van[h][i] * lda2 + (unsigned)C * 2u; } } }
        }
        if (wr == 0) PG8_BAR;
        { const int le = lane_id(); E(acc, cur, wr, wc, le & 15, le >> 4); }
        if (!has_next) break;
#pragma unroll
        for (int a = 0; a < 2; ++a)
#pragma unroll
            for (int b = 0; b < 2; ++b)
#pragma unroll
                for (int m = 0; m < 4; ++m)
#pragma unroll
                    for (int n = 0; n < 2; ++n) acc[a][b][m][n] = (f32x4){0.f, 0.f, 0.f, 0.f};
        cur = nxt; cA = nA; cB = nB; ++ui;
#pragma unroll
        for (int h = 0; h < 2; ++h)
#pragma unroll
            for (int i = 0; i < 2; ++i) vac[h][i] = van[h][i];
        if (wr == 1) PG8_BAR;
    }
    PG8_WAIT_V(0);
    PG8_BAR;
#undef PG8_SA
#undef PG8_SB
#undef PG8_STAGE
#undef PG8_STG_A
#undef PG8_STG_B
#undef PG8_LDA
#undef PG8_LDB
#undef PG8_MMA
#undef PG8_WAIT_V
#undef PG8_WAIT_L
#undef PG8_BAR
#undef PG8_SCHED
}
}

struct SchedInProj {
    static constexpr bool GATHER = false; const char* A; const char* B; int G, c, i0, i1;
    __device__ __forceinline__ bool next(int i, pg8::Unit& u) const { const int ii = i0 + i; if (ii >= i1) return false; const int L = ii * G + c; if (L >= 1162) return false;
        if (L < 1152) pg8::tile_of(pg8::xcd_remap(L, 1152), 64, 18, u.pm, u.pn); else { const int k = L - 1152; u.pm = 64; u.pn = k < 2 ? 4 + k : 8 + k; }
        return true; }
    __device__ __forceinline__ const char* abase(const pg8::Unit& u) const { return A + (size_t)u.pm * 256 * D * 2; }
    __device__ __forceinline__ const char* bbase(const pg8::Unit& u) const { return B + (size_t)u.pn * 256 * D * 2; }
    __device__ __forceinline__ int arow(const pg8::Unit&, int) const { return 0; }
};
struct SchedOutProj {
    static constexpr bool GATHER = false; const char* A; const char* B; int G, c;
    __device__ __forceinline__ bool next(int i, pg8::Unit& u) const { const int L = i * G + c; if (L >= 512) return false; pg8::tile_of(pg8::xcd_remap(L, 512), 64, 8, u.pm, u.pn); return true; }
    __device__ __forceinline__ const char* abase(const pg8::Unit& u) const { return A + (size_t)u.pm * 256 * D * 2; }
    __device__ __forceinline__ const char* bbase(const pg8::Unit& u) const { return B + (size_t)u.pn * 256 * D * 2; }
    __device__ __forceinline__ int arow(const pg8::Unit&, int) const { return 0; }
};
__device__ __forceinline__ void moe_tables(const Frame& F, LAS int* ps) {
    if (F.tid < NE) ps[256 + F.tid] = F.cnt()[F.tid];
    __syncthreads();
    if (F.tid == 0) { int acc = 0, ta = 0; for (int e = 0; e < NE; ++e) { const int mt = (ps[256 + e] + 255) >> 8; ps[e] = acc; ps[128 + e] = ta; acc += mt * 256; ta += mt; }
        ps[64] = acc; ps[128 + 64] = ta; ps[128 + 65] = ta + NTOK / 256; ps[256 + 64] = NTOK; }
    __syncthreads();
    for (int t = F.tid; t < 640; t += 512) { int e = 0; while (e < NE && t >= ps[128 + e + 1]) ++e; ps[384 + t] = e; }
    __syncthreads();
}
template <int NN, bool REV> __device__ __forceinline__ bool moe_unit(const LAS int* ps, int L, pg8::Unit& u, int ntile) {
    const int nU = ntile * NN; if (L >= nU) return false;
    const int wg0 = pg8::xcd_remap(L, nU), wg = REV ? nU - 1 - wg0 : wg0, tile = wg / NN; u.pn = wg % NN;
    const int e = __builtin_amdgcn_readfirstlane(ps[384 + tile]); u.e = e; u.pm = tile - __builtin_amdgcn_readfirstlane(ps[128 + e]); u.r0 = u.pm * 256; u.n = __builtin_amdgcn_readfirstlane(ps[256 + e]);
    u.orow = (e < NE ? __builtin_amdgcn_readfirstlane(ps[e]) : PMAX) + u.r0;
    return true; }
struct SchedGU {
    static constexpr bool GATHER = true; const char* A; const char* B; const int* tokl; const int* cnt; const LAS int* ps; int G, c, ntile;
    __device__ __forceinline__ bool next(int i, pg8::Unit& u) const { return moe_unit<4, false>(ps, i * G + c, u, ntile); }
    __device__ __forceinline__ const char* abase(const pg8::Unit&) const { return A; }
    __device__ __forceinline__ const char* bbase(const pg8::Unit& u) const { return B + ((size_t)u.e * 1024 + u.pn * 256) * D; }
    __device__ __forceinline__ int arow(const pg8::Unit& u, int r) const { const int rr = min(u.r0 + r, u.n - 1); return u.e < NE ? tokl[(size_t)u.e * NTOK + rr] : rr; }
};
struct SchedDown {
    static constexpr bool GATHER = false; const char* A; const char* B; const int* cnt; const LAS int* ps; int G, c, ntile;
    __device__ __forceinline__ bool next(int i, pg8::Unit& u) const { return moe_unit<8, DOWN_REV>(ps, i * G + c, u, ntile); }
    __device__ __forceinline__ const char* abase(const pg8::Unit& u) const { return A + (size_t)u.orow * DE; }
    __device__ __forceinline__ const char* bbase(const pg8::Unit& u) const { return B + ((size_t)u.e * D + u.pn * 256) * DE; }
    __device__ __forceinline__ int arow(const pg8::Unit&, int) const { return 0; }
};
struct SchedDownShared {
    static constexpr bool GATHER = false; const char* A; const char* B; int G, c;
    __device__ __forceinline__ bool next(int i, pg8::Unit& u) const { const int L = i * G + c; if (L >= 512) return false; pg8::tile_of(pg8::xcd_remap(L, 512), 64, 8, u.pm, u.pn);
        u.e = NE; u.r0 = u.pm * 256; u.n = NTOK; u.orow = PMAX + u.r0; return true; }
    __device__ __forceinline__ const char* abase(const pg8::Unit& u) const { return A + (size_t)u.orow * DE; }
    __device__ __forceinline__ const char* bbase(const pg8::Unit& u) const { return B + ((size_t)NE * D + u.pn * 256) * DE; }
    __device__ __forceinline__ int arow(const pg8::Unit&, int) const { return 0; }
};
struct EpiU {
    static constexpr bool F8 = false; static constexpr bool PERM2 = false; static constexpr bool MIDK = false; static constexpr bool PERM = true; bf16_t* U; int nostore;
    __device__ __forceinline__ void operator()(const f32x4 (&acc)[2][2][4][2], const pg8::Unit& u, int wr, int wc, int fr, int fq) const {
        const int row0 = u.pm * 256 + wr * 64 + fr, col0 = u.pn * 256 + wc * 32 + 8 * fq;
        if (nostore) {
#pragma unroll
            for (int ai = 0; ai < 2; ++ai)
#pragma unroll
                for (int bj = 0; bj < 2; ++bj)
#pragma unroll
                    for (int m = 0; m < 4; ++m)
#pragma unroll
                        for (int n = 0; n < 2; ++n) asm volatile("" :: "v"(acc[ai][bj][m][n]));
            return; }
#pragma unroll
        for (int ai = 0; ai < 2; ++ai)
#pragma unroll
            for (int m = 0; m < 4; ++m) { bf16_t* rowp = U + (size_t)(row0 + ai * 128 + m * 16) * INW + col0;
#pragma unroll
                for (int bj = 0; bj < 2; ++bj) { const f32x4 v0 = acc[ai][bj][m][0], v1 = acc[ai][bj][m][1]; u32x4 w;
                    w.x = pg8::cvt_pk_bf16(v0[0], v0[1]); w.y = pg8::cvt_pk_bf16(v0[2], v0[3]); w.z = pg8::cvt_pk_bf16(v1[0], v1[1]); w.w = pg8::cvt_pk_bf16(v1[2], v1[3]);
                    *(u32x4*)(rowp + bj * 128) = w; } }
    }
};
struct EpiZ {
    static constexpr bool F8 = false; static constexpr bool PERM2 = false; static constexpr bool MIDK = true; static constexpr bool PERM = true; bf16_t* Z; const bf16_t* H0; const float* ssq; LAS float* tab;
    __device__ __forceinline__ void unit_begin(const pg8::Unit& u, int tid) const {
        const int row = tid >> 1, grp = tid & 1; const float* p = ssq + (size_t)(u.pm * 256 + row) * 32 + 16 * grp;
        const f32x4 a = *(const f32x4*)p, b4 = *(const f32x4*)(p + 4), c = *(const f32x4*)(p + 8), d = *(const f32x4*)(p + 12);
        const float s = (((a[0] + a[1]) + (a[2] + a[3])) + ((b4[0] + b4[1]) + (b4[2] + b4[3]))) + (((c[0] + c[1]) + (c[2] + c[3])) + ((d[0] + d[1]) + (d[2] + d[3])));
        tab[(u.tb * 256 + row) * 2 + grp] = 1.0f / sqrtf(s * (1.0f / 1024.f) + RMS_EPS);
    }
    __device__ __forceinline__ void mid(f32x4 (&acc)[2][2][4][2], const pg8::Unit& u, int wr, int fr) const {
#pragma unroll
        for (int ai = 0; ai < 2; ++ai)
#pragma unroll
            for (int m = 0; m < 4; ++m) { const int r = ai * 128 + wr * 64 + m * 16 + fr; const float f = tab[(u.tb * 256 + r) * 2] / tab[(u.tb * 256 + r) * 2 + 1];
#pragma unroll
                for (int bj = 0; bj < 2; ++bj)
#pragma unroll
                    for (int n = 0; n < 2; ++n) acc[ai][bj][m][n] *= f; }
    }
    __device__ __forceinline__ void operator()(const f32x4 (&acc)[2][2][4][2], const pg8::Unit& u, int wr, int wc, int fr, int fq) const {
        const int row0 = u.pm * 256 + wr * 64 + fr, col0 = u.pn * 256 + wc * 32 + 8 * fq;
#pragma unroll
        for (int am = 0; am < 4; ++am) {
            u32x4 hv[2][2]; float rb[2];
#pragma unroll
            for (int q = 0; q < 2; ++q) { const int ai = am >> 1, m = (am & 1) * 2 + q; const size_t off = (size_t)(row0 + ai * 128 + m * 16) * D + col0;
                rb[q] = tab[(u.tb * 256 + ai * 128 + wr * 64 + m * 16 + fr) * 2 + 1];
#pragma unroll
                for (int bj = 0; bj < 2; ++bj) hv[q][bj] = *(const u32x4*)(H0 + off + bj * 128); }
#pragma unroll
            for (int q = 0; q < 2; ++q) { const int ai = am >> 1, m = (am & 1) * 2 + q; const size_t off = (size_t)(row0 + ai * 128 + m * 16) * D + col0;
#pragma unroll
                for (int bj = 0; bj < 2; ++bj) { const u32x4 h4 = hv[q][bj];
                    const f32x4 h0v = (f32x4){__uint_as_float(h4.x << 16), __uint_as_float(h4.x & 0xffff0000u), __uint_as_float(h4.y << 16), __uint_as_float(h4.y & 0xffff0000u)};
                    const f32x4 h1v = (f32x4){__uint_as_float(h4.z << 16), __uint_as_float(h4.z & 0xffff0000u), __uint_as_float(h4.w << 16), __uint_as_float(h4.w & 0xffff0000u)};
                    const f32x4 v0 = acc[ai][bj][m][0] * rb[q] + h0v * ALPHA, v1 = acc[ai][bj][m][1] * rb[q] + h1v * ALPHA; u32x4 w;
                    w.x = pg8::cvt_pk_bf16(v0[0], v0[1]); w.y = pg8::cvt_pk_bf16(v0[2], v0[3]); w.z = pg8::cvt_pk_bf16(v1[0], v1[1]); w.w = pg8::cvt_pk_bf16(v1[2], v1[3]);
                    *(u32x4*)(Z + off + bj * 128) = w; } }
            asm volatile("" ::: "memory"); }
    }
};
__device__ __forceinline__ float silu_mul(float g, float u) { return g * __builtin_amdgcn_rcpf(1.0f + __builtin_amdgcn_exp2f(-g * LOG2E)) * u; }
struct EpiGU {
    static constexpr bool F8 = true; static constexpr bool PERM2 = false; static constexpr bool MIDK = false; static constexpr bool PERM = true; unsigned char* H; const float* wl;
    __device__ __forceinline__ void operator()(const f32x4 (&acc)[2][2][4][2], const pg8::Unit& u, int wr, int wc, int fr, int fq) const {
        int rl0 = wr * 64 + fr, col0 = u.pn * 128 + wc * 32 + 8 * fq; asm volatile("" : "+v"(rl0), "+v"(col0));
        float wv[2][4];
#pragma unroll
        for (int ai = 0; ai < 2; ++ai)
#pragma unroll
            for (int m = 0; m < 4; ++m) { const int r = u.r0 + rl0 + ai * 128 + m * 16; wv[ai][m] = (u.e < NE ? (r < u.n ? wl[(size_t)u.e * NTOK + r] : 0.f) : 1.0f) * (S8_GU_INV * S8_HB); }
#pragma unroll
        for (int ai = 0; ai < 2; ++ai)
#pragma unroll
            for (int m = 0; m < 4; ++m) { const f32x4 g0 = acc[ai][0][m][0] * S8_GU_INV, g1 = acc[ai][0][m][1] * S8_GU_INV, u0 = acc[ai][1][m][0] * wv[ai][m], u1 = acc[ai][1][m][1] * wv[ai][m];
                const u32x2 w = (u32x2){e4m3x4(silu_mul(g0[0], u0[0]), silu_mul(g0[1], u0[1]), silu_mul(g0[2], u0[2]), silu_mul(g0[3], u0[3])),
                                        e4m3x4(silu_mul(g1[0], u1[0]), silu_mul(g1[1], u1[1]), silu_mul(g1[2], u1[2]), silu_mul(g1[3], u1[3]))};
                *(u32x2*)(H + (size_t)(u.orow + rl0 + ai * 128 + m * 16) * DE + col0) = w; }
    }
};
struct EpiDownR {
    static constexpr bool F8 = true; static constexpr bool PERM2 = true; static constexpr bool MIDK = false; static constexpr bool PERM = true; unsigned char* Y; int nostore;
    __device__ __forceinline__ void operator()(const f32x4 (&acc)[2][2][4][2], const pg8::Unit& u, int wr, int wc, int fr, int fq) const {
        int rl0 = wr * 64 + fr, col0 = u.pn * 256 + wc * 64 + 16 * fq; asm volatile("" : "+v"(rl0), "+v"(col0));
        if (nostore) {
#pragma unroll
            for (int ai = 0; ai < 2; ++ai)
#pragma unroll
                for (int bj = 0; bj < 2; ++bj)
#pragma unroll
                    for (int m = 0; m < 4; ++m)
#pragma unroll
                        for (int n = 0; n < 2; ++n) asm volatile("" :: "v"(acc[ai][bj][m][n]));
            return; }
#pragma unroll
        for (int ai = 0; ai < 2; ++ai)
#pragma unroll
            for (int m = 0; m < 4; ++m) { const int rl = rl0 + ai * 128 + m * 16; if (u.r0 + rl >= u.n) continue;
                f32x4 a0 = acc[ai][0][m][0], a1 = acc[ai][0][m][1], b0 = acc[ai][1][m][0], b1 = acc[ai][1][m][1];
                asm volatile("" : "+v"(a0), "+v"(a1), "+v"(b0), "+v"(b1));
                const u32x4 q = (u32x4){ym8x4(a0[0], a0[1], a0[2], a0[3]), ym8x4(a1[0], a1[1], a1[2], a1[3]), ym8x4(b0[0], b0[1], b0[2], b0[3]), ym8x4(b1[0], b1[1], b1[2], b1[3])};
                *(u32x4*)(Y + (size_t)(u.orow + rl) * D + col0) = q;
                asm volatile("" ::: "memory"); }
    }
};
struct EpiDownS {
    static constexpr bool F8 = true; static constexpr bool PERM2 = false; static constexpr bool MIDK = false; static constexpr bool PERM = true; bf16_t* O; const bf16_t* H1;
    __device__ __forceinline__ void operator()(const f32x4 (&acc)[2][2][4][2], const pg8::Unit& u, int wr, int wc, int fr, int fq) const {
        int rl0 = wr * 64 + fr, col0 = u.pn * 256 + wc * 32 + 8 * fq; asm volatile("" : "+v"(rl0), "+v"(col0));
#pragma unroll
        for (int am = 0; am < 4; ++am) {
            u32x4 hv[2][2];
#pragma unroll
            for (int q = 0; q < 2; ++q) { const int ai = am >> 1, m = (am & 1) * 2 + q; const size_t off = (size_t)(u.r0 + rl0 + ai * 128 + m * 16) * D + col0;
#pragma unroll
                for (int bj = 0; bj < 2; ++bj) hv[q][bj] = *(const u32x4*)(H1 + off + bj * 128); }
#pragma unroll
            for (int q = 0; q < 2; ++q) { const int ai = am >> 1, m = (am & 1) * 2 + q; const size_t off = (size_t)(u.r0 + rl0 + ai * 128 + m * 16) * D + col0;
#pragma unroll
                for (int bj = 0; bj < 2; ++bj) { const u32x4 h4 = hv[q][bj];
                    const f32x4 h0v = (f32x4){__uint_as_float(h4.x << 16), __uint_as_float(h4.x & 0xffff0000u), __uint_as_float(h4.y << 16), __uint_as_float(h4.y & 0xffff0000u)};
                    const f32x4 h1v = (f32x4){__uint_as_float(h4.z << 16), __uint_as_float(h4.z & 0xffff0000u), __uint_as_float(h4.w << 16), __uint_as_float(h4.w & 0xffff0000u)};
                    const f32x4 v0 = acc[ai][bj][m][0] * S8_DN_INV + h0v * ALPHA, v1 = acc[ai][bj][m][1] * S8_DN_INV + h1v * ALPHA; u32x4 w;
                    w.x = pg8::cvt_pk_bf16(v0[0], v0[1]); w.y = pg8::cvt_pk_bf16(v0[2], v0[3]); w.z = pg8::cvt_pk_bf16(v1[0], v1[1]); w.w = pg8::cvt_pk_bf16(v1[2], v1[3]);
                    *(u32x4*)(O + off + bj * 128) = w; } }
            asm volatile("" ::: "memory"); }
    }
};

#ifndef FAST_P2
#define FAST_P2 1
#endif
namespace att {
typedef short bf16x8 __attribute__((ext_vector_type(8)));
typedef short s16x4 __attribute__((ext_vector_type(4)));
typedef float f32x16 __attribute__((ext_vector_type(16)));
typedef LAS const char* lds_cptr;
constexpr int SLOT = 16384, NSLOT = 6, RING = NSLOT * SLOT;
constexpr int TA_W = 452, TA_OFF = 224;
constexpr int TB_W = 468;
constexpr int OFF_TABA = RING, OFF_TABB = OFF_TABA, OFF_WS = OFF_TABA + 4 * TA_W * 4, OFF_OST = OFF_WS + 8 * 256, ATT_LDS = OFF_OST + 8 * 4096;
static_assert(ATT_LDS <= LDS_BYTES - 16 - 1024, "attention LDS map");
constexpr float NEGB = -1e30f, THR = 8.0f;
#define ATT_MFMA(a, b, c) __builtin_amdgcn_mfma_f32_32x32x16_bf16(a, b, c, 0, 0, 0)
__device__ __forceinline__ int crow(int r, int hi) { return (r & 3) + 8 * (r >> 2) + 4 * hi; }
__device__ __forceinline__ s16x4 vtr(lds_cptr p) { typedef short v4i16_t __attribute__((ext_vector_type(4))); return __builtin_bit_cast(s16x4, __builtin_amdgcn_ds_read_tr16_b64_v4i16((LAS v4i16_t*)p)); }
__device__ __forceinline__ float swapmax(float m) { auto rr = __builtin_amdgcn_permlane32_swap(__float_as_uint(m), __float_as_uint(m), false, false); return fmaxf(__uint_as_float(rr[0]), __uint_as_float(rr[1])); }
__device__ __forceinline__ float swapsum(float m) { auto rr = __builtin_amdgcn_permlane32_swap(__float_as_uint(m), __float_as_uint(m), false, false); return __uint_as_float(rr[0]) + __uint_as_float(rr[1]); }

__device__ __forceinline__ float bf16r(float x) { return __uint_as_float(pg8::cvt_pk_bf16(x, 0.f) << 16); }
__device__ __forceinline__ bf16x8 frag_k0(unsigned bits16, int hi) { const u32x4 w = (u32x4){hi == 0 ? bits16 : 0u, 0u, 0u, 0u}; return __builtin_bit_cast(bf16x8, w); }
template <int NH, int NS, class BiasFn>
__device__ __forceinline__ void tile_qb(const bf16x8 (&kf)[8], const bf16x8 (&qr)[4], bf16x8& mq, const bf16x8& ones, lds_cptr vp, f32x16 (&o)[2], float& m, float& l, LAS float* wsf, int r32, int hi, const BiasFn& bias) {
    f32x16 c[NH];
#pragma unroll
    for (int hf = 0; hf < NH; ++hf)
#pragma unroll
        for (int r = 0; r < 16; ++r) c[hf][r] = bias(hf, r);
    s16x4 vlo[NS][2], vhi[NS][2];
#pragma unroll
    for (int dh = 0; dh < 2; ++dh) { vlo[0][dh] = vtr(vp + dh * 4096); vhi[0][dh] = vtr(vp + dh * 4096 + 512); }
    __builtin_amdgcn_sched_barrier(0);
#pragma unroll
    for (int hf = 0; hf < NH; ++hf) { c[hf] = ATT_MFMA(ones, mq, c[hf]);
#pragma unroll
        for (int d0 = 0; d0 < 4; ++d0) c[hf] = ATT_MFMA(kf[2 * d0 + hf], qr[d0], c[hf]); }
    float mx = NEGB;
#pragma unroll
    for (int hf = 0; hf < NH; ++hf)
#pragma unroll
        for (int r = 0; r < 16; ++r) mx = fmaxf(mx, c[hf][r]);
    mx = swapmax(mx);
    if (__any(mx > THR)) {
        const float mn = bf16r(m + fmaxf(mx, 0.f)), dl = mn - m, f = __builtin_amdgcn_exp2f(-dl); m = mn; l *= f;
        mq = frag_k0(__float_as_uint(-mn) >> 16, hi);
        if (hi == 0) wsf[r32] = f;
        asm volatile("s_waitcnt lgkmcnt(0)" ::: "memory");
#pragma unroll
        for (int r = 0; r < 16; ++r) { const float fr = wsf[crow(r, hi)]; o[0][r] *= fr; o[1][r] *= fr; }
#pragma unroll
        for (int hf = 0; hf < NH; ++hf)
#pragma unroll
            for (int r = 0; r < 16; ++r) c[hf][r] -= dl;
    }
#pragma unroll
    for (int s = 1; s < NS; ++s)
#pragma unroll
        for (int dh = 0; dh < 2; ++dh) { vlo[s][dh] = vtr(vp + dh * 4096 + s * 1024); vhi[s][dh] = vtr(vp + dh * 4096 + s * 1024 + 512); }
    __builtin_amdgcn_sched_barrier(0);
    float ls = 0.f;
#pragma unroll
    for (int hf = 0; hf < NH; ++hf)
#pragma unroll
        for (int r = 0; r < 16; ++r) { c[hf][r] = __builtin_amdgcn_exp2f(c[hf][r]); ls += c[hf][r]; }
    l += ls;
#pragma unroll
    for (int s = 0; s < NS; ++s) {
        const f32x16& cc = c[s >> 1]; const int rb = (s & 1) * 8;
        u32x4 pw; pw.x = pg8::cvt_pk_bf16(cc[rb + 0], cc[rb + 1]); pw.y = pg8::cvt_pk_bf16(cc[rb + 2], cc[rb + 3]); pw.z = pg8::cvt_pk_bf16(cc[rb + 4], cc[rb + 5]); pw.w = pg8::cvt_pk_bf16(cc[rb + 6], cc[rb + 7]);
        const bf16x8 pa = __builtin_bit_cast(bf16x8, pw);
#pragma unroll
        for (int dh = 0; dh < 2; ++dh) { const s16x4 lo = vlo[s][dh], hi4 = vhi[s][dh];
            const bf16x8 vf = (bf16x8){lo[0], lo[1], lo[2], lo[3], hi4[0], hi4[1], hi4[2], hi4[3]};
            o[dh] = ATT_MFMA(pa, vf, o[dh]); }
    }
}
template <class TokFn>
__device__ __forceinline__ void finish_qb(const Frame& F, f32x16 (&o)[2], float l, LAS float* wsf, LAS bf16_t* stg, int lane, int r32, int hi, int ocol, int hidx, const TokFn& tokq) {
    l = swapsum(l);
    asm volatile("s_waitcnt lgkmcnt(0)" ::: "memory");
    if (hi == 0) wsf[32 + r32] = l;
    asm volatile("s_waitcnt lgkmcnt(0)" ::: "memory");
#pragma unroll
    for (int r = 0; r < 16; ++r) { const int orow = crow(r, hi); const float rl = __builtin_amdgcn_rcpf(wsf[32 + orow]);
        stg[orow * 64 + r32] = f2bf(o[0][r] * rl); stg[orow * 64 + 32 + r32] = f2bf(o[1][r] * rl); }
    asm volatile("s_waitcnt lgkmcnt(0)" ::: "memory");
#pragma unroll
    for (int i = 0; i < 4; ++i) { const int row = i * 8 + (lane >> 3), ch = lane & 7; const u32x4 w = *(const LAS u32x4*)(stg + row * 64 + ch * 8); const int tok = tokq(row);
        *(u32x4*)(F.ya() + (size_t)tok * D + ocol + ch * 8) = w;
        float q = 0.f;
#pragma unroll
        for (int j = 0; j < 4; ++j) { const float a = __uint_as_float(w[j] << 16), b = __uint_as_float(w[j] & 0xffff0000u); q += a * a + b * b; }
        q += __shfl_xor(q, 1); q += __shfl_xor(q, 2); q += __shfl_xor(q, 4);
        if (ch == 0) F.ssq()[tok * 32 + hidx] = q; }
    asm volatile("s_waitcnt lgkmcnt(0)" ::: "memory");
}

template <int MODE>
__device__ __forceinline__ void attn_unit(const Frame& F, int L) {
    LAS unsigned char* lds = F.lds;
    const int lane = F.lane, wid = F.wave, r32 = lane & 31, hi = lane >> 5;
    LAS float* wsf = (LAS float*)(lds + OFF_WS + wid * 256); LAS bf16_t* stg = (LAS bf16_t*)(lds + OFF_OST + wid * 4096);
    int b, kcol, vcol, qcol, ocol, hidx, nband, trow0, qtok0;
    int hb = 0, qbw = 0, kt0 = 0;
    int R0 = 0, pr = 0, jc = 0, cb = 0, kr0 = 0;
    if (MODE == 0) { const int kvh = L & 3; hb = (L >> 2) & 127; b = L >> 9; const int hq = 4 * kvh + (wid >> 1); qbw = wid & 1;
        qcol = COL_QA + hq * 64; kcol = COL_KA + kvh * 64; vcol = COL_VA + kvh * 64; ocol = hq * 64; hidx = hq;
        kt0 = max(0, hb - 2); const int kt1 = min(127, hb + 2); nband = kt1 - kt0 + 1; trow0 = b * SEQ + 64 * kt0; qtok0 = b * SEQ + 64 * hb + 32 * qbw;
    } else { const int h = L & 15, rb = (L >> 4) & 31; b = L >> 9; R0 = rb * 4; pr = wid >> 2; jc = wid & 3; cb = min(max(16 * jc - 8, 0), 32);
        qcol = COL_QB + h * 64; kcol = COL_KB + h * 64; vcol = COL_VB + h * 64; ocol = 1024 + h * 64; hidx = 16 + h;
        kr0 = min(max(R0 - 4, 0), 120); const int kr1 = min(max(R0 + 3 - 4, 0), 120) + 7; nband = kr1 - kr0 + 1; trow0 = b * SEQ + kr0 * 64; qtok0 = b * SEQ + (R0 + 2 * pr) * 64 + 16 * jc; }
    const int NT = 1 + nband;
    const bf16_t* ksrc = F.u() + (size_t)lane * INW + kcol + wid * 8;
    const bf16_t* vsrc = F.u() + (size_t)(16 * (wid & 3) + (lane >> 2)) * INW + vcol + (wid >> 2) * 32 + (lane & 3) * 8;
#define ATT_TROW(t) ((t) == 0 ? NTOK : trow0 + ((t) - 1) * 64)
#define ATT_ISSUE(t) do { const size_t ro_ = (size_t)ATT_TROW(t) * INW; const int sl_ = ((t) % NSLOT) * SLOT; \
        __builtin_amdgcn_global_load_lds((const unsigned*)(ksrc + ro_), (LAS unsigned*)(lds + sl_ + wid * 1024), 16, 0, 0); \
        __builtin_amdgcn_global_load_lds((const unsigned*)(vsrc + ro_), (LAS unsigned*)(lds + sl_ + 8192 + wid * 1024), 16, 0, 0); } while (0)
    bf16x8 qr[4];
    { const int tok = MODE == 0 ? qtok0 + r32 : qtok0 + (r32 >> 4) * 64 + (r32 & 15);
#pragma unroll
      for (int d0 = 0; d0 < 4; ++d0) qr[d0] = *(const bf16x8*)(F.u() + (size_t)tok * INW + qcol + d0 * 16 + hi * 8); }
    if (MODE == 0) { LAS float* tA = (LAS float*)(lds + OFF_TABA); const int h0 = 4 * (L & 3);
        for (int i = F.tid; i < 4 * TA_W; i += 512) { const int g = i / TA_W, rel = i % TA_W - TA_OFF; tA[i] = (rel >= -128 && rel <= 128) ? F.tab()[(h0 + g) * 272 + rel + 128] : NEGB; } }
    else { LAS float* tB = (LAS float*)(lds + OFF_TABB); const int h = L & 15;
        for (int i = F.tid; i < 576; i += 512) { const int k = i - 16; tB[i] = (k >= 0 && k < 465) ? F.rpb[h * 465 + k] * LOG2E : ((k >= 465 && k < 496) ? NEGB : 0.f); } }
#pragma unroll
    for (int t = 0; t < 5; ++t) if (t < NT) ATT_ISSUE(t);
    f32x16 o[2]; o[0] = f32x16{}; o[1] = f32x16{}; float m = 0.f, l = 0.f;
    bf16x8 mq = frag_k0(0u, hi); const bf16x8 ones = frag_k0(0x3F80u, hi);
    const LAS float* tabA = (const LAS float*)(lds + OFF_TABA) + (MODE == 0 ? (wid >> 1) : 0) * TA_W;
    const LAS float* tabB = (const LAS float*)(lds + OFF_TABB);
    const int qpos = 64 * hb + 32 * qbw + r32;
    const int qrow = R0 + 2 * pr + (r32 >> 4), qc = 16 * jc + (r32 & 15), rs = min(max(qrow - 4, 0), 120), cs = min(max(qc - 8, 0), 48);
    const int rsw0 = min(max(R0 + 2 * pr - 4, 0), 120), rsw1 = min(max(R0 + 2 * pr + 1 - 4, 0), 120);
    float cm[16];
#pragma unroll
    for (int r = 0; r < 16; ++r) { const int kc = cb + 4 * hi + (r & 3) + 8 * (r >> 2); cm[r] = (MODE == 1 && !(kc >= cs && kc < cs + 16)) ? NEGB : 0.f; }
    const int dc0 = cb + 4 * hi - qc + 15 + 16;
    for (int t = 0; t < NT; ++t) {
        { const int ahead = NT - 1 - t;
          if (ahead >= 4) asm volatile("s_waitcnt vmcnt(8)" ::: "memory"); else if (ahead == 3) asm volatile("s_waitcnt vmcnt(6)" ::: "memory");
          else if (ahead == 2) asm volatile("s_waitcnt vmcnt(4)" ::: "memory"); else if (ahead == 1) asm volatile("s_waitcnt vmcnt(2)" ::: "memory"); else asm volatile("s_waitcnt vmcnt(0)" ::: "memory"); }
        asm volatile("s_waitcnt lgkmcnt(0)" ::: "memory");
        __builtin_amdgcn_s_barrier();
        if (t + 5 < NT) ATT_ISSUE(t + 5);
        const int slot = (t % NSLOT) * SLOT;
        if (MODE == 1 && t > 0) { const int kr = kr0 + t - 1; if (kr < rsw0 || kr > rsw1 + 7) continue; }
        const int cbt = (MODE == 1 && t > 0) ? cb : 0;
        const lds_cptr kp = (lds_cptr)lds + slot + hi * 1024 + (r32 + cbt) * 16;
        const lds_cptr vp = (lds_cptr)lds + slot + 8192 + ((lane >> 4) & 1) * 32 + (lane & 3) * 8 + (4 * hi + ((lane & 15) >> 2) + cbt) * 64;
        bf16x8 kf[8];
        if (MODE == 0 && t > 0) {
#pragma unroll
            for (int d0 = 0; d0 < 4; ++d0) { kf[2 * d0] = *(const LAS bf16x8*)(kp + d0 * 2048); kf[2 * d0 + 1] = *(const LAS bf16x8*)(kp + d0 * 2048 + 512); }
        } else {
#pragma unroll
            for (int d0 = 0; d0 < 4; ++d0) { kf[2 * d0] = *(const LAS bf16x8*)(kp + d0 * 2048); kf[2 * d0 + 1] = kf[2 * d0]; }
        }
        if (t == 0) {
            if (MODE == 0) tile_qb<1, 1>(kf, qr, mq, ones, vp, o, m, l, wsf, r32, hi, [&](int, int r) { return r < 8 ? tabA[max(crow(r, hi) - 16 - qpos, -128) + TA_OFF] : NEGB; });
            else tile_qb<1, 1>(kf, qr, mq, ones, vp, o, m, l, wsf, r32, hi, [&](int, int r) { return r < 8 ? 0.f : NEGB; });
        } else if (MODE == 0) { const volatile LAS float* bp = tabA + 64 * (kt0 + t - 1) + 4 * hi - qpos + TA_OFF;
            tile_qb<2, 4>(kf, qr, mq, ones, vp, o, m, l, wsf, r32, hi, [&](int hf, int r) { return bp[32 * hf + (r & 3) + 8 * (r >> 2)]; });
        } else { const int kr = kr0 + t - 1; const bool rowok = kr >= rs && kr <= rs + 7; const volatile LAS float* bp = tabB + (rowok ? kr - qrow + 7 : 15) * 31 + dc0;
            tile_qb<1, 2>(kf, qr, mq, ones, vp, o, m, l, wsf, r32, hi, [&](int, int r) { return bp[(r & 3) + 8 * (r >> 2)] + cm[r]; });
        }
    }
    if (MODE == 0) { if (hi == 0) l += __builtin_amdgcn_exp2f(F.sink[hidx] * LOG2E - m); }
    if (MODE == 0) finish_qb(F, o, l, wsf, stg, lane, r32, hi, ocol, hidx, [&](int q) { return qtok0 + q; });
    else finish_qb(F, o, l, wsf, stg, lane, r32, hi, ocol, hidx, [&](int q) { return qtok0 + (q >> 4) * 64 + (q & 15); });
    __builtin_amdgcn_s_barrier();
#undef ATT_TROW
#undef ATT_ISSUE
}
__device__ __forceinline__ void attn_phase(const Frame& F, int mask = 3) {
    __syncthreads();
    int L = F.bx, un = 0; const int slot = (mask & 8) ? ((F.bx >> 3) & 7) : 0;
    for (; L < 2048 && un < slot; L += F.G, ++un) { if (L < 1024) { if (mask & 1) attn_unit<0>(F, L); } else if (mask & 2) attn_unit<1>(F, L - 1024); }
    if (mask & 8) { __syncthreads(); const int n = (IT_P6 - IT_MID + F.G - 1) / F.G, a = IT_MID + F.bx * n, e = a + n < IT_P6 ? a + n : IT_P6; if (a < e) conv_range(F, a, e); __syncthreads(); }
    for (; L < 2048; L += F.G) { if (L < 1024) { if (mask & 1) attn_unit<0>(F, L); } else if (mask & 2) attn_unit<1>(F, L - 1024); }
    __syncthreads();
}
}

#ifndef FAST_P5
#define FAST_P5 1
#endif
__device__ __forceinline__ void route_token(const Frame& F, int tok, float lg, int lane) {
    const float score = 1.0f / (1.0f + expf(-lg)), v0 = score + F.rbias[lane];
    int rk = 0;
#pragma unroll
    for (int j = 0; j < 8; ++j) { const int o = (lane & ~7) + j; const float w = __shfl(v0, o); rk += (w > v0 || (w == v0 && o < lane)) ? 1 : 0; }
    float gs = rk < 2 ? v0 : 0.f; gs += __shfl_xor(gs, 1); gs += __shfl_xor(gs, 2); gs += __shfl_xor(gs, 4);
    int grk = 0; const int myg = lane >> 3;
#pragma unroll
    for (int g = 0; g < 8; ++g) { const float w = __shfl(gs, g * 8); grk += (w > gs || (w == gs && g < myg)) ? 1 : 0; }
    const float mv = grk < 4 ? v0 : -INFINITY;
    int erk = 0;
    for (int o = 0; o < 64; ++o) { const float w = __shfl(mv, o); erk += (w > mv || (w == mv && o < lane)) ? 1 : 0; }
    const bool sel = erk < 8;
    const float wsm = wsum(sel ? score : 0.f), wgt = score / (wsm + 1e-20f) * 2.5f;
    if (sel) { const int rr = atomicAdd(F.cnt() + lane, 1); F.tokl()[(size_t)lane * NTOK + rr] = tok; F.wl()[(size_t)lane * NTOK + rr] = wgt; F.tke()[tok * 8 + erk] = lane; F.tkr()[tok * 8 + erk] = rr; }
}
__device__ __forceinline__ void route_token_local(const Frame& F, int tl  , float lg, int lane, LAS int* lcnt, LAS int* sel_e, LAS int* sel_lr, LAS float* sel_w) {
    lg = (lg == lg) ? lg : 0.f;
    const float score = 1.0f / (1.0f + expf(-lg)), v0 = score + F.rbias[lane];
    int rk = 0;
#pragma unroll
    for (int j = 0; j < 8; ++j) { const int o = (lane & ~7) + j; const float w = __shfl(v0, o); rk += (w > v0 || (w == v0 && o < lane)) ? 1 : 0; }
    float gs = rk < 2 ? v0 : 0.f; gs += __shfl_xor(gs, 1); gs += __shfl_xor(gs, 2); gs += __shfl_xor(gs, 4);
    int grk = 0; const int myg = lane >> 3;
#pragma unroll
    for (int g = 0; g < 8; ++g) { const float w = __shfl(gs, g * 8); grk += (w > gs || (w == gs && g < myg)) ? 1 : 0; }
    const float mv = grk < 4 ? v0 : -INFINITY;
    int erk = 0;
#pragma unroll 16
    for (int o = 0; o < 64; ++o) { const float w = __shfl(mv, o); erk += (w > mv || (w == mv && o < lane)) ? 1 : 0; }
    const bool sel = erk < 8;
    const float wsm = wsum(sel ? score : 0.f), wgt = score / (wsm + 1e-20f) * 2.5f;
    if (sel) { const int lr = __hip_atomic_fetch_add(lcnt + lane, 1, __ATOMIC_RELAXED, __HIP_MEMORY_SCOPE_WORKGROUP); sel_e[tl * 8 + erk] = lane; sel_lr[tl * 8 + erk] = lr; sel_w[tl * 8 + erk] = wgt; }
}
__device__ __forceinline__ void phase_ln1_router_fast(Frame& F) {
    constexpr int HSTR = 4112;
    LAS unsigned char* hb = F.lds; LAS float* part = (LAS float*)F.lds;
    LAS int* lcnt = (LAS int*)(F.lds + 132096); LAS int* lbase = lcnt + 64; LAS int* sel_e = lcnt + 128; LAS int* sel_lr = sel_e + 512; LAS float* sel_w = (LAS float*)(sel_lr + 512);
    const int lane = F.lane, w = F.wave, r32 = lane & 31, hi = lane >> 5;
    for (int it2 = F.bx; it2 < NTOK / 64; it2 += F.G) {
        if (F.tid < 64) lcnt[F.tid] = 0;
        for (int sub = 0; sub < 2; ++sub) {
            const int t0 = it2 * 64 + sub * 32;
            u32x4 raw[4][4];
#pragma unroll
            for (int q = 0; q < 4; ++q) { const bf16_t* src = F.z() + (size_t)(t0 + 4 * w + q) * D;
#pragma unroll
                for (int j = 0; j < 4; ++j) raw[q][j] = *(const u32x4*)(src + (lane + 64 * j) * 8); }
#pragma unroll
            for (int q = 0; q < 4; ++q) { const int row = 4 * w + q, tok = t0 + row; float v[4][8]; float s = 0.f;
#pragma unroll
                for (int j = 0; j < 4; ++j)
#pragma unroll
                    for (int i = 0; i < 4; ++i) { v[j][2 * i] = __uint_as_float(raw[q][j][i] << 16); v[j][2 * i + 1] = __uint_as_float(raw[q][j][i] & 0xffff0000u); s += v[j][2 * i] + v[j][2 * i + 1]; }
                const float mu = wsum(s) * (1.0f / D); float qq = 0.f;
#pragma unroll
                for (int j = 0; j < 4; ++j)
#pragma unroll
                    for (int i = 0; i < 8; ++i) { const float d = v[j][i] - mu; qq += d * d; }
                const float rstd = 1.0f / sqrtf(wsum(qq) * (1.0f / D) + LN_EPS);
#pragma unroll
                for (int j = 0; j < 4; ++j) { const int c = (lane + 64 * j) * 8; const f32x4 g0 = *(const f32x4*)(F.l1g + c), g1 = *(const f32x4*)(F.l1g + c + 4), b0 = *(const f32x4*)(F.l1b + c), b1 = *(const f32x4*)(F.l1b + c + 4);
                    u32x4 pk; float y[8];
#pragma unroll
                    for (int i = 0; i < 4; ++i) { y[i] = (v[j][i] - mu) * rstd * g0[i] + b0[i]; y[4 + i] = (v[j][4 + i] - mu) * rstd * g1[i] + b1[i]; }
                    pk.x = pack2(y[0], y[1]); pk.y = pack2(y[2], y[3]); pk.z = pack2(y[4], y[5]); pk.w = pack2(y[6], y[7]);
                    *(u32x4*)(F.h1() + (size_t)tok * D + c) = pk; *(LAS u32x4*)(hb + row * HSTR + c * 2) = pk;
                    *(u32x2*)(F.h1q() + (size_t)tok * D + c) = (u32x2){e4m3x4(y[0] * S8_H1, y[1] * S8_H1, y[2] * S8_H1, y[3] * S8_H1), e4m3x4(y[4] * S8_H1, y[5] * S8_H1, y[6] * S8_H1, y[7] * S8_H1)}; }
                if (lane == 0) { F.stats1()[tok * 2] = mu; F.stats1()[tok * 2 + 1] = rstd; } }
            __syncthreads();
            att::f32x16 acc[2]; acc[0] = att::f32x16{}; acc[1] = att::f32x16{};
            const bf16_t* wb = F.wrt() + (size_t)r32 * D + 256 * w + hi * 8;
#pragma unroll 8
            for (int s = 0; s < 16; ++s) {
                const att::bf16x8 a = *(const LAS att::bf16x8*)(hb + r32 * HSTR + (256 * w + 16 * s + 8 * hi) * 2);
                const att::bf16x8 b0 = *(const att::bf16x8*)(wb + 16 * s), b1 = *(const att::bf16x8*)(wb + (size_t)32 * D + 16 * s);
                acc[0] = __builtin_amdgcn_mfma_f32_32x32x16_bf16(a, b0, acc[0], 0, 0, 0); acc[1] = __builtin_amdgcn_mfma_f32_32x32x16_bf16(a, b1, acc[1], 0, 0, 0); }
            __syncthreads();
#pragma unroll
            for (int nt = 0; nt < 2; ++nt)
#pragma unroll
                for (int r = 0; r < 16; ++r) part[(w * 32 + att::crow(r, hi)) * 64 + 32 * nt + r32] = acc[nt][r];
            __syncthreads();
            for (int q = 0; q < 4; ++q) { const int row = 4 * w + q; float lg = 0.f;
#pragma unroll
                for (int ww = 0; ww < 8; ++ww) lg += part[(ww * 32 + row) * 64 + lane];
                route_token_local(F, sub * 32 + row, lg, lane, lcnt, sel_e, sel_lr, sel_w); }
            __syncthreads();
        }
        if (F.tid < 64) { const int n = lcnt[F.tid]; lbase[F.tid] = n > 0 ? atomicAdd(F.cnt() + F.tid, n) : 0; }
        __syncthreads();
        { const int tl = F.tid >> 3, slot = F.tid & 7, e = sel_e[F.tid], rr = lbase[e] + sel_lr[F.tid], tok = it2 * 64 + tl;
          F.tokl()[(size_t)e * NTOK + rr] = tok; F.wl()[(size_t)e * NTOK + rr] = sel_w[F.tid]; F.tke()[tok * 8 + slot] = e; F.tkr()[tok * 8 + slot] = rr; }
        __syncthreads();
    }
}

__global__ void __launch_bounds__(512, 2) mk_fwd(Args args) {
    extern __shared__ __attribute__((aligned(16))) unsigned char lds_raw[];
    Frame F; F.lds = (LAS unsigned char*)lds_raw; F.wave0 = __builtin_amdgcn_readfirstlane((int)threadIdx.x >> 6); F.fresh(); F.G = gridDim.x; F.bx = blockIdx.x;
    F.x = args.in[0]; F.meta = args.in[1]; F.lng = args.in[2]; F.lnb = args.in[3]; F.t5 = args.in[4]; F.w_in = args.in[5]; F.sink = args.in[6]; F.rpb = args.in[7]; F.ga = args.in[8]; F.gb = args.in[9];
    F.w_out = args.in[10]; F.l1g = args.in[11]; F.l1b = args.in[12]; F.w_router = args.in[13]; F.rbias = args.in[14]; F.w_gate = args.in[15]; F.w_up = args.in[16]; F.w_down = args.in[17];
    F.ws_gate = args.in[18]; F.ws_up = args.in[19]; F.ws_down = args.in[20]; F.l2g = args.in[21]; F.l2b = args.in[22]; F.out = args.out; F.ws = args.ws;
    unsigned char* ws = args.ws;
    volatile LAS unsigned* xbw = (volatile LAS unsigned*)(F.lds + LDS_BYTES - 16);
    LAS int* ps = (LAS int*)(F.lds + 131072);
    if (F.tid < 4) xbw[F.tid] = 0u;
    __syncthreads();
    const int lo = args.ph_lo, hi = args.ph_hi;
    XcdBarrier bar; bar.bar = (unsigned*)(ws + WS_CTL); bar.x = 0; bar.st = xbw; bar.wave0 = F.wave0;
    if (hi - lo > 1) bar = xcd_barrier_post((unsigned*)(ws + WS_CTL), xbw, F.wave0);
    unsigned* xcen = (unsigned*)(ws + WS_CTL + 20480);
    if (XCD_TRUE && hi - lo > 1 && F.tid == 0) { const unsigned x = xb_xcc_id(); xbw[2] = x; xbw[3] = xb_add(&xcen[x * 16], 1u); }
#ifndef PROBE_REPEAT
#define PROBE_REPEAT -1
#endif
#ifndef PROBE_SUB
#define PROBE_SUB 3
#endif
#ifndef PROBE_NOSTORE
#define PROBE_NOSTORE 0
#endif
#ifndef PROBE_HOT
#define PROBE_HOT 0
#endif
#ifndef PROBE_NT
#define PROBE_NT 32
#ifndef PROBE_LD
#define PROBE_LD 2048
#endif
#endif
#define IN(k) (lo <= (k) && (k) < hi)
#define SEAM(k) do { if (IN(k) && IN((k) + 1)) xcd_barrier(bar); } while (0)
    if (IN(0)) { F.fresh(); phase_prologue(F);
#if PROBE_REPEAT == 0
        xcd_barrier(bar); phase_prologue(F);
#endif
    } SEAM(0);
#define P1_BODY(rep) do { const int s_ = (rep) ? 0 : F.bx % 5; EpiU E{F.u(), rep}; { SchedInProj S{(const char*)F.h0(), (const char*)F.wtin(), F.G, F.bx, 0, s_}; pg8::gemm_phase(F.wave0, F.lds, S, E, D, D, D / 64); } if (!(rep)) { conv_inproj_share(F); __syncthreads(); } { SchedInProj S{(const char*)F.h0(), (const char*)F.wtin(), F.G, F.bx, s_, 1 << 20}; pg8::gemm_phase(F.wave0, F.lds, S, E, D, D, D / 64); } } while (0)
#define P4_BODY(rep) do { SchedOutProj S{(const char*)F.ya(), (const char*)F.wtout(), F.G, F.bx}; EpiZ E{F.z(), F.h0(), F.ssq(), (LAS float*)(F.lds + 131072 + 6144)}; pg8::gemm_phase(F.wave0, F.lds, S, E, D, D, D / 64, STAGGER4); } while (0)
#define P6_BODY(rep) do { moe_tables(F, ps); SchedGU S{(const char*)F.h1q(), (const char*)F.wtgu(), F.tokl(), F.cnt(), ps, F.G, F.bx, __builtin_amdgcn_readfirstlane(ps[128 + 65])}; EpiGU E{(unsigned char*)F.hb(), F.wl()}; pg8::gemm_phase(F.wave0, F.lds, S, E, D / 2, D / 2, D / 128); if (!(rep)) { F.fresh(); conv_tail(F, IT_P6, IT_ALL, (ps[128 + 65] * 4) % F.G); } } while (0)
#define P7_BODY(rep) do { moe_tables(F, ps); SchedDown S{(const char*)F.hb(), (const char*)F.wtd(), F.cnt(), ps, F.G, F.bx, __builtin_amdgcn_readfirstlane(ps[128 + 64])}; EpiDownR E{(unsigned char*)F.ym(), rep}; pg8::gemm_phase(F.wave0, F.lds, S, E, DE / 2, DE / 2, DE / 128, STAGGER7); SchedDownShared S2{(const char*)F.hb(), (const char*)F.wtd(), F.G, F.bx}; EpiDownS E2{F.o2(), F.h1()}; pg8::gemm_phase(F.wave0, F.lds, S2, E2, DE / 2, DE / 2, DE / 128); } while (0)
    if (XCD_TRUE && hi - lo > 1 && IN(0)) {
        if (F.tid == 0) { unsigned idx = 0, ok = 1, npop = 0; const unsigned x = xbw[2];
            for (unsigned j = 0; j < 16; ++j) { const unsigned cj = xb_ld(&xcen[j * 16]); if (cj) { ++npop; if (cj * 8u != (unsigned)F.G) ok = 0; if (j < x) ++idx; } }
            xbw[2] = (ok && npop == 8) ? xbw[3] * 8u + idx : (unsigned)blockIdx.x; }
        __syncthreads();
        F.bx = __builtin_amdgcn_readfirstlane((int)xbw[2]);
    }
    if (IN(1)) { F.fresh();
#if FAST_P1
        P1_BODY(0);
#if PROBE_REPEAT == 1
        xcd_barrier(bar); P1_BODY(PROBE_NOSTORE);
#endif
#else
        FnInProj f{F}; sgemm(f, F.lds, F.tid, F.bx, F.G);
#endif
#if PROBE_REPEAT == 9
        xcd_barrier(bar); if (F.bx % 8 == 0) { conv_range(F, IT_P0 + T_OUT, IT_P0 + T_OUT + 512); __syncthreads(); }
#endif
    } SEAM(1);
    if (IN(2)) { F.fresh();
#if FAST_P2
        att::attn_phase(F, 3 | 8);
#if PROBE_REPEAT == 2
        xcd_barrier(bar); att::attn_phase(F, PROBE_SUB);
#endif
#else
        phase_attn_simple(F);
#endif
    } SEAM(2);
#if !FAST_P4
    if (IN(3)) { phase_rmsnorm(F); } SEAM(3);
#endif
    if (IN(4)) { F.fresh();
#if FAST_P4
        P4_BODY(0);
#if PROBE_REPEAT == 4
        xcd_barrier(bar); P4_BODY(1);
#endif
#else
        FnOutProj f{F}; sgemm(f, F.lds, F.tid, F.bx, F.G);
#endif
    } SEAM(4);
#if FAST_P5
#define PH5(F) phase_ln1_router_fast(F)
#else
#define PH5(F) phase_ln1_router(F)
#endif
    if (IN(5)) { F.fresh(); PH5(F);
#if PROBE_REPEAT == 5
        xcd_barrier(bar); if (F.bx == 0 && F.tid < 64) F.cnt()[F.tid] = 0; xcd_barrier(bar); PH5(F);
#endif
    } SEAM(5);
    if (IN(6)) { F.fresh();
#if FAST_P6
        P6_BODY(0);
#if PROBE_REPEAT == 6
        xcd_barrier(bar); P6_BODY(1);
#endif
#else
        expert_starts(F, ps); FnGateUp f{F, ps}; sgemm(f, F.lds, F.tid, F.bx, F.G);
#endif
    } SEAM(6);
    if (IN(7)) { F.fresh();
#if FAST_P7
        P7_BODY(0);
#if PROBE_REPEAT == 7
        xcd_barrier(bar); P7_BODY(PROBE_NOSTORE);
#endif
#else
        expert_starts(F, ps); { FnDown f{F, ps}; sgemm(f, F.lds, F.tid, F.bx, F.G); } { FnFinal f{F, ps}; sgemm(f, F.lds, F.tid, F.bx, F.G); }
#endif
    } SEAM(7);
    if (IN(8)) { F.fresh(); expert_starts(F, ps); phase_ln2(F, ps);
#if PROBE_REPEAT == 8
        xcd_barrier(bar); phase_ln2(F, ps);
#endif
    }
#undef IN
#undef SEAM
}

extern "C" void kernel_launch(void* const* d_in, const int* in_sizes, int n_in, void* d_out, int out_size, void* d_ws, size_t ws_size, hipStream_t stream) {
    static int grid = 0;
    if (grid == 0) {
        if (n_in != 23 || in_sizes[0] != NTOK * D || out_size != NTOK * D || ws_size < WS_END) {
            fprintf(stderr, "kernel_launch: built for 23 inputs, x/out of %d floats, >= %zu bytes of workspace; got n_in %d in0 %d out %d ws %zu; nothing launched\n", NTOK * D, (size_t)WS_END, n_in, n_in > 0 ? in_sizes[0] : -1, out_size, ws_size);
            grid = -1; return; }
        int dev = 0, cus = 0, per_cu = 0;
        if (hipGetDevice(&dev) != hipSuccess || hipDeviceGetAttribute(&cus, hipDeviceAttributeMultiprocessorCount, dev) != hipSuccess) { fprintf(stderr, "kernel_launch: device query failed\n"); grid = -1; return; }
        if (hipFuncSetAttribute((const void*)mk_fwd, hipFuncAttributeMaxDynamicSharedMemorySize, LDS_BYTES) != hipSuccess) { fprintf(stderr, "kernel_launch: hipFuncSetAttribute failed\n"); grid = -1; return; }
        if (hipOccupancyMaxActiveBlocksPerMultiprocessor(&per_cu, (const void*)mk_fwd, 512, LDS_BYTES) != hipSuccess || per_cu < 1) fprintf(stderr, "kernel_launch: note: occupancy query reports %d\n", per_cu);
        (void)hipGetLastError();
        grid = cus;
    }
    if (grid < 0) return;
    if (hipMemsetAsync((char*)d_ws + WS_CTL, 0, CTL_BYTES, stream) != hipSuccess) { fprintf(stderr, "kernel_launch: memset failed\n"); return; }
    Args a{};
    for (int i = 0; i < 23; ++i) a.in[i] = (const float*)d_in[i];
    a.out = (float*)d_out; a.ws = (unsigned char*)d_ws;
#if MK_ONE_LAUNCH
    a.ph_lo = 0; a.ph_hi = NPHASE;
    hipLaunchKernelGGL(mk_fwd, dim3(grid), dim3(512), LDS_BYTES, stream, a);
#else
    for (int p = 0; p < NPHASE; ++p) { a.ph_lo = p; a.ph_hi = p + 1; hipLaunchKernelGGL(mk_fwd, dim3(grid), dim3(512), LDS_BYTES, stream, a); }
#endif
    const hipError_t le = hipPeekAtLastError();
    if (le != hipSuccess) fprintf(stderr, "kernel_launch: launch failed: %s\n", hipGetErrorName(le));
}
```

```cpp
#include <hip/hip_runtime.h>
#include <cstdio>
#include <cstdint>

#define LAS __attribute__((address_space(3)))
typedef unsigned short bf16_t;
typedef float f32x4 __attribute__((ext_vector_type(4)));
typedef unsigned u32x4 __attribute__((ext_vector_type(4)));
typedef unsigned u32x2 __attribute__((ext_vector_type(2)));

#ifndef CONV_P2
#define CONV_P2 28160
#endif
#ifndef CONV_NT
#define CONV_NT 1
#endif
#ifndef MK_ONE_LAUNCH
#define MK_ONE_LAUNCH 1
#endif

constexpr int D = 2048, SEQ = 8192, NB = 2, NTOK = NB * SEQ;
constexpr int NMETA = 16, INW = 4608, MROWS = NTOK + 256;
constexpr int NE = 64, DE = 512, PMAX = 147456, HBROWS = PMAX + NTOK;
constexpr float ALPHA = 1.189207115002721f;
constexpr float LN_EPS = 1e-5f, RMS_EPS = 1e-6f, LOG2E = 1.4426950408889634f, QSCALE = 0.125f * LOG2E;
constexpr int COL_QA = 0, COL_KA = 1024, COL_VA = 1280, COL_QB = 1536, COL_KB = 2560, COL_VB = 3584;
constexpr int NPHASE = 9;
constexpr int LDS_BYTES = 147456;

constexpr size_t WS_CTL = 0, CTL_BYTES = 32768;
constexpr size_t WS_CNT = 16384;
constexpr size_t WS_STATS0 = WS_CTL + CTL_BYTES;
constexpr size_t WS_STATS1 = WS_STATS0 + (size_t)NTOK * 8;
constexpr size_t WS_SSQ = WS_STATS1 + (size_t)NTOK * 8;
constexpr size_t WS_TOKL = WS_SSQ + (size_t)NTOK * 32 * 4;
constexpr size_t WS_WL = WS_TOKL + (size_t)NE * NTOK * 4;
constexpr size_t WS_TKE = WS_WL + (size_t)NE * NTOK * 4;
constexpr size_t WS_TKR = WS_TKE + (size_t)NTOK * 8 * 4;
constexpr size_t WS_TAB = WS_TKR + (size_t)NTOK * 8 * 4;
constexpr size_t WS_WRT = WS_TAB + 32768;
constexpr size_t WS_Z = WS_WRT + (size_t)NE * D * 2;
constexpr size_t WS_O2 = WS_Z + (size_t)NTOK * D * 2;
constexpr size_t WS_WTD = WS_Z + (size_t)NTOK * D * 4;
constexpr size_t WS_HB = WS_WTD + (size_t)65 * 2048 * 512 * 2;
constexpr size_t WS_B = WS_HB + (size_t)HBROWS * 512 * 2;
constexpr size_t WS_WTGU = WS_B;
constexpr size_t WS_WTIN = WS_WTGU + (size_t)65 * 1024 * 2048 * 2;
constexpr size_t WS_WTOUT = WS_WTIN + (size_t)INW * D * 2;
constexpr size_t WS_H0 = WS_WTOUT + (size_t)D * D * 2;
constexpr size_t WS_U = WS_H0 + (size_t)MROWS * D * 2;
constexpr size_t WS_YA = WS_U + (size_t)MROWS * INW * 2;
constexpr size_t WS_H1Q = WS_WTD + (size_t)65 * 2048 * 512;
constexpr size_t WS_H1 = WS_Z;
constexpr size_t WS_YM = WS_B;
constexpr size_t WS_END_A = WS_YA + (size_t)NTOK * D * 2, WS_END_B = WS_YM + (size_t)PMAX * D * 2;
constexpr size_t WS_END = WS_END_A > WS_END_B ? WS_END_A : WS_END_B;
static_assert(WS_END <= ((size_t)1 << 30), "workspace map must fit 1 GiB");

__device__ __forceinline__ float bf2f(bf16_t b) { return __uint_as_float(((unsigned)b) << 16); }
__device__ __forceinline__ bf16_t f2bf(float f) { unsigned u = __float_as_uint(f); u += 0x7FFFu + ((u >> 16) & 1u); return (bf16_t)(u >> 16); }
__device__ __forceinline__ unsigned pack2(float lo, float hi) { return (unsigned)f2bf(lo) | ((unsigned)f2bf(hi) << 16); }
constexpr int ENC8_EXP = 12 << 23;
__device__ __forceinline__ unsigned enc8(float x) {
    const unsigned u = __float_as_uint(x); int t = (int)(u & 0x7fffffffu) - 0x00F80000 - ENC8_EXP;
    t = t < 0x38000000 ? 0x38000000 : (t > 0x3FF00000 ? 0x3FF00000 : t);
    return (((unsigned)t >> 20) & 0x7fu) | ((u >> 24) & 0x80u); }
__device__ __forceinline__ unsigned enc8x4(float a, float b, float c, float d) { return enc8(a) | (enc8(b) << 8) | (enc8(c) << 16) | (enc8(d) << 24); }
__device__ __forceinline__ float dec8(unsigned b) { return __uint_as_float(((b & 0x7fu) << 20) + 0x39000000u + ((b & 0x80u) << 24)); }
typedef unsigned short u16x2 __attribute__((ext_vector_type(2)));
__device__ __forceinline__ unsigned cvt_pk_bf16_g(float lo, float hi) { unsigned r; asm volatile("v_cvt_pk_bf16_f32 %0, %1, %2" : "=v"(r) : "v"(lo), "v"(hi)); return r; }
__device__ __forceinline__ unsigned e4m3x2(float a, float b) {
    const unsigned p = cvt_pk_bf16_g(a, b);
    u16x2 m = __builtin_bit_cast(u16x2, p & 0x7fff7fffu);
    m = (m + (u16x2){8, 8}) >> (u16x2){4, 4};
    m = __builtin_elementwise_sub_sat(m, (u16x2){0x3C0, 0x3C0});
    m = __builtin_elementwise_min(m, (u16x2){0x7E, 0x7E});
    return __builtin_bit_cast(unsigned, m) | ((p >> 8) & 0x00800080u); }
__device__ __forceinline__ unsigned e4m3x4(float a, float b, float c, float d) { return __builtin_amdgcn_perm(e4m3x2(c, d), e4m3x2(a, b), 0x06040200u); }
__device__ __forceinline__ unsigned ym8x2(float a, float b) {
    const unsigned p = cvt_pk_bf16_g(a, b);
    u16x2 m = __builtin_bit_cast(u16x2, p & 0x7fff7fffu);
    m = (m + (u16x2){8, 8}) >> (u16x2){4, 4};
    m = __builtin_elementwise_sub_sat(m, (u16x2){0x3F0, 0x3F0});
    m = __builtin_elementwise_min(m, (u16x2){0x7F, 0x7F});
    return __builtin_bit_cast(unsigned, m) | ((p >> 8) & 0x00800080u); }
__device__ __forceinline__ unsigned ym8x4(float a, float b, float c, float d) { return __builtin_amdgcn_perm(ym8x2(c, d), ym8x2(a, b), 0x06040200u); }
constexpr float S8_H1 = 8.0f, S8_W = 256.0f, S8_HB = 16.0f, S8_GU_INV = 1.0f / (S8_H1 * S8_W), S8_DN_INV = 1.0f / (S8_HB * S8_W);
__device__ __forceinline__ float wsum(float v) {
#pragma unroll
    for (int o = 32; o >= 1; o >>= 1) v += __shfl_xor(v, o);
    return v; }
__device__ __forceinline__ float wmax(float v) {
#pragma unroll
    for (int o = 32; o >= 1; o >>= 1) v = fmaxf(v, __shfl_xor(v, o));
    return v; }
__device__ __forceinline__ int t5_bucket(int rel) {
    const int ret = rel > 0 ? 16 : 0, n = rel < 0 ? -rel : rel;
    if (n < 8) return ret + n;
    const int n2 = n > 32768 ? 0x40000000 : n * n; int lg = 31 - __clz(n2) + 2; if (lg > 15) lg = 15;
    return ret + lg; }

#define XB_TMO      128
#define XB_XCNT(j)  (256  + 64 * (j))
#define XB_XSUB(j)  (1280 + 64 * (j))
#define XB_XGEN(j)  (2304 + 64 * (j))
#define XB_TOP      3328
#define XB_TOPGEN   3392
#define XCD_BAR_WORDS 3456
#define XB_SPIN_CAP (1u << 18)
__device__ __forceinline__ int lane_id() { int l; asm volatile("v_mbcnt_lo_u32_b32 %0, -1, 0\n\tv_mbcnt_hi_u32_b32 %0, -1, %0" : "=v"(l)); return l; }
__device__ __forceinline__ unsigned xb_ld(unsigned* p)              { return __hip_atomic_load(p, __ATOMIC_RELAXED, __HIP_MEMORY_SCOPE_AGENT); }
__device__ __forceinline__ unsigned xb_add(unsigned* p, unsigned v) { return __hip_atomic_fetch_add(p, v, __ATOMIC_RELAXED, __HIP_MEMORY_SCOPE_AGENT); }
__device__ __forceinline__ unsigned xb_xcc_id() { return (unsigned)__builtin_amdgcn_s_getreg((3 << 11) | 20) & 0xFu; }
#define XB_SPIN(cond, bar) do { unsigned _sp = 0; while (cond) { __builtin_amdgcn_s_sleep(1); \
    if ((++_sp & 255u) == 0u) { if (xb_ld(&(bar)[XB_TMO])) break; if (_sp > XB_SPIN_CAP) { atomicAdd(&(bar)[XB_TMO], 1u); break; } } } } while (0)
struct XcdBarrier { unsigned* bar; unsigned x; volatile LAS unsigned* st; int wave0; };
__device__ __forceinline__ XcdBarrier xcd_barrier_post(unsigned* bar, volatile LAS unsigned* st, int wave0) {
    XcdBarrier b; b.bar = bar; b.x = xb_xcc_id(); b.st = st; b.wave0 = wave0;
    if (wave0 == 0 && lane_id() == 0) (void)xb_add(&bar[XB_XCNT(b.x)], 1u);
    return b;
}
__device__ __forceinline__ void xcd_barrier_complete(unsigned* bar, unsigned x, unsigned& nloc, unsigned& nx) {
    const unsigned G = gridDim.x * gridDim.y * gridDim.z;
    unsigned sum, cnt, mine, sp = 0u;
    for (;;) {
        sum = 0u; cnt = 0u; mine = 0u;
#pragma unroll
        for (unsigned j = 0; j < 16; ++j) { const unsigned c = xb_ld(&bar[XB_XCNT(j)]); sum += c; cnt += (c > 0u) ? 1u : 0u; mine = (j == x) ? c : mine; }
        if (sum == G) break;
        __builtin_amdgcn_s_sleep(1);
        if ((++sp & 255u) == 0u) { if (xb_ld(&bar[XB_TMO])) break; if (sp > XB_SPIN_CAP) { atomicAdd(&bar[XB_TMO], 1u); break; } }
    }
    nloc = mine > 0u ? mine : 1u; nx = cnt > 0u ? cnt : 1u;
}
__device__ __forceinline__ void xcd_barrier(const XcdBarrier& b) {
    asm volatile("s_waitcnt vmcnt(0)" ::: "memory");
    __syncthreads();
    if (b.wave0 == 0 && lane_id() == 0) {
        unsigned* bar = b.bar;
        __builtin_amdgcn_s_waitcnt(0);
        unsigned nloc = b.st[0], nx = b.st[1];
        if (nloc == 0u) { xcd_barrier_complete(bar, b.x, nloc, nx); b.st[0] = nloc; b.st[1] = nx; }
        const unsigned old = xb_add(&bar[XB_XSUB(b.x)], 1u);
        const unsigned gen = old / nloc;
        if (old + 1u == (gen + 1u) * nloc) {
            __builtin_amdgcn_fence(__ATOMIC_RELEASE, "agent");
            asm volatile("s_waitcnt vmcnt(0)" ::: "memory");
            const unsigned og = xb_add(&bar[XB_TOP], 1u);
            const unsigned tg = og / nx;
            if (og + 1u == (tg + 1u) * nx) xb_add(&bar[XB_TOPGEN], 1u);
            else XB_SPIN(xb_ld(&bar[XB_TOPGEN]) == tg, bar);
            __builtin_amdgcn_fence(__ATOMIC_ACQUIRE, "agent");
            xb_add(&bar[XB_XGEN(b.x)], 1u);
            asm volatile("s_waitcnt vmcnt(0)" ::: "memory");
        } else {
            XB_SPIN(xb_ld(&bar[XB_XGEN(b.x)]) == gen, bar);
            __builtin_amdgcn_fence(__ATOMIC_ACQUIRE, "agent");
            asm volatile("s_waitcnt vmcnt(0)" ::: "memory");
        }
    }
    __syncthreads();
}

struct Args { const float* in[23]; float* out; unsigned char* ws; int ph_lo, ph_hi; };
struct Frame {
    LAS unsigned char* lds; int tid, lane, wave, G, bx;
    const float *x, *meta, *lng, *lnb, *t5, *w_in, *sink, *rpb, *ga, *gb, *w_out, *l1g, *l1b, *w_router, *rbias, *w_gate, *w_up, *w_down, *ws_gate, *ws_up, *ws_down, *l2g, *l2b;
    float* out; unsigned char* ws;
    int wave0;
    __device__ __forceinline__ void fresh() { int t = wave0 * 64 + lane_id(); asm volatile("" : "+v"(t)); tid = t; lane = t & 63; wave = wave0; }
    __device__ __forceinline__ float* stats0() const { return (float*)(ws + WS_STATS0); }
    __device__ __forceinline__ float* stats1() const { return (float*)(ws + WS_STATS1); }
    __device__ __forceinline__ float* ssq() const { return (float*)(ws + WS_SSQ); }
    __device__ __forceinline__ float* wl() const { return (float*)(ws + WS_WL); }
    __device__ __forceinline__ float* tab() const { return (float*)(ws + WS_TAB); }
    __device__ __forceinline__ int* cnt() const { return (int*)(ws + WS_CNT); }
    __device__ __forceinline__ int* tokl() const { return (int*)(ws + WS_TOKL); }
    __device__ __forceinline__ int* tke() const { return (int*)(ws + WS_TKE); }
    __device__ __forceinline__ int* tkr() const { return (int*)(ws + WS_TKR); }
    __device__ __forceinline__ bf16_t* wtd() const { return (bf16_t*)(ws + WS_WTD); }
    __device__ __forceinline__ bf16_t* hb() const { return (bf16_t*)(ws + WS_HB); }
    __device__ __forceinline__ bf16_t* wtgu() const { return (bf16_t*)(ws + WS_WTGU); }
    __device__ __forceinline__ bf16_t* wtin() const { return (bf16_t*)(ws + WS_WTIN); }
    __device__ __forceinline__ bf16_t* wtout() const { return (bf16_t*)(ws + WS_WTOUT); }
    __device__ __forceinline__ bf16_t* h0() const { return (bf16_t*)(ws + WS_H0); }
    __device__ __forceinline__ bf16_t* u() const { return (bf16_t*)(ws + WS_U); }
    __device__ __forceinline__ bf16_t* ya() const { return (bf16_t*)(ws + WS_YA); }
    __device__ __forceinline__ bf16_t* h1() const { return (bf16_t*)(ws + WS_H1); }
    __device__ __forceinline__ unsigned char* h1q() const { return (unsigned char*)(ws + WS_H1Q); }
    __device__ __forceinline__ bf16_t* ym() const { return (bf16_t*)(ws + WS_YM); }
    __device__ __forceinline__ bf16_t* wrt() const { return (bf16_t*)(ws + WS_WRT); }
    __device__ __forceinline__ bf16_t* z() const { return (bf16_t*)(ws + WS_Z); }
    __device__ __forceinline__ bf16_t* o2() const { return (bf16_t*)(ws + WS_O2); }
};

struct ConvDesc { const float* src; bf16_t* dst; int lds_, ldd_; const float* ksc; float csc; int f8; };
__device__ __forceinline__ void conv_load(const ConvDesc& d, f32x4 (&v)[16], int lane) {
    const int kk = lane & 3, n4 = (lane >> 2) * 4;
#pragma unroll
    for (int p = 0; p < 16; ++p) v[p] = __builtin_nontemporal_load((const f32x4*)(d.src + (size_t)(4 * p + kk) * d.lds_ + n4));
}
__device__ __forceinline__ void conv_finish(const ConvDesc& d, const f32x4 (&v)[16], LAS float* scr, int lane) {
    const int kk = lane & 3, n4 = (lane >> 2) * 4;
#pragma unroll
    for (int p = 0; p < 16; ++p) { const int k = 4 * p + kk; const float s = d.ksc ? d.ksc[k] * d.csc : d.csc;
        scr[k * 65 + n4] = v[p][0] * s; scr[k * 65 + n4 + 1] = v[p][1] * s; scr[k * 65 + n4 + 2] = v[p][2] * s; scr[k * 65 + n4 + 3] = v[p][3] * s; }
    asm volatile("s_waitcnt lgkmcnt(0)" ::: "memory");
    if (d.f8) {
        const int c = lane >> 4;
#pragma unroll
        for (int j = 0; j < 4; ++j) { const int n = (lane & 15) + 16 * j; const LAS float* s = scr + (16 * c) * 65 + n; u32x4 o;
            o.x = e4m3x4(s[0], s[65], s[2 * 65], s[3 * 65]); o.y = e4m3x4(s[4 * 65], s[5 * 65], s[6 * 65], s[7 * 65]);
            o.z = e4m3x4(s[8 * 65], s[9 * 65], s[10 * 65], s[11 * 65]); o.w = e4m3x4(s[12 * 65], s[13 * 65], s[14 * 65], s[15 * 65]);
            __builtin_nontemporal_store(o, (u32x4*)((unsigned char*)d.dst + (size_t)n * d.ldd_ + 16 * c)); }
        asm volatile("s_waitcnt lgkmcnt(0)" ::: "memory");
        return; }
    const int c = lane >> 3;
#pragma unroll
    for (int j = 0; j < 8; ++j) { const int n = (lane & 7) + 8 * j; const LAS float* s = scr + (8 * c) * 65 + n; u32x4 o;
        o.x = pack2(s[0], s[65]); o.y = pack2(s[2 * 65], s[3 * 65]); o.z = pack2(s[4 * 65], s[5 * 65]); o.w = pack2(s[6 * 65], s[7 * 65]);
        __builtin_nontemporal_store(o, (u32x4*)(d.dst + (size_t)n * d.ldd_ + 8 * c)); }
    asm volatile("s_waitcnt lgkmcnt(0)" ::: "memory");
}
constexpr int T_R = 32, T_IN = 72 * 32, T_OUT = 32 * 32, T_GU = 65 * 2 * 8 * 32, T_D = 65 * 32 * 8;
constexpr int IT_P0 = T_R + T_IN, IT_ALL = IT_P0 + T_OUT + T_GU + T_D, IT_P6 = IT_ALL - 3600, IT_MID = IT_P6 - CONV_P2;
__device__ __forceinline__ ConvDesc conv_desc(const Frame& F, int it) {
    int r = it; const float* src; bf16_t* dst; int lds_, ldd_, f8 = 0; const float* ksc = nullptr; float csc = 1.0f;
    if (r < T_R) { src = F.w_router + (size_t)(r * 64) * NE; lds_ = NE; dst = F.wrt() + r * 64; ldd_ = D; }
    else if ((r -= T_R) < T_IN) { const int tn = r % 72, tk = r / 72; const int n0 = tn * 64; const bool isq = (n0 < COL_KA) || (n0 >= COL_QB && n0 < COL_KB);
        src = F.w_in + (size_t)(tk * 64) * INW + n0; lds_ = INW; dst = F.wtin() + (size_t)n0 * D + tk * 64; ldd_ = D; csc = isq ? QSCALE : 1.0f; }
    else if ((r -= T_IN) < T_OUT) { const int tn = r % 32, tk = r / 32; const int k0 = tk * 64;
        src = F.w_out + (size_t)k0 * D + tn * 64; lds_ = D; dst = F.wtout() + (size_t)(tn * 64) * D + k0; ldd_ = D; ksc = k0 < 1024 ? F.ga + k0 : F.gb + (k0 - 1024); }
    else if ((r -= T_OUT) < T_GU) { const int tn = r % 8, tk = (r / 8) % 32, which = (r / 256) % 2, e = r / 512;
        const float* s0 = e < NE ? (which ? F.w_up : F.w_gate) + (size_t)e * D * DE : (which ? F.ws_up : F.ws_gate);
        const int c0 = tn * 64, nprime = 256 * (c0 / 128) + 128 * which + (c0 % 128);
        src = s0 + (size_t)(tk * 64) * DE + c0; lds_ = DE; dst = (bf16_t*)((unsigned char*)F.wtgu() + ((size_t)e * 1024 + nprime) * D + tk * 64); ldd_ = D; f8 = 1; csc = S8_W; }
    else { r -= T_GU; const int tn = r % 32, tk = (r / 32) % 8, e = r / 256;
        const float* s0 = e < NE ? F.w_down + (size_t)e * DE * D : F.ws_down;
        src = s0 + (size_t)(tk * 64) * D + tn * 64; lds_ = D; dst = (bf16_t*)((unsigned char*)F.wtd() + ((size_t)e * D + tn * 64) * DE + tk * 64); ldd_ = DE; f8 = 1; csc = S8_W; }
    return ConvDesc{src, dst, lds_, ldd_, ksc, csc, f8};
}
__device__ __forceinline__ void conv_items(const Frame& F, int first, int last, int step) {
    LAS float* t = (LAS float*)F.lds + F.wave * (64 * 65);
    if (first >= last) return;
    f32x4 va[16], vb[16]; ConvDesc da = conv_desc(F, first), db = da;
    conv_load(da, va, F.lane);
    for (int it = first; it < last; it += 2 * step) {
        const bool hb = it + step < last; if (hb) { db = conv_desc(F, it + step); conv_load(db, vb, F.lane); }
        conv_finish(da, va, t, F.lane);
        if (!hb) break;
        const bool ha = it + 2 * step < last; if (ha) { da = conv_desc(F, it + 2 * step); conv_load(da, va, F.lane); }
        conv_finish(db, vb, t, F.lane);
        if (!ha) break;
    }
}
__device__ __forceinline__ void conv_range(const Frame& F, int first, int last) { conv_items(F, first + F.wave, last, 8); }
__device__ __forceinline__ void conv_inproj_share(const Frame& F) {
    constexpr int N1 = IT_MID - IT_P0, CY = (N1 - 118 * 100 + 255) / 256, CX = CY + 100; int a, n;
    if (F.G == 256) { if (F.bx < 138) { a = F.bx * CY; n = CY; } else { a = 138 * CY + (F.bx - 138) * CX; n = CX; } }
    else { n = (N1 + F.G - 1) / F.G; a = F.bx * n; }
    const int e = a + n < N1 ? a + n : N1;
    if (a < e) conv_range(F, IT_P0 + a, IT_P0 + e);
}
__device__ __forceinline__ void conv_tail(const Frame& F, int first, int last, int c0) {
    int nw = F.G - c0, me = F.bx - c0; if (nw <= 0) { nw = F.G; me = F.bx; }
    if (me < 0) return;
    conv_items(F, first + me * 8 + F.wave, last, nw * 8);
}
__device__ __forceinline__ void phase_prologue(Frame& F) {
    const int gw = F.bx * 8 + F.wave, NGW = F.G * 8;
    conv_items(F, gw, IT_P0, NGW);
    for (int row = gw; row < MROWS; row += NGW) {
        bf16_t* dst = F.h0() + (size_t)row * D;
        if (row >= NTOK + NMETA) {
#pragma unroll
            for (int j = 0; j < 8; ++j) *(u32x2*)(dst + (j * 64 + F.lane) * 4) = (u32x2){0u, 0u};
            continue; }
        const float* src = row < NTOK ? F.x + (size_t)row * D : F.meta + (size_t)(row - NTOK) * D;
        f32x4 v[8]; float s = 0.f;
#pragma unroll
        for (int j = 0; j < 8; ++j) { v[j] = *(const f32x4*)(src + (j * 64 + F.lane) * 4); s += (v[j][0] + v[j][1]) + (v[j][2] + v[j][3]); }
        const float mu = wsum(s) * (1.0f / D); float q = 0.f;
#pragma unroll
        for (int j = 0; j < 8; ++j) { const f32x4 d = v[j] - mu; q += (d[0] * d[0] + d[1] * d[1]) + (d[2] * d[2] + d[3] * d[3]); }
        const float rstd = 1.0f / sqrtf(wsum(q) * (1.0f / D) + LN_EPS);
#pragma unroll
        for (int j = 0; j < 8; ++j) { const int c = (j * 64 + F.lane) * 4; const f32x4 g = *(const f32x4*)(F.lng + c), b = *(const f32x4*)(F.lnb + c); const f32x4 y = (v[j] - mu) * rstd * g + b;
            *(u32x2*)(dst + c) = (u32x2){pack2(y[0], y[1]), pack2(y[2], y[3])}; }
        if (row < NTOK && F.lane == 0) { F.stats0()[row * 2] = mu; F.stats0()[row * 2 + 1] = rstd; }
    }
    if (F.bx == 0) for (int i = F.tid; i < 16 * 272; i += 512) { const int h = i / 272, r = i % 272; F.tab()[i] = r <= 256 ? F.t5[t5_bucket(r - 128) * 16 + h] * LOG2E : 0.f; }
}

template <class Fn> __device__ __forceinline__ void sgemm(const Fn& f, LAS unsigned char* ldsb, int tid, int bx, int G) {
    LAS float* As = (LAS float*)ldsb; LAS float* Bs = As + 32 * 132; LAS float* Bs2 = Bs + 32 * 68;
    const int ntm = f.ntm(), ntn = f.ntn(), K = f.K();
    const int tx = tid & 15, ty = tid >> 4, ar = tid >> 2, akc = (tid & 3) * 8, br = (tid & 255) >> 2;
    for (int tile = bx; tile < ntm * ntn; tile += G) {
        const int tm = tile / ntn, tn = tile % ntn;
        typename Fn::Tile T; if (!f.tile(tm, T)) continue;
        float acc[4][4], acc2[4][4];
#pragma unroll
        for (int i = 0; i < 4; ++i)
#pragma unroll
            for (int j = 0; j < 4; ++j) { acc[i][j] = 0.f; acc2[i][j] = 0.f; }
        const bf16_t* ap = f.arow(T, tm * 128 + ar);
        const bf16_t* bp = tid < 256 ? f.brow(T, tn * 64 + br) : (Fn::DUAL ? f.brow2(T, tn * 64 + br) : nullptr);
        LAS float* Bw = tid < 256 ? Bs : Bs2;
        for (int k0 = 0; k0 < K; k0 += 32) {
            u32x4 av = (u32x4){0u, 0u, 0u, 0u}, bv = (u32x4){0u, 0u, 0u, 0u};
            if (ap) av = *(const u32x4*)(ap + k0 + akc);
            if (bp) bv = *(const u32x4*)(bp + k0 + akc);
            __syncthreads();
#pragma unroll
            for (int i = 0; i < 4; ++i) { As[(akc + 2 * i) * 132 + ar] = __uint_as_float(av[i] << 16); As[(akc + 2 * i + 1) * 132 + ar] = __uint_as_float(av[i] & 0xffff0000u); }
            if (tid < 256 || Fn::DUAL) {
#pragma unroll
                for (int i = 0; i < 4; ++i) { Bw[(akc + 2 * i) * 68 + br] = __uint_as_float(bv[i] << 16); Bw[(akc + 2 * i + 1) * 68 + br] = __uint_as_float(bv[i] & 0xffff0000u); } }
            __syncthreads();
#pragma unroll 8
            for (int kk = 0; kk < 32; ++kk) {
                const f32x4 a = *(const LAS f32x4*)(As + kk * 132 + ty * 4), b = *(const LAS f32x4*)(Bs + kk * 68 + tx * 4);
#pragma unroll
                for (int i = 0; i < 4; ++i)
#pragma unroll
                    for (int j = 0; j < 4; ++j) acc[i][j] += a[i] * b[j];
                if (Fn::DUAL) { const f32x4 b2 = *(const LAS f32x4*)(Bs2 + kk * 68 + tx * 4);
#pragma unroll
                    for (int i = 0; i < 4; ++i)
#pragma unroll
                        for (int j = 0; j < 4; ++j) acc2[i][j] += a[i] * b2[j]; }
            }
        }
#pragma unroll
        for (int i = 0; i < 4; ++i)
#pragma unroll
            for (int j = 0; j < 4; ++j) f.store(T, tm * 128 + ty * 4 + i, tn * 64 + tx * 4 + j, acc[i][j], acc2[i][j]);
    }
}

__device__ __forceinline__ void expert_starts(const Frame& F, LAS int* ps  ) {
    if (F.tid == 0) { int acc = 0; for (int e = 0; e < NE; ++e) { ps[e] = acc; acc += ((F.cnt()[e] + 255) >> 8) << 8; } ps[64] = acc; }
    __syncthreads();
}

struct FnInProj {
    static constexpr bool DUAL = false; struct Tile {}; const Frame& F;
    __device__ int ntm() const { return MROWS / 128; } __device__ int ntn() const { return INW / 64; } __device__ int K() const { return D; }
    __device__ bool tile(int, Tile&) const { return true; }
    __device__ const bf16_t* arow(const Tile&, int row) const { return F.h0() + (size_t)row * D; }
    __device__ const bf16_t* brow(const Tile&, int n) const { return F.wtin() + (size_t)n * D; }
    __device__ const bf16_t* brow2(const Tile&, int) const { return nullptr; }
    __device__ void store(const Tile&, int row, int n, float a, float) const { F.u()[(size_t)row * INW + n] = f2bf(a); }
};
struct FnOutProj {
    static constexpr bool DUAL = false; struct Tile {}; const Frame& F;
    __device__ int ntm() const { return NTOK / 128; } __device__ int ntn() const { return D / 64; } __device__ int K() const { return D; }
    __device__ bool tile(int, Tile&) const { return true; }
    __device__ const bf16_t* arow(const Tile&, int row) const { return F.ya() + (size_t)row * D; }
    __device__ const bf16_t* brow(const Tile&, int n) const { return F.wtout() + (size_t)n * D; }
    __device__ const bf16_t* brow2(const Tile&, int) const { return nullptr; }
    __device__ void store(const Tile&, int row, int n, float a, float) const {
        const float h0 = (F.x[(size_t)row * D + n] - F.stats0()[row * 2]) * F.stats0()[row * 2 + 1] * F.lng[n] + F.lnb[n];
        F.z()[(size_t)row * D + n] = f2bf(a + ALPHA * h0); }
};
struct FnGateUp {
    static constexpr bool DUAL = true; struct Tile { int e, r0, n; }; const Frame& F; const LAS int* ps;
    __device__ int ntm() const { return HBROWS / 128; } __device__ int ntn() const { return DE / 64; } __device__ int K() const { return D; }
    __device__ bool tile(int tm, Tile& T) const { const int row0 = tm * 128;
        if (row0 >= PMAX) { T.e = NE; T.r0 = row0 - PMAX; T.n = NTOK; return true; }
        if (row0 >= ps[64]) return false;
        int e = 0; while (e < NE - 1 && row0 >= ps[e + 1]) ++e;
        T.e = e; T.r0 = row0 - ps[e]; T.n = F.cnt()[e]; return T.r0 < T.n; }
    __device__ const bf16_t* arow(const Tile& T, int row) const { const int r = T.r0 + (row & 127); if (r >= T.n) return nullptr;
        const int tok = T.e < NE ? F.tokl()[(size_t)T.e * NTOK + r] : r; return F.h1() + (size_t)tok * D; }
    __device__ const bf16_t* brow(const Tile& T, int n) const { return F.wtgu() + ((size_t)T.e * 1024 + 256 * (n >> 7) + (n & 127)) * D; }
    __device__ const bf16_t* brow2(const Tile& T, int n) const { return F.wtgu() + ((size_t)T.e * 1024 + 256 * (n >> 7) + 128 + (n & 127)) * D; }
    __device__ void store(const Tile& T, int row, int n, float g, float u) const { const int r = T.r0 + (row & 127); const float w = T.e < NE ? (r < T.n ? F.wl()[(size_t)T.e * NTOK + r] : 0.f) : 1.0f;
        F.hb()[(size_t)row * DE + n] = f2bf(g / (1.0f + __expf(-g)) * (u * w)); }
};
struct FnDown {
    static constexpr bool DUAL = false; struct Tile { int e, r0, n; }; const Frame& F; const LAS int* ps;
    __device__ int ntm() const { return PMAX / 128; } __device__ int ntn() const { return D / 64; } __device__ int K() const { return DE; }
    __device__ bool tile(int tm, Tile& T) const { const int row0 = tm * 128; if (row0 >= ps[64]) return false;
        int e = 0; while (e < NE - 1 && row0 >= ps[e + 1]) ++e;
        T.e = e; T.r0 = row0 - ps[e]; T.n = F.cnt()[e]; return T.r0 < T.n; }
    __device__ const bf16_t* arow(const Tile&, int row) const { return F.hb() + (size_t)row * DE; }
    __device__ const bf16_t* brow(const Tile& T, int n) const { return F.wtd() + ((size_t)T.e * D + n) * DE; }
    __device__ const bf16_t* brow2(const Tile&, int) const { return nullptr; }
    __device__ void store(const Tile& T, int row, int n, float a, float) const { const int r = T.r0 + (row & 127);
        (void)r; ((unsigned char*)F.ym())[(size_t)row * D + n] = (unsigned char)enc8(a); }
};
struct FnFinal {
    static constexpr bool DUAL = false; struct Tile {}; const Frame& F; const LAS int* ps;
    __device__ int ntm() const { return NTOK / 128; } __device__ int ntn() const { return D / 64; } __device__ int K() const { return DE; }
    __device__ bool tile(int, Tile&) const { return true; }
    __device__ const bf16_t* arow(const Tile&, int row) const { return F.hb() + (size_t)(PMAX + row) * DE; }
    __device__ const bf16_t* brow(const Tile&, int n) const { return F.wtd() + ((size_t)NE * D + n) * DE; }
    __device__ const bf16_t* brow2(const Tile&, int) const { return nullptr; }
    __device__ void store(const Tile&, int row, int n, float a, float) const {
        const float h1 = bf2f(F.h1()[(size_t)row * D + n]);
        F.o2()[(size_t)row * D + n] = f2bf(a + ALPHA * h1); }
};

__device__ __forceinline__ void phase_attn_simple(Frame& F) {
    LAS float* qs = (LAS float*)F.lds + F.wave * 512; LAS float* psm = qs + 64;
    const int gw = F.bx * 8 + F.wave, NGW = F.G * 8, lane = F.lane;
    for (int item = gw; item < NTOK * 32; item += NGW) {
        const int tok = item >> 5, hh = item & 31, b = tok >> 13, s = tok & 8191;
        const bool isA = hh < 16; const int h = hh & 15;
        const int qcol = isA ? COL_QA + h * 64 : COL_QB + h * 64, kcol = isA ? COL_KA + (h >> 2) * 64 : COL_KB + h * 64, vcol = isA ? COL_VA + (h >> 2) * 64 : COL_VB + h * 64;
        const int r = s >> 6, c = s & 63, rs = min(max(r - 4, 0), 120), cs = min(max(c - 8, 0), 48);
        const int nkeys = isA ? 16 + 257 : 16 + 128;
        asm volatile("s_waitcnt lgkmcnt(0)" ::: "memory");
        qs[lane] = bf2f(F.u()[(size_t)tok * INW + qcol + lane]);
        asm volatile("s_waitcnt lgkmcnt(0)" ::: "memory");
        float sc[5]; float mx = -INFINITY;
#pragma unroll
        for (int i = 0; i < 5; ++i) {
            const int j = lane + 64 * i; sc[i] = -INFINITY;
            if (j < nkeys) {
                int krow; float bias; bool valid = true;
                if (j < 16) { krow = NTOK + j; bias = isA ? F.t5[t5_bucket(j - 16 - s) * 16 + h] * LOG2E : 0.f; }
                else if (isA) { const int kpos = s - 128 + (j - 16); valid = kpos >= 0 && kpos < SEQ; krow = b * SEQ + kpos; bias = F.tab()[h * 272 + (j - 16)]; }
                else { const int w = j - 16, kr = rs + (w >> 4), kc = cs + (w & 15); krow = b * SEQ + kr * 64 + kc; bias = F.rpb[(h * 15 + (kr - r + 7)) * 31 + (kc - c + 15)] * LOG2E; }
                if (valid) { const bf16_t* kp = F.u() + (size_t)krow * INW + kcol; float dot = 0.f;
#pragma unroll
                    for (int d8 = 0; d8 < 8; ++d8) { const u32x4 kv = *(const u32x4*)(kp + d8 * 8);
#pragma unroll
                        for (int i2 = 0; i2 < 4; ++i2) { dot += qs[d8 * 8 + 2 * i2] * __uint_as_float(kv[i2] << 16); dot += qs[d8 * 8 + 2 * i2 + 1] * __uint_as_float(kv[i2] & 0xffff0000u); } }
                    sc[i] = dot + bias; }
            }
            mx = fmaxf(mx, sc[i]);
        }
        const float sinkl = isA ? F.sink[h] * LOG2E : -INFINITY;
        mx = fmaxf(wmax(mx), sinkl);
        float l = 0.f;
#pragma unroll
        for (int i = 0; i < 5; ++i) { const int j = lane + 64 * i; const float p = sc[i] == -INFINITY ? 0.f : exp2f(sc[i] - mx); l += p; if (j < 320) psm[j] = p; }
        l = wsum(l) + (isA ? exp2f(sinkl - mx) : 0.f);
        asm volatile("s_waitcnt lgkmcnt(0)" ::: "memory");
        float o = 0.f;
        for (int j = 0; j < nkeys; ++j) { const float p = psm[j]; if (p == 0.f) continue;
            int krow; if (j < 16) krow = NTOK + j; else if (isA) krow = b * SEQ + s - 128 + (j - 16); else { const int w = j - 16; krow = b * SEQ + (rs + (w >> 4)) * 64 + cs + (w & 15); }
            o += p * bf2f(F.u()[(size_t)krow * INW + vcol + lane]); }
        o /= l;
        const bf16_t ob = f2bf(o); F.ya()[(size_t)tok * D + hh * 64 + lane] = ob;
        const float of = bf2f(ob), q = wsum(of * of);
        if (lane == 0) F.ssq()[tok * 32 + hh] = q;
    }
}
__device__ __forceinline__ void phase_rmsnorm(Frame& F) {
    const int gw = F.bx * 8 + F.wave, NGW = F.G * 8, lane = F.lane;
    for (int tok = gw; tok < NTOK; tok += NGW) {
        const float q = lane < 32 ? F.ssq()[tok * 32 + lane] : 0.f;
        float qa = lane < 16 ? q : 0.f, qb = (lane >= 16 && lane < 32) ? q : 0.f; qa = wsum(qa); qb = wsum(qb);
        const float ra = 1.0f / sqrtf(qa * (1.0f / 1024.f) + RMS_EPS), rb = 1.0f / sqrtf(qb * (1.0f / 1024.f) + RMS_EPS);
        bf16_t* p = F.ya() + (size_t)tok * D;
#pragma unroll
        for (int j = 0; j < 8; ++j) { const int c = (j * 64 + lane) * 4; const float rr = c < 1024 ? ra : rb; u32x2 w = *(u32x2*)(p + c);
            w.x = pack2(__uint_as_float(w.x << 16) * rr, __uint_as_float(w.x & 0xffff0000u) * rr); w.y = pack2(__uint_as_float(w.y << 16) * rr, __uint_as_float(w.y & 0xffff0000u) * rr); *(u32x2*)(p + c) = w; }
    }
}

__device__ __forceinline__ void phase_ln1_router(Frame& F) {
    LAS float* hs = (LAS float*)F.lds + F.wave * 2048;
    const int gw = F.bx * 8 + F.wave, NGW = F.G * 8, lane = F.lane;
    for (int tok = gw; tok < NTOK; tok += NGW) {
        const bf16_t* src = F.z() + (size_t)tok * D; f32x4 v[8]; float s = 0.f;
#pragma unroll
        for (int j = 0; j < 8; ++j) { const u32x2 w = *(const u32x2*)(src + (j * 64 + lane) * 4); v[j] = (f32x4){__uint_as_float(w.x << 16), __uint_as_float(w.x & 0xffff0000u), __uint_as_float(w.y << 16), __uint_as_float(w.y & 0xffff0000u)}; s += (v[j][0] + v[j][1]) + (v[j][2] + v[j][3]); }
        const float mu = wsum(s) * (1.0f / D); float q = 0.f;
#pragma unroll
        for (int j = 0; j < 8; ++j) { const f32x4 d = v[j] - mu; q += (d[0] * d[0] + d[1] * d[1]) + (d[2] * d[2] + d[3] * d[3]); }
        const float rstd = 1.0f / sqrtf(wsum(q) * (1.0f / D) + LN_EPS);
        asm volatile("s_waitcnt lgkmcnt(0)" ::: "memory");
#pragma unroll
        for (int j = 0; j < 8; ++j) { const int c = (j * 64 + lane) * 4; const f32x4 g = *(const f32x4*)(F.l1g + c), bb = *(const f32x4*)(F.l1b + c); const f32x4 y = (v[j] - mu) * rstd * g + bb;
            *(u32x2*)(F.h1() + (size_t)tok * D + c) = (u32x2){pack2(y[0], y[1]), pack2(y[2], y[3])}; *(LAS f32x4*)(hs + c) = y; }
        if (lane == 0) { F.stats1()[tok * 2] = mu; F.stats1()[tok * 2 + 1] = rstd; }
        asm volatile("s_waitcnt lgkmcnt(0)" ::: "memory");
        float lg = 0.f;
#pragma unroll 8
        for (int n = 0; n < D; ++n) lg += hs[n] * F.w_router[(size_t)n * NE + lane];
        const float score = 1.0f / (1.0f + expf(-lg)), v0 = score + F.rbias[lane];
        int rk = 0;
#pragma unroll
        for (int j = 0; j < 8; ++j) { const int o = (lane & ~7) + j; const float w = __shfl(v0, o); rk += (w > v0 || (w == v0 && o < lane)) ? 1 : 0; }
        float gs = rk < 2 ? v0 : 0.f; gs += __shfl_xor(gs, 1); gs += __shfl_xor(gs, 2); gs += __shfl_xor(gs, 4);
        int grk = 0; const int myg = lane >> 3;
#pragma unroll
        for (int g = 0; g < 8; ++g) { const float w = __shfl(gs, g * 8); grk += (w > gs || (w == gs && g < myg)) ? 1 : 0; }
        const float mv = grk < 4 ? v0 : -INFINITY;
        int erk = 0;
        for (int o = 0; o < 64; ++o) { const float w = __shfl(mv, o); erk += (w > mv || (w == mv && o < lane)) ? 1 : 0; }
        const bool sel = erk < 8;
        const float wsm = wsum(sel ? score : 0.f), wgt = score / (wsm + 1e-20f) * 2.5f;
        if (sel) { const int rr = atomicAdd(F.cnt() + lane, 1); F.tokl()[(size_t)lane * NTOK + rr] = tok; F.wl()[(size_t)lane * NTOK + rr] = wgt; F.tke()[tok * 8 + erk] = lane; F.tkr()[tok * 8 + erk] = rr; }
    }
}
__device__ __forceinline__ void phase_ln2(Frame& F, const LAS int* ps) {
    const int gw = F.bx * 8 + F.wave, NGW = F.G * 8, lane = F.lane;
#pragma unroll 1
    for (int tok = gw; tok < NTOK; tok += NGW) {
        float* dst = F.out + (size_t)tok * D; const bf16_t* o2p = F.o2() + (size_t)tok * D; float v[2][16]; float s = 0.f;
        const int mye = F.tke()[tok * 8 + (lane & 7)], myr = F.tkr()[tok * 8 + (lane & 7)], mypos = ps[mye] + myr;
        u32x4 o[2][2];
#pragma unroll
        for (int k = 0; k < 2; ++k) { o[k][0] = *(const u32x4*)(o2p + (lane + 64 * k) * 16); o[k][1] = *(const u32x4*)(o2p + (lane + 64 * k) * 16 + 8); }
#pragma unroll
        for (int k = 0; k < 2; ++k)
#pragma unroll
            for (int h = 0; h < 2; ++h)
#pragma unroll
                for (int i = 0; i < 4; ++i) { v[k][8 * h + 2 * i] = __uint_as_float(o[k][h][i] << 16); v[k][8 * h + 2 * i + 1] = __uint_as_float(o[k][h][i] & 0xffff0000u); }
        u32x4 y[8][2];
#pragma unroll
        for (int j = 0; j < 8; ++j) { const int p = __shfl(mypos, j); const unsigned char* yp = (const unsigned char*)F.ym() + (size_t)p * D;
#pragma unroll
            for (int k = 0; k < 2; ++k) y[j][k] = *(const u32x4*)(yp + (lane + 64 * k) * 16); }
#pragma unroll
        for (int j = 0; j < 8; ++j)
#pragma unroll
            for (int k = 0; k < 2; ++k)
#pragma unroll
                for (int i = 0; i < 4; ++i) { unsigned w = y[j][k][i]; asm volatile("" : "+v"(w));
                    const unsigned w1 = w >> 8;
                    const unsigned p02 = ((w & 0x007f007fu) << 4) + 0x39003900u + ((w & 0x00800080u) << 8), p13 = ((w1 & 0x007f007fu) << 4) + 0x39003900u + ((w1 & 0x00800080u) << 8);
                    v[k][4 * i] += __uint_as_float(p02 << 16); v[k][4 * i + 2] += __uint_as_float(p02 & 0xffff0000u);
                    v[k][4 * i + 1] += __uint_as_float(p13 << 16); v[k][4 * i + 3] += __uint_as_float(p13 & 0xffff0000u);
                    asm volatile("" : "+v"(v[k][4 * i]), "+v"(v[k][4 * i + 1]), "+v"(v[k][4 * i + 2]), "+v"(v[k][4 * i + 3])); }
#pragma unroll
        for (int k = 0; k < 2; ++k)
#pragma unroll
            for (int i = 0; i < 16; ++i) s += v[k][i];
        const float mu = wsum(s) * (1.0f / D); float q = 0.f;
#pragma unroll
        for (int k = 0; k < 2; ++k)
#pragma unroll
            for (int i = 0; i < 16; ++i) { const float d = v[k][i] - mu; q += d * d; }
        const float rstd = 1.0f / sqrtf(wsum(q) * (1.0f / D) + LN_EPS);
        asm volatile("" ::: "memory");
#pragma unroll
        for (int k = 0; k < 2; ++k)
#pragma unroll
            for (int h = 0; h < 4; ++h) { const int c = (lane + 64 * k) * 16 + 4 * h; const f32x4 g = *(const f32x4*)(F.l2g + c), bb = *(const f32x4*)(F.l2b + c);
                *(f32x4*)(dst + c) = (f32x4){(v[k][4 * h] - mu) * rstd * g[0] + bb[0], (v[k][4 * h + 1] - mu) * rstd * g[1] + bb[1], (v[k][4 * h + 2] - mu) * rstd * g[2] + bb[2], (v[k][4 * h + 3] - mu) * rstd * g[3] + bb[3]}; }
    }
}

#ifndef FAST_P1
#define FAST_P1 1
#endif
#ifndef STAGGER7
#define STAGGER7 0
#endif
#ifndef CONV_NT
#define CONV_NT 1
#endif
#ifndef STAGGER4
#define STAGGER4 0
#endif
#ifndef XCD_TRUE
#define XCD_TRUE 1
#endif
#ifndef DOWN_REV
#define DOWN_REV false
#endif
#ifndef YM_NT
#define YM_NT 0
#endif
#ifndef FAST_P4
#define FAST_P4 1
#endif
#ifndef FAST_P6
#define FAST_P6 1
#endif
#ifndef FAST_P7
#define FAST_P7 1
#endif
namespace pg8 {
typedef short bf16x8 __attribute__((ext_vector_type(8)));
constexpr int BM = 256, BK = 64, HALF = 128, HTB = HALF * BK * 2, STAGE_BYTES = 8 * HTB, NXCD = 8, WGM = 8;
__host__ __device__ __forceinline__ int lds_byte(int r, int c) { const int st = (r >> 4) * 2 + (c >> 5), rr = r & 15, cc = c & 31, ob = rr * 64 + cc * 2; return st * 1024 + (ob ^ (((ob >> 9) & 1) << 5)); }
__host__ __device__ __forceinline__ void stage_rc(int b, int& R, int& C) { const int st = b / 1024, sb = b % 1024, swz = sb ^ (((sb >> 9) & 1) << 5); R = (st >> 1) * 16 + swz / 64; C = (st & 1) * 32 + (swz % 64) / 2; }
__host__ __device__ __forceinline__ int perm32(int rho) { const int n = rho >> 4, i = rho & 15; return 8 * (i >> 2) + 4 * n + (i & 3); }
__device__ __forceinline__ unsigned cvt_pk_bf16(float lo, float hi) { unsigned r; asm volatile("v_cvt_pk_bf16_f32 %0, %1, %2" : "=v"(r) : "v"(lo), "v"(hi)); return r; }
typedef int i32x4 __attribute__((ext_vector_type(4)));
typedef int i32x8 __attribute__((ext_vector_type(8)));
__device__ __forceinline__ i32x8 cat8(bf16x8 a, bf16x8 b) { return __builtin_shufflevector(__builtin_bit_cast(i32x4, a), __builtin_bit_cast(i32x4, b), 0, 1, 2, 3, 4, 5, 6, 7); }
struct Unit { int pm, pn, e, r0, n, orow, tb; };
__device__ __forceinline__ int xcd_remap(int L, int nwg) { const int q = nwg / NXCD, r = nwg % NXCD, xcd = L % NXCD, off = L / NXCD; return (xcd < r ? xcd * (q + 1) : r * (q + 1) + (xcd - r) * q) + off; }
__device__ __forceinline__ void tile_of(int wgid, int nM, int nN, int& pm, int& pn) { const int nig = WGM * nN, gid = wgid / nig, fm = gid * WGM, gsz = (nM - fm) < WGM ? (nM - fm) : WGM; pm = fm + ((wgid % nig) % gsz); pn = (wgid % nig) / gsz; }

template <class Epi, class Sched>
__device__ __forceinline__ void gemm_phase(const int wave0, LAS unsigned char* lds, const Sched& S, const Epi& E, const int lda, const int ldb, const int nt, const int stagger_ticks = 0) {
    int tid = wave0 * 64 + lane_id(); asm volatile("" : "+v"(tid));
    const int wid = wave0, lane = tid & 63, wr = wid >> 2, wc = wid & 3, fr = lane & 15, fq = lane >> 4;
    unsigned voffA[2], voffB[2], voffB2[2], c2[2]; int RA[2];
#pragma unroll
    for (int i = 0; i < 2; ++i) { int R, C; stage_rc(tid * 16 + i * 8192, R, C); const int Rb = Epi::PERM ? ((R & ~31) + perm32(R & 31)) : R;
        voffA[i] = (unsigned)(R * lda + C) * 2u; voffB[i] = (unsigned)(Rb * ldb + C) * 2u; RA[i] = R; c2[i] = (unsigned)C * 2u;
        voffB2[i] = (unsigned)((64 * (R >> 5) + 16 * ((R >> 2) & 3) + 4 * ((R >> 4) & 1) + (R & 3)) * ldb + C) * 2u; }
    const size_t kstep = (size_t)(BK * 2), hstepA = (size_t)HALF * lda * 2, hstepB = (size_t)HALF * ldb * 2, hstepB2 = (size_t)8 * ldb * 2;
    const unsigned lda2 = (unsigned)lda * 2u;
    const unsigned ldsw = (unsigned)wid * 1024u;
    int aoff = lds_byte(wr * 64 + fr, fq * 8), boff = lds_byte(wc * 32 + fr, fq * 8) + 4 * HTB; asm volatile("" : "+v"(aoff), "+v"(boff));
#define PG8_SA(b, h) (((b) * 2 + (h)) * HTB)
#define PG8_SB(b, h) ((4 + (b) * 2 + (h)) * HTB)
#define PG8_STAGE(bufoff, gbase, voff) do { const char* _g = (const char*)(gbase); asm volatile("" : "+s"(_g)); _Pragma("unroll") for (int _i = 0; _i < 2; ++_i) { unsigned _v = (voff)[_i]; asm volatile("" : "+v"(_v)); \
        __builtin_amdgcn_global_load_lds((const unsigned*)(_g + _v), (LAS unsigned*)(lds + (bufoff) + ldsw + _i * 8192), 16, 0, 0); } } while (0)
#define PG8_STG_A(bufoff, p, h, V) do { if constexpr (Sched::GATHER) { PG8_STAGE(bufoff, p, V[h]); } else { PG8_STAGE(bufoff, (p) + (h) * hstepA, voffA); } } while (0)
#define PG8_STG_B(bufoff, p, h) do { if constexpr (Epi::PERM2) { PG8_STAGE(bufoff, (p) + (h) * hstepB2, voffB2); } else { PG8_STAGE(bufoff, (p) + (h) * hstepB, voffB); } } while (0)
#define PG8_LDA(dst, b, h) do { _Pragma("unroll") for (int m = 0; m < 4; ++m) _Pragma("unroll") for (int k = 0; k < 2; ++k) dst[m][k] = *(const LAS bf16x8*)(lds + PG8_SA(b, h) + aoff + m * 2048 + k * 1024); } while (0)
#define PG8_LDB(dst, b, h) do { _Pragma("unroll") for (int n = 0; n < 2; ++n) _Pragma("unroll") for (int k = 0; k < 2; ++k) dst[n][k] = *(const LAS bf16x8*)(lds + boff + (PG8_SB(b, h) - 4 * HTB) + n * 2048 + k * 1024); } while (0)
#define PG8_MMA(ai, bj, At, Bt) do { __builtin_amdgcn_s_setprio(1); _Pragma("unroll") for (int m = 0; m < 4; ++m) _Pragma("unroll") for (int n = 0; n < 2; ++n) { \
        if constexpr (Epi::F8) acc[ai][bj][m][n] = __builtin_amdgcn_mfma_scale_f32_16x16x128_f8f6f4(cat8(Bt[n][0], Bt[n][1]), cat8(At[m][0], At[m][1]), acc[ai][bj][m][n], 0, 0, 0, 0, 0, 0); \
        else { _Pragma("unroll") for (int k = 0; k < 2; ++k) acc[ai][bj][m][n] = __builtin_amdgcn_mfma_f32_16x16x32_bf16(Bt[n][k], At[m][k], acc[ai][bj][m][n], 0, 0, 0); } } __builtin_amdgcn_s_setprio(0); } while (0)
#define PG8_WAIT_V(n) asm volatile("s_waitcnt vmcnt(" #n ")" ::: "memory")
#define PG8_WAIT_L(n) asm volatile("s_waitcnt lgkmcnt(" #n ")" ::: "memory")
#define PG8_BAR __builtin_amdgcn_s_barrier()
#define PG8_SCHED __builtin_amdgcn_sched_barrier(0)
    Unit cur, nxt; int ui = 0;
    if (stagger_ticks) {
        const unsigned long long t0 = __builtin_amdgcn_s_memrealtime(), dl = (unsigned long long)((blockIdx.x >> 3) & 15) * (unsigned)stagger_ticks;
        while (__builtin_amdgcn_s_memrealtime() - t0 < dl) __builtin_amdgcn_s_sleep(4);
        __syncthreads(); }
    if (!S.next(0, cur)) return;
    cur.tb = 0;
    f32x4 acc[2][2][4][2];
#pragma unroll
    for (int a = 0; a < 2; ++a)
#pragma unroll
        for (int b = 0; b < 2; ++b)
#pragma unroll
            for (int m = 0; m < 4; ++m)
#pragma unroll
                for (int n = 0; n < 2; ++n) acc[a][b][m][n] = (f32x4){0.f, 0.f, 0.f, 0.f};
    bf16x8 At[4][2], B0[2][2], B1[2][2];
    unsigned vac[2][2], van[2][2];
    const char* cA = S.abase(cur); const char* cB = S.bbase(cur);
#pragma unroll
    for (int h = 0; h < 2; ++h)
#pragma unroll
        for (int i = 0; i < 2; ++i) { vac[h][i] = Sched::GATHER ? (unsigned)S.arow(cur, h * HALF + RA[i]) * lda2 + c2[i] : 0u; van[h][i] = vac[h][i]; }
    PG8_STG_B(PG8_SB(0, 0), cB, 0); PG8_STG_B(PG8_SB(0, 1), cB, 1); PG8_STG_A(PG8_SA(0, 0), cA, 0, vac); PG8_STG_A(PG8_SA(0, 1), cA, 1, vac);
    if (wr == 1) PG8_BAR;
    PG8_WAIT_V(2); PG8_BAR;
    PG8_STG_B(PG8_SB(1, 0), cB + kstep, 0); PG8_STG_A(PG8_SA(1, 0), cA + kstep, 0, vac); PG8_STG_B(PG8_SB(1, 1), cB + kstep, 1);
    PG8_WAIT_V(6); PG8_BAR;
    for (;;) {
        const bool has_next = S.next(ui + 1, nxt); nxt.tb = (ui + 1) & 1;
        if constexpr (Epi::MIDK) E.unit_begin(cur, wave0 * 64 + lane_id());
        const char* nA = has_next ? S.abase(nxt) : cA; const char* nB = has_next ? S.bbase(nxt) : cB;
        if constexpr (Sched::GATHER) { if (has_next) { const int tq = wave0 * 64 + lane_id();
#pragma unroll
            for (int h = 0; h < 2; ++h)
#pragma unroll
                for (int i = 0; i < 2; ++i) { int R, C; stage_rc(tq * 16 + i * 8192, R, C); van[h][i] = (unsigned)S.arow(nxt, h * HALF + R); } } }
#pragma unroll 1
        for (int t = 0; t < nt; t += 2) {
            const bool last = (t == nt - 2);
            const char* a1 = cA + (size_t)(t + 1) * kstep;
            const char* a2 = last ? nA : cA + (size_t)(t + 2) * kstep; const char* b2 = last ? nB : cB + (size_t)(t + 2) * kstep;
            const char* a3 = a2 + kstep; const char* b3 = b2 + kstep;
            unsigned va2[2][2];
#pragma unroll
            for (int h = 0; h < 2; ++h)
#pragma unroll
                for (int i = 0; i < 2; ++i) va2[h][i] = last ? van[h][i] : vac[h][i];
            PG8_LDB(B0, 0, 0); PG8_LDB(B1, 0, 1); PG8_SCHED; PG8_LDA(At, 0, 0); PG8_STG_A(PG8_SA(1, 1), a1, 1, vac);
            PG8_WAIT_V(8); PG8_WAIT_L(0); PG8_BAR; PG8_MMA(0, 0, At, B0); PG8_MMA(0, 1, At, B1); PG8_BAR; PG8_SCHED;
            PG8_LDA(At, 0, 1); PG8_STG_B(PG8_SB(0, 0), b2, 0); PG8_STG_B(PG8_SB(0, 1), b2, 1); PG8_STG_A(PG8_SA(0, 0), a2, 0, va2);
            PG8_WAIT_V(8); PG8_WAIT_L(0); PG8_BAR; PG8_MMA(1, 0, At, B0); PG8_MMA(1, 1, At, B1); PG8_BAR; PG8_SCHED;
            PG8_LDB(B0, 1, 0); PG8_LDB(B1, 1, 1); PG8_SCHED; PG8_LDA(At, 1, 0); PG8_STG_A(PG8_SA(0, 1), a2, 1, va2);
            PG8_WAIT_V(8); PG8_WAIT_L(0); PG8_BAR; PG8_MMA(0, 0, At, B0); PG8_MMA(0, 1, At, B1); PG8_BAR; PG8_SCHED;
            PG8_LDA(At, 1, 1); PG8_STG_B(PG8_SB(1, 0), b3, 0); PG8_STG_B(PG8_SB(1, 1), b3, 1); PG8_STG_A(PG8_SA(1, 0), a3, 0, va2);
            PG8_WAIT_V(8); PG8_WAIT_L(0); PG8_BAR; PG8_MMA(1, 0, At, B0); PG8_MMA(1, 1, At, B1); PG8_BAR; PG8_SCHED;
            if constexpr (Epi::MIDK) { if (2 * (t + 2) == nt) E.mid(acc, cur, wr, fr); }
            if constexpr (Sched::GATHER) { if (t + 4 == nt && has_next) {
                const int tq = wave0 * 64 + lane_id();
#pragma unroll
                for (int h = 0; h < 2; ++h)
#pragma unroll
                    for (int i = 0; i < 2; ++i) { int R, C; stage_rc(tq * 16 + i * 8192, R, C); asm volatile("" : "+v"(van[h][i])); van[h][i] = van[h][i] * lda2 + (unsigned)C * 2u; } } }
        }
        if (wr == 0) PG8_BAR;
        { const int le = lane_id(); E(acc, cur, wr, wc, le & 15, le >> 4); }
        if (!has_next) break;
#pragma unroll
        for (int a = 0; a < 2; ++a)
#pragma unroll
            for (int b = 0; b < 2; ++b)
#pragma unroll
                for (int m = 0; m < 4; ++m)
#pragma unroll
                    for (int n = 0; n < 2; ++n) acc[a][b][m][n] = (f32x4){0.f, 0.f, 0.f, 0.f};
        cur = nxt; cA = nA; cB = nB; ++ui;
#pragma unroll
        for (int h = 0; h < 2; ++h)
#pragma unroll
            for (int i = 0; i < 2; ++i) vac[h][i] = van[h][i];
        if (wr == 1) PG8_BAR;
    }
    PG8_WAIT_V(0);
    PG8_BAR;
#undef PG8_SA
#undef PG8_SB
#undef PG8_STAGE
#undef PG8_STG_A
#undef PG8_STG_B
#undef PG8_LDA
#undef PG8_LDB
#undef PG8_MMA
#undef PG8_WAIT_V
#undef PG8_WAIT_L
#undef PG8_BAR
#undef PG8_SCHED
}
}

struct SchedInProj {
    static constexpr bool GATHER = false; const char* A; const char* B; int G, c, i0, i1;
    __device__ __forceinline__ bool next(int i, pg8::Unit& u) const { const int ii = i0 + i; if (ii >= i1) return false; const int L = ii * G + c; if (L >= 1162) return false;
        if (L < 1152) pg8::tile_of(pg8::xcd_remap(L, 1152), 64, 18, u.pm, u.pn); else { const int k = L - 1152; u.pm = 64; u.pn = k < 2 ? 4 + k : 8 + k; }
        return true; }
    __device__ __forceinline__ const char* abase(const pg8::Unit& u) const { return A + (size_t)u.pm * 256 * D * 2; }
    __device__ __forceinline__ const char* bbase(const pg8::Unit& u) const { return B + (size_t)u.pn * 256 * D * 2; }
    __device__ __forceinline__ int arow(const pg8::Unit&, int) const { return 0; }
};
struct SchedOutProj {
    static constexpr bool GATHER = false; const char* A; const char* B; int G, c;
    __device__ __forceinline__ bool next(int i, pg8::Unit& u) const { const int L = i * G + c; if (L >= 512) return false; pg8::tile_of(pg8::xcd_remap(L, 512), 64, 8, u.pm, u.pn); return true; }
    __device__ __forceinline__ const char* abase(const pg8::Unit& u) const { return A + (size_t)u.pm * 256 * D * 2; }
    __device__ __forceinline__ const char* bbase(const pg8::Unit& u) const { return B + (size_t)u.pn * 256 * D * 2; }
    __device__ __forceinline__ int arow(const pg8::Unit&, int) const { return 0; }
};
__device__ __forceinline__ void moe_tables(const Frame& F, LAS int* ps) {
    if (F.tid < NE) ps[256 + F.tid] = F.cnt()[F.tid];
    __syncthreads();
    if (F.tid == 0) { int acc = 0, ta = 0; for (int e = 0; e < NE; ++e) { const int mt = (ps[256 + e] + 255) >> 8; ps[e] = acc; ps[128 + e] = ta; acc += mt * 256; ta += mt; }
        ps[64] = acc; ps[128 + 64] = ta; ps[128 + 65] = ta + NTOK / 256; ps[256 + 64] = NTOK; }
    __syncthreads();
    for (int t = F.tid; t < 640; t += 512) { int e = 0; while (e < NE && t >= ps[128 + e + 1]) ++e; ps[384 + t] = e; }
    __syncthreads();
}
template <int NN, bool REV> __device__ __forceinline__ bool moe_unit(const LAS int* ps, int L, pg8::Unit& u, int ntile) {
    const int nU = ntile * NN; if (L >= nU) return false;
    const int wg0 = pg8::xcd_remap(L, nU), wg = REV ? nU - 1 - wg0 : wg0, tile = wg / NN; u.pn = wg % NN;
    const int e = __builtin_amdgcn_readfirstlane(ps[384 + tile]); u.e = e; u.pm = tile - __builtin_amdgcn_readfirstlane(ps[128 + e]); u.r0 = u.pm * 256; u.n = __builtin_amdgcn_readfirstlane(ps[256 + e]);
    u.orow = (e < NE ? __builtin_amdgcn_readfirstlane(ps[e]) : PMAX) + u.r0;
    return true; }
struct SchedGU {
    static constexpr bool GATHER = true; const char* A; const char* B; const int* tokl; const int* cnt; const LAS int* ps; int G, c, ntile;
    __device__ __forceinline__ bool next(int i, pg8::Unit& u) const { return moe_unit<4, false>(ps, i * G + c, u, ntile); }
    __device__ __forceinline__ const char* abase(const pg8::Unit&) const { return A; }
    __device__ __forceinline__ const char* bbase(const pg8::Unit& u) const { return B + ((size_t)u.e * 1024 + u.pn * 256) * D; }
    __device__ __forceinline__ int arow(const pg8::Unit& u, int r) const { const int rr = min(u.r0 + r, u.n - 1); return u.e < NE ? tokl[(size_t)u.e * NTOK + rr] : rr; }
};
struct SchedDown {
    static constexpr bool GATHER = false; const char* A; const char* B; const int* cnt; const LAS int* ps; int G, c, ntile;
    __device__ __forceinline__ bool next(int i, pg8::Unit& u) const { return moe_unit<8, DOWN_REV>(ps, i * G + c, u, ntile); }
    __device__ __forceinline__ const char* abase(const pg8::Unit& u) const { return A + (size_t)u.orow * DE; }
    __device__ __forceinline__ const char* bbase(const pg8::Unit& u) const { return B + ((size_t)u.e * D + u.pn * 256) * DE; }
    __device__ __forceinline__ int arow(const pg8::Unit&, int) const { return 0; }
};
struct SchedDownShared {
    static constexpr bool GATHER = false; const char* A; const char* B; int G, c;
    __device__ __forceinline__ bool next(int i, pg8::Unit& u) const { const int L = i * G + c; if (L >= 512) return false; pg8::tile_of(pg8::xcd_remap(L, 512), 64, 8, u.pm, u.pn);
        u.e = NE; u.r0 = u.pm * 256; u.n = NTOK; u.orow = PMAX + u.r0; return true; }
    __device__ __forceinline__ const char* abase(const pg8::Unit& u) const { return A + (size_t)u.orow * DE; }
    __device__ __forceinline__ const char* bbase(const pg8::Unit& u) const { return B + ((size_t)NE * D + u.pn * 256) * DE; }
    __device__ __forceinline__ int arow(const pg8::Unit&, int) const { return 0; }
};
struct EpiU {
    static constexpr bool F8 = false; static constexpr bool PERM2 = false; static constexpr bool MIDK = false; static constexpr bool PERM = true; bf16_t* U; int nostore;
    __device__ __forceinline__ void operator()(const f32x4 (&acc)[2][2][4][2], const pg8::Unit& u, int wr, int wc, int fr, int fq) const {
        const int row0 = u.pm * 256 + wr * 64 + fr, col0 = u.pn * 256 + wc * 32 + 8 * fq;
        if (nostore) {
#pragma unroll
            for (int ai = 0; ai < 2; ++ai)
#pragma unroll
                for (int bj = 0; bj < 2; ++bj)
#pragma unroll
                    for (int m = 0; m < 4; ++m)
#pragma unroll
                        for (int n = 0; n < 2; ++n) asm volatile("" :: "v"(acc[ai][bj][m][n]));
            return; }
#pragma unroll
        for (int ai = 0; ai < 2; ++ai)
#pragma unroll
            for (int m = 0; m < 4; ++m) { bf16_t* rowp = U + (size_t)(row0 + ai * 128 + m * 16) * INW + col0;
#pragma unroll
                for (int bj = 0; bj < 2; ++bj) { const f32x4 v0 = acc[ai][bj][m][0], v1 = acc[ai][bj][m][1]; u32x4 w;
                    w.x = pg8::cvt_pk_bf16(v0[0], v0[1]); w.y = pg8::cvt_pk_bf16(v0[2], v0[3]); w.z = pg8::cvt_pk_bf16(v1[0], v1[1]); w.w = pg8::cvt_pk_bf16(v1[2], v1[3]);
                    *(u32x4*)(rowp + bj * 128) = w; } }
    }
};
struct EpiZ {
    static constexpr bool F8 = false; static constexpr bool PERM2 = false; static constexpr bool MIDK = true; static constexpr bool PERM = true; bf16_t* Z; const bf16_t* H0; const float* ssq; LAS float* tab;
    __device__ __forceinline__ void unit_begin(const pg8::Unit& u, int tid) const {
        const int row = tid >> 1, grp = tid & 1; const float* p = ssq + (size_t)(u.pm * 256 + row) * 32 + 16 * grp;
        const f32x4 a = *(const f32x4*)p, b4 = *(const f32x4*)(p + 4), c = *(const f32x4*)(p + 8), d = *(const f32x4*)(p + 12);
        const float s = (((a[0] + a[1]) + (a[2] + a[3])) + ((b4[0] + b4[1]) + (b4[2] + b4[3]))) + (((c[0] + c[1]) + (c[2] + c[3])) + ((d[0] + d[1]) + (d[2] + d[3])));
        tab[(u.tb * 256 + row) * 2 + grp] = 1.0f / sqrtf(s * (1.0f / 1024.f) + RMS_EPS);
    }
    __device__ __forceinline__ void mid(f32x4 (&acc)[2][2][4][2], const pg8::Unit& u, int wr, int fr) const {
#pragma unroll
        for (int ai = 0; ai < 2; ++ai)
#pragma unroll
            for (int m = 0; m < 4; ++m) { const int r = ai * 128 + wr * 64 + m * 16 + fr; const float f = tab[(u.tb * 256 + r) * 2] / tab[(u.tb * 256 + r) * 2 + 1];
#pragma unroll
                for (int bj = 0; bj < 2; ++bj)
#pragma unroll
                    for (int n = 0; n < 2; ++n) acc[ai][bj][m][n] *= f; }
    }
    __device__ __forceinline__ void operator()(const f32x4 (&acc)[2][2][4][2], const pg8::Unit& u, int wr, int wc, int fr, int fq) const {
        const int row0 = u.pm * 256 + wr * 64 + fr, col0 = u.pn * 256 + wc * 32 + 8 * fq;
#pragma unroll
        for (int am = 0; am < 4; ++am) {
            u32x4 hv[2][2]; float rb[2];
#pragma unroll
            for (int q = 0; q < 2; ++q) { const int ai = am >> 1, m = (am & 1) * 2 + q; const size_t off = (size_t)(row0 + ai * 128 + m * 16) * D + col0;
                rb[q] = tab[(u.tb * 256 + ai * 128 + wr * 64 + m * 16 + fr) * 2 + 1];
#pragma unroll
                for (int bj = 0; bj < 2; ++bj) hv[q][bj] = *(const u32x4*)(H0 + off + bj * 128); }
#pragma unroll
            for (int q = 0; q < 2; ++q) { const int ai = am >> 1, m = (am & 1) * 2 + q; const size_t off = (size_t)(row0 + ai * 128 + m * 16) * D + col0;
#pragma unroll
                for (int bj = 0; bj < 2; ++bj) { const u32x4 h4 = hv[q][bj];
                    const f32x4 h0v = (f32x4){__uint_as_float(h4.x << 16), __uint_as_float(h4.x & 0xffff0000u), __uint_as_float(h4.y << 16), __uint_as_float(h4.y & 0xffff0000u)};
                    const f32x4 h1v = (f32x4){__uint_as_float(h4.z << 16), __uint_as_float(h4.z & 0xffff0000u), __uint_as_float(h4.w << 16), __uint_as_float(h4.w & 0xffff0000u)};
                    const f32x4 v0 = acc[ai][bj][m][0] * rb[q] + h0v * ALPHA, v1 = acc[ai][bj][m][1] * rb[q] + h1v * ALPHA; u32x4 w;
                    w.x = pg8::cvt_pk_bf16(v0[0], v0[1]); w.y = pg8::cvt_pk_bf16(v0[2], v0[3]); w.z = pg8::cvt_pk_bf16(v1[0], v1[1]); w.w = pg8::cvt_pk_bf16(v1[2], v1[3]);
                    *(u32x4*)(Z + off + bj * 128) = w; } }
            asm volatile("" ::: "memory"); }
    }
};
__device__ __forceinline__ float silu_mul(float g, float u) { return g * __builtin_amdgcn_rcpf(1.0f + __builtin_amdgcn_exp2f(-g * LOG2E)) * u; }
struct EpiGU {
    static constexpr bool F8 = true; static constexpr bool PERM2 = false; static constexpr bool MIDK = false; static constexpr bool PERM = true; unsigned char* H; const float* wl;
    __device__ __forceinline__ void operator()(const f32x4 (&acc)[2][2][4][2], const pg8::Unit& u, int wr, int wc, int fr, int fq) const {
        int rl0 = wr * 64 + fr, col0 = u.pn * 128 + wc * 32 + 8 * fq; asm volatile("" : "+v"(rl0), "+v"(col0));
        float wv[2][4];
#pragma unroll
        for (int ai = 0; ai < 2; ++ai)
#pragma unroll
            for (int m = 0; m < 4; ++m) { const int r = u.r0 + rl0 + ai * 128 + m * 16; wv[ai][m] = (u.e < NE ? (r < u.n ? wl[(size_t)u.e * NTOK + r] : 0.f) : 1.0f) * (S8_GU_INV * S8_HB); }
#pragma unroll
        for (int ai = 0; ai < 2; ++ai)
#pragma unroll
            for (int m = 0; m < 4; ++m) { const f32x4 g0 = acc[ai][0][m][0] * S8_GU_INV, g1 = acc[ai][0][m][1] * S8_GU_INV, u0 = acc[ai][1][m][0] * wv[ai][m], u1 = acc[ai][1][m][1] * wv[ai][m];
                const u32x2 w = (u32x2){e4m3x4(silu_mul(g0[0], u0[0]), silu_mul(g0[1], u0[1]), silu_mul(g0[2], u0[2]), silu_mul(g0[3], u0[3])),
                                        e4m3x4(silu_mul(g1[0], u1[0]), silu_mul(g1[1], u1[1]), silu_mul(g1[2], u1[2]), silu_mul(g1[3], u1[3]))};
                *(u32x2*)(H + (size_t)(u.orow + rl0 + ai * 128 + m * 16) * DE + col0) = w; }
    }
};
struct EpiDownR {
    static constexpr bool F8 = true; static constexpr bool PERM2 = true; static constexpr bool MIDK = false; static constexpr bool PERM = true; unsigned char* Y; int nostore;
    __device__ __forceinline__ void operator()(const f32x4 (&acc)[2][2][4][2], const pg8::Unit& u, int wr, int wc, int fr, int fq) const {
        int rl0 = wr * 64 + fr, col0 = u.pn * 256 + wc * 64 + 16 * fq; asm volatile("" : "+v"(rl0), "+v"(col0));
        if (nostore) {
#pragma unroll
            for (int ai = 0; ai < 2; ++ai)
#pragma unroll
                for (int bj = 0; bj < 2; ++bj)
#pragma unroll
                    for (int m = 0; m < 4; ++m)
#pragma unroll
                        for (int n = 0; n < 2; ++n) asm volatile("" :: "v"(acc[ai][bj][m][n]));
            return; }
#pragma unroll
        for (int ai = 0; ai < 2; ++ai)
#pragma unroll
            for (int m = 0; m < 4; ++m) { const int rl = rl0 + ai * 128 + m * 16; if (u.r0 + rl >= u.n) continue;
                f32x4 a0 = acc[ai][0][m][0], a1 = acc[ai][0][m][1], b0 = acc[ai][1][m][0], b1 = acc[ai][1][m][1];
                asm volatile("" : "+v"(a0), "+v"(a1), "+v"(b0), "+v"(b1));
                const u32x4 q = (u32x4){ym8x4(a0[0], a0[1], a0[2], a0[3]), ym8x4(a1[0], a1[1], a1[2], a1[3]), ym8x4(b0[0], b0[1], b0[2], b0[3]), ym8x4(b1[0], b1[1], b1[2], b1[3])};
                *(u32x4*)(Y + (size_t)(u.orow + rl) * D + col0) = q;
                asm volatile("" ::: "memory"); }
    }
};
struct EpiDownS {
    static constexpr bool F8 = true; static constexpr bool PERM2 = false; static constexpr bool MIDK = false; static constexpr bool PERM = true; bf16_t* O; const bf16_t* H1;
    __device__ __forceinline__ void operator()(const f32x4 (&acc)[2][2][4][2], const pg8::Unit& u, int wr, int wc, int fr, int fq) const {
        int rl0 = wr * 64 + fr, col0 = u.pn * 256 + wc * 32 + 8 * fq; asm volatile("" : "+v"(rl0), "+v"(col0));
#pragma unroll
        for (int am = 0; am < 4; ++am) {
            u32x4 hv[2][2];
#pragma unroll
            for (int q = 0; q < 2; ++q) { const int ai = am >> 1, m = (am & 1) * 2 + q; const size_t off = (size_t)(u.r0 + rl0 + ai * 128 + m * 16) * D + col0;
#pragma unroll
                for (int bj = 0; bj < 2; ++bj) hv[q][bj] = *(const u32x4*)(H1 + off + bj * 128); }
#pragma unroll
            for (int q = 0; q < 2; ++q) { const int ai = am >> 1, m = (am & 1) * 2 + q; const size_t off = (size_t)(u.r0 + rl0 + ai * 128 + m * 16) * D + col0;
#pragma unroll
                for (int bj = 0; bj < 2; ++bj) { const u32x4 h4 = hv[q][bj];
                    const f32x4 h0v = (f32x4){__uint_as_float(h4.x << 16), __uint_as_float(h4.x & 0xffff0000u), __uint_as_float(h4.y << 16), __uint_as_float(h4.y & 0xffff0000u)};
                    const f32x4 h1v = (f32x4){__uint_as_float(h4.z << 16), __uint_as_float(h4.z & 0xffff0000u), __uint_as_float(h4.w << 16), __uint_as_float(h4.w & 0xffff0000u)};
                    const f32x4 v0 = acc[ai][bj][m][0] * S8_DN_INV + h0v * ALPHA, v1 = acc[ai][bj][m][1] * S8_DN_INV + h1v * ALPHA; u32x4 w;
                    w.x = pg8::cvt_pk_bf16(v0[0], v0[1]); w.y = pg8::cvt_pk_bf16(v0[2], v0[3]); w.z = pg8::cvt_pk_bf16(v1[0], v1[1]); w.w = pg8::cvt_pk_bf16(v1[2], v1[3]);
                    *(u32x4*)(O + off + bj * 128) = w; } }
            asm volatile("" ::: "memory"); }
    }
};

#ifndef FAST_P2
#define FAST_P2 1
#endif
namespace att {
typedef short bf16x8 __attribute__((ext_vector_type(8)));
typedef short s16x4 __attribute__((ext_vector_type(4)));
typedef float f32x16 __attribute__((ext_vector_type(16)));
typedef LAS const char* lds_cptr;
constexpr int SLOT = 16384, NSLOT = 6, RING = NSLOT * SLOT;
constexpr int TA_W = 452, TA_OFF = 224;
constexpr int TB_W = 468;
constexpr int OFF_TABA = RING, OFF_TABB = OFF_TABA, OFF_WS = OFF_TABA + 4 * TA_W * 4, OFF_OST = OFF_WS + 8 * 256, ATT_LDS = OFF_OST + 8 * 4096;
static_assert(ATT_LDS <= LDS_BYTES - 16 - 1024, "attention LDS map");
constexpr float NEGB = -1e30f, THR = 8.0f;
#define ATT_MFMA(a, b, c) __builtin_amdgcn_mfma_f32_32x32x16_bf16(a, b, c, 0, 0, 0)
__device__ __forceinline__ int crow(int r, int hi) { return (r & 3) + 8 * (r >> 2) + 4 * hi; }
__device__ __forceinline__ s16x4 vtr(lds_cptr p) { typedef short v4i16_t __attribute__((ext_vector_type(4))); return __builtin_bit_cast(s16x4, __builtin_amdgcn_ds_read_tr16_b64_v4i16((LAS v4i16_t*)p)); }
__device__ __forceinline__ float swapmax(float m) { auto rr = __builtin_amdgcn_permlane32_swap(__float_as_uint(m), __float_as_uint(m), false, false); return fmaxf(__uint_as_float(rr[0]), __uint_as_float(rr[1])); }
__device__ __forceinline__ float swapsum(float m) { auto rr = __builtin_amdgcn_permlane32_swap(__float_as_uint(m), __float_as_uint(m), false, false); return __uint_as_float(rr[0]) + __uint_as_float(rr[1]); }

__device__ __forceinline__ float bf16r(float x) { return __uint_as_float(pg8::cvt_pk_bf16(x, 0.f) << 16); }
__device__ __forceinline__ bf16x8 frag_k0(unsigned bits16, int hi) { const u32x4 w = (u32x4){hi == 0 ? bits16 : 0u, 0u, 0u, 0u}; return __builtin_bit_cast(bf16x8, w); }
template <int NH, int NS, class BiasFn>
__device__ __forceinline__ void tile_qb(const bf16x8 (&kf)[8], const bf16x8 (&qr)[4], bf16x8& mq, const bf16x8& ones, lds_cptr vp, f32x16 (&o)[2], float& m, float& l, LAS float* wsf, int r32, int hi, const BiasFn& bias) {
    f32x16 c[NH];
#pragma unroll
    for (int hf = 0; hf < NH; ++hf)
#pragma unroll
        for (int r = 0; r < 16; ++r) c[hf][r] = bias(hf, r);
    s16x4 vlo[NS][2], vhi[NS][2];
#pragma unroll
    for (int dh = 0; dh < 2; ++dh) { vlo[0][dh] = vtr(vp + dh * 4096); vhi[0][dh] = vtr(vp + dh * 4096 + 512); }
    __builtin_amdgcn_sched_barrier(0);
#pragma unroll
    for (int hf = 0; hf < NH; ++hf) { c[hf] = ATT_MFMA(ones, mq, c[hf]);
#pragma unroll
        for (int d0 = 0; d0 < 4; ++d0) c[hf] = ATT_MFMA(kf[2 * d0 + hf], qr[d0], c[hf]); }
    float mx = NEGB;
#pragma unroll
    for (int hf = 0; hf < NH; ++hf)
#pragma unroll
        for (int r = 0; r < 16; ++r) mx = fmaxf(mx, c[hf][r]);
    mx = swapmax(mx);
    if (__any(mx > THR)) {
        const float mn = bf16r(m + fmaxf(mx, 0.f)), dl = mn - m, f = __builtin_amdgcn_exp2f(-dl); m = mn; l *= f;
        mq = frag_k0(__float_as_uint(-mn) >> 16, hi);
        if (hi == 0) wsf[r32] = f;
        asm volatile("s_waitcnt lgkmcnt(0)" ::: "memory");
#pragma unroll
        for (int r = 0; r < 16; ++r) { const float fr = wsf[crow(r, hi)]; o[0][r] *= fr; o[1][r] *= fr; }
#pragma unroll
        for (int hf = 0; hf < NH; ++hf)
#pragma unroll
            for (int r = 0; r < 16; ++r) c[hf][r] -= dl;
    }
#pragma unroll
    for (int s = 1; s < NS; ++s)
#pragma unroll
        for (int dh = 0; dh < 2; ++dh) { vlo[s][dh] = vtr(vp + dh * 4096 + s * 1024); vhi[s][dh] = vtr(vp + dh * 4096 + s * 1024 + 512); }
    __builtin_amdgcn_sched_barrier(0);
    float ls = 0.f;
#pragma unroll
    for (int hf = 0; hf < NH; ++hf)
#pragma unroll
        for (int r = 0; r < 16; ++r) { c[hf][r] = __builtin_amdgcn_exp2f(c[hf][r]); ls += c[hf][r]; }
    l += ls;
#pragma unroll
    for (int s = 0; s < NS; ++s) {
        const f32x16& cc = c[s >> 1]; const int rb = (s & 1) * 8;
        u32x4 pw; pw.x = pg8::cvt_pk_bf16(cc[rb + 0], cc[rb + 1]); pw.y = pg8::cvt_pk_bf16(cc[rb + 2], cc[rb + 3]); pw.z = pg8::cvt_pk_bf16(cc[rb + 4], cc[rb + 5]); pw.w = pg8::cvt_pk_bf16(cc[rb + 6], cc[rb + 7]);
        const bf16x8 pa = __builtin_bit_cast(bf16x8, pw);
#pragma unroll
        for (int dh = 0; dh < 2; ++dh) { const s16x4 lo = vlo[s][dh], hi4 = vhi[s][dh];
            const bf16x8 vf = (bf16x8){lo[0], lo[1], lo[2], lo[3], hi4[0], hi4[1], hi4[2], hi4[3]};
            o[dh] = ATT_MFMA(pa, vf, o[dh]); }
    }
}
template <class TokFn>
__device__ __forceinline__ void finish_qb(const Frame& F, f32x16 (&o)[2], float l, LAS float* wsf, LAS bf16_t* stg, int lane, int r32, int hi, int ocol, int hidx, const TokFn& tokq) {
    l = swapsum(l);
    asm volatile("s_waitcnt lgkmcnt(0)" ::: "memory");
    if (hi == 0) wsf[32 + r32] = l;
    asm volatile("s_waitcnt lgkmcnt(0)" ::: "memory");
#pragma unroll
    for (int r = 0; r < 16; ++r) { const int orow = crow(r, hi); const float rl = __builtin_amdgcn_rcpf(wsf[32 + orow]);
        stg[orow * 64 + r32] = f2bf(o[0][r] * rl); stg[orow * 64 + 32 + r32] = f2bf(o[1][r] * rl); }
    asm volatile("s_waitcnt lgkmcnt(0)" ::: "memory");
#pragma unroll
    for (int i = 0; i < 4; ++i) { const int row = i * 8 + (lane >> 3), ch = lane & 7; const u32x4 w = *(const LAS u32x4*)(stg + row * 64 + ch * 8); const int tok = tokq(row);
        *(u32x4*)(F.ya() + (size_t)tok * D + ocol + ch * 8) = w;
        float q = 0.f;
#pragma unroll
        for (int j = 0; j < 4; ++j) { const float a = __uint_as_float(w[j] << 16), b = __uint_as_float(w[j] & 0xffff0000u); q += a * a + b * b; }
        q += __shfl_xor(q, 1); q += __shfl_xor(q, 2); q += __shfl_xor(q, 4);
        if (ch == 0) F.ssq()[tok * 32 + hidx] = q; }
    asm volatile("s_waitcnt lgkmcnt(0)" ::: "memory");
}

template <int MODE>
__device__ __forceinline__ void attn_unit(const Frame& F, int L) {
    LAS unsigned char* lds = F.lds;
    const int lane = F.lane, wid = F.wave, r32 = lane & 31, hi = lane >> 5;
    LAS float* wsf = (LAS float*)(lds + OFF_WS + wid * 256); LAS bf16_t* stg = (LAS bf16_t*)(lds + OFF_OST + wid * 4096);
    int b, kcol, vcol, qcol, ocol, hidx, nband, trow0, qtok0;
    int hb = 0, qbw = 0, kt0 = 0;
    int R0 = 0, pr = 0, jc = 0, cb = 0, kr0 = 0;
    if (MODE == 0) { const int kvh = L & 3; hb = (L >> 2) & 127; b = L >> 9; const int hq = 4 * kvh + (wid >> 1); qbw = wid & 1;
        qcol = COL_QA + hq * 64; kcol = COL_KA + kvh * 64; vcol = COL_VA + kvh * 64; ocol = hq * 64; hidx = hq;
        kt0 = max(0, hb - 2); const int kt1 = min(127, hb + 2); nband = kt1 - kt0 + 1; trow0 = b * SEQ + 64 * kt0; qtok0 = b * SEQ + 64 * hb + 32 * qbw;
    } else { const int h = L & 15, rb = (L >> 4) & 31; b = L >> 9; R0 = rb * 4; pr = wid >> 2; jc = wid & 3; cb = min(max(16 * jc - 8, 0), 32);
        qcol = COL_QB + h * 64; kcol = COL_KB + h * 64; vcol = COL_VB + h * 64; ocol = 1024 + h * 64; hidx = 16 + h;
        kr0 = min(max(R0 - 4, 0), 120); const int kr1 = min(max(R0 + 3 - 4, 0), 120) + 7; nband = kr1 - kr0 + 1; trow0 = b * SEQ + kr0 * 64; qtok0 = b * SEQ + (R0 + 2 * pr) * 64 + 16 * jc; }
    const int NT = 1 + nband;
    const bf16_t* ksrc = F.u() + (size_t)lane * INW + kcol + wid * 8;
    const bf16_t* vsrc = F.u() + (size_t)(16 * (wid & 3) + (lane >> 2)) * INW + vcol + (wid >> 2) * 32 + (lane & 3) * 8;
#define ATT_TROW(t) ((t) == 0 ? NTOK : trow0 + ((t) - 1) * 64)
#define ATT_ISSUE(t) do { const size_t ro_ = (size_t)ATT_TROW(t) * INW; const int sl_ = ((t) % NSLOT) * SLOT; \
        __builtin_amdgcn_global_load_lds((const unsigned*)(ksrc + ro_), (LAS unsigned*)(lds + sl_ + wid * 1024), 16, 0, 0); \
        __builtin_amdgcn_global_load_lds((const unsigned*)(vsrc + ro_), (LAS unsigned*)(lds + sl_ + 8192 + wid * 1024), 16, 0, 0); } while (0)
    bf16x8 qr[4];
    { const int tok = MODE == 0 ? qtok0 + r32 : qtok0 + (r32 >> 4) * 64 + (r32 & 15);
#pragma unroll
      for (int d0 = 0; d0 < 4; ++d0) qr[d0] = *(const bf16x8*)(F.u() + (size_t)tok * INW + qcol + d0 * 16 + hi * 8); }
    if (MODE == 0) { LAS float* tA = (LAS float*)(lds + OFF_TABA); const int h0 = 4 * (L & 3);
        for (int i = F.tid; i < 4 * TA_W; i += 512) { const int g = i / TA_W, rel = i % TA_W - TA_OFF; tA[i] = (rel >= -128 && rel <= 128) ? F.tab()[(h0 + g) * 272 + rel + 128] : NEGB; } }
    else { LAS float* tB = (LAS float*)(lds + OFF_TABB); const int h = L & 15;
        for (int i = F.tid; i < 576; i += 512) { const int k = i - 16; tB[i] = (k >= 0 && k < 465) ? F.rpb[h * 465 + k] * LOG2E : ((k >= 465 && k < 496) ? NEGB : 0.f); } }
#pragma unroll
    for (int t = 0; t < 5; ++t) if (t < NT) ATT_ISSUE(t);
    f32x16 o[2]; o[0] = f32x16{}; o[1] = f32x16{}; float m = 0.f, l = 0.f;
    bf16x8 mq = frag_k0(0u, hi); const bf16x8 ones = frag_k0(0x3F80u, hi);
    const LAS float* tabA = (const LAS float*)(lds + OFF_TABA) + (MODE == 0 ? (wid >> 1) : 0) * TA_W;
    const LAS float* tabB = (const LAS float*)(lds + OFF_TABB);
    const int qpos = 64 * hb + 32 * qbw + r32;
    const int qrow = R0 + 2 * pr + (r32 >> 4), qc = 16 * jc + (r32 & 15), rs = min(max(qrow - 4, 0), 120), cs = min(max(qc - 8, 0), 48);
    const int rsw0 = min(max(R0 + 2 * pr - 4, 0), 120), rsw1 = min(max(R0 + 2 * pr + 1 - 4, 0), 120);
    float cm[16];
#pragma unroll
    for (int r = 0; r < 16; ++r) { const int kc = cb + 4 * hi + (r & 3) + 8 * (r >> 2); cm[r] = (MODE == 1 && !(kc >= cs && kc < cs + 16)) ? NEGB : 0.f; }
    const int dc0 = cb + 4 * hi - qc + 15 + 16;
    for (int t = 0; t < NT; ++t) {
        { const int ahead = NT - 1 - t;
          if (ahead >= 4) asm volatile("s_waitcnt vmcnt(8)" ::: "memory"); else if (ahead == 3) asm volatile("s_waitcnt vmcnt(6)" ::: "memory");
          else if (ahead == 2) asm volatile("s_waitcnt vmcnt(4)" ::: "memory"); else if (ahead == 1) asm volatile("s_waitcnt vmcnt(2)" ::: "memory"); else asm volatile("s_waitcnt vmcnt(0)" ::: "memory"); }
        asm volatile("s_waitcnt lgkmcnt(0)" ::: "memory");
        __builtin_amdgcn_s_barrier();
        if (t + 5 < NT) ATT_ISSUE(t + 5);
        const int slot = (t % NSLOT) * SLOT;
        if (MODE == 1 && t > 0) { const int kr = kr0 + t - 1; if (kr < rsw0 || kr > rsw1 + 7) continue; }
        const int cbt = (MODE == 1 && t > 0) ? cb : 0;
        const lds_cptr kp = (lds_cptr)lds + slot + hi * 1024 + (r32 + cbt) * 16;
        const lds_cptr vp = (lds_cptr)lds + slot + 8192 + ((lane >> 4) & 1) * 32 + (lane & 3) * 8 + (4 * hi + ((lane & 15) >> 2) + cbt) * 64;
        bf16x8 kf[8];
        if (MODE == 0 && t > 0) {
#pragma unroll
            for (int d0 = 0; d0 < 4; ++d0) { kf[2 * d0] = *(const LAS bf16x8*)(kp + d0 * 2048); kf[2 * d0 + 1] = *(const LAS bf16x8*)(kp + d0 * 2048 + 512); }
        } else {
#pragma unroll
            for (int d0 = 0; d0 < 4; ++d0) { kf[2 * d0] = *(const LAS bf16x8*)(kp + d0 * 2048); kf[2 * d0 + 1] = kf[2 * d0]; }
        }
        if (t == 0) {
            if (MODE == 0) tile_qb<1, 1>(kf, qr, mq, ones, vp, o, m, l, wsf, r32, hi, [&](int, int r) { return r < 8 ? tabA[max(crow(r, hi) - 16 - qpos, -128) + TA_OFF] : NEGB; });
            else tile_qb<1, 1>(kf, qr, mq, ones, vp, o, m, l, wsf, r32, hi, [&](int, int r) { return r < 8 ? 0.f : NEGB; });
        } else if (MODE == 0) { const volatile LAS float* bp = tabA + 64 * (kt0 + t - 1) + 4 * hi - qpos + TA_OFF;
            tile_qb<2, 4>(kf, qr, mq, ones, vp, o, m, l, wsf, r32, hi, [&](int hf, int r) { return bp[32 * hf + (r & 3) + 8 * (r >> 2)]; });
        } else { const int kr = kr0 + t - 1; const bool rowok = kr >= rs && kr <= rs + 7; const volatile LAS float* bp = tabB + (rowok ? kr - qrow + 7 : 15) * 31 + dc0;
            tile_qb<1, 2>(kf, qr, mq, ones, vp, o, m, l, wsf, r32, hi, [&](int, int r) { return bp[(r & 3) + 8 * (r >> 2)] + cm[r]; });
        }
    }
    if (MODE == 0) { if (hi == 0) l += __builtin_amdgcn_exp2f(F.sink[hidx] * LOG2E - m); }
    if (MODE == 0) finish_qb(F, o, l, wsf, stg, lane, r32, hi, ocol, hidx, [&](int q) { return qtok0 + q; });
    else finish_qb(F, o, l, wsf, stg, lane, r32, hi, ocol, hidx, [&](int q) { return qtok0 + (q >> 4) * 64 + (q & 15); });
    __builtin_amdgcn_s_barrier();
#undef ATT_TROW
#undef ATT_ISSUE
}
__device__ __forceinline__ void attn_phase(const Frame& F, int mask = 3) {
    __syncthreads();
    int L = F.bx, un = 0; const int slot = (mask & 8) ? ((F.bx >> 3) & 7) : 0;
    for (; L < 2048 && un < slot; L += F.G, ++un) { if (L < 1024) { if (mask & 1) attn_unit<0>(F, L); } else if (mask & 2) attn_unit<1>(F, L - 1024); }
    if (mask & 8) { __syncthreads(); const int n = (IT_P6 - IT_MID + F.G - 1) / F.G, a = IT_MID + F.bx * n, e = a + n < IT_P6 ? a + n : IT_P6; if (a < e) conv_range(F, a, e); __syncthreads(); }
    for (; L < 2048; L += F.G) { if (L < 1024) { if (mask & 1) attn_unit<0>(F, L); } else if (mask & 2) attn_unit<1>(F, L - 1024); }
    __syncthreads();
}
}

#ifndef FAST_P5
#define FAST_P5 1
#endif
__device__ __forceinline__ void route_token(const Frame& F, int tok, float lg, int lane) {
    const float score = 1.0f / (1.0f + expf(-lg)), v0 = score + F.rbias[lane];
    int rk = 0;
#pragma unroll
    for (int j = 0; j < 8; ++j) { const int o = (lane & ~7) + j; const float w = __shfl(v0, o); rk += (w > v0 || (w == v0 && o < lane)) ? 1 : 0; }
    float gs = rk < 2 ? v0 : 0.f; gs += __shfl_xor(gs, 1); gs += __shfl_xor(gs, 2); gs += __shfl_xor(gs, 4);
    int grk = 0; const int myg = lane >> 3;
#pragma unroll
    for (int g = 0; g < 8; ++g) { const float w = __shfl(gs, g * 8); grk += (w > gs || (w == gs && g < myg)) ? 1 : 0; }
    const float mv = grk < 4 ? v0 : -INFINITY;
    int erk = 0;
    for (int o = 0; o < 64; ++o) { const float w = __shfl(mv, o); erk += (w > mv || (w == mv && o < lane)) ? 1 : 0; }
    const bool sel = erk < 8;
    const float wsm = wsum(sel ? score : 0.f), wgt = score / (wsm + 1e-20f) * 2.5f;
    if (sel) { const int rr = atomicAdd(F.cnt() + lane, 1); F.tokl()[(size_t)lane * NTOK + rr] = tok; F.wl()[(size_t)lane * NTOK + rr] = wgt; F.tke()[tok * 8 + erk] = lane; F.tkr()[tok * 8 + erk] = rr; }
}
__device__ __forceinline__ void route_token_local(const Frame& F, int tl  , float lg, int lane, LAS int* lcnt, LAS int* sel_e, LAS int* sel_lr, LAS float* sel_w) {
    lg = (lg == lg) ? lg : 0.f;
    const float score = 1.0f / (1.0f + expf(-lg)), v0 = score + F.rbias[lane];
    int rk = 0;
#pragma unroll
    for (int j = 0; j < 8; ++j) { const int o = (lane & ~7) + j; const float w = __shfl(v0, o); rk += (w > v0 || (w == v0 && o < lane)) ? 1 : 0; }
    float gs = rk < 2 ? v0 : 0.f; gs += __shfl_xor(gs, 1); gs += __shfl_xor(gs, 2); gs += __shfl_xor(gs, 4);
    int grk = 0; const int myg = lane >> 3;
#pragma unroll
    for (int g = 0; g < 8; ++g) { const float w = __shfl(gs, g * 8); grk += (w > gs || (w == gs && g < myg)) ? 1 : 0; }
    const float mv = grk < 4 ? v0 : -INFINITY;
    int erk = 0;
#pragma unroll 16
    for (int o = 0; o < 64; ++o) { const float w = __shfl(mv, o); erk += (w > mv || (w == mv && o < lane)) ? 1 : 0; }
    const bool sel = erk < 8;
    const float wsm = wsum(sel ? score : 0.f), wgt = score / (wsm + 1e-20f) * 2.5f;
    if (sel) { const int lr = __hip_atomic_fetch_add(lcnt + lane, 1, __ATOMIC_RELAXED, __HIP_MEMORY_SCOPE_WORKGROUP); sel_e[tl * 8 + erk] = lane; sel_lr[tl * 8 + erk] = lr; sel_w[tl * 8 + erk] = wgt; }
}
__device__ __forceinline__ void phase_ln1_router_fast(Frame& F) {
    constexpr int HSTR = 4112;
    LAS unsigned char* hb = F.lds; LAS float* part = (LAS float*)F.lds;
    LAS int* lcnt = (LAS int*)(F.lds + 132096); LAS int* lbase = lcnt + 64; LAS int* sel_e = lcnt + 128; LAS int* sel_lr = sel_e + 512; LAS float* sel_w = (LAS float*)(sel_lr + 512);
    const int lane = F.lane, w = F.wave, r32 = lane & 31, hi = lane >> 5;
    for (int it2 = F.bx; it2 < NTOK / 64; it2 += F.G) {
        if (F.tid < 64) lcnt[F.tid] = 0;
        for (int sub = 0; sub < 2; ++sub) {
            const int t0 = it2 * 64 + sub * 32;
            u32x4 raw[4][4];
#pragma unroll
            for (int q = 0; q < 4; ++q) { const bf16_t* src = F.z() + (size_t)(t0 + 4 * w + q) * D;
#pragma unroll
                for (int j = 0; j < 4; ++j) raw[q][j] = *(const u32x4*)(src + (lane + 64 * j) * 8); }
#pragma unroll
            for (int q = 0; q < 4; ++q) { const int row = 4 * w + q, tok = t0 + row; float v[4][8]; float s = 0.f;
#pragma unroll
                for (int j = 0; j < 4; ++j)
#pragma unroll
                    for (int i = 0; i < 4; ++i) { v[j][2 * i] = __uint_as_float(raw[q][j][i] << 16); v[j][2 * i + 1] = __uint_as_float(raw[q][j][i] & 0xffff0000u); s += v[j][2 * i] + v[j][2 * i + 1]; }
                const float mu = wsum(s) * (1.0f / D); float qq = 0.f;
#pragma unroll
                for (int j = 0; j < 4; ++j)
#pragma unroll
                    for (int i = 0; i < 8; ++i) { const float d = v[j][i] - mu; qq += d * d; }
                const float rstd = 1.0f / sqrtf(wsum(qq) * (1.0f / D) + LN_EPS);
#pragma unroll
                for (int j = 0; j < 4; ++j) { const int c = (lane + 64 * j) * 8; const f32x4 g0 = *(const f32x4*)(F.l1g + c), g1 = *(const f32x4*)(F.l1g + c + 4), b0 = *(const f32x4*)(F.l1b + c), b1 = *(const f32x4*)(F.l1b + c + 4);
                    u32x4 pk; float y[8];
#pragma unroll
                    for (int i = 0; i < 4; ++i) { y[i] = (v[j][i] - mu) * rstd * g0[i] + b0[i]; y[4 + i] = (v[j][4 + i] - mu) * rstd * g1[i] + b1[i]; }
                    pk.x = pack2(y[0], y[1]); pk.y = pack2(y[2], y[3]); pk.z = pack2(y[4], y[5]); pk.w = pack2(y[6], y[7]);
                    *(u32x4*)(F.h1() + (size_t)tok * D + c) = pk; *(LAS u32x4*)(hb + row * HSTR + c * 2) = pk;
                    *(u32x2*)(F.h1q() + (size_t)tok * D + c) = (u32x2){e4m3x4(y[0] * S8_H1, y[1] * S8_H1, y[2] * S8_H1, y[3] * S8_H1), e4m3x4(y[4] * S8_H1, y[5] * S8_H1, y[6] * S8_H1, y[7] * S8_H1)}; }
                if (lane == 0) { F.stats1()[tok * 2] = mu; F.stats1()[tok * 2 + 1] = rstd; } }
            __syncthreads();
            att::f32x16 acc[2]; acc[0] = att::f32x16{}; acc[1] = att::f32x16{};
            const bf16_t* wb = F.wrt() + (size_t)r32 * D + 256 * w + hi * 8;
#pragma unroll 8
            for (int s = 0; s < 16; ++s) {
                const att::bf16x8 a = *(const LAS att::bf16x8*)(hb + r32 * HSTR + (256 * w + 16 * s + 8 * hi) * 2);
                const att::bf16x8 b0 = *(const att::bf16x8*)(wb + 16 * s), b1 = *(const att::bf16x8*)(wb + (size_t)32 * D + 16 * s);
                acc[0] = __builtin_amdgcn_mfma_f32_32x32x16_bf16(a, b0, acc[0], 0, 0, 0); acc[1] = __builtin_amdgcn_mfma_f32_32x32x16_bf16(a, b1, acc[1], 0, 0, 0); }
            __syncthreads();
#pragma unroll
            for (int nt = 0; nt < 2; ++nt)
#pragma unroll
                for (int r = 0; r < 16; ++r) part[(w * 32 + att::crow(r, hi)) * 64 + 32 * nt + r32] = acc[nt][r];
            __syncthreads();
            for (int q = 0; q < 4; ++q) { const int row = 4 * w + q; float lg = 0.f;
#pragma unroll
                for (int ww = 0; ww < 8; ++ww) lg += part[(ww * 32 + row) * 64 + lane];
                route_token_local(F, sub * 32 + row, lg, lane, lcnt, sel_e, sel_lr, sel_w); }
            __syncthreads();
        }
        if (F.tid < 64) { const int n = lcnt[F.tid]; lbase[F.tid] = n > 0 ? atomicAdd(F.cnt() + F.tid, n) : 0; }
        __syncthreads();
        { const int tl = F.tid >> 3, slot = F.tid & 7, e = sel_e[F.tid], rr = lbase[e] + sel_lr[F.tid], tok = it2 * 64 + tl;
          F.tokl()[(size_t)e * NTOK + rr] = tok; F.wl()[(size_t)e * NTOK + rr] = sel_w[F.tid]; F.tke()[tok * 8 + slot] = e; F.tkr()[tok * 8 + slot] = rr; }
        __syncthreads();
    }
}

__global__ void __launch_bounds__(512, 2) mk_fwd(Args args) {
    extern __shared__ __attribute__((aligned(16))) unsigned char lds_raw[];
    Frame F; F.lds = (LAS unsigned char*)lds_raw; F.wave0 = __builtin_amdgcn_readfirstlane((int)threadIdx.x >> 6); F.fresh(); F.G = gridDim.x; F.bx = blockIdx.x;
    F.x = args.in[0]; F.meta = args.in[1]; F.lng = args.in[2]; F.lnb = args.in[3]; F.t5 = args.in[4]; F.w_in = args.in[5]; F.sink = args.in[6]; F.rpb = args.in[7]; F.ga = args.in[8]; F.gb = args.in[9];
    F.w_out = args.in[10]; F.l1g = args.in[11]; F.l1b = args.in[12]; F.w_router = args.in[13]; F.rbias = args.in[14]; F.w_gate = args.in[15]; F.w_up = args.in[16]; F.w_down = args.in[17];
    F.ws_gate = args.in[18]; F.ws_up = args.in[19]; F.ws_down = args.in[20]; F.l2g = args.in[21]; F.l2b = args.in[22]; F.out = args.out; F.ws = args.ws;
    unsigned char* ws = args.ws;
    volatile LAS unsigned* xbw = (volatile LAS unsigned*)(F.lds + LDS_BYTES - 16);
    LAS int* ps = (LAS int*)(F.lds + 131072);
    if (F.tid < 4) xbw[F.tid] = 0u;
    __syncthreads();
    const int lo = args.ph_lo, hi = args.ph_hi;
    XcdBarrier bar; bar.bar = (unsigned*)(ws + WS_CTL); bar.x = 0; bar.st = xbw; bar.wave0 = F.wave0;
    if (hi - lo > 1) bar = xcd_barrier_post((unsigned*)(ws + WS_CTL), xbw, F.wave0);
    unsigned* xcen = (unsigned*)(ws + WS_CTL + 20480);
    if (XCD_TRUE && hi - lo > 1 && F.tid == 0) { const unsigned x = xb_xcc_id(); xbw[2] = x; xbw[3] = xb_add(&xcen[x * 16], 1u); }
#ifndef PROBE_REPEAT
#define PROBE_REPEAT -1
#endif
#ifndef PROBE_SUB
#define PROBE_SUB 3
#endif
#ifndef PROBE_NOSTORE
#define PROBE_NOSTORE 0
#endif
#ifndef PROBE_HOT
#define PROBE_HOT 0
#endif
#ifndef PROBE_NT
#define PROBE_NT 32
#ifndef PROBE_LD
#define PROBE_LD 2048
#endif
#endif
#define IN(k) (lo <= (k) && (k) < hi)
#define SEAM(k) do { if (IN(k) && IN((k) + 1)) xcd_barrier(bar); } while (0)
    if (IN(0)) { F.fresh(); phase_prologue(F);
#if PROBE_REPEAT == 0
        xcd_barrier(bar); phase_prologue(F);
#endif
    } SEAM(0);
#define P1_BODY(rep) do { const int s_ = (rep) ? 0 : F.bx % 5; EpiU E{F.u(), rep}; { SchedInProj S{(const char*)F.h0(), (const char*)F.wtin(), F.G, F.bx, 0, s_}; pg8::gemm_phase(F.wave0, F.lds, S, E, D, D, D / 64); } if (!(rep)) { conv_inproj_share(F); __syncthreads(); } { SchedInProj S{(const char*)F.h0(), (const char*)F.wtin(), F.G, F.bx, s_, 1 << 20}; pg8::gemm_phase(F.wave0, F.lds, S, E, D, D, D / 64); } } while (0)
#define P4_BODY(rep) do { SchedOutProj S{(const char*)F.ya(), (const char*)F.wtout(), F.G, F.bx}; EpiZ E{F.z(), F.h0(), F.ssq(), (LAS float*)(F.lds + 131072 + 6144)}; pg8::gemm_phase(F.wave0, F.lds, S, E, D, D, D / 64, STAGGER4); } while (0)
#define P6_BODY(rep) do { moe_tables(F, ps); SchedGU S{(const char*)F.h1q(), (const char*)F.wtgu(), F.tokl(), F.cnt(), ps, F.G, F.bx, __builtin_amdgcn_readfirstlane(ps[128 + 65])}; EpiGU E{(unsigned char*)F.hb(), F.wl()}; pg8::gemm_phase(F.wave0, F.lds, S, E, D / 2, D / 2, D / 128); if (!(rep)) { F.fresh(); conv_tail(F, IT_P6, IT_ALL, (ps[128 + 65] * 4) % F.G); } } while (0)
#define P7_BODY(rep) do { moe_tables(F, ps); SchedDown S{(const char*)F.hb(), (const char*)F.wtd(), F.cnt(), ps, F.G, F.bx, __builtin_amdgcn_readfirstlane(ps[128 + 64])}; EpiDownR E{(unsigned char*)F.ym(), rep}; pg8::gemm_phase(F.wave0, F.lds, S, E, DE / 2, DE / 2, DE / 128, STAGGER7); SchedDownShared S2{(const char*)F.hb(), (const char*)F.wtd(), F.G, F.bx}; EpiDownS E2{F.o2(), F.h1()}; pg8::gemm_phase(F.wave0, F.lds, S2, E2, DE / 2, DE / 2, DE / 128); } while (0)
    if (XCD_TRUE && hi - lo > 1 && IN(0)) {
        if (F.tid == 0) { unsigned idx = 0, ok = 1, npop = 0; const unsigned x = xbw[2];
            for (unsigned j = 0; j < 16; ++j) { const unsigned cj = xb_ld(&xcen[j * 16]); if (cj) { ++npop; if (cj * 8u != (unsigned)F.G) ok = 0; if (j < x) ++idx; } }
            xbw[2] = (ok && npop == 8) ? xbw[3] * 8u + idx : (unsigned)blockIdx.x; }
        __syncthreads();
        F.bx = __builtin_amdgcn_readfirstlane((int)xbw[2]);
    }
    if (IN(1)) { F.fresh();
#if FAST_P1
        P1_BODY(0);
#if PROBE_REPEAT == 1
        xcd_barrier(bar); P1_BODY(PROBE_NOSTORE);
#endif
#else
        FnInProj f{F}; sgemm(f, F.lds, F.tid, F.bx, F.G);
#endif
#if PROBE_REPEAT == 9
        xcd_barrier(bar); if (F.bx % 8 == 0) { conv_range(F, IT_P0 + T_OUT, IT_P0 + T_OUT + 512); __syncthreads(); }
#endif
    } SEAM(1);
    if (IN(2)) { F.fresh();
#if FAST_P2
        att::attn_phase(F, 3 | 8);
#if PROBE_REPEAT == 2
        xcd_barrier(bar); att::attn_phase(F, PROBE_SUB);
#endif
#else
        phase_attn_simple(F);
#endif
    } SEAM(2);
#if !FAST_P4
    if (IN(3)) { phase_rmsnorm(F); } SEAM(3);
#endif
    if (IN(4)) { F.fresh();
#if FAST_P4
        P4_BODY(0);
#if PROBE_REPEAT == 4
        xcd_barrier(bar); P4_BODY(1);
#endif
#else
        FnOutProj f{F}; sgemm(f, F.lds, F.tid, F.bx, F.G);
#endif
    } SEAM(4);
#if FAST_P5
#define PH5(F) phase_ln1_router_fast(F)
#else
#define PH5(F) phase_ln1_router(F)
#endif
    if (IN(5)) { F.fresh(); PH5(F);
#if PROBE_REPEAT == 5
        xcd_barrier(bar); if (F.bx == 0 && F.tid < 64) F.cnt()[F.tid] = 0; xcd_barrier(bar); PH5(F);
#endif
    } SEAM(5);
    if (IN(6)) { F.fresh();
#if FAST_P6
        P6_BODY(0);
#if PROBE_REPEAT == 6
        xcd_barrier(bar); P6_BODY(1);
#endif
#else
        expert_starts(F, ps); FnGateUp f{F, ps}; sgemm(f, F.lds, F.tid, F.bx, F.G);
#endif
    } SEAM(6);
    if (IN(7)) { F.fresh();
#if FAST_P7
        P7_BODY(0);
#if PROBE_REPEAT == 7
        xcd_barrier(bar); P7_BODY(PROBE_NOSTORE);
#endif
#else
        expert_starts(F, ps); { FnDown f{F, ps}; sgemm(f, F.lds, F.tid, F.bx, F.G); } { FnFinal f{F, ps}; sgemm(f, F.lds, F.tid, F.bx, F.G); }
#endif
    } SEAM(7);
    if (IN(8)) { F.fresh(); expert_starts(F, ps); phase_ln2(F, ps);
#if PROBE_REPEAT == 8
        xcd_barrier(bar); phase_ln2(F, ps);
#endif
    }
#undef IN
#undef SEAM
}

extern "C" void kernel_launch(void* const* d_in, const int* in_sizes, int n_in, void* d_out, int out_size, void* d_ws, size_t ws_size, hipStream_t stream) {
    static int grid = 0;
    if (grid == 0) {
        if (n_in != 23 || in_sizes[0] != NTOK * D || out_size != NTOK * D || ws_size < WS_END) {
            fprintf(stderr, "kernel_launch: built for 23 inputs, x/out of %d floats, >= %zu bytes of workspace; got n_in %d in0 %d out %d ws %zu; nothing launched\n", NTOK * D, (size_t)WS_END, n_in, n_in > 0 ? in_sizes[0] : -1, out_size, ws_size);
            grid = -1; return; }
        int dev = 0, cus = 0, per_cu = 0;
        if (hipGetDevice(&dev) != hipSuccess || hipDeviceGetAttribute(&cus, hipDeviceAttributeMultiprocessorCount, dev) != hipSuccess) { fprintf(stderr, "kernel_launch: device query failed\n"); grid = -1; return; }
        if (hipFuncSetAttribute((const void*)mk_fwd, hipFuncAttributeMaxDynamicSharedMemorySize, LDS_BYTES) != hipSuccess) { fprintf(stderr, "kernel_launch: hipFuncSetAttribute failed\n"); grid = -1; return; }
        if (hipOccupancyMaxActiveBlocksPerMultiprocessor(&per_cu, (const void*)mk_fwd, 512, LDS_BYTES) != hipSuccess || per_cu < 1) fprintf(stderr, "kernel_launch: note: occupancy query reports %d\n", per_cu);
        (void)hipGetLastError();
        grid = cus;
    }
    if (grid < 0) return;
    if (hipMemsetAsync((char*)d_ws + WS_CTL, 0, CTL_BYTES, stream) != hipSuccess) { fprintf(stderr, "kernel_launch: memset failed\n"); return; }
    Args a{};
    for (int i = 0; i < 23; ++i) a.in[i] = (const float*)d_in[i];
    a.out = (float*)d_out; a.ws = (unsigned char*)d_ws;
#if MK_ONE_LAUNCH
    a.ph_lo = 0; a.ph_hi = NPHASE;
    hipLaunchKernelGGL(mk_fwd, dim3(grid), dim3(512), LDS_BYTES, stream, a);
#else
    for (int p = 0; p < NPHASE; ++p) { a.ph_lo = p; a.ph_hi = p + 1; hipLaunchKernelGGL(mk_fwd, dim3(grid), dim3(512), LDS_BYTES, stream, a); }
#endif
    const hipError_t le = hipPeekAtLastError();
    if (le != hipSuccess) fprintf(stderr, "kernel_launch: launch failed: %s\n", hipGetErrorName(le));
}
```

```cpp
#include <hip/hip_runtime.h>
#include <cstdio>
#include <cstdint>

#define LAS __attribute__((address_space(3)))
typedef unsigned short bf16_t;
typedef float f32x4 __attribute__((ext_vector_type(4)));
typedef unsigned u32x4 __attribute__((ext_vector_type(4)));
typedef unsigned u32x2 __attribute__((ext_vector_type(2)));

#ifndef CONV_P2
#define CONV_P2 28160
#endif
#ifndef CONV_NT
#define CONV_NT 1
#endif
#ifndef MK_ONE_LAUNCH
#define MK_ONE_LAUNCH 1
#endif

constexpr int D = 2048, SEQ = 8192, NB = 2, NTOK = NB * SEQ;
constexpr int NMETA = 16, INW = 4608, MROWS = NTOK + 256;
constexpr int NE = 64, DE = 512, PMAX = 147456, HBROWS = PMAX + NTOK;
constexpr float ALPHA = 1.189207115002721f;
constexpr float LN_EPS = 1e-5f, RMS_EPS = 1e-6f, LOG2E = 1.4426950408889634f, QSCALE = 0.125f * LOG2E;
constexpr int COL_QA = 0, COL_KA = 1024, COL_VA = 1280, COL_QB = 1536, COL_KB = 2560, COL_VB = 3584;
constexpr int NPHASE = 9;
constexpr int LDS_BYTES = 147456;

constexpr size_t WS_CTL = 0, CTL_BYTES = 32768;
constexpr size_t WS_CNT = 16384;
constexpr size_t WS_STATS0 = WS_CTL + CTL_BYTES;
constexpr size_t WS_STATS1 = WS_STATS0 + (size_t)NTOK * 8;
constexpr size_t WS_SSQ = WS_STATS1 + (size_t)NTOK * 8;
constexpr size_t WS_TOKL = WS_SSQ + (size_t)NTOK * 32 * 4;
constexpr size_t WS_WL = WS_TOKL + (size_t)NE * NTOK * 4;
constexpr size_t WS_TKE = WS_WL + (size_t)NE * NTOK * 4;
constexpr size_t WS_TKR = WS_TKE + (size_t)NTOK * 8 * 4;
constexpr size_t WS_TAB = WS_TKR + (size_t)NTOK * 8 * 4;
constexpr size_t WS_WRT = WS_TAB + 32768;
constexpr size_t WS_Z = WS_WRT + (size_t)NE * D * 2;
constexpr size_t WS_O2 = WS_Z + (size_t)NTOK * D * 2;
constexpr size_t WS_WTD = WS_Z + (size_t)NTOK * D * 4;
constexpr size_t WS_HB = WS_WTD + (size_t)65 * 2048 * 512 * 2;
constexpr size_t WS_B = WS_HB + (size_t)HBROWS * 512 * 2;
constexpr size_t WS_WTGU = WS_B;
constexpr size_t WS_WTIN = WS_WTGU + (size_t)65 * 1024 * 2048 * 2;
constexpr size_t WS_WTOUT = WS_WTIN + (size_t)INW * D * 2;
constexpr size_t WS_H0 = WS_WTOUT + (size_t)D * D * 2;
constexpr size_t WS_U = WS_H0 + (size_t)MROWS * D * 2;
constexpr size_t WS_YA = WS_U + (size_t)MROWS * INW * 2;
constexpr size_t WS_H1Q = WS_WTD + (size_t)65 * 2048 * 512;
constexpr size_t WS_H1 = WS_Z;
constexpr size_t WS_YM = WS_B;
constexpr size_t WS_END_A = WS_YA + (size_t)NTOK * D * 2, WS_END_B = WS_YM + (size_t)PMAX * D * 2;
constexpr size_t WS_END = WS_END_A > WS_END_B ? WS_END_A : WS_END_B;
static_assert(WS_END <= ((size_t)1 << 30), "workspace map must fit 1 GiB");

__device__ __forceinline__ float bf2f(bf16_t b) { return __uint_as_float(((unsigned)b) << 16); }
__device__ __forceinline__ bf16_t f2bf(float f) { unsigned u = __float_as_uint(f); u += 0x7FFFu + ((u >> 16) & 1u); return (bf16_t)(u >> 16); }
__device__ __forceinline__ unsigned pack2(float lo, float hi) { return (unsigned)f2bf(lo) | ((unsigned)f2bf(hi) << 16); }
constexpr int ENC8_EXP = 12 << 23;
__device__ __forceinline__ unsigned enc8(float x) {
    const unsigned u = __float_as_uint(x); int t = (int)(u & 0x7fffffffu) - 0x00F80000 - ENC8_EXP;
    t = t < 0x38000000 ? 0x38000000 : (t > 0x3FF00000 ? 0x3FF00000 : t);
    return (((unsigned)t >> 20) & 0x7fu) | ((u >> 24) & 0x80u); }
__device__ __forceinline__ unsigned enc8x4(float a, float b, float c, float d) { return enc8(a) | (enc8(b) << 8) | (enc8(c) << 16) | (enc8(d) << 24); }
__device__ __forceinline__ float dec8(unsigned b) { return __uint_as_float(((b & 0x7fu) << 20) + 0x39000000u + ((b & 0x80u) << 24)); }
typedef unsigned short u16x2 __attribute__((ext_vector_type(2)));
__device__ __forceinline__ unsigned cvt_pk_bf16_g(float lo, float hi) { unsigned r; asm volatile("v_cvt_pk_bf16_f32 %0, %1, %2" : "=v"(r) : "v"(lo), "v"(hi)); return r; }
__device__ __forceinline__ unsigned e4m3x2(float a, float b) {
    const unsigned p = cvt_pk_bf16_g(a, b);
    u16x2 m = __builtin_bit_cast(u16x2, p & 0x7fff7fffu);
    m = (m + (u16x2){8, 8}) >> (u16x2){4, 4};
    m = __builtin_elementwise_sub_sat(m, (u16x2){0x3C0, 0x3C0});
    m = __builtin_elementwise_min(m, (u16x2){0x7E, 0x7E});
    return __builtin_bit_cast(unsigned, m) | ((p >> 8) & 0x00800080u); }
__device__ __forceinline__ unsigned e4m3x4(float a, float b, float c, float d) { return __builtin_amdgcn_perm(e4m3x2(c, d), e4m3x2(a, b), 0x06040200u); }
__device__ __forceinline__ unsigned ym8x2(float a, float b) {
    const unsigned p = cvt_pk_bf16_g(a, b);
    u16x2 m = __builtin_bit_cast(u16x2, p & 0x7fff7fffu);
    m = (m + (u16x2){8, 8}) >> (u16x2){4, 4};
    m = __builtin_elementwise_sub_sat(m, (u16x2){0x3F0, 0x3F0});
    m = __builtin_elementwise_min(m, (u16x2){0x7F, 0x7F});
    return __builtin_bit_cast(unsigned, m) | ((p >> 8) & 0x00800080u); }
__device__ __forceinline__ unsigned ym8x4(float a, float b, float c, float d) { return __builtin_amdgcn_perm(ym8x2(c, d), ym8x2(a, b), 0x06040200u); }
constexpr float S8_H1 = 8.0f, S8_W = 256.0f, S8_HB = 16.0f, S8_GU_INV = 1.0f / (S8_H1 * S8_W), S8_DN_INV = 1.0f / (S8_HB * S8_W);
constexpr float S8_YA = 64.0f, S8_WO = 512.0f, S8_OP_INV = 1.0f / (S8_YA * S8_WO);
__device__ __forceinline__ float wsum(float v) {
#pragma unroll
    for (int o = 32; o >= 1; o >>= 1) v += __shfl_xor(v, o);
    return v; }
__device__ __forceinline__ float wmax(float v) {
#pragma unroll
    for (int o = 32; o >= 1; o >>= 1) v = fmaxf(v, __shfl_xor(v, o));
    return v; }
__device__ __forceinline__ int t5_bucket(int rel) {
    const int ret = rel > 0 ? 16 : 0, n = rel < 0 ? -rel : rel;
    if (n < 8) return ret + n;
    const int n2 = n > 32768 ? 0x40000000 : n * n; int lg = 31 - __clz(n2) + 2; if (lg > 15) lg = 15;
    return ret + lg; }

#define XB_TMO      128
#define XB_XCNT(j)  (256  + 64 * (j))
#define XB_XSUB(j)  (1280 + 64 * (j))
#define XB_XGEN(j)  (2304 + 64 * (j))
#define XB_TOP      3328
#define XB_TOPGEN   3392
#define XCD_BAR_WORDS 3456
#define XB_SPIN_CAP (1u << 18)
__device__ __forceinline__ int lane_id() { int l; asm volatile("v_mbcnt_lo_u32_b32 %0, -1, 0\n\tv_mbcnt_hi_u32_b32 %0, -1, %0" : "=v"(l)); return l; }
__device__ __forceinline__ unsigned xb_ld(unsigned* p)              { return __hip_atomic_load(p, __ATOMIC_RELAXED, __HIP_MEMORY_SCOPE_AGENT); }
__device__ __forceinline__ unsigned xb_add(unsigned* p, unsigned v) { return __hip_atomic_fetch_add(p, v, __ATOMIC_RELAXED, __HIP_MEMORY_SCOPE_AGENT); }
__device__ __forceinline__ unsigned xb_xcc_id() { return (unsigned)__builtin_amdgcn_s_getreg((3 << 11) | 20) & 0xFu; }
#define XB_SPIN(cond, bar) do { unsigned _sp = 0; while (cond) { __builtin_amdgcn_s_sleep(1); \
    if ((++_sp & 255u) == 0u) { if (xb_ld(&(bar)[XB_TMO])) break; if (_sp > XB_SPIN_CAP) { atomicAdd(&(bar)[XB_TMO], 1u); break; } } } } while (0)
struct XcdBarrier { unsigned* bar; unsigned x; volatile LAS unsigned* st; int wave0; };
__device__ __forceinline__ XcdBarrier xcd_barrier_post(unsigned* bar, volatile LAS unsigned* st, int wave0) {
    XcdBarrier b; b.bar = bar; b.x = xb_xcc_id(); b.st = st; b.wave0 = wave0;
    if (wave0 == 0 && lane_id() == 0) (void)xb_add(&bar[XB_XCNT(b.x)], 1u);
    return b;
}
__device__ __forceinline__ void xcd_barrier_complete(unsigned* bar, unsigned x, unsigned& nloc, unsigned& nx) {
    const unsigned G = gridDim.x * gridDim.y * gridDim.z;
    unsigned sum, cnt, mine, sp = 0u;
    for (;;) {
        sum = 0u; cnt = 0u; mine = 0u;
#pragma unroll
        for (unsigned j = 0; j < 16; ++j) { const unsigned c = xb_ld(&bar[XB_XCNT(j)]); sum += c; cnt += (c > 0u) ? 1u : 0u; mine = (j == x) ? c : mine; }
        if (sum == G) break;
        __builtin_amdgcn_s_sleep(1);
        if ((++sp & 255u) == 0u) { if (xb_ld(&bar[XB_TMO])) break; if (sp > XB_SPIN_CAP) { atomicAdd(&bar[XB_TMO], 1u); break; } }
    }
    nloc = mine > 0u ? mine : 1u; nx = cnt > 0u ? cnt : 1u;
}
__device__ __forceinline__ void xcd_barrier(const XcdBarrier& b) {
    asm volatile("s_waitcnt vmcnt(0)" ::: "memory");
    __syncthreads();
    if (b.wave0 == 0 && lane_id() == 0) {
        unsigned* bar = b.bar;
        __builtin_amdgcn_s_waitcnt(0);
        unsigned nloc = b.st[0], nx = b.st[1];
        if (nloc == 0u) { xcd_barrier_complete(bar, b.x, nloc, nx); b.st[0] = nloc; b.st[1] = nx; }
        const unsigned old = xb_add(&bar[XB_XSUB(b.x)], 1u);
        const unsigned gen = old / nloc;
        if (old + 1u == (gen + 1u) * nloc) {
            __builtin_amdgcn_fence(__ATOMIC_RELEASE, "agent");
            asm volatile("s_waitcnt vmcnt(0)" ::: "memory");
            const unsigned og = xb_add(&bar[XB_TOP], 1u);
            const unsigned tg = og / nx;
            if (og + 1u == (tg + 1u) * nx) xb_add(&bar[XB_TOPGEN], 1u);
            else XB_SPIN(xb_ld(&bar[XB_TOPGEN]) == tg, bar);
            __builtin_amdgcn_fence(__ATOMIC_ACQUIRE, "agent");
            xb_add(&bar[XB_XGEN(b.x)], 1u);
            asm volatile("s_waitcnt vmcnt(0)" ::: "memory");
        } else {
            XB_SPIN(xb_ld(&bar[XB_XGEN(b.x)]) == gen, bar);
            __builtin_amdgcn_fence(__ATOMIC_ACQUIRE, "agent");
            asm volatile("s_waitcnt vmcnt(0)" ::: "memory");
        }
    }
    __syncthreads();
}

struct Args { const float* in[23]; float* out; unsigned char* ws; int ph_lo, ph_hi; };
struct Frame {
    LAS unsigned char* lds; int tid, lane, wave, G, bx;
    const float *x, *meta, *lng, *lnb, *t5, *w_in, *sink, *rpb, *ga, *gb, *w_out, *l1g, *l1b, *w_router, *rbias, *w_gate, *w_up, *w_down, *ws_gate, *ws_up, *ws_down, *l2g, *l2b;
    float* out; unsigned char* ws;
    int wave0;
    __device__ __forceinline__ void fresh() { int t = wave0 * 64 + lane_id(); asm volatile("" : "+v"(t)); tid = t; lane = t & 63; wave = wave0; }
    __device__ __forceinline__ float* stats0() const { return (float*)(ws + WS_STATS0); }
    __device__ __forceinline__ float* stats1() const { return (float*)(ws + WS_STATS1); }
    __device__ __forceinline__ float* ssq() const { return (float*)(ws + WS_SSQ); }
    __device__ __forceinline__ float* wl() const { return (float*)(ws + WS_WL); }
    __device__ __forceinline__ float* tab() const { return (float*)(ws + WS_TAB); }
    __device__ __forceinline__ int* cnt() const { return (int*)(ws + WS_CNT); }
    __device__ __forceinline__ int* tokl() const { return (int*)(ws + WS_TOKL); }
    __device__ __forceinline__ int* tke() const { return (int*)(ws + WS_TKE); }
    __device__ __forceinline__ int* tkr() const { return (int*)(ws + WS_TKR); }
    __device__ __forceinline__ bf16_t* wtd() const { return (bf16_t*)(ws + WS_WTD); }
    __device__ __forceinline__ bf16_t* hb() const { return (bf16_t*)(ws + WS_HB); }
    __device__ __forceinline__ bf16_t* wtgu() const { return (bf16_t*)(ws + WS_WTGU); }
    __device__ __forceinline__ bf16_t* wtin() const { return (bf16_t*)(ws + WS_WTIN); }
    __device__ __forceinline__ bf16_t* wtout() const { return (bf16_t*)(ws + WS_WTOUT); }
    __device__ __forceinline__ bf16_t* h0() const { return (bf16_t*)(ws + WS_H0); }
    __device__ __forceinline__ bf16_t* u() const { return (bf16_t*)(ws + WS_U); }
    __device__ __forceinline__ bf16_t* ya() const { return (bf16_t*)(ws + WS_YA); }
    __device__ __forceinline__ bf16_t* h1() const { return (bf16_t*)(ws + WS_H1); }
    __device__ __forceinline__ unsigned char* h1q() const { return (unsigned char*)(ws + WS_H1Q); }
    __device__ __forceinline__ bf16_t* ym() const { return (bf16_t*)(ws + WS_YM); }
    __device__ __forceinline__ bf16_t* wrt() const { return (bf16_t*)(ws + WS_WRT); }
    __device__ __forceinline__ bf16_t* z() const { return (bf16_t*)(ws + WS_Z); }
    __device__ __forceinline__ bf16_t* o2() const { return (bf16_t*)(ws + WS_O2); }
};

struct ConvDesc { const float* src; bf16_t* dst; int lds_, ldd_; const float* ksc; float csc; int f8; };
__device__ __forceinline__ void conv_load(const ConvDesc& d, f32x4 (&v)[16], int lane) {
    const int kk = lane & 3, n4 = (lane >> 2) * 4;
#pragma unroll
    for (int p = 0; p < 16; ++p) v[p] = __builtin_nontemporal_load((const f32x4*)(d.src + (size_t)(4 * p + kk) * d.lds_ + n4));
}
__device__ __forceinline__ void conv_finish(const ConvDesc& d, const f32x4 (&v)[16], LAS float* scr, int lane) {
    const int kk = lane & 3, n4 = (lane >> 2) * 4;
#pragma unroll
    for (int p = 0; p < 16; ++p) { const int k = 4 * p + kk; const float s = d.ksc ? d.ksc[k] * d.csc : d.csc;
        scr[k * 65 + n4] = v[p][0] * s; scr[k * 65 + n4 + 1] = v[p][1] * s; scr[k * 65 + n4 + 2] = v[p][2] * s; scr[k * 65 + n4 + 3] = v[p][3] * s; }
    asm volatile("s_waitcnt lgkmcnt(0)" ::: "memory");
    if (d.f8) {
        const int c = lane >> 4;
#pragma unroll
        for (int j = 0; j < 4; ++j) { const int n = (lane & 15) + 16 * j; const LAS float* s = scr + (16 * c) * 65 + n; u32x4 o;
            o.x = e4m3x4(s[0], s[65], s[2 * 65], s[3 * 65]); o.y = e4m3x4(s[4 * 65], s[5 * 65], s[6 * 65], s[7 * 65]);
            o.z = e4m3x4(s[8 * 65], s[9 * 65], s[10 * 65], s[11 * 65]); o.w = e4m3x4(s[12 * 65], s[13 * 65], s[14 * 65], s[15 * 65]);
            __builtin_nontemporal_store(o, (u32x4*)((unsigned char*)d.dst + (size_t)n * d.ldd_ + 16 * c)); }
        asm volatile("s_waitcnt lgkmcnt(0)" ::: "memory");
        return; }
    const int c = lane >> 3;
#pragma unroll
    for (int j = 0; j < 8; ++j) { const int n = (lane & 7) + 8 * j; const LAS float* s = scr + (8 * c) * 65 + n; u32x4 o;
        o.x = pack2(s[0], s[65]); o.y = pack2(s[2 * 65], s[3 * 65]); o.z = pack2(s[4 * 65], s[5 * 65]); o.w = pack2(s[6 * 65], s[7 * 65]);
        __builtin_nontemporal_store(o, (u32x4*)(d.dst + (size_t)n * d.ldd_ + 8 * c)); }
    asm volatile("s_waitcnt lgkmcnt(0)" ::: "memory");
}
constexpr int T_R = 32, T_IN = 72 * 32, T_OUT = 32 * 32, T_GU = 65 * 2 * 8 * 32, T_D = 65 * 32 * 8;
constexpr int IT_P0 = T_R + T_IN, IT_ALL = IT_P0 + T_OUT + T_GU + T_D, IT_P6 = IT_ALL - 3600, IT_MID = IT_P6 - CONV_P2;
__device__ __forceinline__ ConvDesc conv_desc(const Frame& F, int it) {
    int r = it; const float* src; bf16_t* dst; int lds_, ldd_, f8 = 0; const float* ksc = nullptr; float csc = 1.0f;
    if (r < T_R) { src = F.w_router + (size_t)(r * 64) * NE; lds_ = NE; dst = F.wrt() + r * 64; ldd_ = D; }
    else if ((r -= T_R) < T_IN) { const int tn = r % 72, tk = r / 72; const int n0 = tn * 64; const bool isq = (n0 < COL_KA) || (n0 >= COL_QB && n0 < COL_KB);
        src = F.w_in + (size_t)(tk * 64) * INW + n0; lds_ = INW; dst = F.wtin() + (size_t)n0 * D + tk * 64; ldd_ = D; csc = isq ? QSCALE : 1.0f; }
    else if ((r -= T_IN) < T_OUT) { const int tn = r % 32, tk = r / 32; const int k0 = tk * 64;
        src = F.w_out + (size_t)k0 * D + tn * 64; lds_ = D; dst = (bf16_t*)((unsigned char*)F.wtout() + (size_t)(tn * 64) * D + k0); ldd_ = D; ksc = k0 < 1024 ? F.ga + k0 : F.gb + (k0 - 1024); f8 = 1; csc = S8_WO; }
    else if ((r -= T_OUT) < T_GU) { const int tn = r % 8, tk = (r / 8) % 32, which = (r / 256) % 2, e = r / 512;
        const float* s0 = e < NE ? (which ? F.w_up : F.w_gate) + (size_t)e * D * DE : (which ? F.ws_up : F.ws_gate);
        const int c0 = tn * 64, nprime = 256 * (c0 / 128) + 128 * which + (c0 % 128);
        src = s0 + (size_t)(tk * 64) * DE + c0; lds_ = DE; dst = (bf16_t*)((unsigned char*)F.wtgu() + ((size_t)e * 1024 + nprime) * D + tk * 64); ldd_ = D; f8 = 1; csc = S8_W; }
    else { r -= T_GU; const int tn = r % 32, tk = (r / 32) % 8, e = r / 256;
        const float* s0 = e < NE ? F.w_down + (size_t)e * DE * D : F.ws_down;
        src = s0 + (size_t)(tk * 64) * D + tn * 64; lds_ = D; dst = (bf16_t*)((unsigned char*)F.wtd() + ((size_t)e * D + tn * 64) * DE + tk * 64); ldd_ = DE; f8 = 1; csc = S8_W; }
    return ConvDesc{src, dst, lds_, ldd_, ksc, csc, f8};
}
__device__ __forceinline__ void conv_items(const Frame& F, int first, int last, int step) {
    LAS float* t = (LAS float*)F.lds + F.wave * (64 * 65);
    if (first >= last) return;
    f32x4 va[16], vb[16]; ConvDesc da = conv_desc(F, first), db = da;
    conv_load(da, va, F.lane);
    for (int it = first; it < last; it += 2 * step) {
        const bool hb = it + step < last; if (hb) { db = conv_desc(F, it + step); conv_load(db, vb, F.lane); }
        conv_finish(da, va, t, F.lane);
        if (!hb) break;
        const bool ha = it + 2 * step < last; if (ha) { da = conv_desc(F, it + 2 * step); conv_load(da, va, F.lane); }
        conv_finish(db, vb, t, F.lane);
        if (!ha) break;
    }
}
__device__ __forceinline__ void conv_range(const Frame& F, int first, int last) { conv_items(F, first + F.wave, last, 8); }
__device__ __forceinline__ void conv_inproj_share(const Frame& F) {
    constexpr int N1 = IT_MID - IT_P0, CY = (N1 - 118 * 100 + 255) / 256, CX = CY + 100; int a, n;
    if (F.G == 256) { if (F.bx < 138) { a = F.bx * CY; n = CY; } else { a = 138 * CY + (F.bx - 138) * CX; n = CX; } }
    else { n = (N1 + F.G - 1) / F.G; a = F.bx * n; }
    const int e = a + n < N1 ? a + n : N1;
    if (a < e) conv_range(F, IT_P0 + a, IT_P0 + e);
}
__device__ __forceinline__ void conv_tail(const Frame& F, int first, int last, int c0) {
    int nw = F.G - c0, me = F.bx - c0; if (nw <= 0) { nw = F.G; me = F.bx; }
    if (me < 0) return;
    conv_items(F, first + me * 8 + F.wave, last, nw * 8);
}
__device__ __forceinline__ void phase_prologue(Frame& F) {
    const int gw = F.bx * 8 + F.wave, NGW = F.G * 8;
    conv_items(F, gw, IT_P0, NGW);
    for (int row = gw; row < MROWS; row += NGW) {
        bf16_t* dst = F.h0() + (size_t)row * D;
        if (row >= NTOK + NMETA) {
#pragma unroll
            for (int j = 0; j < 8; ++j) *(u32x2*)(dst + (j * 64 + F.lane) * 4) = (u32x2){0u, 0u};
            continue; }
        const float* src = row < NTOK ? F.x + (size_t)row * D : F.meta + (size_t)(row - NTOK) * D;
        f32x4 v[8]; float s = 0.f;
#pragma unroll
        for (int j = 0; j < 8; ++j) { v[j] = *(const f32x4*)(src + (j * 64 + F.lane) * 4); s += (v[j][0] + v[j][1]) + (v[j][2] + v[j][3]); }
        const float mu = wsum(s) * (1.0f / D); float q = 0.f;
#pragma unroll
        for (int j = 0; j < 8; ++j) { const f32x4 d = v[j] - mu; q += (d[0] * d[0] + d[1] * d[1]) + (d[2] * d[2] + d[3] * d[3]); }
        const float rstd = 1.0f / sqrtf(wsum(q) * (1.0f / D) + LN_EPS);
#pragma unroll
        for (int j = 0; j < 8; ++j) { const int c = (j * 64 + F.lane) * 4; const f32x4 g = *(const f32x4*)(F.lng + c), b = *(const f32x4*)(F.lnb + c); const f32x4 y = (v[j] - mu) * rstd * g + b;
            *(u32x2*)(dst + c) = (u32x2){pack2(y[0], y[1]), pack2(y[2], y[3])}; }
        if (row < NTOK && F.lane == 0) { F.stats0()[row * 2] = mu; F.stats0()[row * 2 + 1] = rstd; }
    }
    if (F.bx == 0) for (int i = F.tid; i < 16 * 272; i += 512) { const int h = i / 272, r = i % 272; F.tab()[i] = r <= 256 ? F.t5[t5_bucket(r - 128) * 16 + h] * LOG2E : 0.f; }
}

template <class Fn> __device__ __forceinline__ void sgemm(const Fn& f, LAS unsigned char* ldsb, int tid, int bx, int G) {
    LAS float* As = (LAS float*)ldsb; LAS float* Bs = As + 32 * 132; LAS float* Bs2 = Bs + 32 * 68;
    const int ntm = f.ntm(), ntn = f.ntn(), K = f.K();
    const int tx = tid & 15, ty = tid >> 4, ar = tid >> 2, akc = (tid & 3) * 8, br = (tid & 255) >> 2;
    for (int tile = bx; tile < ntm * ntn; tile += G) {
        const int tm = tile / ntn, tn = tile % ntn;
        typename Fn::Tile T; if (!f.tile(tm, T)) continue;
        float acc[4][4], acc2[4][4];
#pragma unroll
        for (int i = 0; i < 4; ++i)
#pragma unroll
            for (int j = 0; j < 4; ++j) { acc[i][j] = 0.f; acc2[i][j] = 0.f; }
        const bf16_t* ap = f.arow(T, tm * 128 + ar);
        const bf16_t* bp = tid < 256 ? f.brow(T, tn * 64 + br) : (Fn::DUAL ? f.brow2(T, tn * 64 + br) : nullptr);
        LAS float* Bw = tid < 256 ? Bs : Bs2;
        for (int k0 = 0; k0 < K; k0 += 32) {
            u32x4 av = (u32x4){0u, 0u, 0u, 0u}, bv = (u32x4){0u, 0u, 0u, 0u};
            if (ap) av = *(const u32x4*)(ap + k0 + akc);
            if (bp) bv = *(const u32x4*)(bp + k0 + akc);
            __syncthreads();
#pragma unroll
            for (int i = 0; i < 4; ++i) { As[(akc + 2 * i) * 132 + ar] = __uint_as_float(av[i] << 16); As[(akc + 2 * i + 1) * 132 + ar] = __uint_as_float(av[i] & 0xffff0000u); }
            if (tid < 256 || Fn::DUAL) {
#pragma unroll
                for (int i = 0; i < 4; ++i) { Bw[(akc + 2 * i) * 68 + br] = __uint_as_float(bv[i] << 16); Bw[(akc + 2 * i + 1) * 68 + br] = __uint_as_float(bv[i] & 0xffff0000u); } }
            __syncthreads();
#pragma unroll 8
            for (int kk = 0; kk < 32; ++kk) {
                const f32x4 a = *(const LAS f32x4*)(As + kk * 132 + ty * 4), b = *(const LAS f32x4*)(Bs + kk * 68 + tx * 4);
#pragma unroll
                for (int i = 0; i < 4; ++i)
#pragma unroll
                    for (int j = 0; j < 4; ++j) acc[i][j] += a[i] * b[j];
                if (Fn::DUAL) { const f32x4 b2 = *(const LAS f32x4*)(Bs2 + kk * 68 + tx * 4);
#pragma unroll
                    for (int i = 0; i < 4; ++i)
#pragma unroll
                        for (int j = 0; j < 4; ++j) acc2[i][j] += a[i] * b2[j]; }
            }
        }
#pragma unroll
        for (int i = 0; i < 4; ++i)
#pragma unroll
            for (int j = 0; j < 4; ++j) f.store(T, tm * 128 + ty * 4 + i, tn * 64 + tx * 4 + j, acc[i][j], acc2[i][j]);
    }
}

__device__ __forceinline__ void expert_starts(const Frame& F, LAS int* ps  ) {
    if (F.tid == 0) { int acc = 0; for (int e = 0; e < NE; ++e) { ps[e] = acc; acc += ((F.cnt()[e] + 255) >> 8) << 8; } ps[64] = acc; }
    __syncthreads();
}

struct FnInProj {
    static constexpr bool DUAL = false; struct Tile {}; const Frame& F;
    __device__ int ntm() const { return MROWS / 128; } __device__ int ntn() const { return INW / 64; } __device__ int K() const { return D; }
    __device__ bool tile(int, Tile&) const { return true; }
    __device__ const bf16_t* arow(const Tile&, int row) const { return F.h0() + (size_t)row * D; }
    __device__ const bf16_t* brow(const Tile&, int n) const { return F.wtin() + (size_t)n * D; }
    __device__ const bf16_t* brow2(const Tile&, int) const { return nullptr; }
    __device__ void store(const Tile&, int row, int n, float a, float) const { F.u()[(size_t)row * INW + n] = f2bf(a); }
};
struct FnOutProj {
    static constexpr bool DUAL = false; struct Tile {}; const Frame& F;
    __device__ int ntm() const { return NTOK / 128; } __device__ int ntn() const { return D / 64; } __device__ int K() const { return D; }
    __device__ bool tile(int, Tile&) const { return true; }
    __device__ const bf16_t* arow(const Tile&, int row) const { return F.ya() + (size_t)row * D; }
    __device__ const bf16_t* brow(const Tile&, int n) const { return F.wtout() + (size_t)n * D; }
    __device__ const bf16_t* brow2(const Tile&, int) const { return nullptr; }
    __device__ void store(const Tile&, int row, int n, float a, float) const {
        const float h0 = (F.x[(size_t)row * D + n] - F.stats0()[row * 2]) * F.stats0()[row * 2 + 1] * F.lng[n] + F.lnb[n];
        F.z()[(size_t)row * D + n] = f2bf(a + ALPHA * h0); }
};
struct FnGateUp {
    static constexpr bool DUAL = true; struct Tile { int e, r0, n; }; const Frame& F; const LAS int* ps;
    __device__ int ntm() const { return HBROWS / 128; } __device__ int ntn() const { return DE / 64; } __device__ int K() const { return D; }
    __device__ bool tile(int tm, Tile& T) const { const int row0 = tm * 128;
        if (row0 >= PMAX) { T.e = NE; T.r0 = row0 - PMAX; T.n = NTOK; return true; }
        if (row0 >= ps[64]) return false;
        int e = 0; while (e < NE - 1 && row0 >= ps[e + 1]) ++e;
        T.e = e; T.r0 = row0 - ps[e]; T.n = F.cnt()[e]; return T.r0 < T.n; }
    __device__ const bf16_t* arow(const Tile& T, int row) const { const int r = T.r0 + (row & 127); if (r >= T.n) return nullptr;
        const int tok = T.e < NE ? F.tokl()[(size_t)T.e * NTOK + r] : r; return F.h1() + (size_t)tok * D; }
    __device__ const bf16_t* brow(const Tile& T, int n) const { return F.wtgu() + ((size_t)T.e * 1024 + 256 * (n >> 7) + (n & 127)) * D; }
    __device__ const bf16_t* brow2(const Tile& T, int n) const { return F.wtgu() + ((size_t)T.e * 1024 + 256 * (n >> 7) + 128 + (n & 127)) * D; }
    __device__ void store(const Tile& T, int row, int n, float g, float u) const { const int r = T.r0 + (row & 127); const float w = T.e < NE ? (r < T.n ? F.wl()[(size_t)T.e * NTOK + r] : 0.f) : 1.0f;
        F.hb()[(size_t)row * DE + n] = f2bf(g / (1.0f + __expf(-g)) * (u * w)); }
};
struct FnDown {
    static constexpr bool DUAL = false; struct Tile { int e, r0, n; }; const Frame& F; const LAS int* ps;
    __device__ int ntm() const { return PMAX / 128; } __device__ int ntn() const { return D / 64; } __device__ int K() const { return DE; }
    __device__ bool tile(int tm, Tile& T) const { const int row0 = tm * 128; if (row0 >= ps[64]) return false;
        int e = 0; while (e < NE - 1 && row0 >= ps[e + 1]) ++e;
        T.e = e; T.r0 = row0 - ps[e]; T.n = F.cnt()[e]; return T.r0 < T.n; }
    __device__ const bf16_t* arow(const Tile&, int row) const { return F.hb() + (size_t)row * DE; }
    __device__ const bf16_t* brow(const Tile& T, int n) const { return F.wtd() + ((size_t)T.e * D + n) * DE; }
    __device__ const bf16_t* brow2(const Tile&, int) const { return nullptr; }
    __device__ void store(const Tile& T, int row, int n, float a, float) const { const int r = T.r0 + (row & 127);
        (void)r; ((unsigned char*)F.ym())[(size_t)row * D + n] = (unsigned char)enc8(a); }
};
struct FnFinal {
    static constexpr bool DUAL = false; struct Tile {}; const Frame& F; const LAS int* ps;
    __device__ int ntm() const { return NTOK / 128; } __device__ int ntn() const { return D / 64; } __device__ int K() const { return DE; }
    __device__ bool tile(int, Tile&) const { return true; }
    __device__ const bf16_t* arow(const Tile&, int row) const { return F.hb() + (size_t)(PMAX + row) * DE; }
    __device__ const bf16_t* brow(const Tile&, int n) const { return F.wtd() + ((size_t)NE * D + n) * DE; }
    __device__ const bf16_t* brow2(const Tile&, int) const { return nullptr; }
    __device__ void store(const Tile&, int row, int n, float a, float) const {
        const float h1 = bf2f(F.h1()[(size_t)row * D + n]);
        F.o2()[(size_t)row * D + n] = f2bf(a + ALPHA * h1); }
};

__device__ __forceinline__ void phase_attn_simple(Frame& F) {
    LAS float* qs = (LAS float*)F.lds + F.wave * 512; LAS float* psm = qs + 64;
    const int gw = F.bx * 8 + F.wave, NGW = F.G * 8, lane = F.lane;
    for (int item = gw; item < NTOK * 32; item += NGW) {
        const int tok = item >> 5, hh = item & 31, b = tok >> 13, s = tok & 8191;
        const bool isA = hh < 16; const int h = hh & 15;
        const int qcol = isA ? COL_QA + h * 64 : COL_QB + h * 64, kcol = isA ? COL_KA + (h >> 2) * 64 : COL_KB + h * 64, vcol = isA ? COL_VA + (h >> 2) * 64 : COL_VB + h * 64;
        const int r = s >> 6, c = s & 63, rs = min(max(r - 4, 0), 120), cs = min(max(c - 8, 0), 48);
        const int nkeys = isA ? 16 + 257 : 16 + 128;
        asm volatile("s_waitcnt lgkmcnt(0)" ::: "memory");
        qs[lane] = bf2f(F.u()[(size_t)tok * INW + qcol + lane]);
        asm volatile("s_waitcnt lgkmcnt(0)" ::: "memory");
        float sc[5]; float mx = -INFINITY;
#pragma unroll
        for (int i = 0; i < 5; ++i) {
            const int j = lane + 64 * i; sc[i] = -INFINITY;
            if (j < nkeys) {
                int krow; float bias; bool valid = true;
                if (j < 16) { krow = NTOK + j; bias = isA ? F.t5[t5_bucket(j - 16 - s) * 16 + h] * LOG2E : 0.f; }
                else if (isA) { const int kpos = s - 128 + (j - 16); valid = kpos >= 0 && kpos < SEQ; krow = b * SEQ + kpos; bias = F.tab()[h * 272 + (j - 16)]; }
                else { const int w = j - 16, kr = rs + (w >> 4), kc = cs + (w & 15); krow = b * SEQ + kr * 64 + kc; bias = F.rpb[(h * 15 + (kr - r + 7)) * 31 + (kc - c + 15)] * LOG2E; }
                if (valid) { const bf16_t* kp = F.u() + (size_t)krow * INW + kcol; float dot = 0.f;
#pragma unroll
                    for (int d8 = 0; d8 < 8; ++d8) { const u32x4 kv = *(const u32x4*)(kp + d8 * 8);
#pragma unroll
                        for (int i2 = 0; i2 < 4; ++i2) { dot += qs[d8 * 8 + 2 * i2] * __uint_as_float(kv[i2] << 16); dot += qs[d8 * 8 + 2 * i2 + 1] * __uint_as_float(kv[i2] & 0xffff0000u); } }
                    sc[i] = dot + bias; }
            }
            mx = fmaxf(mx, sc[i]);
        }
        const float sinkl = isA ? F.sink[h] * LOG2E : -INFINITY;
        mx = fmaxf(wmax(mx), sinkl);
        float l = 0.f;
#pragma unroll
        for (int i = 0; i < 5; ++i) { const int j = lane + 64 * i; const float p = sc[i] == -INFINITY ? 0.f : exp2f(sc[i] - mx); l += p; if (j < 320) psm[j] = p; }
        l = wsum(l) + (isA ? exp2f(sinkl - mx) : 0.f);
        asm volatile("s_waitcnt lgkmcnt(0)" ::: "memory");
        float o = 0.f;
        for (int j = 0; j < nkeys; ++j) { const float p = psm[j]; if (p == 0.f) continue;
            int krow; if (j < 16) krow = NTOK + j; else if (isA) krow = b * SEQ + s - 128 + (j - 16); else { const int w = j - 16; krow = b * SEQ + (rs + (w >> 4)) * 64 + cs + (w & 15); }
            o += p * bf2f(F.u()[(size_t)krow * INW + vcol + lane]); }
        o /= l;
        const bf16_t ob = f2bf(o); F.ya()[(size_t)tok * D + hh * 64 + lane] = ob;
        const float of = bf2f(ob), q = wsum(of * of);
        if (lane == 0) F.ssq()[tok * 32 + hh] = q;
    }
}
__device__ __forceinline__ void phase_rmsnorm(Frame& F) {
    const int gw = F.bx * 8 + F.wave, NGW = F.G * 8, lane = F.lane;
    for (int tok = gw; tok < NTOK; tok += NGW) {
        const float q = lane < 32 ? F.ssq()[tok * 32 + lane] : 0.f;
        float qa = lane < 16 ? q : 0.f, qb = (lane >= 16 && lane < 32) ? q : 0.f; qa = wsum(qa); qb = wsum(qb);
        const float ra = 1.0f / sqrtf(qa * (1.0f / 1024.f) + RMS_EPS), rb = 1.0f / sqrtf(qb * (1.0f / 1024.f) + RMS_EPS);
        bf16_t* p = F.ya() + (size_t)tok * D;
#pragma unroll
        for (int j = 0; j < 8; ++j) { const int c = (j * 64 + lane) * 4; const float rr = c < 1024 ? ra : rb; u32x2 w = *(u32x2*)(p + c);
            w.x = pack2(__uint_as_float(w.x << 16) * rr, __uint_as_float(w.x & 0xffff0000u) * rr); w.y = pack2(__uint_as_float(w.y << 16) * rr, __uint_as_float(w.y & 0xffff0000u) * rr); *(u32x2*)(p + c) = w; }
    }
}

__device__ __forceinline__ void phase_ln1_router(Frame& F) {
    LAS float* hs = (LAS float*)F.lds + F.wave * 2048;
    const int gw = F.bx * 8 + F.wave, NGW = F.G * 8, lane = F.lane;
    for (int tok = gw; tok < NTOK; tok += NGW) {
        const bf16_t* src = F.z() + (size_t)tok * D; f32x4 v[8]; float s = 0.f;
#pragma unroll
        for (int j = 0; j < 8; ++j) { const u32x2 w = *(const u32x2*)(src + (j * 64 + lane) * 4); v[j] = (f32x4){__uint_as_float(w.x << 16), __uint_as_float(w.x & 0xffff0000u), __uint_as_float(w.y << 16), __uint_as_float(w.y & 0xffff0000u)}; s += (v[j][0] + v[j][1]) + (v[j][2] + v[j][3]); }
        const float mu = wsum(s) * (1.0f / D); float q = 0.f;
#pragma unroll
        for (int j = 0; j < 8; ++j) { const f32x4 d = v[j] - mu; q += (d[0] * d[0] + d[1] * d[1]) + (d[2] * d[2] + d[3] * d[3]); }
        const float rstd = 1.0f / sqrtf(wsum(q) * (1.0f / D) + LN_EPS);
        asm volatile("s_waitcnt lgkmcnt(0)" ::: "memory");
#pragma unroll
        for (int j = 0; j < 8; ++j) { const int c = (j * 64 + lane) * 4; const f32x4 g = *(const f32x4*)(F.l1g + c), bb = *(const f32x4*)(F.l1b + c); const f32x4 y = (v[j] - mu) * rstd * g + bb;
            *(u32x2*)(F.h1() + (size_t)tok * D + c) = (u32x2){pack2(y[0], y[1]), pack2(y[2], y[3])}; *(LAS f32x4*)(hs + c) = y; }
        if (lane == 0) { F.stats1()[tok * 2] = mu; F.stats1()[tok * 2 + 1] = rstd; }
        asm volatile("s_waitcnt lgkmcnt(0)" ::: "memory");
        float lg = 0.f;
#pragma unroll 8
        for (int n = 0; n < D; ++n) lg += hs[n] * F.w_router[(size_t)n * NE + lane];
        const float score = 1.0f / (1.0f + expf(-lg)), v0 = score + F.rbias[lane];
        int rk = 0;
#pragma unroll
        for (int j = 0; j < 8; ++j) { const int o = (lane & ~7) + j; const float w = __shfl(v0, o); rk += (w > v0 || (w == v0 && o < lane)) ? 1 : 0; }
        float gs = rk < 2 ? v0 : 0.f; gs += __shfl_xor(gs, 1); gs += __shfl_xor(gs, 2); gs += __shfl_xor(gs, 4);
        int grk = 0; const int myg = lane >> 3;
#pragma unroll
        for (int g = 0; g < 8; ++g) { const float w = __shfl(gs, g * 8); grk += (w > gs || (w == gs && g < myg)) ? 1 : 0; }
        const float mv = grk < 4 ? v0 : -INFINITY;
        int erk = 0;
        for (int o = 0; o < 64; ++o) { const float w = __shfl(mv, o); erk += (w > mv || (w == mv && o < lane)) ? 1 : 0; }
        const bool sel = erk < 8;
        const float wsm = wsum(sel ? score : 0.f), wgt = score / (wsm + 1e-20f) * 2.5f;
        if (sel) { const int rr = atomicAdd(F.cnt() + lane, 1); F.tokl()[(size_t)lane * NTOK + rr] = tok; F.wl()[(size_t)lane * NTOK + rr] = wgt; F.tke()[tok * 8 + erk] = lane; F.tkr()[tok * 8 + erk] = rr; }
    }
}
__device__ __forceinline__ void phase_ln2(Frame& F, const LAS int* ps) {
    const int gw = F.bx * 8 + F.wave, NGW = F.G * 8, lane = F.lane;
#pragma unroll 1
    for (int tok = gw; tok < NTOK; tok += NGW) {
        float* dst = F.out + (size_t)tok * D; const bf16_t* o2p = F.o2() + (size_t)tok * D; float v[2][16]; float s = 0.f;
        const int mye = F.tke()[tok * 8 + (lane & 7)], myr = F.tkr()[tok * 8 + (lane & 7)], mypos = ps[mye] + myr;
        u32x4 o[2][2];
#pragma unroll
        for (int k = 0; k < 2; ++k) { o[k][0] = *(const u32x4*)(o2p + (lane + 64 * k) * 16); o[k][1] = *(const u32x4*)(o2p + (lane + 64 * k) * 16 + 8); }
#pragma unroll
        for (int k = 0; k < 2; ++k)
#pragma unroll
            for (int h = 0; h < 2; ++h)
#pragma unroll
                for (int i = 0; i < 4; ++i) { v[k][8 * h + 2 * i] = __uint_as_float(o[k][h][i] << 16); v[k][8 * h + 2 * i + 1] = __uint_as_float(o[k][h][i] & 0xffff0000u); }
        u32x4 y[8][2];
#pragma unroll
        for (int j = 0; j < 8; ++j) { const int p = __shfl(mypos, j); const unsigned char* yp = (const unsigned char*)F.ym() + (size_t)p * D;
#pragma unroll
            for (int k = 0; k < 2; ++k) y[j][k] = *(const u32x4*)(yp + (lane + 64 * k) * 16); }
#pragma unroll
        for (int j = 0; j < 8; ++j)
#pragma unroll
            for (int k = 0; k < 2; ++k)
#pragma unroll
                for (int i = 0; i < 4; ++i) { unsigned w = y[j][k][i]; asm volatile("" : "+v"(w));
                    const unsigned w1 = w >> 8;
                    const unsigned p02 = ((w & 0x007f007fu) << 4) + 0x39003900u + ((w & 0x00800080u) << 8), p13 = ((w1 & 0x007f007fu) << 4) + 0x39003900u + ((w1 & 0x00800080u) << 8);
                    v[k][4 * i] += __uint_as_float(p02 << 16); v[k][4 * i + 2] += __uint_as_float(p02 & 0xffff0000u);
                    v[k][4 * i + 1] += __uint_as_float(p13 << 16); v[k][4 * i + 3] += __uint_as_float(p13 & 0xffff0000u);
                    asm volatile("" : "+v"(v[k][4 * i]), "+v"(v[k][4 * i + 1]), "+v"(v[k][4 * i + 2]), "+v"(v[k][4 * i + 3])); }
#pragma unroll
        for (int k = 0; k < 2; ++k)
#pragma unroll
            for (int i = 0; i < 16; ++i) s += v[k][i];
        const float mu = wsum(s) * (1.0f / D); float q = 0.f;
#pragma unroll
        for (int k = 0; k < 2; ++k)
#pragma unroll
            for (int i = 0; i < 16; ++i) { const float d = v[k][i] - mu; q += d * d; }
        const float rstd = 1.0f / sqrtf(wsum(q) * (1.0f / D) + LN_EPS);
        asm volatile("" ::: "memory");
#pragma unroll
        for (int k = 0; k < 2; ++k)
#pragma unroll
            for (int h = 0; h < 4; ++h) { const int c = (lane + 64 * k) * 16 + 4 * h; const f32x4 g = *(const f32x4*)(F.l2g + c), bb = *(const f32x4*)(F.l2b + c);
                *(f32x4*)(dst + c) = (f32x4){(v[k][4 * h] - mu) * rstd * g[0] + bb[0], (v[k][4 * h + 1] - mu) * rstd * g[1] + bb[1], (v[k][4 * h + 2] - mu) * rstd * g[2] + bb[2], (v[k][4 * h + 3] - mu) * rstd * g[3] + bb[3]}; }
    }
}

#ifndef FAST_P1
#define FAST_P1 1
#endif
#ifndef STAGGER7
#define STAGGER7 0
#endif
#ifndef CONV_NT
#define CONV_NT 1
#endif
#ifndef STAGGER4
#define STAGGER4 0
#endif
#ifndef XCD_TRUE
#define XCD_TRUE 1
#endif
#ifndef DOWN_REV
#define DOWN_REV false
#endif
#ifndef YM_NT
#define YM_NT 0
#endif
#ifndef FAST_P4
#define FAST_P4 1
#endif
#ifndef FAST_P6
#define FAST_P6 1
#endif
#ifndef FAST_P7
#define FAST_P7 1
#endif
namespace pg8 {
typedef short bf16x8 __attribute__((ext_vector_type(8)));
constexpr int BM = 256, BK = 64, HALF = 128, HTB = HALF * BK * 2, STAGE_BYTES = 8 * HTB, NXCD = 8, WGM = 8;
__host__ __device__ __forceinline__ int lds_byte(int r, int c) { const int st = (r >> 4) * 2 + (c >> 5), rr = r & 15, cc = c & 31, ob = rr * 64 + cc * 2; return st * 1024 + (ob ^ (((ob >> 9) & 1) << 5)); }
__host__ __device__ __forceinline__ void stage_rc(int b, int& R, int& C) { const int st = b / 1024, sb = b % 1024, swz = sb ^ (((sb >> 9) & 1) << 5); R = (st >> 1) * 16 + swz / 64; C = (st & 1) * 32 + (swz % 64) / 2; }
__host__ __device__ __forceinline__ int perm32(int rho) { const int n = rho >> 4, i = rho & 15; return 8 * (i >> 2) + 4 * n + (i & 3); }
__device__ __forceinline__ unsigned cvt_pk_bf16(float lo, float hi) { unsigned r; asm volatile("v_cvt_pk_bf16_f32 %0, %1, %2" : "=v"(r) : "v"(lo), "v"(hi)); return r; }
typedef int i32x4 __attribute__((ext_vector_type(4)));
typedef int i32x8 __attribute__((ext_vector_type(8)));
__device__ __forceinline__ i32x8 cat8(bf16x8 a, bf16x8 b) { return __builtin_shufflevector(__builtin_bit_cast(i32x4, a), __builtin_bit_cast(i32x4, b), 0, 1, 2, 3, 4, 5, 6, 7); }
struct Unit { int pm, pn, e, r0, n, orow, tb; };
__device__ __forceinline__ int xcd_remap(int L, int nwg) { const int q = nwg / NXCD, r = nwg % NXCD, xcd = L % NXCD, off = L / NXCD; return (xcd < r ? xcd * (q + 1) : r * (q + 1) + (xcd - r) * q) + off; }
__device__ __forceinline__ void tile_of(int wgid, int nM, int nN, int& pm, int& pn) { const int nig = WGM * nN, gid = wgid / nig, fm = gid * WGM, gsz = (nM - fm) < WGM ? (nM - fm) : WGM; pm = fm + ((wgid % nig) % gsz); pn = (wgid % nig) / gsz; }

template <class Epi, class Sched>
__device__ __forceinline__ void gemm_phase(const int wave0, LAS unsigned char* lds, const Sched& S, const Epi& E, const int lda, const int ldb, const int nt, const int stagger_ticks = 0) {
    int tid = wave0 * 64 + lane_id(); asm volatile("" : "+v"(tid));
    const int wid = wave0, lane = tid & 63, wr = wid >> 2, wc = wid & 3, fr = lane & 15, fq = lane >> 4;
    unsigned voffA[2], voffB[2], voffB2[2], c2[2]; int RA[2];
#pragma unroll
    for (int i = 0; i < 2; ++i) { int R, C; stage_rc(tid * 16 + i * 8192, R, C); const int Rb = Epi::PERM ? ((R & ~31) + perm32(R & 31)) : R;
        voffA[i] = (unsigned)(R * lda + C) * 2u; voffB[i] = (unsigned)(Rb * ldb + C) * 2u; RA[i] = R; c2[i] = (unsigned)C * 2u;
        voffB2[i] = (unsigned)((64 * (R >> 5) + 16 * ((R >> 2) & 3) + 4 * ((R >> 4) & 1) + (R & 3)) * ldb + C) * 2u; }
    const size_t kstep = (size_t)(BK * 2), hstepA = (size_t)HALF * lda * 2, hstepB = (size_t)HALF * ldb * 2, hstepB2 = (size_t)8 * ldb * 2;
    const unsigned lda2 = (unsigned)lda * 2u;
    const unsigned ldsw = (unsigned)wid * 1024u;
    int aoff = lds_byte(wr * 64 + fr, fq * 8), boff = lds_byte(wc * 32 + fr, fq * 8) + 4 * HTB; asm volatile("" : "+v"(aoff), "+v"(boff));
#define PG8_SA(b, h) (((b) * 2 + (h)) * HTB)
#define PG8_SB(b, h) ((4 + (b) * 2 + (h)) * HTB)
#define PG8_STAGE(bufoff, gbase, voff) do { const char* _g = (const char*)(gbase); asm volatile("" : "+s"(_g)); _Pragma("unroll") for (int _i = 0; _i < 2; ++_i) { unsigned _v = (voff)[_i]; asm volatile("" : "+v"(_v)); \
        __builtin_amdgcn_global_load_lds((const unsigned*)(_g + _v), (LAS unsigned*)(lds + (bufoff) + ldsw + _i * 8192), 16, 0, 0); } } while (0)
#define PG8_STG_A(bufoff, p, h, V) do { if constexpr (Sched::GATHER) { PG8_STAGE(bufoff, p, V[h]); } else { PG8_STAGE(bufoff, (p) + (h) * hstepA, voffA); } } while (0)
#define PG8_STG_B(bufoff, p, h) do { if constexpr (Epi::PERM2) { PG8_STAGE(bufoff, (p) + (h) * hstepB2, voffB2); } else { PG8_STAGE(bufoff, (p) + (h) * hstepB, voffB); } } while (0)
#define PG8_LDA(dst, b, h) do { _Pragma("unroll") for (int m = 0; m < 4; ++m) _Pragma("unroll") for (int k = 0; k < 2; ++k) dst[m][k] = *(const LAS bf16x8*)(lds + PG8_SA(b, h) + aoff + m * 2048 + k * 1024); } while (0)
#define PG8_LDB(dst, b, h) do { _Pragma("unroll") for (int n = 0; n < 2; ++n) _Pragma("unroll") for (int k = 0; k < 2; ++k) dst[n][k] = *(const LAS bf16x8*)(lds + boff + (PG8_SB(b, h) - 4 * HTB) + n * 2048 + k * 1024); } while (0)
#define PG8_MMA(ai, bj, At, Bt) do { __builtin_amdgcn_s_setprio(1); _Pragma("unroll") for (int m = 0; m < 4; ++m) _Pragma("unroll") for (int n = 0; n < 2; ++n) { \
        if constexpr (Epi::F8) acc[ai][bj][m][n] = __builtin_amdgcn_mfma_scale_f32_16x16x128_f8f6f4(cat8(Bt[n][0], Bt[n][1]), cat8(At[m][0], At[m][1]), acc[ai][bj][m][n], 0, 0, 0, 0, 0, 0); \
        else { _Pragma("unroll") for (int k = 0; k < 2; ++k) acc[ai][bj][m][n] = __builtin_amdgcn_mfma_f32_16x16x32_bf16(Bt[n][k], At[m][k], acc[ai][bj][m][n], 0, 0, 0); } } __builtin_amdgcn_s_setprio(0); } while (0)
#define PG8_WAIT_V(n) asm volatile("s_waitcnt vmcnt(" #n ")" ::: "memory")
#define PG8_WAIT_L(n) asm volatile("s_waitcnt lgkmcnt(" #n ")" ::: "memory")
#define PG8_BAR __builtin_amdgcn_s_barrier()
#define PG8_SCHED __builtin_amdgcn_sched_barrier(0)
    Unit cur, nxt; int ui = 0;
    if (stagger_ticks) {
        const unsigned long long t0 = __builtin_amdgcn_s_memrealtime(), dl = (unsigned long long)((blockIdx.x >> 3) & 15) * (unsigned)stagger_ticks;
        while (__builtin_amdgcn_s_memrealtime() - t0 < dl) __builtin_amdgcn_s_sleep(4);
        __syncthreads(); }
    if (!S.next(0, cur)) return;
    cur.tb = 0;
    f32x4 acc[2][2][4][2];
#pragma unroll
    for (int a = 0; a < 2; ++a)
#pragma unroll
        for (int b = 0; b < 2; ++b)
#pragma unroll
            for (int m = 0; m < 4; ++m)
#pragma unroll
                for (int n = 0; n < 2; ++n) acc[a][b][m][n] = (f32x4){0.f, 0.f, 0.f, 0.f};
    bf16x8 At[4][2], B0[2][2], B1[2][2];
    unsigned vac[2][2], van[2][2];
    const char* cA = S.abase(cur); const char* cB = S.bbase(cur);
#pragma unroll
    for (int h = 0; h < 2; ++h)
#pragma unroll
        for (int i = 0; i < 2; ++i) { vac[h][i] = Sched::GATHER ? (unsigned)S.arow(cur, h * HALF + RA[i]) * lda2 + c2[i] : 0u; van[h][i] = vac[h][i]; }
    PG8_STG_B(PG8_SB(0, 0), cB, 0); PG8_STG_B(PG8_SB(0, 1), cB, 1); PG8_STG_A(PG8_SA(0, 0), cA, 0, vac); PG8_STG_A(PG8_SA(0, 1), cA, 1, vac);
    if (wr == 1) PG8_BAR;
    PG8_WAIT_V(2); PG8_BAR;
    PG8_STG_B(PG8_SB(1, 0), cB + kstep, 0); PG8_STG_A(PG8_SA(1, 0), cA + kstep, 0, vac); PG8_STG_B(PG8_SB(1, 1), cB + kstep, 1);
    PG8_WAIT_V(6); PG8_BAR;
    for (;;) {
        const bool has_next = S.next(ui + 1, nxt); nxt.tb = (ui + 1) & 1;
        if constexpr (Epi::MIDK) E.unit_begin(cur, wave0 * 64 + lane_id());
        const char* nA = has_next ? S.abase(nxt) : cA; const char* nB = has_next ? S.bbase(nxt) : cB;
        if constexpr (Sched::GATHER) { if (has_next) { const int tq = wave0 * 64 + lane_id();
#pragma unroll
            for (int h = 0; h < 2; ++h)
#pragma unroll
                for (int i = 0; i < 2; ++i) { int R, C; stage_rc(tq * 16 + i * 8192, R, C); van[h][i] = (unsigned)S.arow(nxt, h * HALF + R); } } }
#pragma unroll 1
        for (int t = 0; t < nt; t += 2) {
            const bool last = (t == nt - 2);
            const char* a1 = cA + (size_t)(t + 1) * kstep;
            const char* a2 = last ? nA : cA + (size_t)(t + 2) * kstep; const char* b2 = last ? nB : cB + (size_t)(t + 2) * kstep;
            const char* a3 = a2 + kstep; const char* b3 = b2 + kstep;
            unsigned va2[2][2];
#pragma unroll
            for (int h = 0; h < 2; ++h)
#pragma unroll
                for (int i = 0; i < 2; ++i) va2[h][i] = last ? van[h][i] : vac[h][i];
            PG8_LDB(B0, 0, 0); PG8_LDB(B1, 0, 1); PG8_SCHED; PG8_LDA(At, 0, 0); PG8_STG_A(PG8_SA(1, 1), a1, 1, vac);
            PG8_WAIT_V(8); PG8_WAIT_L(0); PG8_BAR; PG8_MMA(0, 0, At, B0); PG8_MMA(0, 1, At, B1); PG8_BAR; PG8_SCHED;
            PG8_LDA(At, 0, 1); PG8_STG_B(PG8_SB(0, 0), b2, 0); PG8_STG_B(PG8_SB(0, 1), b2, 1); PG8_STG_A(PG8_SA(0, 0), a2, 0, va2);
            PG8_WAIT_V(8); PG8_WAIT_L(0); PG8_BAR; PG8_MMA(1, 0, At, B0); PG8_MMA(1, 1, At, B1); PG8_BAR; PG8_SCHED;
            PG8_LDB(B0, 1, 0); PG8_LDB(B1, 1, 1); PG8_SCHED; PG8_LDA(At, 1, 0); PG8_STG_A(PG8_SA(0, 1), a2, 1, va2);
            PG8_WAIT_V(8); PG8_WAIT_L(0); PG8_BAR; PG8_MMA(0, 0, At, B0); PG8_MMA(0, 1, At, B1); PG8_BAR; PG8_SCHED;
            PG8_LDA(At, 1, 1); PG8_STG_B(PG8_SB(1, 0), b3, 0); PG8_STG_B(PG8_SB(1, 1), b3, 1); PG8_STG_A(PG8_SA(1, 0), a3, 0, va2);
            PG8_WAIT_V(8); PG8_WAIT_L(0); PG8_BAR; PG8_MMA(1, 0, At, B0); PG8_MMA(1, 1, At, B1); PG8_BAR; PG8_SCHED;
            if constexpr (Epi::MIDK) { if (2 * (t + 2) == nt) E.mid(acc, cur, wr, fr); }
            if constexpr (Sched::GATHER) { if (t + 4 == nt && has_next) {
                const int tq = wave0 * 64 + lane_id();
#pragma unroll
                for (int h = 0; h < 2; ++h)
#pragma unroll
                    for (int i = 0; i < 2; ++i) { int R, C; stage_rc(tq * 16 + i * 8192, R, C); asm volatile("" : "+v"(van[h][i])); van[h][i] = van[h][i] * lda2 + (unsigned)C * 2u; } } }
        }
        if (wr == 0) PG8_BAR;
        { const int le = lane_id(); E(acc, cur, wr, wc, le & 15, le >> 4); }
        if (!has_next) break;
#pragma unroll
        for (int a = 0; a < 2; ++a)
#pragma unroll
            for (int b = 0; b < 2; ++b)
#pragma unroll
                for (int m = 0; m < 4; ++m)
#pragma unroll
                    for (int n = 0; n < 2; ++n) acc[a][b][m][n] = (f32x4){0.f, 0.f, 0.f, 0.f};
        cur = nxt; cA = nA; cB = nB; ++ui;
#pragma unroll
        for (int h = 0; h < 2; ++h)
#pragma unroll
            for (int i = 0; i < 2; ++i) vac[h][i] = van[h][i];
        if (wr == 1) PG8_BAR;
    }
    PG8_WAIT_V(0);
    PG8_BAR;
#undef PG8_SA
#undef PG8_SB
#undef PG8_STAGE
#undef PG8_STG_A
#undef PG8_STG_B
#undef PG8_LDA
#undef PG8_LDB
#undef PG8_MMA
#undef PG8_WAIT_V
#undef PG8_WAIT_L
#undef PG8_BAR
#undef PG8_SCHED
}
}

struct SchedInProj {
    static constexpr bool GATHER = false; const char* A; const char* B; int G, c, i0, i1;
    __device__ __forceinline__ bool next(int i, pg8::Unit& u) const { const int ii = i0 + i; if (ii >= i1) return false; const int L = ii * G + c; if (L >= 1162) return false;
        if (L < 1152) pg8::tile_of(pg8::xcd_remap(L, 1152), 64, 18, u.pm, u.pn); else { const int k = L - 1152; u.pm = 64; u.pn = k < 2 ? 4 + k : 8 + k; }
        return true; }
    __device__ __forceinline__ const char* abase(const pg8::Unit& u) const { return A + (size_t)u.pm * 256 * D * 2; }
    __device__ __forceinline__ const char* bbase(const pg8::Unit& u) const { return B + (size_t)u.pn * 256 * D * 2; }
    __device__ __forceinline__ int arow(const pg8::Unit&, int) const { return 0; }
};
struct SchedOutProj {
    static constexpr bool GATHER = false; const char* A; const char* B; int G, c;
    __device__ __forceinline__ bool next(int i, pg8::Unit& u) const { const int L = i * G + c; if (L >= 512) return false; pg8::tile_of(pg8::xcd_remap(L, 512), 64, 8, u.pm, u.pn); return true; }
    __device__ __forceinline__ const char* abase(const pg8::Unit& u) const { return A + (size_t)u.pm * 256 * D; }
    __device__ __forceinline__ const char* bbase(const pg8::Unit& u) const { return B + (size_t)u.pn * 256 * D; }
    __device__ __forceinline__ int arow(const pg8::Unit&, int) const { return 0; }
};
__device__ __forceinline__ void moe_tables(const Frame& F, LAS int* ps) {
    if (F.tid < NE) ps[256 + F.tid] = F.cnt()[F.tid];
    __syncthreads();
    if (F.tid == 0) { int acc = 0, ta = 0; for (int e = 0; e < NE; ++e) { const int mt = (ps[256 + e] + 255) >> 8; ps[e] = acc; ps[128 + e] = ta; acc += mt * 256; ta += mt; }
        ps[64] = acc; ps[128 + 64] = ta; ps[128 + 65] = ta + NTOK / 256; ps[256 + 64] = NTOK; }
    __syncthreads();
    for (int t = F.tid; t < 640; t += 512) { int e = 0; while (e < NE && t >= ps[128 + e + 1]) ++e; ps[384 + t] = e; }
    __syncthreads();
}
template <int NN, bool REV> __device__ __forceinline__ bool moe_unit(const LAS int* ps, int L, pg8::Unit& u, int ntile) {
    const int nU = ntile * NN; if (L >= nU) return false;
    const int wg0 = pg8::xcd_remap(L, nU), wg = REV ? nU - 1 - wg0 : wg0, tile = wg / NN; u.pn = wg % NN;
    const int e = __builtin_amdgcn_readfirstlane(ps[384 + tile]); u.e = e; u.pm = tile - __builtin_amdgcn_readfirstlane(ps[128 + e]); u.r0 = u.pm * 256; u.n = __builtin_amdgcn_readfirstlane(ps[256 + e]);
    u.orow = (e < NE ? __builtin_amdgcn_readfirstlane(ps[e]) : PMAX) + u.r0;
    return true; }
struct SchedGU {
    static constexpr bool GATHER = true; const char* A; const char* B; const int* tokl; const int* cnt; const LAS int* ps; int G, c, ntile;
    __device__ __forceinline__ bool next(int i, pg8::Unit& u) const { return moe_unit<4, false>(ps, i * G + c, u, ntile); }
    __device__ __forceinline__ const char* abase(const pg8::Unit&) const { return A; }
    __device__ __forceinline__ const char* bbase(const pg8::Unit& u) const { return B + ((size_t)u.e * 1024 + u.pn * 256) * D; }
    __device__ __forceinline__ int arow(const pg8::Unit& u, int r) const { const int rr = min(u.r0 + r, u.n - 1); return u.e < NE ? tokl[(size_t)u.e * NTOK + rr] : rr; }
};
struct SchedDown {
    static constexpr bool GATHER = false; const char* A; const char* B; const int* cnt; const LAS int* ps; int G, c, ntile;
    __device__ __forceinline__ bool next(int i, pg8::Unit& u) const { return moe_unit<8, DOWN_REV>(ps, i * G + c, u, ntile); }
    __device__ __forceinline__ const char* abase(const pg8::Unit& u) const { return A + (size_t)u.orow * DE; }
    __device__ __forceinline__ const char* bbase(const pg8::Unit& u) const { return B + ((size_t)u.e * D + u.pn * 256) * DE; }
    __device__ __forceinline__ int arow(const pg8::Unit&, int) const { return 0; }
};
struct SchedDownShared {
    static constexpr bool GATHER = false; const char* A; const char* B; int G, c;
    __device__ __forceinline__ bool next(int i, pg8::Unit& u) const { const int L = i * G + c; if (L >= 512) return false; pg8::tile_of(pg8::xcd_remap(L, 512), 64, 8, u.pm, u.pn);
        u.e = NE; u.r0 = u.pm * 256; u.n = NTOK; u.orow = PMAX + u.r0; return true; }
    __device__ __forceinline__ const char* abase(const pg8::Unit& u) const { return A + (size_t)u.orow * DE; }
    __device__ __forceinline__ const char* bbase(const pg8::Unit& u) const { return B + ((size_t)NE * D + u.pn * 256) * DE; }
    __device__ __forceinline__ int arow(const pg8::Unit&, int) const { return 0; }
};
struct EpiU {
    static constexpr bool F8 = false; static constexpr bool PERM2 = false; static constexpr bool MIDK = false; static constexpr bool PERM = true; bf16_t* U; int nostore;
    __device__ __forceinline__ void operator()(const f32x4 (&acc)[2][2][4][2], const pg8::Unit& u, int wr, int wc, int fr, int fq) const {
        const int row0 = u.pm * 256 + wr * 64 + fr, col0 = u.pn * 256 + wc * 32 + 8 * fq;
        if (nostore) {
#pragma unroll
            for (int ai = 0; ai < 2; ++ai)
#pragma unroll
                for (int bj = 0; bj < 2; ++bj)
#pragma unroll
                    for (int m = 0; m < 4; ++m)
#pragma unroll
                        for (int n = 0; n < 2; ++n) asm volatile("" :: "v"(acc[ai][bj][m][n]));
            return; }
#pragma unroll
        for (int ai = 0; ai < 2; ++ai)
#pragma unroll
            for (int m = 0; m < 4; ++m) { bf16_t* rowp = U + (size_t)(row0 + ai * 128 + m * 16) * INW + col0;
#pragma unroll
                for (int bj = 0; bj < 2; ++bj) { const f32x4 v0 = acc[ai][bj][m][0], v1 = acc[ai][bj][m][1]; u32x4 w;
                    w.x = pg8::cvt_pk_bf16(v0[0], v0[1]); w.y = pg8::cvt_pk_bf16(v0[2], v0[3]); w.z = pg8::cvt_pk_bf16(v1[0], v1[1]); w.w = pg8::cvt_pk_bf16(v1[2], v1[3]);
                    *(u32x4*)(rowp + bj * 128) = w; } }
    }
};
struct EpiZ {
    static constexpr bool F8 = true; static constexpr bool PERM2 = false; static constexpr bool MIDK = true; static constexpr bool PERM = true; bf16_t* Z; const bf16_t* H0; const float* ssq; LAS float* tab;
    __device__ __forceinline__ void unit_begin(const pg8::Unit& u, int tid) const {
        const int row = tid >> 1, grp = tid & 1; const float* p = ssq + (size_t)(u.pm * 256 + row) * 32 + 16 * grp;
        const f32x4 a = *(const f32x4*)p, b4 = *(const f32x4*)(p + 4), c = *(const f32x4*)(p + 8), d = *(const f32x4*)(p + 12);
        const float s = (((a[0] + a[1]) + (a[2] + a[3])) + ((b4[0] + b4[1]) + (b4[2] + b4[3]))) + (((c[0] + c[1]) + (c[2] + c[3])) + ((d[0] + d[1]) + (d[2] + d[3])));
        tab[(u.tb * 256 + row) * 2 + grp] = 1.0f / sqrtf(s * (1.0f / 1024.f) + RMS_EPS);
    }
    __device__ __forceinline__ void mid(f32x4 (&acc)[2][2][4][2], const pg8::Unit& u, int wr, int fr) const {
#pragma unroll
        for (int ai = 0; ai < 2; ++ai)
#pragma unroll
            for (int m = 0; m < 4; ++m) { const int r = ai * 128 + wr * 64 + m * 16 + fr; const float f = tab[(u.tb * 256 + r) * 2] / tab[(u.tb * 256 + r) * 2 + 1];
#pragma unroll
                for (int bj = 0; bj < 2; ++bj)
#pragma unroll
                    for (int n = 0; n < 2; ++n) acc[ai][bj][m][n] *= f; }
    }
    __device__ __forceinline__ void operator()(const f32x4 (&acc)[2][2][4][2], const pg8::Unit& u, int wr, int wc, int fr, int fq) const {
        const int row0 = u.pm * 256 + wr * 64 + fr, col0 = u.pn * 256 + wc * 32 + 8 * fq;
#pragma unroll
        for (int am = 0; am < 4; ++am) {
            u32x4 hv[2][2]; float rb[2];
#pragma unroll
            for (int q = 0; q < 2; ++q) { const int ai = am >> 1, m = (am & 1) * 2 + q; const size_t off = (size_t)(row0 + ai * 128 + m * 16) * D + col0;
                rb[q] = tab[(u.tb * 256 + ai * 128 + wr * 64 + m * 16 + fr) * 2 + 1] * S8_OP_INV;
#pragma unroll
                for (int bj = 0; bj < 2; ++bj) hv[q][bj] = *(const u32x4*)(H0 + off + bj * 128); }
#pragma unroll
            for (int q = 0; q < 2; ++q) { const int ai = am >> 1, m = (am & 1) * 2 + q; const size_t off = (size_t)(row0 + ai * 128 + m * 16) * D + col0;
#pragma unroll
                for (int bj = 0; bj < 2; ++bj) { const u32x4 h4 = hv[q][bj];
                    const f32x4 h0v = (f32x4){__uint_as_float(h4.x << 16), __uint_as_float(h4.x & 0xffff0000u), __uint_as_float(h4.y << 16), __uint_as_float(h4.y & 0xffff0000u)};
                    const f32x4 h1v = (f32x4){__uint_as_float(h4.z << 16), __uint_as_float(h4.z & 0xffff0000u), __uint_as_float(h4.w << 16), __uint_as_float(h4.w & 0xffff0000u)};
                    const f32x4 v0 = acc[ai][bj][m][0] * rb[q] + h0v * ALPHA, v1 = acc[ai][bj][m][1] * rb[q] + h1v * ALPHA; u32x4 w;
                    w.x = pg8::cvt_pk_bf16(v0[0], v0[1]); w.y = pg8::cvt_pk_bf16(v0[2], v0[3]); w.z = pg8::cvt_pk_bf16(v1[0], v1[1]); w.w = pg8::cvt_pk_bf16(v1[2], v1[3]);
                    *(u32x4*)(Z + off + bj * 128) = w; } }
            asm volatile("" ::: "memory"); }
    }
};
__device__ __forceinline__ float silu_mul(float g, float u) { return g * __builtin_amdgcn_rcpf(1.0f + __builtin_amdgcn_exp2f(-g * LOG2E)) * u; }
struct EpiGU {
    static constexpr bool F8 = true; static constexpr bool PERM2 = false; static constexpr bool MIDK = false; static constexpr bool PERM = true; unsigned char* H; const float* wl;
    __device__ __forceinline__ void operator()(const f32x4 (&acc)[2][2][4][2], const pg8::Unit& u, int wr, int wc, int fr, int fq) const {
        int rl0 = wr * 64 + fr, col0 = u.pn * 128 + wc * 32 + 8 * fq; asm volatile("" : "+v"(rl0), "+v"(col0));
        float wv[2][4];
#pragma unroll
        for (int ai = 0; ai < 2; ++ai)
#pragma unroll
            for (int m = 0; m < 4; ++m) { const int r = u.r0 + rl0 + ai * 128 + m * 16; wv[ai][m] = (u.e < NE ? (r < u.n ? wl[(size_t)u.e * NTOK + r] : 0.f) : 1.0f) * (S8_GU_INV * S8_HB); }
#pragma unroll
        for (int ai = 0; ai < 2; ++ai)
#pragma unroll
            for (int m = 0; m < 4; ++m) { const f32x4 g0 = acc[ai][0][m][0] * S8_GU_INV, g1 = acc[ai][0][m][1] * S8_GU_INV, u0 = acc[ai][1][m][0] * wv[ai][m], u1 = acc[ai][1][m][1] * wv[ai][m];
                const u32x2 w = (u32x2){e4m3x4(silu_mul(g0[0], u0[0]), silu_mul(g0[1], u0[1]), silu_mul(g0[2], u0[2]), silu_mul(g0[3], u0[3])),
                                        e4m3x4(silu_mul(g1[0], u1[0]), silu_mul(g1[1], u1[1]), silu_mul(g1[2], u1[2]), silu_mul(g1[3], u1[3]))};
                *(u32x2*)(H + (size_t)(u.orow + rl0 + ai * 128 + m * 16) * DE + col0) = w; }
    }
};
struct EpiDownR {
    static constexpr bool F8 = true; static constexpr bool PERM2 = true; static constexpr bool MIDK = false; static constexpr bool PERM = true; unsigned char* Y; int nostore;
    __device__ __forceinline__ void operator()(const f32x4 (&acc)[2][2][4][2], const pg8::Unit& u, int wr, int wc, int fr, int fq) const {
        int rl0 = wr * 64 + fr, col0 = u.pn * 256 + wc * 64 + 16 * fq; asm volatile("" : "+v"(rl0), "+v"(col0));
        if (nostore) {
#pragma unroll
            for (int ai = 0; ai < 2; ++ai)
#pragma unroll
                for (int bj = 0; bj < 2; ++bj)
#pragma unroll
                    for (int m = 0; m < 4; ++m)
#pragma unroll
                        for (int n = 0; n < 2; ++n) asm volatile("" :: "v"(acc[ai][bj][m][n]));
            return; }
#pragma unroll
        for (int ai = 0; ai < 2; ++ai)
#pragma unroll
            for (int m = 0; m < 4; ++m) { const int rl = rl0 + ai * 128 + m * 16; if (u.r0 + rl >= u.n) continue;
                f32x4 a0 = acc[ai][0][m][0], a1 = acc[ai][0][m][1], b0 = acc[ai][1][m][0], b1 = acc[ai][1][m][1];
                asm volatile("" : "+v"(a0), "+v"(a1), "+v"(b0), "+v"(b1));
                const u32x4 q = (u32x4){ym8x4(a0[0], a0[1], a0[2], a0[3]), ym8x4(a1[0], a1[1], a1[2], a1[3]), ym8x4(b0[0], b0[1], b0[2], b0[3]), ym8x4(b1[0], b1[1], b1[2], b1[3])};
                *(u32x4*)(Y + (size_t)(u.orow + rl) * D + col0) = q;
                asm volatile("" ::: "memory"); }
    }
};
struct EpiDownS {
    static constexpr bool F8 = true; static constexpr bool PERM2 = false; static constexpr bool MIDK = false; static constexpr bool PERM = true; bf16_t* O; const bf16_t* H1;
    __device__ __forceinline__ void operator()(const f32x4 (&acc)[2][2][4][2], const pg8::Unit& u, int wr, int wc, int fr, int fq) const {
        int rl0 = wr * 64 + fr, col0 = u.pn * 256 + wc * 32 + 8 * fq; asm volatile("" : "+v"(rl0), "+v"(col0));
#pragma unroll
        for (int am = 0; am < 4; ++am) {
            u32x4 hv[2][2];
#pragma unroll
            for (int q = 0; q < 2; ++q) { const int ai = am >> 1, m = (am & 1) * 2 + q; const size_t off = (size_t)(u.r0 + rl0 + ai * 128 + m * 16) * D + col0;
#pragma unroll
                for (int bj = 0; bj < 2; ++bj) hv[q][bj] = *(const u32x4*)(H1 + off + bj * 128); }
#pragma unroll
            for (int q = 0; q < 2; ++q) { const int ai = am >> 1, m = (am & 1) * 2 + q; const size_t off = (size_t)(u.r0 + rl0 + ai * 128 + m * 16) * D + col0;
#pragma unroll
                for (int bj = 0; bj < 2; ++bj) { const u32x4 h4 = hv[q][bj];
                    const f32x4 h0v = (f32x4){__uint_as_float(h4.x << 16), __uint_as_float(h4.x & 0xffff0000u), __uint_as_float(h4.y << 16), __uint_as_float(h4.y & 0xffff0000u)};
                    const f32x4 h1v = (f32x4){__uint_as_float(h4.z << 16), __uint_as_float(h4.z & 0xffff0000u), __uint_as_float(h4.w << 16), __uint_as_float(h4.w & 0xffff0000u)};
                    const f32x4 v0 = acc[ai][bj][m][0] * S8_DN_INV + h0v * ALPHA, v1 = acc[ai][bj][m][1] * S8_DN_INV + h1v * ALPHA; u32x4 w;
                    w.x = pg8::cvt_pk_bf16(v0[0], v0[1]); w.y = pg8::cvt_pk_bf16(v0[2], v0[3]); w.z = pg8::cvt_pk_bf16(v1[0], v1[1]); w.w = pg8::cvt_pk_bf16(v1[2], v1[3]);
                    *(u32x4*)(O + off + bj * 128) = w; } }
            asm volatile("" ::: "memory"); }
    }
};

#ifndef FAST_P2
#define FAST_P2 1
#endif
namespace att {
typedef short bf16x8 __attribute__((ext_vector_type(8)));
typedef short s16x4 __attribute__((ext_vector_type(4)));
typedef float f32x16 __attribute__((ext_vector_type(16)));
typedef LAS const char* lds_cptr;
constexpr int SLOT = 16384, NSLOT = 6, RING = NSLOT * SLOT;
constexpr int TA_W = 452, TA_OFF = 224;
constexpr int TB_W = 468;
constexpr int OFF_TABA = RING, OFF_TABB = OFF_TABA, OFF_WS = OFF_TABA + 4 * TA_W * 4, OFF_OST = OFF_WS + 8 * 256, ATT_LDS = OFF_OST + 8 * 4096;
static_assert(ATT_LDS <= LDS_BYTES - 16 - 1024, "attention LDS map");
constexpr float NEGB = -1e30f, THR = 8.0f;
#define ATT_MFMA(a, b, c) __builtin_amdgcn_mfma_f32_32x32x16_bf16(a, b, c, 0, 0, 0)
__device__ __forceinline__ int crow(int r, int hi) { return (r & 3) + 8 * (r >> 2) + 4 * hi; }
__device__ __forceinline__ s16x4 vtr(lds_cptr p) { typedef short v4i16_t __attribute__((ext_vector_type(4))); return __builtin_bit_cast(s16x4, __builtin_amdgcn_ds_read_tr16_b64_v4i16((LAS v4i16_t*)p)); }
__device__ __forceinline__ float swapmax(float m) { auto rr = __builtin_amdgcn_permlane32_swap(__float_as_uint(m), __float_as_uint(m), false, false); return fmaxf(__uint_as_float(rr[0]), __uint_as_float(rr[1])); }
__device__ __forceinline__ float swapsum(float m) { auto rr = __builtin_amdgcn_permlane32_swap(__float_as_uint(m), __float_as_uint(m), false, false); return __uint_as_float(rr[0]) + __uint_as_float(rr[1]); }

__device__ __forceinline__ float bf16r(float x) { return __uint_as_float(pg8::cvt_pk_bf16(x, 0.f) << 16); }
__device__ __forceinline__ bf16x8 frag_k0(unsigned bits16, int hi) { const u32x4 w = (u32x4){hi == 0 ? bits16 : 0u, 0u, 0u, 0u}; return __builtin_bit_cast(bf16x8, w); }
template <int NH, int NS, class BiasFn>
__device__ __forceinline__ void tile_qb(const bf16x8 (&kf)[8], const bf16x8 (&qr)[4], bf16x8& mq, const bf16x8& ones, lds_cptr vp, f32x16 (&o)[2], float& m, float& l, LAS float* wsf, int r32, int hi, const BiasFn& bias) {
    f32x16 c[NH];
#pragma unroll
    for (int hf = 0; hf < NH; ++hf)
#pragma unroll
        for (int r = 0; r < 16; ++r) c[hf][r] = bias(hf, r);
    s16x4 vlo[NS][2], vhi[NS][2];
#pragma unroll
    for (int dh = 0; dh < 2; ++dh) { vlo[0][dh] = vtr(vp + dh * 4096); vhi[0][dh] = vtr(vp + dh * 4096 + 512); }
    __builtin_amdgcn_sched_barrier(0);
#pragma unroll
    for (int hf = 0; hf < NH; ++hf) { c[hf] = ATT_MFMA(ones, mq, c[hf]);
#pragma unroll
        for (int d0 = 0; d0 < 4; ++d0) c[hf] = ATT_MFMA(kf[2 * d0 + hf], qr[d0], c[hf]); }
    float mx = NEGB;
#pragma unroll
    for (int hf = 0; hf < NH; ++hf)
#pragma unroll
        for (int r = 0; r < 16; ++r) mx = fmaxf(mx, c[hf][r]);
    mx = swapmax(mx);
    if (__any(mx > THR)) {
        const float mn = bf16r(m + fmaxf(mx, 0.f)), dl = mn - m, f = __builtin_amdgcn_exp2f(-dl); m = mn; l *= f;
        mq = frag_k0(__float_as_uint(-mn) >> 16, hi);
        if (hi == 0) wsf[r32] = f;
        asm volatile("s_waitcnt lgkmcnt(0)" ::: "memory");
#pragma unroll
        for (int r = 0; r < 16; ++r) { const float fr = wsf[crow(r, hi)]; o[0][r] *= fr; o[1][r] *= fr; }
#pragma unroll
        for (int hf = 0; hf < NH; ++hf)
#pragma unroll
            for (int r = 0; r < 16; ++r) c[hf][r] -= dl;
    }
#pragma unroll
    for (int s = 1; s < NS; ++s)
#pragma unroll
        for (int dh = 0; dh < 2; ++dh) { vlo[s][dh] = vtr(vp + dh * 4096 + s * 1024); vhi[s][dh] = vtr(vp + dh * 4096 + s * 1024 + 512); }
    __builtin_amdgcn_sched_barrier(0);
    float ls = 0.f;
#pragma unroll
    for (int hf = 0; hf < NH; ++hf)
#pragma unroll
        for (int r = 0; r < 16; ++r) { c[hf][r] = __builtin_amdgcn_exp2f(c[hf][r]); ls += c[hf][r]; }
    l += ls;
#pragma unroll
    for (int s = 0; s < NS; ++s) {
        const f32x16& cc = c[s >> 1]; const int rb = (s & 1) * 8;
        u32x4 pw; pw.x = pg8::cvt_pk_bf16(cc[rb + 0], cc[rb + 1]); pw.y = pg8::cvt_pk_bf16(cc[rb + 2], cc[rb + 3]); pw.z = pg8::cvt_pk_bf16(cc[rb + 4], cc[rb + 5]); pw.w = pg8::cvt_pk_bf16(cc[rb + 6], cc[rb + 7]);
        const bf16x8 pa = __builtin_bit_cast(bf16x8, pw);
#pragma unroll
        for (int dh = 0; dh < 2; ++dh) { const s16x4 lo = vlo[s][dh], hi4 = vhi[s][dh];
            const bf16x8 vf = (bf16x8){lo[0], lo[1], lo[2], lo[3], hi4[0], hi4[1], hi4[2], hi4[3]};
            o[dh] = ATT_MFMA(pa, vf, o[dh]); }
    }
}
template <class TokFn>
__device__ __forceinline__ void finish_qb(const Frame& F, f32x16 (&o)[2], float l, LAS float* wsf, LAS bf16_t* stg, int lane, int r32, int hi, int ocol, int hidx, const TokFn& tokq) {
    l = swapsum(l);
    asm volatile("s_waitcnt lgkmcnt(0)" ::: "memory");
    if (hi == 0) wsf[32 + r32] = l;
    asm volatile("s_waitcnt lgkmcnt(0)" ::: "memory");
#pragma unroll
    for (int r = 0; r < 16; ++r) { const int orow = crow(r, hi); const float rl = __builtin_amdgcn_rcpf(wsf[32 + orow]);
        stg[orow * 64 + r32] = f2bf(o[0][r] * rl); stg[orow * 64 + 32 + r32] = f2bf(o[1][r] * rl); }
    asm volatile("s_waitcnt lgkmcnt(0)" ::: "memory");
#pragma unroll
    for (int i = 0; i < 4; ++i) { const int row = i * 8 + (lane >> 3), ch = lane & 7; const u32x4 w = *(const LAS u32x4*)(stg + row * 64 + ch * 8); const int tok = tokq(row);
        float q = 0.f, f[8];
#pragma unroll
        for (int j = 0; j < 4; ++j) { const float a = __uint_as_float(w[j] << 16), b = __uint_as_float(w[j] & 0xffff0000u); q += a * a + b * b; f[2 * j] = a * S8_YA; f[2 * j + 1] = b * S8_YA; }
        *(u32x2*)((unsigned char*)F.ya() + (size_t)tok * D + ocol + ch * 8) = (u32x2){e4m3x4(f[0], f[1], f[2], f[3]), e4m3x4(f[4], f[5], f[6], f[7])};
        q += __shfl_xor(q, 1); q += __shfl_xor(q, 2); q += __shfl_xor(q, 4);
        if (ch == 0) F.ssq()[tok * 32 + hidx] = q; }
    asm volatile("s_waitcnt lgkmcnt(0)" ::: "memory");
}

template <int MODE>
__device__ __forceinline__ void attn_unit(const Frame& F, int L) {
    LAS unsigned char* lds = F.lds;
    const int lane = F.lane, wid = F.wave, r32 = lane & 31, hi = lane >> 5;
    LAS float* wsf = (LAS float*)(lds + OFF_WS + wid * 256); LAS bf16_t* stg = (LAS bf16_t*)(lds + OFF_OST + wid * 4096);
    int b, kcol, vcol, qcol, ocol, hidx, nband, trow0, qtok0;
    int hb = 0, qbw = 0, kt0 = 0;
    int R0 = 0, pr = 0, jc = 0, cb = 0, kr0 = 0;
    if (MODE == 0) { const int kvh = L & 3; hb = (L >> 2) & 127; b = L >> 9; const int hq = 4 * kvh + (wid >> 1); qbw = wid & 1;
        qcol = COL_QA + hq * 64; kcol = COL_KA + kvh * 64; vcol = COL_VA + kvh * 64; ocol = hq * 64; hidx = hq;
        kt0 = max(0, hb - 2); const int kt1 = min(127, hb + 2); nband = kt1 - kt0 + 1; trow0 = b * SEQ + 64 * kt0; qtok0 = b * SEQ + 64 * hb + 32 * qbw;
    } else { const int h = L & 15, rb = (L >> 4) & 31; b = L >> 9; R0 = rb * 4; pr = wid >> 2; jc = wid & 3; cb = min(max(16 * jc - 8, 0), 32);
        qcol = COL_QB + h * 64; kcol = COL_KB + h * 64; vcol = COL_VB + h * 64; ocol = 1024 + h * 64; hidx = 16 + h;
        kr0 = min(max(R0 - 4, 0), 120); const int kr1 = min(max(R0 + 3 - 4, 0), 120) + 7; nband = kr1 - kr0 + 1; trow0 = b * SEQ + kr0 * 64; qtok0 = b * SEQ + (R0 + 2 * pr) * 64 + 16 * jc; }
    const int NT = 1 + nband;
    const bf16_t* ksrc = F.u() + (size_t)lane * INW + kcol + wid * 8;
    const bf16_t* vsrc = F.u() + (size_t)(16 * (wid & 3) + (lane >> 2)) * INW + vcol + (wid >> 2) * 32 + (lane & 3) * 8;
#define ATT_TROW(t) ((t) == 0 ? NTOK : trow0 + ((t) - 1) * 64)
#define ATT_ISSUE(t) do { const size_t ro_ = (size_t)ATT_TROW(t) * INW; const int sl_ = ((t) % NSLOT) * SLOT; \
        __builtin_amdgcn_global_load_lds((const unsigned*)(ksrc + ro_), (LAS unsigned*)(lds + sl_ + wid * 1024), 16, 0, 0); \
        __builtin_amdgcn_global_load_lds((const unsigned*)(vsrc + ro_), (LAS unsigned*)(lds + sl_ + 8192 + wid * 1024), 16, 0, 0); } while (0)
    bf16x8 qr[4];
    { const int tok = MODE == 0 ? qtok0 + r32 : qtok0 + (r32 >> 4) * 64 + (r32 & 15);
#pragma unroll
      for (int d0 = 0; d0 < 4; ++d0) qr[d0] = *(const bf16x8*)(F.u() + (size_t)tok * INW + qcol + d0 * 16 + hi * 8); }
    if (MODE == 0) { LAS float* tA = (LAS float*)(lds + OFF_TABA); const int h0 = 4 * (L & 3);
        for (int i = F.tid; i < 4 * TA_W; i += 512) { const int g = i / TA_W, rel = i % TA_W - TA_OFF; tA[i] = (rel >= -128 && rel <= 128) ? F.tab()[(h0 + g) * 272 + rel + 128] : NEGB; } }
    else { LAS float* tB = (LAS float*)(lds + OFF_TABB); const int h = L & 15;
        for (int i = F.tid; i < 576; i += 512) { const int k = i - 16; tB[i] = (k >= 0 && k < 465) ? F.rpb[h * 465 + k] * LOG2E : ((k >= 465 && k < 496) ? NEGB : 0.f); } }
#pragma unroll
    for (int t = 0; t < 5; ++t) if (t < NT) ATT_ISSUE(t);
    f32x16 o[2]; o[0] = f32x16{}; o[1] = f32x16{}; float m = 0.f, l = 0.f;
    bf16x8 mq = frag_k0(0u, hi); const bf16x8 ones = frag_k0(0x3F80u, hi);
    const LAS float* tabA = (const LAS float*)(lds + OFF_TABA) + (MODE == 0 ? (wid >> 1) : 0) * TA_W;
    const LAS float* tabB = (const LAS float*)(lds + OFF_TABB);
    const int qpos = 64 * hb + 32 * qbw + r32;
    const int qrow = R0 + 2 * pr + (r32 >> 4), qc = 16 * jc + (r32 & 15), rs = min(max(qrow - 4, 0), 120), cs = min(max(qc - 8, 0), 48);
    const int rsw0 = min(max(R0 + 2 * pr - 4, 0), 120), rsw1 = min(max(R0 + 2 * pr + 1 - 4, 0), 120);
    float cm[16];
#pragma unroll
    for (int r = 0; r < 16; ++r) { const int kc = cb + 4 * hi + (r & 3) + 8 * (r >> 2); cm[r] = (MODE == 1 && !(kc >= cs && kc < cs + 16)) ? NEGB : 0.f; }
    const int dc0 = cb + 4 * hi - qc + 15 + 16;
    for (int t = 0; t < NT; ++t) {
        { const int ahead = NT - 1 - t;
          if (ahead >= 4) asm volatile("s_waitcnt vmcnt(8)" ::: "memory"); else if (ahead == 3) asm volatile("s_waitcnt vmcnt(6)" ::: "memory");
          else if (ahead == 2) asm volatile("s_waitcnt vmcnt(4)" ::: "memory"); else if (ahead == 1) asm volatile("s_waitcnt vmcnt(2)" ::: "memory"); else asm volatile("s_waitcnt vmcnt(0)" ::: "memory"); }
        asm volatile("s_waitcnt lgkmcnt(0)" ::: "memory");
        __builtin_amdgcn_s_barrier();
        if (t + 5 < NT) ATT_ISSUE(t + 5);
        const int slot = (t % NSLOT) * SLOT;
        if (MODE == 1 && t > 0) { const int kr = kr0 + t - 1; if (kr < rsw0 || kr > rsw1 + 7) continue; }
        const int cbt = (MODE == 1 && t > 0) ? cb : 0;
        const lds_cptr kp = (lds_cptr)lds + slot + hi * 1024 + (r32 + cbt) * 16;
        const lds_cptr vp = (lds_cptr)lds + slot + 8192 + ((lane >> 4) & 1) * 32 + (lane & 3) * 8 + (4 * hi + ((lane & 15) >> 2) + cbt) * 64;
        bf16x8 kf[8];
        if (MODE == 0 && t > 0) {
#pragma unroll
            for (int d0 = 0; d0 < 4; ++d0) { kf[2 * d0] = *(const LAS bf16x8*)(kp + d0 * 2048); kf[2 * d0 + 1] = *(const LAS bf16x8*)(kp + d0 * 2048 + 512); }
        } else {
#pragma unroll
            for (int d0 = 0; d0 < 4; ++d0) { kf[2 * d0] = *(const LAS bf16x8*)(kp + d0 * 2048); kf[2 * d0 + 1] = kf[2 * d0]; }
        }
        if (t == 0) {
            if (MODE == 0) tile_qb<1, 1>(kf, qr, mq, ones, vp, o, m, l, wsf, r32, hi, [&](int, int r) { return r < 8 ? tabA[max(crow(r, hi) - 16 - qpos, -128) + TA_OFF] : NEGB; });
            else tile_qb<1, 1>(kf, qr, mq, ones, vp, o, m, l, wsf, r32, hi, [&](int, int r) { return r < 8 ? 0.f : NEGB; });
        } else if (MODE == 0) { const volatile LAS float* bp = tabA + 64 * (kt0 + t - 1) + 4 * hi - qpos + TA_OFF;
            tile_qb<2, 4>(kf, qr, mq, ones, vp, o, m, l, wsf, r32, hi, [&](int hf, int r) { return bp[32 * hf + (r & 3) + 8 * (r >> 2)]; });
        } else { const int kr = kr0 + t - 1; const bool rowok = kr >= rs && kr <= rs + 7; const volatile LAS float* bp = tabB + (rowok ? kr - qrow + 7 : 15) * 31 + dc0;
            tile_qb<1, 2>(kf, qr, mq, ones, vp, o, m, l, wsf, r32, hi, [&](int, int r) { return bp[(r & 3) + 8 * (r >> 2)] + cm[r]; });
        }
    }
    if (MODE == 0) { if (hi == 0) l += __builtin_amdgcn_exp2f(F.sink[hidx] * LOG2E - m); }
    if (MODE == 0) finish_qb(F, o, l, wsf, stg, lane, r32, hi, ocol, hidx, [&](int q) { return qtok0 + q; });
    else finish_qb(F, o, l, wsf, stg, lane, r32, hi, ocol, hidx, [&](int q) { return qtok0 + (q >> 4) * 64 + (q & 15); });
    __builtin_amdgcn_s_barrier();
#undef ATT_TROW
#undef ATT_ISSUE
}
__device__ __forceinline__ void attn_phase(const Frame& F, int mask = 3) {
    __syncthreads();
    int L = F.bx, un = 0; const int slot = (mask & 8) ? ((F.bx >> 3) & 7) : 0;
    for (; L < 2048 && un < slot; L += F.G, ++un) { if (L < 1024) { if (mask & 1) attn_unit<0>(F, L); } else if (mask & 2) attn_unit<1>(F, L - 1024); }
    if (mask & 8) { __syncthreads(); const int n = (IT_P6 - IT_MID + F.G - 1) / F.G, a = IT_MID + F.bx * n, e = a + n < IT_P6 ? a + n : IT_P6; if (a < e) conv_range(F, a, e); __syncthreads(); }
    for (; L < 2048; L += F.G) { if (L < 1024) { if (mask & 1) attn_unit<0>(F, L); } else if (mask & 2) attn_unit<1>(F, L - 1024); }
    __syncthreads();
}
}

#ifndef FAST_P5
#define FAST_P5 1
#endif
__device__ __forceinline__ void route_token(const Frame& F, int tok, float lg, int lane) {
    const float score = 1.0f / (1.0f + expf(-lg)), v0 = score + F.rbias[lane];
    int rk = 0;
#pragma unroll
    for (int j = 0; j < 8; ++j) { const int o = (lane & ~7) + j; const float w = __shfl(v0, o); rk += (w > v0 || (w == v0 && o < lane)) ? 1 : 0; }
    float gs = rk < 2 ? v0 : 0.f; gs += __shfl_xor(gs, 1); gs += __shfl_xor(gs, 2); gs += __shfl_xor(gs, 4);
    int grk = 0; const int myg = lane >> 3;
#pragma unroll
    for (int g = 0; g < 8; ++g) { const float w = __shfl(gs, g * 8); grk += (w > gs || (w == gs && g < myg)) ? 1 : 0; }
    const float mv = grk < 4 ? v0 : -INFINITY;
    int erk = 0;
    for (int o = 0; o < 64; ++o) { const float w = __shfl(mv, o); erk += (w > mv || (w == mv && o < lane)) ? 1 : 0; }
    const bool sel = erk < 8;
    const float wsm = wsum(sel ? score : 0.f), wgt = score / (wsm + 1e-20f) * 2.5f;
    if (sel) { const int rr = atomicAdd(F.cnt() + lane, 1); F.tokl()[(size_t)lane * NTOK + rr] = tok; F.wl()[(size_t)lane * NTOK + rr] = wgt; F.tke()[tok * 8 + erk] = lane; F.tkr()[tok * 8 + erk] = rr; }
}
__device__ __forceinline__ void route_token_local(const Frame& F, int tl  , float lg, int lane, LAS int* lcnt, LAS int* sel_e, LAS int* sel_lr, LAS float* sel_w) {
    lg = (lg == lg) ? lg : 0.f;
    const float score = 1.0f / (1.0f + expf(-lg)), v0 = score + F.rbias[lane];
    int rk = 0;
#pragma unroll
    for (int j = 0; j < 8; ++j) { const int o = (lane & ~7) + j; const float w = __shfl(v0, o); rk += (w > v0 || (w == v0 && o < lane)) ? 1 : 0; }
    float gs = rk < 2 ? v0 : 0.f; gs += __shfl_xor(gs, 1); gs += __shfl_xor(gs, 2); gs += __shfl_xor(gs, 4);
    int grk = 0; const int myg = lane >> 3;
#pragma unroll
    for (int g = 0; g < 8; ++g) { const float w = __shfl(gs, g * 8); grk += (w > gs || (w == gs && g < myg)) ? 1 : 0; }
    const float mv = grk < 4 ? v0 : -INFINITY;
    int erk = 0;
#pragma unroll 16
    for (int o = 0; o < 64; ++o) { const float w = __shfl(mv, o); erk += (w > mv || (w == mv && o < lane)) ? 1 : 0; }
    const bool sel = erk < 8;
    const float wsm = wsum(sel ? score : 0.f), wgt = score / (wsm + 1e-20f) * 2.5f;
    if (sel) { const int lr = __hip_atomic_fetch_add(lcnt + lane, 1, __ATOMIC_RELAXED, __HIP_MEMORY_SCOPE_WORKGROUP); sel_e[tl * 8 + erk] = lane; sel_lr[tl * 8 + erk] = lr; sel_w[tl * 8 + erk] = wgt; }
}
__device__ __forceinline__ void phase_ln1_router_fast(Frame& F) {
    constexpr int HSTR = 4112;
    LAS unsigned char* hb = F.lds; LAS float* part = (LAS float*)F.lds;
    LAS int* lcnt = (LAS int*)(F.lds + 132096); LAS int* lbase = lcnt + 64; LAS int* sel_e = lcnt + 128; LAS int* sel_lr = sel_e + 512; LAS float* sel_w = (LAS float*)(sel_lr + 512);
    const int lane = F.lane, w = F.wave, r32 = lane & 31, hi = lane >> 5;
    for (int it2 = F.bx; it2 < NTOK / 64; it2 += F.G) {
        if (F.tid < 64) lcnt[F.tid] = 0;
        for (int sub = 0; sub < 2; ++sub) {
            const int t0 = it2 * 64 + sub * 32;
            u32x4 raw[4][4];
#pragma unroll
            for (int q = 0; q < 4; ++q) { const bf16_t* src = F.z() + (size_t)(t0 + 4 * w + q) * D;
#pragma unroll
                for (int j = 0; j < 4; ++j) raw[q][j] = *(const u32x4*)(src + (lane + 64 * j) * 8); }
#pragma unroll
            for (int q = 0; q < 4; ++q) { const int row = 4 * w + q, tok = t0 + row; float v[4][8]; float s = 0.f;
#pragma unroll
                for (int j = 0; j < 4; ++j)
#pragma unroll
                    for (int i = 0; i < 4; ++i) { v[j][2 * i] = __uint_as_float(raw[q][j][i] << 16); v[j][2 * i + 1] = __uint_as_float(raw[q][j][i] & 0xffff0000u); s += v[j][2 * i] + v[j][2 * i + 1]; }
                const float mu = wsum(s) * (1.0f / D); float qq = 0.f;
#pragma unroll
                for (int j = 0; j < 4; ++j)
#pragma unroll
                    for (int i = 0; i < 8; ++i) { const float d = v[j][i] - mu; qq += d * d; }
                const float rstd = 1.0f / sqrtf(wsum(qq) * (1.0f / D) + LN_EPS);
#pragma unroll
                for (int j = 0; j < 4; ++j) { const int c = (lane + 64 * j) * 8; const f32x4 g0 = *(const f32x4*)(F.l1g + c), g1 = *(const f32x4*)(F.l1g + c + 4), b0 = *(const f32x4*)(F.l1b + c), b1 = *(const f32x4*)(F.l1b + c + 4);
                    u32x4 pk; float y[8];
#pragma unroll
                    for (int i = 0; i < 4; ++i) { y[i] = (v[j][i] - mu) * rstd * g0[i] + b0[i]; y[4 + i] = (v[j][4 + i] - mu) * rstd * g1[i] + b1[i]; }
                    pk.x = pack2(y[0], y[1]); pk.y = pack2(y[2], y[3]); pk.z = pack2(y[4], y[5]); pk.w = pack2(y[6], y[7]);
                    *(u32x4*)(F.h1() + (size_t)tok * D + c) = pk; *(LAS u32x4*)(hb + row * HSTR + c * 2) = pk;
                    *(u32x2*)(F.h1q() + (size_t)tok * D + c) = (u32x2){e4m3x4(y[0] * S8_H1, y[1] * S8_H1, y[2] * S8_H1, y[3] * S8_H1), e4m3x4(y[4] * S8_H1, y[5] * S8_H1, y[6] * S8_H1, y[7] * S8_H1)}; }
                if (lane == 0) { F.stats1()[tok * 2] = mu; F.stats1()[tok * 2 + 1] = rstd; } }
            __syncthreads();
            att::f32x16 acc[2]; acc[0] = att::f32x16{}; acc[1] = att::f32x16{};
            const bf16_t* wb = F.wrt() + (size_t)r32 * D + 256 * w + hi * 8;
#pragma unroll 8
            for (int s = 0; s < 16; ++s) {
                const att::bf16x8 a = *(const LAS att::bf16x8*)(hb + r32 * HSTR + (256 * w + 16 * s + 8 * hi) * 2);
                const att::bf16x8 b0 = *(const att::bf16x8*)(wb + 16 * s), b1 = *(const att::bf16x8*)(wb + (size_t)32 * D + 16 * s);
                acc[0] = __builtin_amdgcn_mfma_f32_32x32x16_bf16(a, b0, acc[0], 0, 0, 0); acc[1] = __builtin_amdgcn_mfma_f32_32x32x16_bf16(a, b1, acc[1], 0, 0, 0); }
            __syncthreads();
#pragma unroll
            for (int nt = 0; nt < 2; ++nt)
#pragma unroll
                for (int r = 0; r < 16; ++r) part[(w * 32 + att::crow(r, hi)) * 64 + 32 * nt + r32] = acc[nt][r];
            __syncthreads();
            for (int q = 0; q < 4; ++q) { const int row = 4 * w + q; float lg = 0.f;
#pragma unroll
                for (int ww = 0; ww < 8; ++ww) lg += part[(ww * 32 + row) * 64 + lane];
                route_token_local(F, sub * 32 + row, lg, lane, lcnt, sel_e, sel_lr, sel_w); }
            __syncthreads();
        }
        if (F.tid < 64) { const int n = lcnt[F.tid]; lbase[F.tid] = n > 0 ? atomicAdd(F.cnt() + F.tid, n) : 0; }
        __syncthreads();
        { const int tl = F.tid >> 3, slot = F.tid & 7, e = sel_e[F.tid], rr = lbase[e] + sel_lr[F.tid], tok = it2 * 64 + tl;
          F.tokl()[(size_t)e * NTOK + rr] = tok; F.wl()[(size_t)e * NTOK + rr] = sel_w[F.tid]; F.tke()[tok * 8 + slot] = e; F.tkr()[tok * 8 + slot] = rr; }
        __syncthreads();
    }
}

__global__ void __launch_bounds__(512, 2) mk_fwd(Args args) {
    extern __shared__ __attribute__((aligned(16))) unsigned char lds_raw[];
    Frame F; F.lds = (LAS unsigned char*)lds_raw; F.wave0 = __builtin_amdgcn_readfirstlane((int)threadIdx.x >> 6); F.fresh(); F.G = gridDim.x; F.bx = blockIdx.x;
    F.x = args.in[0]; F.meta = args.in[1]; F.lng = args.in[2]; F.lnb = args.in[3]; F.t5 = args.in[4]; F.w_in = args.in[5]; F.sink = args.in[6]; F.rpb = args.in[7]; F.ga = args.in[8]; F.gb = args.in[9];
    F.w_out = args.in[10]; F.l1g = args.in[11]; F.l1b = args.in[12]; F.w_router = args.in[13]; F.rbias = args.in[14]; F.w_gate = args.in[15]; F.w_up = args.in[16]; F.w_down = args.in[17];
    F.ws_gate = args.in[18]; F.ws_up = args.in[19]; F.ws_down = args.in[20]; F.l2g = args.in[21]; F.l2b = args.in[22]; F.out = args.out; F.ws = args.ws;
    unsigned char* ws = args.ws;
    volatile LAS unsigned* xbw = (volatile LAS unsigned*)(F.lds + LDS_BYTES - 16);
    LAS int* ps = (LAS int*)(F.lds + 131072);
    if (F.tid < 4) xbw[F.tid] = 0u;
    __syncthreads();
    const int lo = args.ph_lo, hi = args.ph_hi;
    XcdBarrier bar; bar.bar = (unsigned*)(ws + WS_CTL); bar.x = 0; bar.st = xbw; bar.wave0 = F.wave0;
    if (hi - lo > 1) bar = xcd_barrier_post((unsigned*)(ws + WS_CTL), xbw, F.wave0);
    unsigned* xcen = (unsigned*)(ws + WS_CTL + 20480);
    if (XCD_TRUE && hi - lo > 1 && F.tid == 0) { const unsigned x = xb_xcc_id(); xbw[2] = x; xbw[3] = xb_add(&xcen[x * 16], 1u); }
#ifndef PROBE_REPEAT
#define PROBE_REPEAT -1
#endif
#ifndef PROBE_SUB
#define PROBE_SUB 3
#endif
#ifndef PROBE_NOSTORE
#define PROBE_NOSTORE 0
#endif
#ifndef PROBE_HOT
#define PROBE_HOT 0
#endif
#ifndef PROBE_NT
#define PROBE_NT 32
#ifndef PROBE_LD
#define PROBE_LD 2048
#endif
#endif
#define IN(k) (lo <= (k) && (k) < hi)
#define SEAM(k) do { if (IN(k) && IN((k) + 1)) xcd_barrier(bar); } while (0)
    if (IN(0)) { F.fresh(); phase_prologue(F);
#if PROBE_REPEAT == 0
        xcd_barrier(bar); phase_prologue(F);
#endif
    } SEAM(0);
#define P1_BODY(rep) do { const int s_ = (rep) ? 0 : F.bx % 5; EpiU E{F.u(), rep}; { SchedInProj S{(const char*)F.h0(), (const char*)F.wtin(), F.G, F.bx, 0, s_}; pg8::gemm_phase(F.wave0, F.lds, S, E, D, D, D / 64); } if (!(rep)) { conv_inproj_share(F); __syncthreads(); } { SchedInProj S{(const char*)F.h0(), (const char*)F.wtin(), F.G, F.bx, s_, 1 << 20}; pg8::gemm_phase(F.wave0, F.lds, S, E, D, D, D / 64); } } while (0)
#define P4_BODY(rep) do { SchedOutProj S{(const char*)F.ya(), (const char*)F.wtout(), F.G, F.bx}; EpiZ E{F.z(), F.h0(), F.ssq(), (LAS float*)(F.lds + 131072 + 6144)}; pg8::gemm_phase(F.wave0, F.lds, S, E, D / 2, D / 2, D / 128, STAGGER4); } while (0)
#define P6_BODY(rep) do { moe_tables(F, ps); SchedGU S{(const char*)F.h1q(), (const char*)F.wtgu(), F.tokl(), F.cnt(), ps, F.G, F.bx, __builtin_amdgcn_readfirstlane(ps[128 + 65])}; EpiGU E{(unsigned char*)F.hb(), F.wl()}; pg8::gemm_phase(F.wave0, F.lds, S, E, D / 2, D / 2, D / 128); if (!(rep)) { F.fresh(); conv_tail(F, IT_P6, IT_ALL, (ps[128 + 65] * 4) % F.G); } } while (0)
#define P7_BODY(rep) do { moe_tables(F, ps); SchedDown S{(const char*)F.hb(), (const char*)F.wtd(), F.cnt(), ps, F.G, F.bx, __builtin_amdgcn_readfirstlane(ps[128 + 64])}; EpiDownR E{(unsigned char*)F.ym(), rep}; pg8::gemm_phase(F.wave0, F.lds, S, E, DE / 2, DE / 2, DE / 128, STAGGER7); SchedDownShared S2{(const char*)F.hb(), (const char*)F.wtd(), F.G, F.bx}; EpiDownS E2{F.o2(), F.h1()}; pg8::gemm_phase(F.wave0, F.lds, S2, E2, DE / 2, DE / 2, DE / 128); } while (0)
    if (XCD_TRUE && hi - lo > 1 && IN(0)) {
        if (F.tid == 0) { unsigned idx = 0, ok = 1, npop = 0; const unsigned x = xbw[2];
            for (unsigned j = 0; j < 16; ++j) { const unsigned cj = xb_ld(&xcen[j * 16]); if (cj) { ++npop; if (cj * 8u != (unsigned)F.G) ok = 0; if (j < x) ++idx; } }
            xbw[2] = (ok && npop == 8) ? xbw[3] * 8u + idx : (unsigned)blockIdx.x; }
        __syncthreads();
        F.bx = __builtin_amdgcn_readfirstlane((int)xbw[2]);
    }
    if (IN(1)) { F.fresh();
#if FAST_P1
        P1_BODY(0);
#if PROBE_REPEAT == 1
        xcd_barrier(bar); P1_BODY(PROBE_NOSTORE);
#endif
#else
        FnInProj f{F}; sgemm(f, F.lds, F.tid, F.bx, F.G);
#endif
#if PROBE_REPEAT == 9
        xcd_barrier(bar); if (F.bx % 8 == 0) { conv_range(F, IT_P0 + T_OUT, IT_P0 + T_OUT + 512); __syncthreads(); }
#endif
    } SEAM(1);
    if (IN(2)) { F.fresh();
#if FAST_P2
        att::attn_phase(F, 3 | 8);
#if PROBE_REPEAT == 2
        xcd_barrier(bar); att::attn_phase(F, PROBE_SUB);
#endif
#else
        phase_attn_simple(F);
#endif
    } SEAM(2);
#if !FAST_P4
    if (IN(3)) { phase_rmsnorm(F); } SEAM(3);
#endif
    if (IN(4)) { F.fresh();
#if FAST_P4
        P4_BODY(0);
#if PROBE_REPEAT == 4
        xcd_barrier(bar); P4_BODY(1);
#endif
#else
        FnOutProj f{F}; sgemm(f, F.lds, F.tid, F.bx, F.G);
#endif
    } SEAM(4);
#if FAST_P5
#define PH5(F) phase_ln1_router_fast(F)
#else
#define PH5(F) phase_ln1_router(F)
#endif
    if (IN(5)) { F.fresh(); PH5(F);
#if PROBE_REPEAT == 5
        xcd_barrier(bar); if (F.bx == 0 && F.tid < 64) F.cnt()[F.tid] = 0; xcd_barrier(bar); PH5(F);
#endif
    } SEAM(5);
    if (IN(6)) { F.fresh();
#if FAST_P6
        P6_BODY(0);
#if PROBE_REPEAT == 6
        xcd_barrier(bar); P6_BODY(1);
#endif
#else
        expert_starts(F, ps); FnGateUp f{F, ps}; sgemm(f, F.lds, F.tid, F.bx, F.G);
#endif
    } SEAM(6);
    if (IN(7)) { F.fresh();
#if FAST_P7
        P7_BODY(0);
#if PROBE_REPEAT == 7
        xcd_barrier(bar); P7_BODY(PROBE_NOSTORE);
#endif
#else
        expert_starts(F, ps); { FnDown f{F, ps}; sgemm(f, F.lds, F.tid, F.bx, F.G); } { FnFinal f{F, ps}; sgemm(f, F.lds, F.tid, F.bx, F.G); }
#endif
    } SEAM(7);
    if (IN(8)) { F.fresh(); expert_starts(F, ps); phase_ln2(F, ps);
#if PROBE_REPEAT == 8
        xcd_barrier(bar); phase_ln2(F, ps);
#endif
    }
#undef IN
#undef SEAM
}

extern "C" void kernel_launch(void* const* d_in, const int* in_sizes, int n_in, void* d_out, int out_size, void* d_ws, size_t ws_size, hipStream_t stream) {
    static int grid = 0;
    if (grid == 0) {
        if (n_in != 23 || in_sizes[0] != NTOK * D || out_size != NTOK * D || ws_size < WS_END) {
            fprintf(stderr, "kernel_launch: built for 23 inputs, x/out of %d floats, >= %zu bytes of workspace; got n_in %d in0 %d out %d ws %zu; nothing launched\n", NTOK * D, (size_t)WS_END, n_in, n_in > 0 ? in_sizes[0] : -1, out_size, ws_size);
            grid = -1; return; }
        int dev = 0, cus = 0, per_cu = 0;
        if (hipGetDevice(&dev) != hipSuccess || hipDeviceGetAttribute(&cus, hipDeviceAttributeMultiprocessorCount, dev) != hipSuccess) { fprintf(stderr, "kernel_launch: device query failed\n"); grid = -1; return; }
        if (hipFuncSetAttribute((const void*)mk_fwd, hipFuncAttributeMaxDynamicSharedMemorySize, LDS_BYTES) != hipSuccess) { fprintf(stderr, "kernel_launch: hipFuncSetAttribute failed\n"); grid = -1; return; }
        if (hipOccupancyMaxActiveBlocksPerMultiprocessor(&per_cu, (const void*)mk_fwd, 512, LDS_BYTES) != hipSuccess || per_cu < 1) fprintf(stderr, "kernel_launch: note: occupancy query reports %d\n", per_cu);
        (void)hipGetLastError();
        grid = cus;
    }
    if (grid < 0) return;
    if (hipMemsetAsync((char*)d_ws + WS_CTL, 0, CTL_BYTES, stream) != hipSuccess) { fprintf(stderr, "kernel_launch: memset failed\n"); return; }
    Args a{};
    for (int i = 0; i < 23; ++i) a.in[i] = (const float*)d_in[i];
    a.out = (float*)d_out; a.ws = (unsigned char*)d_ws;
#if MK_ONE_LAUNCH
    a.ph_lo = 0; a.ph_hi = NPHASE;
    hipLaunchKernelGGL(mk_fwd, dim3(grid), dim3(512), LDS_BYTES, stream, a);
#else
    for (int p = 0; p < NPHASE; ++p) { a.ph_lo = p; a.ph_hi = p + 1; hipLaunchKernelGGL(mk_fwd, dim3(grid), dim3(512), LDS_BYTES, stream, a); }
#endif
    const hipError_t le = hipPeekAtLastError();
    if (le != hipSuccess) fprintf(stderr, "kernel_launch: launch failed: %s\n", hipGetErrorName(le));
}
```
